# Optimizing an MI355X kernel written in HIP

```python
import math
import jax
import jax.numpy as jnp
from jax import lax
import numpy as np

D_MODEL = 1024
BATCH = 16
SEQ = 256
DEPTH = 4
DEC_BATCH = 4
DEC_SEQ = 1024
PAST_LEN = 256

GRID_W = 64
GROUP_W = 512
D_MIX = 3 * GROUP_W
MLA_HEADS = 4
MLA_NOPE = 128
MLA_ROPE = 64
MLA_V = 128
MLA_Q_RANK = 384
MLA_KV_RANK = 256
DIFF_HEADS = 4
DIFF_D = 64
ML_HEADS = 4
ML_DK = 128
ML_DV = 128
ML_CHUNK = 64
CONV_K = 3
FORGET_BIAS = 3.0
ROPE_THETA = 10000.0
NORM_EPS = 1e-6
ATTN_BLOCK = 128
N_ML_GATES = 2 * 2 * ML_HEADS
IN_SIZES = (MLA_Q_RANK, MLA_KV_RANK, MLA_ROPE, GROUP_W,
            GROUP_W, GROUP_W, GROUP_W, GROUP_W,
            GROUP_W, GROUP_W, GROUP_W, GROUP_W, GROUP_W,
            N_ML_GATES)
N_IN = int(sum(IN_SIZES))
IN_SPLITS = tuple(int(s) for s in np.cumsum(IN_SIZES)[:-1])
MLA_SCALE = (MLA_NOPE + MLA_ROPE) ** -0.5
DIFF_SCALE = DIFF_D ** -0.5

kernel_name = 'hybrid_mla_diff_mlstm_dit_step'


def rmsnorm(x, g):
    xf = x.astype(jnp.float32)
    y = xf * lax.rsqrt(jnp.mean(xf * xf, axis=-1, keepdims=True) + NORM_EPS)
    return y.astype(x.dtype) * g.astype(x.dtype)


def axial_rope_tables(n_rows, rot_dim):
    n_freq = rot_dim // 4
    inv = ROPE_THETA ** (-jnp.arange(n_freq, dtype=jnp.float32) / n_freq)
    row = jnp.repeat(jnp.arange(n_rows, dtype=jnp.float32), GRID_W)
    col = jnp.tile(jnp.arange(GRID_W, dtype=jnp.float32), n_rows)
    ang = jnp.concatenate([row[:, None] * inv, col[:, None] * inv], axis=-1)
    return jnp.cos(ang), jnp.sin(ang)


def apply_rope(x, cos, sin):
    half = x.shape[-1] // 2
    c = cos[:, None, :].astype(x.dtype)
    s = sin[:, None, :].astype(x.dtype)
    x1, x2 = x[..., :half], x[..., half:]
    return jnp.concatenate([x1 * c - x2 * s, x1 * s + x2 * c], axis=-1)


def rope_sub(x, cos, sin):
    B, T, H, E = x.shape
    return apply_rope(x.reshape(B, T, 2 * H, DIFF_D), cos, sin).reshape(B, T, H, E)


def attention(q, k, v, scale):
    B, Tq, H, dq = q.shape
    nb = Tq // ATTN_BLOCK
    qb = jnp.moveaxis(q.reshape(B, nb, ATTN_BLOCK, H, dq), 1, 0)

    def one_block(q_blk):
        s = jnp.einsum('bqhd,bkhd->bhqk', q_blk, k).astype(jnp.float32) * scale
        p = jax.nn.softmax(s, axis=-1).astype(v.dtype)
        return jnp.einsum('bhqk,bkhd->bqhd', p, v)

    o = lax.map(one_block, qb)
    return jnp.moveaxis(o, 0, 1).reshape(B, Tq, H, v.shape[-1])


def short_conv(u, w):
    ch = u.shape[-1]
    return lax.conv_general_dilated(
        u, w[:, None, :].astype(u.dtype), window_strides=(1,),
        padding=[(CONV_K // 2, CONV_K // 2)],
        dimension_numbers=('NWC', 'WIO', 'NWC'), feature_group_count=ch)


def mlstm_scan(q, k, v, ig, lf, C0, n0, m0):
    B, H, T, DK = q.shape
    nc = T // ML_CHUNK

    def to_chunks(a):
        return jnp.moveaxis(a.reshape(B, H, nc, ML_CHUNK, *a.shape[3:]), 2, 0)

    bcum = jnp.cumsum(lf.reshape(B, H, nc, ML_CHUNK), axis=-1)
    xs = (to_chunks(q), to_chunks(k), to_chunks(v), to_chunks(ig), jnp.moveaxis(bcum, 2, 0))
    mask = jnp.tril(jnp.ones((ML_CHUNK, ML_CHUNK), dtype=bool))

    def step(carry, inp):
        C, n, m = carry
        qc, kc, vc, igc, bc = inp
        d = bc[..., :, None] - bc[..., None, :] + igc[..., None, :]
        d = jnp.where(mask, d, -jnp.inf)
        g = bc + m[..., None]
        m_t = jnp.maximum(g, jnp.max(d, axis=-1))
        w_intra = jnp.exp(d - m_t[..., None])
        w_inter = jnp.exp(g - m_t)
        sw = jnp.einsum('bhtd,bhsd->bhts', qc, kc) * w_intra
        num = jnp.einsum('bhts,bhsv->bhtv', sw, vc) + w_inter[..., None] * jnp.einsum('bhtd,bhdv->bhtv', qc, C)
        den = jnp.sum(sw, axis=-1) + w_inter * jnp.einsum('bhtd,bhd->bht', qc, n)
        h = num / jnp.maximum(jnp.abs(den), jnp.exp(-m_t))[..., None]
        b_last = bc[..., -1]
        m_new = m_t[..., -1]
        a_prev = jnp.exp(b_last + m - m_new)
        w_s = jnp.exp(b_last[..., None] - bc + igc - m_new[..., None])
        kw = kc * w_s[..., None]
        C_new = a_prev[..., None, None] * C + jnp.einsum('bhsd,bhsv->bhdv', kw, vc)
        n_new = a_prev[..., None] * n + jnp.sum(kw, axis=2)
        return (C_new, n_new, m_new), h

    (C, n, m), h = lax.scan(step, (C0, n0, m0), xs)
    h = jnp.moveaxis(h, 0, 2).reshape(B, H, T, v.shape[-1])
    return h, C, n, m


def mla_expand(ckv_n, krope, w_ukv):
    B, T, _ = ckv_n.shape
    kv = (ckv_n @ w_ukv).reshape(B, T, MLA_HEADS, MLA_NOPE + MLA_V)
    k_rope = jnp.broadcast_to(krope[:, :, None, :].astype(kv.dtype), (B, T, MLA_HEADS, MLA_ROPE))
    return jnp.concatenate([kv[..., :MLA_NOPE], k_rope], axis=-1), kv[..., MLA_NOPE:]


def mixer_layer(x, mod, l, W, rope, ctx):
    B, T, _ = x.shape
    shift, scale, gate = jnp.split(mod, 3, axis=-1)
    h = rmsnorm(x, W['g_norm'][l]) * (1 + scale) + shift
    proj = h @ W['W_in'][l]
    (cq, ckv, krope, z_a, dq, dk, dv, z_b, mq, mk, mv, mo, z_c, mg) = jnp.split(proj, IN_SPLITS, axis=-1)

    q_a = (rmsnorm(cq, W['mla_q_norm'][l]) @ W['W_uq'][l]).reshape(B, T, MLA_HEADS, MLA_NOPE + MLA_ROPE)
    ckv_n = rmsnorm(ckv, W['mla_kv_norm'][l])
    if rope is not None:
        cos_a, sin_a = rope[0]
        q_a = jnp.concatenate([q_a[..., :MLA_NOPE], apply_rope(q_a[..., MLA_NOPE:], cos_a, sin_a)], axis=-1)
        krope_use = apply_rope(krope[:, :, None, :], cos_a, sin_a)[:, :, 0, :]
    else:
        krope_use = krope
    k_a, v_a = mla_expand(ckv_n, krope_use, W['W_ukv'][l])
    if ctx is not None:
        k_c, v_c = mla_expand(ctx['ckv'], ctx['krope'], W['W_ukv'][l])
        k_a = jnp.concatenate([k_a, k_c.astype(k_a.dtype)], axis=1)
        v_a = jnp.concatenate([v_a, v_c.astype(v_a.dtype)], axis=1)
    o_a = attention(q_a, k_a, v_a, MLA_SCALE)

    q_b = dq.reshape(B, T, DIFF_HEADS, 2 * DIFF_D)
    k_b = dk.reshape(B, T, DIFF_HEADS, 2 * DIFF_D)
    v_b = dv.reshape(B, T, DIFF_HEADS, 2 * DIFF_D)
    if rope is not None:
        cos_b, sin_b = rope[1]
        q_b = rope_sub(q_b, cos_b, sin_b)
        keys_b = rope_sub(k_b, cos_b, sin_b)
    else:
        keys_b = k_b
    vals_b = v_b
    if ctx is not None:
        keys_b = jnp.concatenate([keys_b, ctx['dk'].astype(keys_b.dtype)], axis=1)
        vals_b = jnp.concatenate([vals_b, ctx['dv'].astype(vals_b.dtype)], axis=1)
    lam_init = 0.8 - 0.6 * math.exp(-0.3 * l)
    lp = W['diff_lambda'][l].astype(jnp.float32)
    lam = jnp.exp(jnp.sum(lp[0] * lp[1])) - jnp.exp(jnp.sum(lp[2] * lp[3])) + lam_init
    o1 = attention(q_b[..., :DIFF_D], keys_b[..., :DIFF_D], vals_b, DIFF_SCALE)
    o2 = attention(q_b[..., DIFF_D:], keys_b[..., DIFF_D:], vals_b, DIFF_SCALE)
    o_b = rmsnorm(o1 - lam.astype(o1.dtype) * o2, W['diff_norm'][l]) * (1.0 - lam_init)

    qk = jax.nn.silu(short_conv(jnp.concatenate([mq, mk], axis=-1), W['ml_conv'][l]))
    mq_c, mk_c = qk[..., :GROUP_W], qk[..., GROUP_W:]
    f32 = jnp.float32
    qh = (mq_c * (ML_DK ** -0.5)).reshape(B, T, ML_HEADS, ML_DK).transpose(0, 2, 1, 3).astype(f32)
    kh = mk_c.reshape(B, T, ML_HEADS, ML_DK).transpose(0, 2, 1, 3).astype(f32)
    vh = mv.reshape(B, T, ML_HEADS, ML_DV).transpose(0, 2, 1, 3).astype(f32)
    gts = (mg + W['ml_gate_b'][l].reshape(N_ML_GATES).astype(mg.dtype)).astype(f32)
    gts = jnp.moveaxis(gts.reshape(B, T, 2, 2, ML_HEADS), 1, -1)
    ig_f, lf_f = gts[:, 0, 0], jax.nn.log_sigmoid(gts[:, 0, 1])
    ig_b, lf_b = gts[:, 1, 0], jax.nn.log_sigmoid(gts[:, 1, 1])
    if ctx is None:
        zC = jnp.zeros((B, ML_HEADS, ML_DK, ML_DV), f32)
        zn = jnp.zeros((B, ML_HEADS, ML_DK), f32)
        zm = jnp.zeros((B, ML_HEADS), f32)
        init_f, init_b = (zC, zn, zm), (zC, zn, zm)
    else:
        Cc, nc_, mc = ctx['C'].astype(f32), ctx['n'].astype(f32), ctx['m'].astype(f32)
        init_f = (Cc[:, 0], nc_[:, 0], mc[:, 0])
        init_b = (Cc[:, 1], nc_[:, 1], mc[:, 1])
    h_f, C_f, n_f, m_f = mlstm_scan(qh, kh, vh, ig_f, lf_f, *init_f)
    flip = lambda a: jnp.flip(a, axis=2)
    h_b, C_b, n_b, m_b = mlstm_scan(flip(qh), flip(kh), flip(vh), flip(ig_b), flip(lf_b), *init_b)
    h_c = (h_f + flip(h_b)).transpose(0, 2, 1, 3).astype(x.dtype)
    h_c = jax.nn.sigmoid(mo).reshape(B, T, ML_HEADS, ML_DV) * h_c
    o_c = rmsnorm(h_c, W['ml_norm'][l])

    y = jnp.concatenate([o_a.reshape(B, T, GROUP_W) * jax.nn.silu(z_a),
                         o_b.reshape(B, T, GROUP_W) * jax.nn.silu(z_b),
                         o_c.reshape(B, T, GROUP_W) * jax.nn.silu(z_c)], axis=-1) @ W['W_out'][l]
    x_new = x + gate * y
    side = (ckv_n, krope, k_b, v_b,
            jnp.stack([C_f, C_b], axis=1), jnp.stack([n_f, n_b], axis=1), jnp.stack([m_f, m_b], axis=1))
    return x_new, side


def setup_inputs(seed: int = 0) -> dict:
    key = jax.random.key(seed)
    ks = jax.random.split(key, 32)
    nrm = lambda k, shape, s: jax.random.normal(k, shape, jnp.float32) * s
    gain = lambda k, shape: 1.0 + 0.02 * jax.random.normal(k, shape, jnp.float32)
    gate_b = nrm(ks[21], (DEPTH, 2, 2, ML_HEADS), 0.1) + jnp.array([0.0, FORGET_BIAS], jnp.float32)[None, None, :, None]
    return {
        'x_prompt': nrm(ks[0], (BATCH, SEQ, D_MODEL), 1.0),
        'x_sample': nrm(ks[1], (DEC_BATCH, DEC_SEQ, D_MODEL), 1.0),
        'cache_mla_ckv': nrm(ks[2], (DEC_BATCH, DEPTH, PAST_LEN, MLA_KV_RANK), 1.0),
        'cache_mla_krope': nrm(ks[3], (DEC_BATCH, DEPTH, PAST_LEN, MLA_ROPE), 1.0),
        'cache_diff_k': nrm(ks[4], (DEC_BATCH, DEPTH, PAST_LEN, DIFF_HEADS, 2 * DIFF_D), 1.0),
        'cache_diff_v': nrm(ks[5], (DEC_BATCH, DEPTH, PAST_LEN, DIFF_HEADS, 2 * DIFF_D), 1.0),
        'state_mlstm_C': nrm(ks[6], (DEC_BATCH, DEPTH, 2, ML_HEADS, ML_DK, ML_DV), 1.0),
        'state_mlstm_n': nrm(ks[7], (DEC_BATCH, DEPTH, 2, ML_HEADS, ML_DK), 1.0),
        'state_mlstm_m': nrm(ks[8], (DEC_BATCH, DEPTH, 2, ML_HEADS), 1.0),
        'c': nrm(ks[9], (DEC_BATCH, D_MODEL), 1.0),
        'c_ctx': nrm(ks[10], (D_MODEL,), 1.0),
        'g_norm': gain(ks[11], (DEPTH, D_MODEL)),
        'W_mod': nrm(ks[12], (DEPTH, D_MODEL, 3 * D_MODEL), 0.5 * D_MODEL ** -0.5),
        'b_mod': nrm(ks[13], (DEPTH, 3 * D_MODEL), 0.02),
        'W_in': nrm(ks[14], (DEPTH, D_MODEL, N_IN), D_MODEL ** -0.5),
        'mla_q_norm': gain(ks[15], (DEPTH, MLA_Q_RANK)),
        'W_uq': nrm(ks[16], (DEPTH, MLA_Q_RANK, MLA_HEADS * (MLA_NOPE + MLA_ROPE)), MLA_Q_RANK ** -0.5),
        'mla_kv_norm': gain(ks[17], (DEPTH, MLA_KV_RANK)),
        'W_ukv': nrm(ks[18], (DEPTH, MLA_KV_RANK, MLA_HEADS * (MLA_NOPE + MLA_V)), MLA_KV_RANK ** -0.5),
        'diff_lambda': nrm(ks[19], (DEPTH, 4, DIFF_D), 0.1),
        'diff_norm': gain(ks[20], (DEPTH, 2 * DIFF_D)),
        'ml_conv': nrm(ks[22], (DEPTH, CONV_K, 2 * GROUP_W), CONV_K ** -0.5),
        'ml_gate_b': gate_b,
        'ml_norm': gain(ks[23], (DEPTH, ML_HEADS, ML_DV)),
        'W_out': nrm(ks[24], (DEPTH, D_MIX, D_MODEL), D_MIX ** -0.5),
        'g_final': gain(ks[25], (D_MODEL,)),
    }


def reference(x_prompt, x_sample, cache_mla_ckv, cache_mla_krope, cache_diff_k, cache_diff_v,
              state_mlstm_C, state_mlstm_n, state_mlstm_m, c, c_ctx, g_norm, W_mod, b_mod, W_in,
              mla_q_norm, W_uq, mla_kv_norm, W_ukv, diff_lambda, diff_norm, ml_conv, ml_gate_b,
              ml_norm, W_out, g_final):
    W = {'g_norm': g_norm, 'W_in': W_in, 'mla_q_norm': mla_q_norm, 'W_uq': W_uq,
         'mla_kv_norm': mla_kv_norm, 'W_ukv': W_ukv, 'diff_lambda': diff_lambda, 'diff_norm': diff_norm,
         'ml_conv': ml_conv, 'ml_gate_b': ml_gate_b, 'ml_norm': ml_norm, 'W_out': W_out}

    x = x_prompt
    sides = []
    for l in range(DEPTH):
        mod = (jax.nn.silu(c_ctx) @ W_mod[l] + b_mod[l])[None, None, :]
        x, side = mixer_layer(x, mod, l, W, None, None)
        sides.append(side)
    y_prompt = rmsnorm(x, g_final)
    new_mla_ckv = jnp.stack([s[0] for s in sides], axis=1)
    new_mla_krope = jnp.stack([s[1] for s in sides], axis=1)
    new_diff_k = jnp.stack([s[2] for s in sides], axis=1)
    new_diff_v = jnp.stack([s[3] for s in sides], axis=1)
    new_mlstm_C = jnp.stack([s[4] for s in sides], axis=1)
    new_mlstm_n = jnp.stack([s[5] for s in sides], axis=1)
    new_mlstm_m = jnp.stack([s[6] for s in sides], axis=1)

    n_rows = x_sample.shape[1] // GRID_W
    rope = (axial_rope_tables(n_rows, MLA_ROPE), axial_rope_tables(n_rows, DIFF_D))
    x = x_sample
    for l in range(DEPTH):
        mod = (jax.nn.silu(c) @ W_mod[l] + b_mod[l])[:, None, :]
        ctx = {'ckv': cache_mla_ckv[:, l], 'krope': cache_mla_krope[:, l],
               'dk': cache_diff_k[:, l], 'dv': cache_diff_v[:, l],
               'C': state_mlstm_C[:, l], 'n': state_mlstm_n[:, l], 'm': state_mlstm_m[:, l]}
        x, _ = mixer_layer(x, mod, l, W, rope, ctx)
    y_sample = rmsnorm(x, g_final)

    return (y_prompt, y_sample, new_mla_ckv, new_mla_krope, new_diff_k, new_diff_v,
            new_mlstm_C, new_mlstm_n, new_mlstm_m)
```

```cpp
#include <hip/hip_runtime.h>
#include <hip/hip_cooperative_groups.h>
#include <cstdio>
namespace cg = cooperative_groups;

typedef unsigned short bf16;
typedef __attribute__((ext_vector_type(8))) short bf16x8;
typedef __attribute__((ext_vector_type(4))) short s16x4;
typedef __attribute__((ext_vector_type(16))) float f32x16;
typedef __attribute__((ext_vector_type(4))) float f32x4;
typedef __attribute__((ext_vector_type(4))) unsigned u32x4;
typedef __attribute__((ext_vector_type(2))) unsigned u32x2;

#define DI __device__ __forceinline__
#define MFMA(a, b, c) __builtin_amdgcn_mfma_f32_32x32x16_bf16((a), (b), (c), 0, 0, 0)

#ifndef COOP
#define COOP 1
#endif
#define PROBE_DUP 0

constexpr int NTOK = 8192;
constexpr int NPROJ = 5888;
constexpr int NPHASE = 26;
constexpr float EPS = 1e-6f;
constexpr int SMEM_BYTES = 56 * 1024;

constexpr size_t O_YP = 0, O_YS = 4194304, O_CKV = 8388608, O_KROPE = 12582912, O_DK = 13631488,
                 O_DV = 22020096, O_MC = 30408704, O_MN = 38797312, O_MM = 38862848;

constexpr size_t al256(size_t x) { return (x + 255) & ~(size_t)255; }
constexpr size_t OFF_WinT = 0;
constexpr size_t OFF_WuqT = OFF_WinT + al256((size_t)4 * NPROJ * 1024 * 2);
constexpr size_t OFF_WukvT = OFF_WuqT + al256((size_t)4 * 768 * 384 * 2);
constexpr size_t OFF_WukvTp = OFF_WukvT + al256((size_t)4 * 1024 * 256 * 2);
constexpr size_t OFF_WoutT = OFF_WukvTp + al256((size_t)4 * 1024 * 256 * 2);
constexpr size_t OFF_mod = OFF_WoutT + al256((size_t)4 * 1024 * 1536 * 2);
constexpr size_t OFF_ropec = OFF_mod + al256((size_t)4 * 5 * 3072 * 4);
constexpr size_t OFF_ropes = OFF_ropec + al256((size_t)1024 * 32 * 4);
constexpr size_t OFF_lam = OFF_ropes + al256((size_t)1024 * 32 * 4);
constexpr size_t OFF_hbuf = OFF_lam + al256((size_t)256);
constexpr size_t OFF_xbuf = OFF_hbuf + al256((size_t)NTOK * 1024 * 2);
constexpr size_t OFF_proj = OFF_xbuf + al256((size_t)NTOK * 1024 * 4);
constexpr size_t OFF_Qa = OFF_proj + al256((size_t)NTOK * NPROJ * 2);
constexpr size_t OFF_Ka = OFF_Qa + al256((size_t)NTOK * 768 * 2);
constexpr size_t OFF_VaT = OFF_Ka + al256((size_t)NTOK * 768 * 2);
constexpr size_t OFF_Kb = OFF_VaT + al256((size_t)NTOK * 512 * 2);
constexpr size_t OFF_VbT = OFF_Kb + al256((size_t)NTOK * 512 * 2);
constexpr size_t OFF_VmT = OFF_VbT + al256((size_t)NTOK * 512 * 2);
constexpr size_t OFF_ycat = OFF_VmT + al256((size_t)NTOK * 512 * 2);
constexpr size_t OFF_gates = OFF_ycat + al256((size_t)NTOK * 1536 * 2);
constexpr size_t OFF_Cst = OFF_gates + al256((size_t)NTOK * 16 * 4);
constexpr size_t OFF_nst = OFF_Cst + al256((size_t)1024 * 16384 * 2);
constexpr size_t OFF_mst = OFF_nst + al256((size_t)1024 * 128 * 4);
constexpr size_t OFF_cckv = OFF_mst + al256((size_t)1024 * 4);
constexpr size_t OFF_cKa = OFF_cckv + al256((size_t)4096 * 256 * 2);
constexpr size_t OFF_cVaT = OFF_cKa + al256((size_t)64 * 256 * 192 * 2);
constexpr size_t OFF_cKb = OFF_cVaT + al256((size_t)64 * 128 * 256 * 2);
constexpr size_t OFF_cVbT = OFF_cKb + al256((size_t)64 * 256 * 128 * 2);
constexpr size_t OFF_blA = OFF_cVbT + al256((size_t)64 * 128 * 256 * 2);
constexpr size_t OFF_mlA = OFF_blA + 4096;
constexpr size_t OFF_ctr = OFF_mlA + 4096;
constexpr size_t OFF_qc = OFF_ctr + 16384;
constexpr size_t WS_TOTAL = OFF_qc + 4096;
struct P {
  const float *x_prompt, *x_sample, *c_ckv, *c_krope, *c_dk, *c_dv, *st_C, *st_n, *st_m, *c, *c_ctx, *g_norm, *W_mod,
      *b_mod, *W_in, *q_norm, *W_uq, *kv_norm, *W_ukv, *dlam, *dnorm, *mconv, *mgb, *mnorm, *W_out, *g_final;
  float* out;
  char* ws;
  __device__ __forceinline__ bf16* WinT() const { return (bf16*)(ws + OFF_WinT); }
  __device__ __forceinline__ bf16* WuqT() const { return (bf16*)(ws + OFF_WuqT); }
  __device__ __forceinline__ bf16* WukvT() const { return (bf16*)(ws + OFF_WukvT); }
  __device__ __forceinline__ bf16* WukvTp() const { return (bf16*)(ws + OFF_WukvTp); }
  __device__ __forceinline__ bf16* WoutT() const { return (bf16*)(ws + OFF_WoutT); }
  __device__ __forceinline__ float* mod() const { return (float*)(ws + OFF_mod); }
  __device__ __forceinline__ float* ropec() const { return (float*)(ws + OFF_ropec); }
  __device__ __forceinline__ float* ropes() const { return (float*)(ws + OFF_ropes); }
  __device__ __forceinline__ float* lam() const { return (float*)(ws + OFF_lam); }
  __device__ __forceinline__ bf16* hbuf() const { return (bf16*)(ws + OFF_hbuf); }
  __device__ __forceinline__ float* xbuf() const { return (float*)(ws + OFF_xbuf); }
  __device__ __forceinline__ bf16* proj() const { return (bf16*)(ws + OFF_proj); }
  __device__ __forceinline__ bf16* Qa() const { return (bf16*)(ws + OFF_Qa); }
  __device__ __forceinline__ bf16* Ka() const { return (bf16*)(ws + OFF_Ka); }
  __device__ __forceinline__ bf16* VaT() const { return (bf16*)(ws + OFF_VaT); }
  __device__ __forceinline__ bf16* Kb() const { return (bf16*)(ws + OFF_Kb); }
  __device__ __forceinline__ bf16* VbT() const { return (bf16*)(ws + OFF_VbT); }
  __device__ __forceinline__ bf16* VmT() const { return (bf16*)(ws + OFF_VmT); }
  __device__ __forceinline__ bf16* ycat() const { return (bf16*)(ws + OFF_ycat); }
  __device__ __forceinline__ float* gates() const { return (float*)(ws + OFF_gates); }
  __device__ __forceinline__ bf16* Cst() const { return (bf16*)(ws + OFF_Cst); }
  __device__ __forceinline__ float* nst() const { return (float*)(ws + OFF_nst); }
  __device__ __forceinline__ float* mst() const { return (float*)(ws + OFF_mst); }
  __device__ __forceinline__ bf16* cckv() const { return (bf16*)(ws + OFF_cckv); }
  __device__ __forceinline__ bf16* cKa() const { return (bf16*)(ws + OFF_cKa); }
  __device__ __forceinline__ bf16* cVaT() const { return (bf16*)(ws + OFF_cVaT); }
  __device__ __forceinline__ bf16* cKb() const { return (bf16*)(ws + OFF_cKb); }
  __device__ __forceinline__ bf16* cVbT() const { return (bf16*)(ws + OFF_cVbT); }
  __device__ __forceinline__ int* ctr() const { return (int*)(ws + OFF_ctr); }
  __device__ __forceinline__ int* qc() const { return (int*)(ws + OFF_qc); }
  __device__ __forceinline__ float* blA() const { return (float*)(ws + OFF_blA); }
  __device__ __forceinline__ float* mlA() const { return (float*)(ws + OFF_mlA); }
};

DI int tidx() { int t = threadIdx.x; asm volatile("" : "+v"(t)); return t; }
DI void tidx_init() {}
DI int wave_of(int tid) { return __builtin_amdgcn_readfirstlane(tid >> 6); }
typedef __attribute__((ext_vector_type(2))) __bf16 bf16v2;
typedef __attribute__((ext_vector_type(2))) float f32x2;
DI unsigned pack2(float a, float b) {
  f32x2 v; v[0] = a; v[1] = b;
  return __builtin_bit_cast(unsigned, __builtin_convertvector(v, bf16v2));
}
DI bf16 f2bf(float x) { return (bf16)(pack2(x, 0.f) & 0xffffu); }
DI float bf2f(bf16 b) { return __uint_as_float(((unsigned)b) << 16); }
DI float fexp2(float x) { return __builtin_amdgcn_exp2f(x); }
DI float fexp(float x) { return __builtin_amdgcn_exp2f(x * 1.4426950408889634f); }
DI float bflo(unsigned u) { return __uint_as_float(u << 16); }
DI float bfhi(unsigned u) { return __uint_as_float(u & 0xffff0000u); }
DI float silu_f(float x) { return x * __builtin_amdgcn_rcpf(1.f + fexp(-x)); }
DI float sigmoid_f(float x) { return __builtin_amdgcn_rcpf(1.f + fexp(-x)); }
DI float logsig_f(float x) { return fminf(x, 0.f) - log1pf(fexp(-fabsf(x))); }

struct TokInfo { int lat, b, t, T, tok0, modj; };
DI TokInfo tinfo(int tok) {
  TokInfo r;
  if (tok < 4096) { r.lat = 0; r.b = tok >> 8; r.t = tok & 255; r.T = 256; r.tok0 = tok & ~255; r.modj = 0; }
  else { int u = tok - 4096; r.lat = 1; r.b = u >> 10; r.t = u & 1023; r.T = 1024; r.tok0 = 4096 + (u & ~1023); r.modj = 1 + r.b; }
  return r;
}

template <bool ROWSS>
DI void gemm_core(const bf16* __restrict__ A, int lda, const bf16* __restrict__ Bt, int ldb, int K, char* smem,
                  f32x16 (&acc)[2][2]) {
  bf16* sA = (bf16*)smem;
  bf16* sB = sA + 128 * 72;
  float* sRow = (float*)(sB + 128 * 72);
  const int tid = tidx(), lane = tid & 63, w = wave_of(tid);
  const int wm = w >> 1, wn = w & 1, lq = lane & 31, h = lane >> 5;
  const int lr = tid >> 3, lc = tid & 7;
  u32x4 ra0[4], rb0[4], ra1[4], rb1[4];
  float ss[4] = {0.f, 0.f, 0.f, 0.f};
#pragma unroll
  for (int i = 0; i < 2; ++i)
#pragma unroll
    for (int j = 0; j < 2; ++j)
#pragma unroll
      for (int r = 0; r < 16; ++r) acc[i][j][r] = 0.f;
  const bf16* ap = A + (size_t)lr * lda + lc * 8;
  const bf16* bp = Bt + (size_t)lr * ldb + lc * 8;
  const size_t a32 = (size_t)32 * lda, b32 = (size_t)32 * ldb;
#pragma unroll
  for (int i = 0; i < 4; ++i) { ra0[i] = *(const u32x4*)(ap + i * a32); rb0[i] = *(const u32x4*)(bp + i * b32); }
#pragma unroll
  for (int i = 0; i < 4; ++i) { ra1[i] = *(const u32x4*)(ap + 64 + i * a32); rb1[i] = *(const u32x4*)(bp + 64 + i * b32); }
  const int nk = K >> 6;
  auto step = [&](u32x4 (&ra)[4], u32x4 (&rb)[4], int kt) {
    if (kt) __syncthreads();
#pragma unroll
    for (int i = 0; i < 4; ++i) {
      *(u32x4*)(sA + (lr + 32 * i) * 72 + lc * 8) = ra[i];
      *(u32x4*)(sB + (lr + 32 * i) * 72 + lc * 8) = rb[i];
    }
    if (ROWSS) {
#pragma unroll
      for (int i = 0; i < 4; ++i)
#pragma unroll
        for (int e = 0; e < 4; ++e) {
          float a0 = bflo(ra[i][e]), a1 = bfhi(ra[i][e]);
          ss[i] += a0 * a0 + a1 * a1;
        }
    }
    __syncthreads();
    {
      const int kn = (kt + 2 < nk) ? kt + 2 : kt;
      const bf16* ap2 = ap + (size_t)kn * 64;
      const bf16* bp2 = bp + (size_t)kn * 64;
#pragma unroll
      for (int i = 0; i < 4; ++i) { ra[i] = *(const u32x4*)(ap2 + i * a32); rb[i] = *(const u32x4*)(bp2 + i * b32); }
    }
#pragma unroll
    for (int ks = 0; ks < 4; ++ks) {
      bf16x8 af[2], bfr[2];
#pragma unroll
      for (int i = 0; i < 2; ++i) af[i] = *(const bf16x8*)(sA + (wm * 64 + i * 32 + lq) * 72 + ks * 16 + h * 8);
#pragma unroll
      for (int j = 0; j < 2; ++j) bfr[j] = *(const bf16x8*)(sB + (wn * 64 + j * 32 + lq) * 72 + ks * 16 + h * 8);
#pragma unroll
      for (int i = 0; i < 2; ++i)
#pragma unroll
        for (int j = 0; j < 2; ++j) acc[i][j] = MFMA(af[i], bfr[j], acc[i][j]);
    }
  };
  for (int kt = 0; kt < nk; kt += 2) {
    step(ra0, rb0, kt);
    step(ra1, rb1, kt + 1);
  }
  if (ROWSS) {
#pragma unroll
    for (int i = 0; i < 4; ++i) {
      float v = ss[i];
      v += __shfl_xor(v, 1); v += __shfl_xor(v, 2); v += __shfl_xor(v, 4);
      if (lc == 0) sRow[lr + 32 * i] = v;
    }
  }
  __syncthreads();
}

DI void store_vt4(bf16* VT, size_t idx, float a, float b, float c, float d) {
  u32x2 v; v[0] = pack2(a, b); v[1] = pack2(c, d);
  *(u32x2*)(VT + idx) = v;
}

DI void transpose_tile(const float* __restrict__ src, int N, int Nvalid, bf16* __restrict__ dst, int K, int k0, int n0,
                       const float* __restrict__ gk, bf16* __restrict__ dst2, char* smem) {
  float* t = (float*)smem;
  const int tid = tidx();
#pragma unroll
  for (int i = 0; i < 4; ++i) {
    int idx = tid + 256 * i; int r = idx >> 4, c = (idx & 15) * 4;
    int n = n0 + c;
    f32x4 v = {0.f, 0.f, 0.f, 0.f};
    if (n < Nvalid) v = __builtin_nontemporal_load((const f32x4*)(src + (size_t)(k0 + r) * N + n));
    t[r * 65 + c] = v[0]; t[r * 65 + c + 1] = v[1]; t[r * 65 + c + 2] = v[2]; t[r * 65 + c + 3] = v[3];
  }
  __syncthreads();
  const int c2h = (tid & 31) * 2;
  const float gk0 = gk ? gk[k0 + c2h] : 1.f, gk1 = gk ? gk[k0 + c2h + 1] : 1.f;
#pragma unroll
  for (int i = 0; i < 8; ++i) {
    int idx = tid + 256 * i; int r = idx >> 5, c2 = (idx & 31) * 2;
    float v0 = t[c2 * 65 + r], v1 = t[(c2 + 1) * 65 + r];
    if (dst2) *(unsigned*)(dst2 + (size_t)(n0 + r) * K + k0 + c2) = pack2(v0, v1);
    v0 *= gk0; v1 *= gk1;
    *(unsigned*)(dst + (size_t)(n0 + r) * K + k0 + c2) = pack2(v0, v1);
  }
  __syncthreads();
}

DI void mod_item(const P& p, int it, char* smem) {
  float* sl = (float*)smem;
  float* red = sl + 5 * 1024;
  const int tid = tidx(), lane = tid & 63, w = wave_of(tid);
  const int l = it / 48, n0 = (it % 48) * 64;
  for (int idx = tid; idx < 5120; idx += 256) {
    int j = idx >> 10, k = idx & 1023;
    float cv = (j == 0) ? p.c_ctx[k] : p.c[(j - 1) * 1024 + k];
    sl[idx] = silu_f(cv);
  }
  __syncthreads();
  float a[5] = {0.f, 0.f, 0.f, 0.f, 0.f};
  const float* wp = p.W_mod + (size_t)l * 1024 * 3072 + n0 + lane;
  for (int k = w * 256; k < w * 256 + 256; k += 16) {
    float wv[16];
#pragma unroll
    for (int u = 0; u < 16; ++u) wv[u] = __builtin_nontemporal_load(wp + (size_t)(k + u) * 3072);
#pragma unroll
    for (int u = 0; u < 16; ++u)
#pragma unroll
      for (int j = 0; j < 5; ++j) a[j] += sl[j * 1024 + k + u] * wv[u];
  }
#pragma unroll
  for (int j = 0; j < 5; ++j) red[(w * 5 + j) * 64 + lane] = a[j];
  __syncthreads();
  for (int idx = tid; idx < 320; idx += 256) {
    int j = idx >> 6, c = idx & 63;
    float s = red[(0 * 5 + j) * 64 + c] + red[(1 * 5 + j) * 64 + c] + red[(2 * 5 + j) * 64 + c] + red[(3 * 5 + j) * 64 + c];
    p.mod()[(size_t)(l * 5 + j) * 3072 + n0 + c] = s + p.b_mod[l * 3072 + n0 + c];
  }
  __syncthreads();
}

DI void phase_prepass(const P& p, char* smem) {
  const int G = gridDim.x, B = blockIdx.x, tid = tidx();
  const int N_MOD = 192, N_WIN = 4 * 92 * 16, N_WOUT = 4 * 16 * 24, N_WUQ = 4 * 12 * 6, N_WUKV = 4 * 16 * 4;
  const int total = N_MOD + N_WIN + N_WOUT + N_WUQ + N_WUKV;
  for (int it = B; it < total; it += G) {
    int u = it;
    if (u < N_MOD) { mod_item(p, u, smem); continue; }
    u -= N_MOD;
    if (u < N_WIN) {
      int l = u / (92 * 16), r = u % (92 * 16), nt = r / 16, kt = r % 16;
      transpose_tile(p.W_in + (size_t)l * 1024 * 5840, 5840, 5840, p.WinT() + (size_t)l * NPROJ * 1024, 1024, kt * 64, nt * 64, nullptr, nullptr, smem);
      continue;
    }
    u -= N_WIN;
    if (u < N_WOUT) {
      int l = u / (16 * 24), r = u % (16 * 24), nt = r / 24, kt = r % 24;
      transpose_tile(p.W_out + (size_t)l * 1536 * 1024, 1024, 1024, p.WoutT() + (size_t)l * 1024 * 1536, 1536, kt * 64, nt * 64, nullptr, nullptr, smem);
      continue;
    }
    u -= N_WOUT;
    if (u < N_WUQ) {
      int l = u / 72, r = u % 72, nt = r / 6, kt = r % 6;
      transpose_tile(p.W_uq + (size_t)l * 384 * 768, 768, 768, p.WuqT() + (size_t)l * 768 * 384, 384, kt * 64, nt * 64, p.q_norm + l * 384, nullptr, smem);
      continue;
    }
    u -= N_WUQ;
    {
      int l = u / 64, r = u % 64, nt = r / 4, kt = r % 4;
      transpose_tile(p.W_ukv + (size_t)l * 256 * 1024, 1024, 1024, p.WukvT() + (size_t)l * 1024 * 256, 256, kt * 64, nt * 64, p.kv_norm + l * 256, p.WukvTp() + (size_t)l * 1024 * 256, smem);
    }
  }
  const int gtid = B * 256 + tid, gsz = G * 256;
  for (int idx = gtid; idx < 1024 * 32; idx += gsz) {
    int t = idx >> 5, i = idx & 31;
    float pos = (i < 16) ? (float)(t >> 6) : (float)(t & 63);
    float inv = powf(10000.f, -(float)(i & 15) / 16.f);
    float ang = pos * inv;
    p.ropec()[idx] = cosf(ang); p.ropes()[idx] = sinf(ang);
  }
  if (gtid < 4) {
    int l = gtid; const float* lp = p.dlam + l * 256;
    float s1 = 0.f, s2 = 0.f;
    for (int i = 0; i < 64; ++i) { s1 += lp[i] * lp[64 + i]; s2 += lp[128 + i] * lp[192 + i]; }
    float lam_init = 0.8f - 0.6f * expf(-0.3f * (float)l);
    p.lam()[l] = expf(s1) - expf(s2) + lam_init;
  }
  for (int idx = gtid; idx < 4 * 4 * 256 * 256; idx += gsz) {
    int d = idx & 255, t = (idx >> 8) & 255, b = (idx >> 16) & 3, l = idx >> 18;
    p.cckv()[idx] = f2bf(p.c_ckv[(size_t)((b * 4 + l) * 256 + t) * 256 + d]);
  }
  for (int idx = gtid; idx < 4 * 4 * 4 * 256 * 64; idx += gsz) {
    int r = idx & 63, t = (idx >> 6) & 255, hd = (idx >> 14) & 3, b = (idx >> 16) & 3, l = idx >> 18;
    p.cKa()[(size_t)((((l * 4 + b) * 4 + hd) * 256) + t) * 192 + 128 + r] = f2bf(p.c_krope[(size_t)((b * 4 + l) * 256 + t) * 64 + r]);
  }
  for (int idx = gtid; idx < 4 * 4 * 4 * 256 * 128; idx += gsz) {
    int d = idx & 127, t = (idx >> 7) & 255, hd = (idx >> 15) & 3, b = (idx >> 17) & 3, l = idx >> 19;
    p.cKb()[idx] = f2bf(p.c_dk[(size_t)(((b * 4 + l) * 256 + t) * 4 + hd) * 128 + d]);
  }
  for (int idx = gtid; idx < 4 * 4 * 4 * 128 * 256; idx += gsz) {
    int t = idx & 255, d = (idx >> 8) & 127, hd = (idx >> 15) & 3, b = (idx >> 17) & 3, l = idx >> 19;
    p.cVbT()[idx] = f2bf(p.c_dv[(size_t)(((b * 4 + l) * 256 + t) * 4 + hd) * 128 + d]);
  }
}

DI void norm_row(const P& p, int l, int tok, int mode) {
  const int lane = tidx() & 63;
  TokInfo ti = tinfo(tok);
  const float* x;
  if (mode == 0 && l == 0) x = ti.lat ? (p.x_sample + (size_t)(tok - 4096) * 1024) : (p.x_prompt + (size_t)tok * 1024);
  else x = p.xbuf() + (size_t)tok * 1024;
  f32x4 v[4];
  float ss = 0.f;
#pragma unroll
  for (int i = 0; i < 4; ++i) {
    v[i] = *(const f32x4*)(x + i * 256 + lane * 4);
    ss += v[i][0] * v[i][0] + v[i][1] * v[i][1] + v[i][2] * v[i][2] + v[i][3] * v[i][3];
  }
#pragma unroll
  for (int o = 32; o >= 1; o >>= 1) ss += __shfl_xor(ss, o);
  const float rstd = rsqrtf(ss * (1.f / 1024.f) + EPS);
  if (mode == 0) {
    const float* g = p.g_norm + l * 1024;
    const float* md = p.mod() + (size_t)(l * 5 + ti.modj) * 3072;
#pragma unroll
    for (int i = 0; i < 4; ++i) {
      int c = i * 256 + lane * 4;
      f32x4 gv = *(const f32x4*)(g + c), sh = *(const f32x4*)(md + c), sc = *(const f32x4*)(md + 1024 + c);
      float o0 = v[i][0] * rstd * gv[0] * (1.f + sc[0]) + sh[0];
      float o1 = v[i][1] * rstd * gv[1] * (1.f + sc[1]) + sh[1];
      float o2 = v[i][2] * rstd * gv[2] * (1.f + sc[2]) + sh[2];
      float o3 = v[i][3] * rstd * gv[3] * (1.f + sc[3]) + sh[3];
      u32x2 pk; pk[0] = pack2(o0, o1); pk[1] = pack2(o2, o3);
      *(u32x2*)(p.hbuf() + (size_t)tok * 1024 + c) = pk;
    }
  } else {
    float* o = p.out + (ti.lat ? (O_YS + (size_t)(tok - 4096) * 1024) : (O_YP + (size_t)tok * 1024));
#pragma unroll
    for (int i = 0; i < 4; ++i) {
      int c = i * 256 + lane * 4;
      f32x4 gv = *(const f32x4*)(p.g_final + c);
      f32x4 r; r[0] = v[i][0] * rstd * gv[0]; r[1] = v[i][1] * rstd * gv[1]; r[2] = v[i][2] * rstd * gv[2]; r[3] = v[i][3] * rstd * gv[3];
      *(f32x4*)(o + c) = r;
    }
  }
}

DI void epi_inproj(const P& p, int l, int m0, int n0, f32x16 (&acc)[2][2]) {
  const int tid_ = tidx(); const int lane = tid_ & 63, w = wave_of(tid_), wm = w >> 1, wn = w & 1, lq = lane & 31, h = lane >> 5;
  const int mb = m0 + wm * 64, nb = n0 + wn * 64;
  const int cb = nb >> 6;
  TokInfo tb = tinfo(mb);
  const bool lat = tb.lat;
  const bool ropeT = lat && (cb == 10 || (cb >= 19 && cb <= 34));
  if (ropeT) {
#pragma unroll
    for (int i = 0; i < 2; ++i)
#pragma unroll
      for (int r = 0; r < 16; ++r) {
        int t = tb.t + i * 32 + 8 * (r >> 2) + 4 * h + (r & 3);
        float cs = p.ropec()[t * 32 + lq], sn = p.ropes()[t * 32 + lq];
        float x1 = acc[i][0][r], x2 = acc[i][1][r];
        acc[i][0][r] = x1 * cs - x2 * sn;
        acc[i][1][r] = x1 * sn + x2 * cs;
      }
  }
  if (cb == 91) {
    if (lq < 16) {
      float bias = p.mgb[l * 16 + lq];
#pragma unroll
      for (int i = 0; i < 2; ++i)
#pragma unroll
        for (int r = 0; r < 16; ++r) {
          int row = mb + i * 32 + 8 * (r >> 2) + 4 * h + (r & 3);
          p.gates()[row * 16 + lq] = acc[i][0][r] + bias;
        }
    }
    return;
  }
  if (cb == 10) {
#pragma unroll
    for (int i = 0; i < 2; ++i)
#pragma unroll
      for (int j = 0; j < 2; ++j)
#pragma unroll
        for (int r = 0; r < 16; ++r) {
          int row = mb + i * 32 + 8 * (r >> 2) + 4 * h + (r & 3);
          int c = j * 32 + lq;
          float v = acc[i][j][r];
          if (!lat) p.out[O_KROPE + (size_t)((tb.b * 4 + l) * 256 + (row & 255)) * 64 + c] = v;
          bf16 bv = f2bf(v);
#pragma unroll
          for (int hd = 0; hd < 4; ++hd) p.Ka()[(size_t)(row * 4 + hd) * 192 + 128 + c] = bv;
        }
    return;
  }
  if (cb >= 27 && cb <= 34) {
    int hd = (cb - 27) >> 1, sub = (cb - 27) & 1;
#pragma unroll
    for (int i = 0; i < 2; ++i)
#pragma unroll
      for (int j = 0; j < 2; ++j)
#pragma unroll
        for (int r = 0; r < 16; ++r) {
          int row = mb + i * 32 + 8 * (r >> 2) + 4 * h + (r & 3);
          int c = j * 32 + lq;
          float v = acc[i][j][r];
          if (!lat) p.out[O_DK + (size_t)((tb.b * 4 + l) * 256 + (row & 255)) * 512 + (cb - 27) * 64 + c] = v;
          p.Kb()[(size_t)(row * 4 + hd) * 128 + sub * 64 + c] = f2bf(v);
        }
    return;
  }
  if ((cb >= 35 && cb <= 42) || (cb >= 67 && cb <= 74)) {
    const bool isdv = cb <= 42;
    int cc = isdv ? cb - 35 : cb - 67;
    int hd = cc >> 1, sub = cc & 1;
    bf16* VT = isdv ? p.VbT() : p.VmT();
#pragma unroll
    for (int i = 0; i < 2; ++i)
#pragma unroll
      for (int j = 0; j < 2; ++j) {
        int d = sub * 64 + j * 32 + lq;
#pragma unroll
        for (int g = 0; g < 4; ++g) {
          int tl = tb.t + i * 32 + 8 * g + 4 * h;
          store_vt4(VT, (size_t)tb.tok0 * 512 + (size_t)(hd * 128 + d) * tb.T + tl, acc[i][j][4 * g], acc[i][j][4 * g + 1], acc[i][j][4 * g + 2], acc[i][j][4 * g + 3]);
          if (isdv && !lat) {
#pragma unroll
            for (int jj = 0; jj < 4; ++jj)
              p.out[O_DV + (size_t)((tb.b * 4 + l) * 256 + tl + jj) * 512 + cc * 64 + j * 32 + lq] = acc[i][j][4 * g + jj];
          }
        }
      }
    return;
  }
#pragma unroll
  for (int i = 0; i < 2; ++i)
#pragma unroll
    for (int j = 0; j < 2; ++j)
#pragma unroll
      for (int r = 0; r < 16; ++r) {
        int row = mb + i * 32 + 8 * (r >> 2) + 4 * h + (r & 3);
        int col = nb + j * 32 + lq;
        float v = acc[i][j][r];
        p.proj()[(size_t)row * NPROJ + col] = f2bf(v);
      }
}

DI void epi_qa(const P& p, int m0, int n0, f32x16 (&acc)[2][2], const float* sRow) {
  const int tid_ = tidx(); const int lane = tid_ & 63, w = wave_of(tid_), wm = w >> 1, wn = w & 1, lq = lane & 31, h = lane >> 5;
  const int mb = m0 + wm * 64, nb = n0 + wn * 64;
  const int cb = nb >> 6, hd = cb / 3, part = cb % 3;
  TokInfo tb = tinfo(mb);
  const bool dorope = tb.lat && part == 2;
#pragma unroll
  for (int i = 0; i < 2; ++i) {
    float cs[16], sn[16];
#pragma unroll
    for (int r = 0; r < 16; ++r) { cs[r] = 1.f; sn[r] = 0.f; }
    if (dorope) {
#pragma unroll
      for (int r = 0; r < 16; ++r) {
        int t = tb.t + i * 32 + 8 * (r >> 2) + 4 * h + (r & 3);
        cs[r] = p.ropec()[t * 32 + lq]; sn[r] = p.ropes()[t * 32 + lq];
      }
    }
#pragma unroll
    for (int r = 0; r < 16; ++r) {
      int rl = wm * 64 + i * 32 + 8 * (r >> 2) + 4 * h + (r & 3);
      float rstd = rsqrtf(sRow[rl] * (1.f / 384.f) + EPS);
      float x1 = acc[i][0][r] * rstd, x2 = acc[i][1][r] * rstd;
      {
        float y1 = x1 * cs[r] - x2 * sn[r], y2 = x1 * sn[r] + x2 * cs[r];
        x1 = y1; x2 = y2;
      }
      int row = m0 + rl;
      bf16* q = p.Qa() + (size_t)(row * 4 + hd) * 192 + part * 64;
      q[lq] = f2bf(x1); q[32 + lq] = f2bf(x2);
    }
  }
}

DI void epi_kv(const P& p, int m0, int n0, f32x16 (&acc)[2][2], const float* sRow, bool cache) {
  const int tid_ = tidx(); const int lane = tid_ & 63, w = wave_of(tid_), wm = w >> 1, wn = w & 1, lq = lane & 31, h = lane >> 5;
  const int mb = m0 + wm * 64, nb = n0 + wn * 64;
  const int cb = nb >> 6, hd = cb >> 2, part = cb & 3;
  TokInfo tb = tinfo(mb);
#pragma unroll
  for (int i = 0; i < 2; ++i)
#pragma unroll
    for (int j = 0; j < 2; ++j)
#pragma unroll
      for (int g = 0; g < 4; ++g) {
        float v[4];
#pragma unroll
        for (int jj = 0; jj < 4; ++jj) {
          int rl = wm * 64 + i * 32 + 8 * g + 4 * h + jj;
          float rstd = cache ? 1.f : rsqrtf(sRow[rl] * (1.f / 256.f) + EPS);
          v[jj] = acc[i][j][4 * g + jj] * rstd;
        }
        int c = j * 32 + lq;
        int row0 = mb + i * 32 + 8 * g + 4 * h;
        if (part < 2) {
#pragma unroll
          for (int jj = 0; jj < 4; ++jj) {
            int row = row0 + jj;
            if (cache) {
              int lb = row >> 8, t = row & 255;
              p.cKa()[(size_t)((lb * 4 + hd) * 256 + t) * 192 + part * 64 + c] = f2bf(v[jj]);
            } else {
              p.Ka()[(size_t)(row * 4 + hd) * 192 + part * 64 + c] = f2bf(v[jj]);
            }
          }
        } else {
          int d = (part - 2) * 64 + c;
          if (cache) {
            int lb = row0 >> 8, t = row0 & 255;
            store_vt4(p.cVaT(), (size_t)((lb * 4 + hd) * 128 + d) * 256 + t, v[0], v[1], v[2], v[3]);
          } else {
            int tl = tb.t + i * 32 + 8 * g + 4 * h;
            store_vt4(p.VaT(), (size_t)tb.tok0 * 512 + (size_t)(hd * 128 + d) * tb.T + tl, v[0], v[1], v[2], v[3]);
          }
        }
      }
}

DI void epi_out(const P& p, int l, int m0, int n0, f32x16 (&acc)[2][2]) {
  const int tid_ = tidx(); const int lane = tid_ & 63, w = wave_of(tid_), wm = w >> 1, wn = w & 1, lq = lane & 31, h = lane >> 5;
  const int mb = m0 + wm * 64, nb = n0 + wn * 64;
  TokInfo tb = tinfo(mb);
  const float* gate = p.mod() + (size_t)(l * 5 + tb.modj) * 3072 + 2048;
  const float* xsrc = (l == 0) ? (tb.lat ? p.x_sample - (size_t)4096 * 1024 : p.x_prompt) : (const float*)p.xbuf();
#pragma unroll
  for (int i = 0; i < 2; ++i)
#pragma unroll
    for (int j = 0; j < 2; ++j) {
      int col = nb + j * 32 + lq;
      float gv = gate[col];
      float xo[16];
#pragma unroll
      for (int r = 0; r < 16; ++r) {
        int row = mb + i * 32 + 8 * (r >> 2) + 4 * h + (r & 3);
        xo[r] = xsrc[(size_t)row * 1024 + col];
      }
#pragma unroll
      for (int r = 0; r < 16; ++r) {
        int row = mb + i * 32 + 8 * (r >> 2) + 4 * h + (r & 3);
        p.xbuf()[(size_t)row * 1024 + col] = xo[r] + gv * acc[i][j][r];
      }
    }
}

template <int KW, int DQ, int KSPLIT>
DI void attn_pass(const bf16* __restrict__ qptr, int koff, int kh, const bf16* __restrict__ Kmain, int ldk, int Tmain,
                  const bf16* __restrict__ Kc, int ldkc, int Tc, const bf16* __restrict__ VTmain,
                  const bf16* __restrict__ VTc, float c, char* smem, f32x16 (&o)[4], float& lsum, float& m_out) {
  constexpr int KS = KW + 8;
  constexpr int NKB = 2 / KSPLIT;
  bf16* sK = (bf16*)smem;
  bf16* sV = sK + 64 * KS;
  const int tid = tidx(), lane = tid & 63, lq = lane & 31, h = lane >> 5;
  bf16x8 qf[DQ / 16];
#pragma unroll
  for (int ks = 0; ks < DQ / 16; ++ks) qf[ks] = *(const bf16x8*)(qptr + ks * 16 + h * 8);
#pragma unroll
  for (int db = 0; db < 4; ++db)
#pragma unroll
    for (int r = 0; r < 16; ++r) o[db][r] = 0.f;
  lsum = 0.f;
  float m_run = -INFINITY;
  const int nt = (Tmain + Tc) >> 6;
  constexpr int CH = KW / 8, NKL = 64 * CH / 256;
  u32x4 kr[NKL], vr[4];
  auto issue = [&](int kt) {
    const bf16* ksrc; int ld; const bf16* vsrc; int ldv;
    if (kt * 64 < Tmain) { ksrc = Kmain + (size_t)(kt * 64) * ldk; ld = ldk; vsrc = VTmain + kt * 64; ldv = Tmain; }
    else { ksrc = Kc + (size_t)(kt * 64 - Tmain) * ldkc; ld = ldkc; vsrc = VTc + (kt * 64 - Tmain); ldv = Tc; }
#pragma unroll
    for (int i = 0; i < NKL; ++i) {
      int idx = tid + 256 * i; int r = idx / CH, cc = idx % CH;
      kr[i] = *(const u32x4*)(ksrc + (size_t)r * ld + cc * 8);
    }
    if (KSPLIT == 1) {
#pragma unroll
      for (int i = 0; i < 4; ++i) {
        int idx = tid + 256 * i; int r = idx >> 3, cc = idx & 7;
        vr[i] = *(const u32x4*)(vsrc + (size_t)r * ldv + cc * 8);
      }
    }
  };
  issue(0);
  for (int kt = 0; kt < nt; ++kt) {
    __syncthreads();
#pragma unroll
    for (int i = 0; i < NKL; ++i) {
      int idx = tid + 256 * i; int r = idx / CH, cc = idx % CH;
      *(u32x4*)(sK + r * KS + cc * 8) = kr[i];
    }
    if (KSPLIT != 1) {
      const bf16* vsrc; int ldv;
      if (kt * 64 < Tmain) { vsrc = VTmain + kt * 64; ldv = Tmain; } else { vsrc = VTc + (kt * 64 - Tmain); ldv = Tc; }
#pragma unroll
      for (int i = 0; i < 4; ++i) {
        int idx = tid + 256 * i; int r = idx >> 3, cc = idx & 7;
        vr[i] = *(const u32x4*)(vsrc + (size_t)r * ldv + cc * 8);
      }
    }
#pragma unroll
    for (int i = 0; i < 4; ++i) {
      int idx = tid + 256 * i; int r = idx >> 3, cc = idx & 7;
      *(u32x4*)(sV + r * 72 + cc * 8) = vr[i];
    }
    __syncthreads();
    issue((kt + 1 < nt) ? kt + 1 : kt);
    f32x16 s[NKB];
#pragma unroll
    for (int kbi = 0; kbi < NKB; ++kbi)
#pragma unroll
      for (int r = 0; r < 16; ++r) s[kbi][r] = 0.f;
#pragma unroll
    for (int ks = 0; ks < DQ / 16; ++ks)
#pragma unroll
      for (int kbi = 0; kbi < NKB; ++kbi) {
        const int kb = (KSPLIT == 2) ? kh : kbi;
        bf16x8 a = *(const bf16x8*)(sK + (kb * 32 + lq) * KS + koff + ks * 16 + h * 8);
        s[kbi] = MFMA(a, qf[ks], s[kbi]);
      }
    float mx = -INFINITY;
#pragma unroll
    for (int kbi = 0; kbi < NKB; ++kbi)
#pragma unroll
      for (int r = 0; r < 16; ++r) mx = fmaxf(mx, s[kbi][r]);
    mx = fmaxf(mx, __shfl_xor(mx, 32));
    const float m_new = fmaxf(m_run, mx);
    const float alpha = fexp2((m_run - m_new) * c);
    m_run = m_new;
    lsum *= alpha;
#pragma unroll
    for (int db = 0; db < 4; ++db)
#pragma unroll
      for (int r = 0; r < 16; ++r) o[db][r] *= alpha;
    const float mc = m_new * c;
#pragma unroll
    for (int kbi = 0; kbi < NKB; ++kbi)
#pragma unroll
      for (int r = 0; r < 16; ++r) { float pv = fexp2(s[kbi][r] * c - mc); s[kbi][r] = pv; lsum += pv; }
#pragma unroll
    for (int kbi = 0; kbi < NKB; ++kbi) {
      const int kb = (KSPLIT == 2) ? kh : kbi;
#pragma unroll
      for (int s2 = 0; s2 < 2; ++s2) {
        u32x4 pk;
#pragma unroll
        for (int e = 0; e < 4; ++e) pk[e] = pack2(s[kbi][8 * s2 + 2 * e], s[kbi][8 * s2 + 2 * e + 1]);
        bf16x8 pb = __builtin_bit_cast(bf16x8, pk);
#pragma unroll
        for (int db = 0; db < 4; ++db) {
          const bf16* vp = sV + (db * 32 + lq) * 72 + kb * 32 + s2 * 16 + 4 * h;
          u32x2 lo = *(const u32x2*)vp, hi = *(const u32x2*)(vp + 8);
          u32x4 av; av[0] = lo[0]; av[1] = lo[1]; av[2] = hi[0]; av[3] = hi[1];
          o[db] = MFMA(__builtin_bit_cast(bf16x8, av), pb, o[db]);
        }
      }
    }
  }
  lsum += __shfl_xor(lsum, 32);
  m_out = m_run;
}

DI void mla_item(const P& p, int l, int it, char* smem) {
  const int tid = tidx(), lane = tid & 63, w = wave_of(tid), lq = lane & 31, h = lane >> 5;
  int lat, b, hd, qb;
  if (it < 256) { lat = 1; b = it >> 6; hd = (it >> 4) & 3; qb = it & 15; }
  else { int u = it - 256; lat = 0; b = u >> 4; hd = (u >> 2) & 3; qb = u & 3; }
  const int T = lat ? 1024 : 256, tok0 = lat ? 4096 + b * 1024 : b * 256;
  const int qsub = w & 1, kh = w >> 1;
  const int tok = tok0 + qb * 64 + qsub * 32 + lq;
  f32x16 o[4]; float lsum, mrun;
  const float c = 0.07216878364870322f * 1.4426950408889634f;
  attn_pass<192, 192, 2>(p.Qa() + (size_t)(tok * 4 + hd) * 192, 0, kh, p.Ka() + (size_t)(tok0 * 4 + hd) * 192, 768, T,
                 p.cKa() + (size_t)((l * 4 + b) * 4 + hd) * 256 * 192, 192, lat ? 256 : 0,
                 p.VaT() + (size_t)tok0 * 512 + (size_t)hd * 128 * T, p.cVaT() + (size_t)((l * 4 + b) * 4 + hd) * 128 * 256, c, smem, o, lsum, mrun);
  float* ex = (float*)smem;
  float* exm = ex + 2 * 128 * 32;
  float* exl = exm + 64;
  __syncthreads();
  if (kh == 1) {
#pragma unroll
    for (int db = 0; db < 4; ++db)
#pragma unroll
      for (int r = 0; r < 16; ++r) {
        int dv = db * 32 + 8 * (r >> 2) + 4 * h + (r & 3);
        ex[(qsub * 128 + dv) * 32 + lq] = o[db][r];
      }
    if (h == 0) { exm[qsub * 32 + lq] = mrun; exl[qsub * 32 + lq] = lsum; }
  }
  __syncthreads();
  if (kh == 0) {
    const float m1 = exm[qsub * 32 + lq], l1 = exl[qsub * 32 + lq];
    const float mm = fmaxf(mrun, m1);
    const float f0 = fexp2((mrun - mm) * c), f1 = fexp2((m1 - mm) * c);
    const float inv = 1.f / (lsum * f0 + l1 * f1);
    const float g0 = f0 * inv, g1 = f1 * inv;
    u32x2 zz[4][4];
#pragma unroll
    for (int db = 0; db < 4; ++db)
#pragma unroll
      for (int g = 0; g < 4; ++g) zz[db][g] = *(const u32x2*)(p.proj() + (size_t)tok * NPROJ + 704 + hd * 128 + db * 32 + 8 * g + 4 * h);
#pragma unroll
    for (int db = 0; db < 4; ++db)
#pragma unroll
      for (int g = 0; g < 4; ++g) {
        int dv = db * 32 + 8 * g + 4 * h;
        float ov4[4];
#pragma unroll
        for (int jj = 0; jj < 4; ++jj) ov4[jj] = o[db][4 * g + jj] * g0 + ex[(qsub * 128 + dv + jj) * 32 + lq] * g1;
        u32x2 z = zz[db][g];
        float z0 = bflo(z[0]), z1 = bfhi(z[0]), z2 = bflo(z[1]), z3 = bfhi(z[1]);
        u32x2 ov;
        ov[0] = pack2(ov4[0] * silu_f(z0), ov4[1] * silu_f(z1));
        ov[1] = pack2(ov4[2] * silu_f(z2), ov4[3] * silu_f(z3));
        *(u32x2*)(p.ycat() + (size_t)tok * 1536 + hd * 128 + dv) = ov;
      }
  }
}

DI void diff_item(const P& p, int l, int it, char* smem) {
  const int tid = tidx(), lane = tid & 63, w = wave_of(tid), lq = lane & 31, h = lane >> 5;
  int lat, b, hd, qb;
  if (it < 256) { lat = 1; b = it >> 6; hd = (it >> 4) & 3; qb = it & 15; }
  else { int u = it - 256; lat = 0; b = u >> 4; hd = (u >> 2) & 3; qb = u & 3; }
  const int T = lat ? 1024 : 256, tok0 = lat ? 4096 + b * 1024 : b * 256;
  const int map = w >> 1, qsub = w & 1;
  const int tok = tok0 + qb * 64 + qsub * 32 + lq;
  const float c = 0.125f * 1.4426950408889634f;
  const bf16* vt = p.VbT() + (size_t)tok0 * 512 + (size_t)hd * 128 * T;
  const bf16* vtc = p.cVbT() + (size_t)((l * 4 + b) * 4 + hd) * 128 * 256;
  const bf16* kc = p.cKb() + (size_t)((l * 4 + b) * 4 + hd) * 256 * 128;
  f32x16 o[4]; float ls, mdummy;
  attn_pass<128, 64, 1>(p.proj() + (size_t)tok * NPROJ + 1216 + hd * 128 + map * 64, map * 64, 0, p.Kb() + (size_t)(tok0 * 4 + hd) * 128, 512, T, kc, 128,
                     lat ? 256 : 0, vt, vtc, c, smem, o, ls, mdummy);
  float* ex = (float*)smem;
  __syncthreads();
  if (map == 1) {
    const float sc2 = p.lam()[l] / ls;
#pragma unroll
    for (int db = 0; db < 4; ++db)
#pragma unroll
      for (int r = 0; r < 16; ++r) {
        int dv = db * 32 + 8 * (r >> 2) + 4 * h + (r & 3);
        ex[(qsub * 128 + dv) * 32 + lq] = o[db][r] * sc2;
      }
  }
  __syncthreads();
  if (map == 0) {
    const float i1 = 1.f / ls;
    float ss = 0.f;
#pragma unroll
    for (int db = 0; db < 4; ++db)
#pragma unroll
      for (int r = 0; r < 16; ++r) {
        int dv = db * 32 + 8 * (r >> 2) + 4 * h + (r & 3);
        float v = o[db][r] * i1 - ex[(qsub * 128 + dv) * 32 + lq];
        o[db][r] = v; ss += v * v;
      }
    ss += __shfl_xor(ss, 32);
    const float lam_init = 0.8f - 0.6f * fexp(-0.3f * (float)l);
    const float sc = rsqrtf(ss * (1.f / 128.f) + EPS) * (1.f - lam_init);
#pragma unroll
    for (int db = 0; db < 4; ++db) {
      u32x2 zz[4]; f32x4 gg[4];
#pragma unroll
      for (int g = 0; g < 4; ++g) {
        int dv = db * 32 + 8 * g + 4 * h;
        zz[g] = *(const u32x2*)(p.proj() + (size_t)tok * NPROJ + 2752 + hd * 128 + dv);
        gg[g] = *(const f32x4*)(p.dnorm + l * 128 + dv);
      }
#pragma unroll
      for (int g = 0; g < 4; ++g) {
        int dv = db * 32 + 8 * g + 4 * h;
        u32x2 z = zz[g];
        f32x4 gn = gg[g];
        float z0 = bflo(z[0]), z1 = bfhi(z[0]), z2 = bflo(z[1]), z3 = bfhi(z[1]);
        u32x2 ov;
        ov[0] = pack2(o[db][4 * g] * sc * gn[0] * silu_f(z0), o[db][4 * g + 1] * sc * gn[1] * silu_f(z1));
        ov[1] = pack2(o[db][4 * g + 2] * sc * gn[2] * silu_f(z2), o[db][4 * g + 3] * sc * gn[3] * silu_f(z3));
        *(u32x2*)(p.ycat() + (size_t)tok * 1536 + 512 + hd * 128 + dv) = ov;
      }
    }
  }
}

DI void conv8(const P& p, int l, int tok, int t, int T, int col, int wcol, float (&o)[8]) {
  const bf16* base = p.proj() + (size_t)tok * NPROJ + col;
  u32x4 cur = *(const u32x4*)base;
  u32x4 prv = {0u, 0u, 0u, 0u}, nxt = {0u, 0u, 0u, 0u};
  if (t > 0) prv = *(const u32x4*)(base - NPROJ);
  if (t < T - 1) nxt = *(const u32x4*)(base + NPROJ);
  const float* w0 = p.mconv + (size_t)l * 3 * 1024 + wcol;
  f32x4 wa0 = *(const f32x4*)w0, wa1 = *(const f32x4*)(w0 + 4);
  f32x4 wb0 = *(const f32x4*)(w0 + 1024), wb1 = *(const f32x4*)(w0 + 1028);
  f32x4 wc0 = *(const f32x4*)(w0 + 2048), wc1 = *(const f32x4*)(w0 + 2052);
#pragma unroll
  for (int e = 0; e < 4; ++e) {
    float wA0 = e < 2 ? wa0[2 * e] : wa1[2 * e - 4], wA1 = e < 2 ? wa0[2 * e + 1] : wa1[2 * e - 3];
    float wB0 = e < 2 ? wb0[2 * e] : wb1[2 * e - 4], wB1 = e < 2 ? wb0[2 * e + 1] : wb1[2 * e - 3];
    float wC0 = e < 2 ? wc0[2 * e] : wc1[2 * e - 4], wC1 = e < 2 ? wc0[2 * e + 1] : wc1[2 * e - 3];
    float v0 = wA0 * bflo(prv[e]) + wB0 * bflo(cur[e]) + wC0 * bflo(nxt[e]);
    float v1 = wA1 * bfhi(prv[e]) + wB1 * bfhi(cur[e]) + wC1 * bfhi(nxt[e]);
    o[2 * e] = silu_f(v0); o[2 * e + 1] = silu_f(v1);
  }
}

DI float wave_incl_scan_add(float v, int lane) {
#pragma unroll
  for (int o = 1; o < 64; o <<= 1) { float t = __shfl_up(v, o); if (lane >= o) v += t; }
  return v;
}
DI float wave_incl_scan_max(float v, int lane) {
#pragma unroll
  for (int o = 1; o < 64; o <<= 1) { float t = __shfl_up(v, o); if (lane >= o) v = fmaxf(v, t); }
  return v;
}

DI void mlstm_local(const P& p, int l, int slot, char* smem) {
  bf16* vT = (bf16*)smem;
  bf16* kT = vT + 128 * 72;
  float* wbuf = (float*)(kT + 128 * 72);
  const int tid = tidx(), lane = tid & 63, w = wave_of(tid), lq = lane & 31, h = lane >> 5;
  const int cp = slot >> 3, hd = (slot >> 1) & 3, dir = slot & 1;
  const int ctok = cp * 64;
  TokInfo ti = tinfo(ctok);
  const int T = ti.T;
  if (w == 0) {
    const int s = dir ? 63 - lane : lane;
    const int tk = ctok + s;
    const float ig = p.gates()[tk * 16 + dir * 8 + hd];
    const float lf = logsig_f(p.gates()[tk * 16 + dir * 8 + 4 + hd]);
    const float bc = wave_incl_scan_add(lf, lane);
    const float b_last = __shfl(bc, 63);
    const float val = b_last - bc + ig;
    float mx = val;
#pragma unroll
    for (int o = 32; o >= 1; o >>= 1) mx = fmaxf(mx, __shfl_xor(mx, o));
    wbuf[s] = fexp(val - mx);
    if (lane == 0) { p.blA()[slot] = b_last; p.mlA()[slot] = mx; }
  }
  __syncthreads();
  {
    const int s = tid >> 2, chb = (tid & 3) * 32;
    const float ws = wbuf[s];
#pragma unroll 2
    for (int q = 0; q < 4; ++q) {
      float kv[8];
      const int ch = chb + q * 8;
      conv8(p, l, ctok + s, ti.t + s, T, 3776 + hd * 128 + ch, 512 + hd * 128 + ch, kv);
#pragma unroll
      for (int e = 0; e < 8; ++e) kT[(ch + e) * 72 + s] = f2bf(kv[e] * ws);
    }
    const bf16* vsrc = p.VmT() + (size_t)ti.tok0 * 512 + (size_t)hd * 128 * T + ti.t;
#pragma unroll
    for (int i = 0; i < 4; ++i) {
      int idx = tid + 256 * i; int r = idx >> 3, cc = idx & 7;
      *(u32x4*)(vT + r * 72 + cc * 8) = *(const u32x4*)(vsrc + (size_t)r * T + cc * 8);
    }
  }
  __syncthreads();
  f32x16 acc[4];
#pragma unroll
  for (int cb = 0; cb < 4; ++cb)
#pragma unroll
    for (int r = 0; r < 16; ++r) acc[cb][r] = 0.f;
#pragma unroll
  for (int ks = 0; ks < 4; ++ks) {
    bf16x8 a = *(const bf16x8*)(vT + (32 * w + lq) * 72 + ks * 16 + 8 * h);
#pragma unroll
    for (int cb = 0; cb < 4; ++cb) {
      bf16x8 bb = *(const bf16x8*)(kT + (32 * cb + lq) * 72 + ks * 16 + 8 * h);
      acc[cb] = MFMA(a, bb, acc[cb]);
    }
  }
  bf16* cs = p.Cst() + (size_t)slot * 16384;
#pragma unroll
  for (int cb = 0; cb < 4; ++cb)
#pragma unroll
    for (int r = 0; r < 16; ++r) {
      int dvv = 32 * w + 8 * (r >> 2) + 4 * h + (r & 3);
      cs[dvv * 128 + 32 * cb + lq] = f2bf(acc[cb][r]);
    }
  if (tid < 128) {
    float sum = 0.f;
#pragma unroll
    for (int q = 0; q < 8; ++q) {
      u32x4 v = *(const u32x4*)(kT + tid * 72 + q * 8);
#pragma unroll
      for (int e = 0; e < 4; ++e) sum += bflo(v[e]) + bfhi(v[e]);
    }
    p.nst()[slot * 128 + tid] = sum;
  }
}

DI void mlstm_scan(const P& p, int l, int it) {
  const int tid = tidx();
  const int ch = it >> 2, qt = it & 3;
  int lat, b, hd, dir;
  if (ch < 32) { lat = 1; b = ch >> 3; hd = (ch >> 1) & 3; dir = ch & 1; }
  else { int u = ch - 32; lat = 0; b = u >> 3; hd = (u >> 1) & 3; dir = u & 1; }
  const int T = lat ? 1024 : 256, tok0 = lat ? 4096 + b * 1024 : b * 256, nc = T >> 6;
  const int dv0 = 32 * qt + 4 * (tid >> 5), dk0 = 4 * (tid & 31);
  float C[4][4];
  float n_val = 0.f, m_prev = 0.f;
  const bool do_n = (qt == 0) && (tid < 128);
  const size_t sidx = (size_t)((b * 4 + l) * 2 + dir) * 4 + hd;
  if (lat) {
    const float* C0 = p.st_C + sidx * 16384;
#pragma unroll
    for (int j = 0; j < 4; ++j) {
      f32x4 v = *(const f32x4*)(C0 + (size_t)(dk0 + j) * 128 + dv0);
      C[0][j] = v[0]; C[1][j] = v[1]; C[2][j] = v[2]; C[3][j] = v[3];
    }
    if (do_n) n_val = p.st_n[sidx * 128 + tid];
    m_prev = p.st_m[sidx];
  } else {
#pragma unroll
    for (int i = 0; i < 4; ++i)
#pragma unroll
      for (int j = 0; j < 4; ++j) C[i][j] = 0.f;
  }
  u32x2 dnx[4]; float blx, mlx, dnnx = 0.f;
  {
    const int c = dir ? nc - 1 : 0;
    const int slot = ((((tok0 >> 6) + c) * 4 + hd) * 2) + dir;
    const bf16* cs = p.Cst() + (size_t)slot * 16384 + dv0 * 128 + dk0;
#pragma unroll
    for (int i = 0; i < 4; ++i) dnx[i] = *(const u32x2*)(cs + i * 128);
    blx = p.blA()[slot]; mlx = p.mlA()[slot];
    if (do_n) dnnx = p.nst()[slot * 128 + tid];
  }
  for (int ci = 0; ci < nc; ++ci) {
    const int c = dir ? nc - 1 - ci : ci;
    const int slot = ((((tok0 >> 6) + c) * 4 + hd) * 2) + dir;
    bf16* cs = p.Cst() + (size_t)slot * 16384 + dv0 * 128 + dk0;
    u32x2 d[4];
#pragma unroll
    for (int i = 0; i < 4; ++i) d[i] = dnx[i];
    const float bl = blx, ml = mlx;
    const float dn = dnnx;
    {
      const int cn = (ci + 1 < nc) ? (dir ? nc - 2 - ci : ci + 1) : c;
      const int sn = ((((tok0 >> 6) + cn) * 4 + hd) * 2) + dir;
      const bf16* csn = p.Cst() + (size_t)sn * 16384 + dv0 * 128 + dk0;
#pragma unroll
      for (int i = 0; i < 4; ++i) dnx[i] = *(const u32x2*)(csn + i * 128);
      blx = p.blA()[sn]; mlx = p.mlA()[sn];
      if (do_n) dnnx = p.nst()[sn * 128 + tid];
    }
#pragma unroll
    for (int i = 0; i < 4; ++i) {
      u32x2 o; o[0] = pack2(C[i][0], C[i][1]); o[1] = pack2(C[i][2], C[i][3]);
      *(u32x2*)(cs + i * 128) = o;
    }
    if (do_n) p.nst()[slot * 128 + tid] = n_val;
    if (qt == 0 && tid == 0) p.mst()[slot] = m_prev;
    const float m_new = fmaxf(bl + m_prev, ml);
    const float a = fexp(bl + m_prev - m_new), bs = fexp(ml - m_new);
#pragma unroll
    for (int i = 0; i < 4; ++i) {
      C[i][0] = a * C[i][0] + bs * bflo(d[i][0]); C[i][1] = a * C[i][1] + bs * bfhi(d[i][0]);
      C[i][2] = a * C[i][2] + bs * bflo(d[i][1]); C[i][3] = a * C[i][3] + bs * bfhi(d[i][1]);
    }
    n_val = a * n_val + bs * dn;
    m_prev = m_new;
  }
  if (!lat) {
    float* Co = p.out + O_MC + sidx * 16384;
#pragma unroll
    for (int j = 0; j < 4; ++j) {
      f32x4 v; v[0] = C[0][j]; v[1] = C[1][j]; v[2] = C[2][j]; v[3] = C[3][j];
      *(f32x4*)(Co + (size_t)(dk0 + j) * 128 + dv0) = v;
    }
    if (do_n) p.out[O_MN + sidx * 128 + tid] = n_val;
    if (qt == 0 && tid == 0) p.out[O_MM + sidx] = m_prev;
  }
}

DI void mlstm_out(const P& p, int l, int it, char* smem) {
  bf16* sq = (bf16*)smem;
  bf16* sk = sq + 64 * 136;
  bf16* vT = sk + 64 * 136;
  float* bcA = (float*)(vT + 128 * 72);
  float* uA = bcA + 64, *mtA = uA + 64, *nA = mtA + 64  , *ssb = nA + 128  ;
  const int tid = tidx(), lane = tid & 63, w = wave_of(tid), lq = lane & 31, h = lane >> 5;
  const int cp = it >> 2, hd = it & 3;
  const int ctok = cp * 64;
  TokInfo ti = tinfo(ctok);
  const int T = ti.T;
  {
    const int s = tid >> 2, chb = (tid & 3) * 32;
#pragma unroll 1
    for (int q = 0; q < 4; ++q) {
      const int ch = chb + q * 8;
      float v[8];
      conv8(p, l, ctok + s, ti.t + s, T, 3264 + hd * 128 + ch, hd * 128 + ch, v);
      u32x4 pk;
#pragma unroll
      for (int e = 0; e < 4; ++e) pk[e] = pack2(v[2 * e] * 0.08838834764831845f, v[2 * e + 1] * 0.08838834764831845f);
      *(u32x4*)(sq + s * 136 + ch) = pk;
      conv8(p, l, ctok + s, ti.t + s, T, 3776 + hd * 128 + ch, 512 + hd * 128 + ch, v);
#pragma unroll
      for (int e = 0; e < 4; ++e) pk[e] = pack2(v[2 * e], v[2 * e + 1]);
      *(u32x4*)(sk + s * 136 + ch) = pk;
    }
    const bf16* vsrc = p.VmT() + (size_t)ti.tok0 * 512 + (size_t)hd * 128 * T + ti.t;
#pragma unroll
    for (int i = 0; i < 4; ++i) {
      int idx = tid + 256 * i; int r = idx >> 3, cc = idx & 7;
      *(u32x4*)(vT + r * 72 + cc * 8) = *(const u32x4*)(vsrc + (size_t)r * T + cc * 8);
    }
  }
  const int tb = w & 1, dvh = w >> 1;
  const int t = 32 * tb + lq;
  f32x16 hacc[2];
#pragma unroll
  for (int d2 = 0; d2 < 2; ++d2)
#pragma unroll
    for (int r = 0; r < 16; ++r) hacc[d2][r] = 0.f;
  const bf16* sqt = sq + t * 136 + 8 * h;
  for (int dir = 0; dir < 2; ++dir) {
    const int slot = (cp * 4 + hd) * 2 + dir;
    const float m_prev = p.mst()[slot];
    __syncthreads();
    if (w == 0) {
      const int s = dir ? 63 - lane : lane;
      const int tk = ctok + s;
      const float ig = p.gates()[tk * 16 + dir * 8 + hd];
      const float lf = logsig_f(p.gates()[tk * 16 + dir * 8 + 4 + hd]);
      const float bc = wave_incl_scan_add(lf, lane);
      const float u = ig - bc;
      const float pm = wave_incl_scan_max(u, lane);
      bcA[s] = bc; uA[s] = u; mtA[s] = bc + fmaxf(m_prev, pm);
    } else if (w < 3) {
      nA[tid - 64] = p.nst()[slot * 128 + tid - 64];
    }
    __syncthreads();
    const float bc_t = bcA[t], mt = mtA[t];
    const float w_inter = fexp(bc_t + m_prev - mt);
    float den = 0.f;
    const float e0 = bc_t - mt;
    u32x4 pk[2][2];
#pragma unroll
    for (int sb = 0; sb < 2; ++sb) {
      asm volatile("" ::: "memory");
      f32x16 sv;
#pragma unroll
      for (int r = 0; r < 16; ++r) sv[r] = 0.f;
#pragma unroll
      for (int ks = 0; ks < 8; ++ks) {
        bf16x8 a = *(const bf16x8*)(sk + (32 * sb + lq) * 136 + ks * 16 + 8 * h);
        sv = MFMA(a, *(const bf16x8*)(sqt + ks * 16), sv);
      }
#pragma unroll
      for (int r = 0; r < 16; ++r) {
        const int sidx = 32 * sb + 8 * (r >> 2) + 4 * h + (r & 3);
        const bool valid = dir ? (sidx >= t) : (sidx <= t);
        const float wgt = valid ? fexp(e0 + uA[sidx]) : 0.f;
        const float v = sv[r] * wgt;
        sv[r] = v; den += v;
      }
#pragma unroll
      for (int s2 = 0; s2 < 2; ++s2)
#pragma unroll
        for (int e = 0; e < 4; ++e) pk[sb][s2][e] = pack2(sv[8 * s2 + 2 * e], sv[8 * s2 + 2 * e + 1]);
    }
    asm volatile("" ::: "memory");
    den += __shfl_xor(den, 32);
    float qn = 0.f;
#pragma unroll
    for (int ks = 0; ks < 8; ++ks) {
      u32x4 qv = *(const u32x4*)(sqt + ks * 16);
#pragma unroll
      for (int e = 0; e < 4; ++e) {
        qn += bflo(qv[e]) * nA[ks * 16 + 8 * h + 2 * e] + bfhi(qv[e]) * nA[ks * 16 + 8 * h + 2 * e + 1];
      }
    }
    qn += __shfl_xor(qn, 32);
    den += w_inter * qn;
    asm volatile("" ::: "memory");
    const float rden = 1.f / fmaxf(fabsf(den), fexp(-mt));
    const bf16* cs = p.Cst() + (size_t)slot * 16384;
#pragma unroll
    for (int d2 = 0; d2 < 2; ++d2) {
      const int dvb = 2 * dvh + d2;
      f32x16 acc;
#pragma unroll
      for (int r = 0; r < 16; ++r) acc[r] = 0.f;
      bf16x8 cf[8];
#pragma unroll
      for (int ks = 0; ks < 8; ++ks) cf[ks] = *(const bf16x8*)(cs + (dvb * 32 + lq) * 128 + ks * 16 + 8 * h);
      asm volatile("" : "+v"(cf[0]), "+v"(cf[1]), "+v"(cf[2]), "+v"(cf[3]), "+v"(cf[4]), "+v"(cf[5]), "+v"(cf[6]), "+v"(cf[7]));
#pragma unroll
      for (int ks = 0; ks < 8; ++ks) acc = MFMA(cf[ks], *(const bf16x8*)(sqt + ks * 16), acc);
#pragma unroll
      for (int r = 0; r < 16; ++r) acc[r] *= w_inter;
#pragma unroll
      for (int sb = 0; sb < 2; ++sb)
#pragma unroll
        for (int s2 = 0; s2 < 2; ++s2) {
          const bf16* vp = vT + (dvb * 32 + lq) * 72 + sb * 32 + s2 * 16 + 4 * h;
          u32x2 lo = *(const u32x2*)vp, hi = *(const u32x2*)(vp + 8);
          u32x4 av; av[0] = lo[0]; av[1] = lo[1]; av[2] = hi[0]; av[3] = hi[1];
          acc = MFMA(__builtin_bit_cast(bf16x8, av), __builtin_bit_cast(bf16x8, pk[sb][s2]), acc);
        }
#pragma unroll
      for (int r = 0; r < 16; ++r) hacc[d2][r] += acc[r] * rden;
    }
  }
  const int tok = ctok + t;
  float ss = 0.f;
#pragma unroll
  for (int d2 = 0; d2 < 2; ++d2)
#pragma unroll
    for (int g = 0; g < 4; ++g) {
      int dv = (2 * dvh + d2) * 32 + 8 * g + 4 * h;
      u32x2 mo = *(const u32x2*)(p.proj() + (size_t)tok * NPROJ + 4800 + hd * 128 + dv);
      float m0 = bflo(mo[0]), m1 = bfhi(mo[0]), m2 = bflo(mo[1]), m3 = bfhi(mo[1]);
      float v0 = hacc[d2][4 * g] * sigmoid_f(m0), v1 = hacc[d2][4 * g + 1] * sigmoid_f(m1);
      float v2 = hacc[d2][4 * g + 2] * sigmoid_f(m2), v3 = hacc[d2][4 * g + 3] * sigmoid_f(m3);
      hacc[d2][4 * g] = v0; hacc[d2][4 * g + 1] = v1; hacc[d2][4 * g + 2] = v2; hacc[d2][4 * g + 3] = v3;
      ss += v0 * v0 + v1 * v1 + v2 * v2 + v3 * v3;
    }
  ss += __shfl_xor(ss, 32);
  if (h == 0) ssb[dvh * 64 + t] = ss;
  __syncthreads();
  const float rstd = rsqrtf((ssb[t] + ssb[64 + t]) * (1.f / 128.f) + EPS);
  u32x2 zz[2][4]; f32x4 gg[2][4];
#pragma unroll
  for (int d2 = 0; d2 < 2; ++d2)
#pragma unroll
    for (int g = 0; g < 4; ++g) {
      int dv = (2 * dvh + d2) * 32 + 8 * g + 4 * h;
      zz[d2][g] = *(const u32x2*)(p.proj() + (size_t)tok * NPROJ + 5312 + hd * 128 + dv);
      gg[d2][g] = *(const f32x4*)(p.mnorm + l * 512 + hd * 128 + dv);
    }
#pragma unroll
  for (int d2 = 0; d2 < 2; ++d2)
#pragma unroll
    for (int g = 0; g < 4; ++g) {
      int dv = (2 * dvh + d2) * 32 + 8 * g + 4 * h;
      u32x2 z = zz[d2][g];
      f32x4 gn = gg[d2][g];
      float z0 = bflo(z[0]), z1 = bfhi(z[0]), z2 = bflo(z[1]), z3 = bfhi(z[1]);
      u32x2 ov;
      ov[0] = pack2(hacc[d2][4 * g] * rstd * gn[0] * silu_f(z0), hacc[d2][4 * g + 1] * rstd * gn[1] * silu_f(z1));
      ov[1] = pack2(hacc[d2][4 * g + 2] * rstd * gn[2] * silu_f(z2), hacc[d2][4 * g + 3] * rstd * gn[3] * silu_f(z3));
      *(u32x2*)(p.ycat() + (size_t)tok * 1536 + 1024 + hd * 128 + dv) = ov;
    }
}

DI void ckv_fin(const P& p, int l, int tok) {
  const int lane = tidx() & 63;
  const int b = tok >> 8, t = tok & 255;
  float* o = p.out + O_CKV + (size_t)((b * 4 + l) * 256 + t) * 256 + lane * 4;
  u32x2 raw = *(const u32x2*)(p.proj() + (size_t)tok * NPROJ + 384 + lane * 4);
  f32x4 v; v[0] = bflo(raw[0]); v[1] = bfhi(raw[0]); v[2] = bflo(raw[1]); v[3] = bfhi(raw[1]);
  float ss = v[0] * v[0] + v[1] * v[1] + v[2] * v[2] + v[3] * v[3];
#pragma unroll
  for (int of = 32; of >= 1; of >>= 1) ss += __shfl_xor(ss, of);
  const float rstd = rsqrtf(ss * (1.f / 256.f) + EPS);
  f32x4 g = *(const f32x4*)(p.kv_norm + l * 256 + lane * 4);
  v[0] *= rstd * g[0]; v[1] *= rstd * g[1]; v[2] *= rstd * g[2]; v[3] *= rstd * g[3];
  *(f32x4*)o = v;
}

#define XB_TMO      128
#define XB_XCNT(j)  (256  + 64 * (j))
#define XB_XSUB(j)  (1280 + 64 * (j))
#define XB_XGEN(j)  (2304 + 64 * (j))
#define XB_TOP      3328
#define XB_TOPGEN   3392
#define XCD_BAR_WORDS 3456
#define XB_SPIN_CAP (1u << 18)
#define LAS __attribute__((address_space(3)))

__device__ __forceinline__ unsigned xb_ld(unsigned* p)              { return __hip_atomic_load(p, __ATOMIC_RELAXED, __HIP_MEMORY_SCOPE_AGENT); }
__device__ __forceinline__ unsigned xb_add(unsigned* p, unsigned v) { return __hip_atomic_fetch_add(p, v, __ATOMIC_RELAXED, __HIP_MEMORY_SCOPE_AGENT); }
__device__ __forceinline__ unsigned xb_xcc_id() { return (unsigned)__builtin_amdgcn_s_getreg((3 << 11) | 20) & 0xFu; }
#define XB_SPIN(cond, bar) do { unsigned _sp = 0; while (cond) { __builtin_amdgcn_s_sleep(1); \
    if ((++_sp & 255u) == 0u) { if (xb_ld(&(bar)[XB_TMO])) break; if (_sp > XB_SPIN_CAP) { atomicAdd(&(bar)[XB_TMO], 1u); break; } } } } while (0)

struct XcdBarrier {
    unsigned* bar; unsigned x;
    volatile LAS unsigned* st;
};

__device__ __forceinline__ XcdBarrier xcd_barrier_post(unsigned* bar, volatile LAS unsigned* st) {
    XcdBarrier b; b.bar = bar; b.x = xb_xcc_id(); b.st = st;
    if (tidx() == 0) (void)xb_add(&bar[XB_XCNT(b.x)], 1u);
    return b;
}
__device__ __forceinline__ void xcd_barrier_complete(unsigned* bar, unsigned x, unsigned& nloc, unsigned& nx) {
    const unsigned G = gridDim.x * gridDim.y * gridDim.z;
    unsigned sum, cnt, mine, sp = 0u;
    for (;;) {
        sum = 0u; cnt = 0u; mine = 0u;
#pragma unroll
        for (unsigned j = 0; j < 16; ++j) { const unsigned c = xb_ld(&bar[XB_XCNT(j)]); sum += c; cnt += (c > 0u) ? 1u : 0u; mine = (j == x) ? c : mine; }
        if (sum == G) break;
        __builtin_amdgcn_s_sleep(1);
        if ((++sp & 255u) == 0u) { if (xb_ld(&bar[XB_TMO])) break; if (sp > XB_SPIN_CAP) { atomicAdd(&bar[XB_TMO], 1u); break; } }
    }
    nloc = mine > 0u ? mine : 1u; nx = cnt > 0u ? cnt : 1u;
}

__device__ __forceinline__ void xcd_barrier(const XcdBarrier& b) {
    asm volatile("s_waitcnt vmcnt(0)" ::: "memory");
    __syncthreads();
    if (tidx() == 0) {
        unsigned* bar = b.bar;
        __builtin_amdgcn_s_waitcnt(0);
        unsigned nloc = b.st[0], nx = b.st[1];
        if (nloc == 0u) { xcd_barrier_complete(bar, b.x, nloc, nx); b.st[0] = nloc; b.st[1] = nx; }
        const unsigned old = xb_add(&bar[XB_XSUB(b.x)], 1u);
        const unsigned gen = old / nloc;
        if (old + 1u == (gen + 1u) * nloc) {
            __builtin_amdgcn_fence(__ATOMIC_RELEASE, "agent");
            asm volatile("s_waitcnt vmcnt(0)" ::: "memory");
            const unsigned og = xb_add(&bar[XB_TOP], 1u);
            const unsigned tg = og / nx;
            if (og + 1u == (tg + 1u) * nx) xb_add(&bar[XB_TOPGEN], 1u);
            else XB_SPIN(xb_ld(&bar[XB_TOPGEN]) == tg, bar);
            __builtin_amdgcn_fence(__ATOMIC_ACQUIRE, "agent");
            xb_add(&bar[XB_XGEN(b.x)], 1u);
            asm volatile("s_waitcnt vmcnt(0)" ::: "memory");
        } else {
            XB_SPIN(xb_ld(&bar[XB_XGEN(b.x)]) == gen, bar);
            __builtin_amdgcn_fence(__ATOMIC_ACQUIRE, "agent");
            asm volatile("s_waitcnt vmcnt(0)" ::: "memory");
        }
    }
    __syncthreads();
}


DI P launder(const P& p) {
  P q = p;
#define LND(m) { asm volatile("" : "+s"(q.m)); q.m = (decltype(q.m))(__attribute__((address_space(1))) void*)(void*)q.m; }
  LND(x_prompt) LND(x_sample) LND(c_ckv) LND(c_krope) LND(c_dk) LND(c_dv) LND(st_C) LND(st_n) LND(st_m) LND(c) LND(c_ctx)
  LND(g_norm) LND(W_mod) LND(b_mod) LND(W_in) LND(q_norm) LND(W_uq) LND(kv_norm) LND(W_ukv) LND(dlam) LND(dnorm) LND(mconv)
  LND(mgb) LND(mnorm) LND(W_out) LND(g_final) LND(out) LND(ws)
#undef LND
  return q;
}

template <int KIND>
DI void run_phase(const P& p0, int ph, char* smem) {
  const P& p = p0;
  const int G = gridDim.x, B = blockIdx.x, w = wave_of(tidx());
  if ((KIND < 0 || KIND == 0) && ph == 0) { phase_prepass(p, smem); return; }
  if ((KIND < 0 || KIND == 1) && ph == 1) {
    for (int it = B; it < 256 + 2048; it += G) {
      if (it < 256) {
        int mt = it >> 3, nt = it & 7;
        int l = (mt * 128) >> 10;
        f32x16 acc[2][2];
        gemm_core<false>(p.cckv() + (size_t)mt * 128 * 256, 256, p.WukvTp() + (size_t)l * 1024 * 256 + (size_t)nt * 128 * 256, 256, 256, smem, acc);
        epi_kv(p, mt * 128, nt * 128, acc, nullptr, true);
      } else {
        norm_row(p, 0, (it - 256) * 4 + w, 0);
      }
    }
    return;
  }
  const int l = (ph - 2) / 6, sub = (ph - 2) % 6;
  if ((KIND < 0 || KIND == 2) && sub == 0) {
    const int x = B & 7, j = B >> 3, per = G >> 3;
    for (int q = j; q < 6 * 64; q += per) {
      const int r = q >> 6, jj = q & 63;
      const int st = r * 8 + x;
      const int mt = (st / 6) * 8 + (jj >> 3), nt = (st % 6) * 8 + (jj & 7);
      if (nt >= 46) continue;
      f32x16 acc[2][2];
      gemm_core<false>(p.hbuf() + (size_t)mt * 128 * 1024, 1024, p.WinT() + (size_t)l * NPROJ * 1024 + (size_t)nt * 128 * 1024, 1024, 1024, smem, acc);
      epi_inproj(p, l, mt * 128, nt * 128, acc);
    }
  } else if ((KIND < 0 || KIND == 3) && sub == 1) {
    const int N_CH = 1024, N_QA = 64 * 6, N_KV = 64 * 8, N_CF = 1024;
    for (int it = B; it < N_CH + N_QA + N_KV + N_CF; it += G) {
      int u = it;
      __syncthreads();
      if (u < N_CH) { mlstm_local(p, l, u, smem); continue; }
      u -= N_CH;
      if (u < N_QA) {
        int mt = u / 6, nt = u % 6;
        f32x16 acc[2][2];
        gemm_core<true>(p.proj() + (size_t)mt * 128 * NPROJ, NPROJ, p.WuqT() + (size_t)l * 768 * 384 + (size_t)nt * 128 * 384, 384, 384, smem, acc);
        epi_qa(p, mt * 128, nt * 128, acc, (const float*)(smem + 2 * 128 * 72 * 2));
        continue;
      }
      u -= N_QA;
      if (u < N_KV) {
        int mt = u >> 3, nt = u & 7;
        f32x16 acc[2][2];
        gemm_core<true>(p.proj() + (size_t)mt * 128 * NPROJ + 384, NPROJ, p.WukvT() + (size_t)l * 1024 * 256 + (size_t)nt * 128 * 256, 256, 256, smem, acc);
        epi_kv(p, mt * 128, nt * 128, acc, (const float*)(smem + 2 * 128 * 72 * 2), false);
        continue;
      }
      u -= N_KV;
      ckv_fin(p, l, u * 4 + w);
    }
  } else if ((KIND < 0 || KIND == 7) && sub == 2) {
    for (int it = B; it < 640; it += G) mlstm_scan(p, l, it);
  } else if ((KIND < 0 || KIND == 4) && sub == 3) {
    const int x = B & 7;
    int* qctr = p.qc() + ph * 8 + x;
    int* sslot = (int*)(smem + SMEM_BYTES - 16);
    for (;;) {
      __syncthreads();
      if (tidx() == 0) *sslot = atomicAdd(qctr, 1);
      __syncthreads();
      const int q = *sslot;
      if (q >= 192) break;
      __syncthreads();
      if (q < 32) { const int pr = 2 * x + (q >> 4); mla_item(p, l, pr * 16 + (q & 15), smem); }
      else if (q < 64) { const int u = q - 32; const int pr = 2 * x + (u >> 4); diff_item(p, l, pr * 16 + (u & 15), smem); }
      else if (q < 128) mlstm_out(p, l, x * 64 + (q - 64), smem);
      else if (q < 160) { const int u = q - 128; const int pr = 8 * x + (u >> 2); mla_item(p, l, 256 + pr * 4 + (u & 3), smem); }
      else { const int u = q - 160; const int pr = 8 * x + (u >> 2); diff_item(p, l, 256 + pr * 4 + (u & 3), smem); }
    }
  } else if ((KIND < 0 || KIND == 5) && sub == 4) {
    const int x = B & 7, j = B >> 3, per = G >> 3;
    for (int q = j; q < 64; q += per) {
      const int mt = x * 8 + (q >> 3), nt = q & 7;
      f32x16 acc[2][2];
      gemm_core<false>(p.ycat() + (size_t)mt * 128 * 1536, 1536, p.WoutT() + (size_t)l * 1024 * 1536 + (size_t)nt * 128 * 1536, 1536, 1536, smem, acc);
      epi_out(p, l, mt * 128, nt * 128, acc);
    }
  } else if ((KIND < 0 || KIND == 6) && sub == 5) {
    for (int it = B; it < 2048; it += G) {
      if (l < 3) norm_row(p, l + 1, it * 4 + w, 0);
      else norm_row(p, 0, it * 4 + w, 1);
    }
  }
}

#if COOP
__global__ void __launch_bounds__(256, 2) mega(P p, int lo, int hi, int coop) {
  __shared__ __attribute__((aligned(16))) char smem[SMEM_BYTES];
  __shared__ uint4 xb_words;
  if (threadIdx.x == 0) xb_words = make_uint4(0u, 0u, 0u, 0u);
  tidx_init();
  XcdBarrier xb = xcd_barrier_post((unsigned*)p.ctr(), (volatile LAS unsigned*)&xb_words);
  for (int ph = lo; ph < hi; ++ph) {
    run_phase<-1>(p, ph, smem);
    if (PROBE_DUP) {
      const int kind = ph < 2 ? ph : 2 + (ph - 2) % 6;
      if ((PROBE_DUP >> kind) & 1) { xcd_barrier(xb); run_phase<-1>(p, ph, smem); }
    }
    if (ph + 1 < hi) xcd_barrier(xb);
  }
  if (coop == 2) cg::this_grid().sync();
}
#endif
template <int KIND>
__global__ void __launch_bounds__(256) phase_k(P p, int ph) {
  __shared__ __attribute__((aligned(16))) char smem[SMEM_BYTES];
  tidx_init();
  run_phase<KIND>(p, ph, smem);
}

extern "C" void kernel_launch(void* const* d_in, const int* in_sizes, int n_in, void* d_out, int out_size, void* d_ws,
                              size_t ws_size, hipStream_t stream) {
  P p{};
  const float** ins = (const float**)&p;
  for (int i = 0; i < 26; ++i) ins[i] = (const float*)d_in[i];
  p.out = (float*)d_out;
  p.ws = (char*)d_ws;
  if (WS_TOTAL > ws_size) { fprintf(stderr, "workspace too small: need %zu have %zu\n", (size_t)WS_TOTAL, ws_size); return; }

#if COOP
  static int grid_blocks = 0;
  if (!grid_blocks) {
    int dev = 0, cus = 0, per_cu = 0;
    (void)hipGetDevice(&dev);
    (void)hipDeviceGetAttribute(&cus, hipDeviceAttributeMultiprocessorCount, dev);
    (void)hipOccupancyMaxActiveBlocksPerMultiprocessor(&per_cu, mega, 256, 0);
    if (per_cu > 2) per_cu = 2;
    grid_blocks = cus * per_cu;
  }
  (void)hipMemsetAsync(p.ws + OFF_ctr, 0, 16384 + 4096, stream);
  int lo = 0, hi = NPHASE, coop = 1;
  void* args[] = {&p, &lo, &hi, &coop};
  hipError_t e = hipLaunchCooperativeKernel((void*)mega, dim3(grid_blocks), dim3(256), args, 0, stream);
  if (e != hipSuccess) fprintf(stderr, "cooperative launch failed: %s (grid %d)\n", hipGetErrorString(e), grid_blocks);
#else
  for (int ph = 0; ph < NPHASE; ++ph) {
    static const int kmap[6] = {2, 3, 7, 4, 5, 6};
    int kind = ph < 2 ? ph : kmap[(ph - 2) % 6];
    switch (kind) {
      case 0: phase_k<0><<<512, 256, 0, stream>>>(p, ph); break;
      case 1: phase_k<1><<<512, 256, 0, stream>>>(p, ph); break;
      case 2: phase_k<2><<<512, 256, 0, stream>>>(p, ph); break;
      case 3: phase_k<3><<<512, 256, 0, stream>>>(p, ph); break;
      case 4: phase_k<4><<<512, 256, 0, stream>>>(p, ph); break;
      case 5: phase_k<5><<<512, 256, 0, stream>>>(p, ph); break;
      case 7: phase_k<7><<<512, 256, 0, stream>>>(p, ph); break;
      default: phase_k<6><<<512, 256, 0, stream>>>(p, ph); break;
    }
  }
#endif
}
```

```cpp
#include <hip/hip_runtime.h>
#include <hip/hip_cooperative_groups.h>
#include <cstdio>
namespace cg = cooperative_groups;

typedef unsigned short bf16;
typedef __attribute__((ext_vector_type(8))) short bf16x8;
typedef __attribute__((ext_vector_type(4))) short s16x4;
typedef __attribute__((ext_vector_type(16))) float f32x16;
typedef __attribute__((ext_vector_type(4))) float f32x4;
typedef __attribute__((ext_vector_type(4))) unsigned u32x4;
typedef __attribute__((ext_vector_type(2))) unsigned u32x2;

#define DI __device__ __forceinline__
#define MFMA(a, b, c) __builtin_amdgcn_mfma_f32_32x32x16_bf16((a), (b), (c), 0, 0, 0)

#ifndef COOP
#define COOP 1
#endif
#define PROBE_DUP 0

constexpr int NTOK = 8192;
constexpr int NPROJ = 5888;
constexpr int NPHASE = 26;
constexpr float EPS = 1e-6f;
constexpr int SMEM_BYTES = 56 * 1024;

constexpr size_t O_YP = 0, O_YS = 4194304, O_CKV = 8388608, O_KROPE = 12582912, O_DK = 13631488,
                 O_DV = 22020096, O_MC = 30408704, O_MN = 38797312, O_MM = 38862848;

constexpr size_t al256(size_t x) { return (x + 255) & ~(size_t)255; }
constexpr size_t OFF_WinT = 0;
constexpr size_t OFF_WuqT = OFF_WinT + al256((size_t)4 * NPROJ * 1024 * 2);
constexpr size_t OFF_WukvT = OFF_WuqT + al256((size_t)4 * 768 * 384 * 2);
constexpr size_t OFF_WukvTp = OFF_WukvT + al256((size_t)4 * 1024 * 256 * 2);
constexpr size_t OFF_WoutT = OFF_WukvTp + al256((size_t)4 * 1024 * 256 * 2);
constexpr size_t OFF_mod = OFF_WoutT + al256((size_t)4 * 1024 * 1536 * 2);
constexpr size_t OFF_ropec = OFF_mod + al256((size_t)4 * 5 * 3072 * 4);
constexpr size_t OFF_ropes = OFF_ropec + al256((size_t)1024 * 32 * 4);
constexpr size_t OFF_lam = OFF_ropes + al256((size_t)1024 * 32 * 4);
constexpr size_t OFF_hbuf = OFF_lam + al256((size_t)256);
constexpr size_t OFF_xbuf = OFF_hbuf + al256((size_t)NTOK * 1024 * 2);
constexpr size_t OFF_proj = OFF_xbuf + al256((size_t)NTOK * 1024 * 4);
constexpr size_t OFF_Qa = OFF_proj + al256((size_t)NTOK * NPROJ * 2);
constexpr size_t OFF_Ka = OFF_Qa + al256((size_t)NTOK * 768 * 2);
constexpr size_t OFF_VaT = OFF_Ka + al256((size_t)NTOK * 768 * 2);
constexpr size_t OFF_Kb = OFF_VaT + al256((size_t)NTOK * 512 * 2);
constexpr size_t OFF_VbT = OFF_Kb + al256((size_t)NTOK * 512 * 2);
constexpr size_t OFF_VmT = OFF_VbT + al256((size_t)NTOK * 512 * 2);
constexpr size_t OFF_ycat = OFF_VmT + al256((size_t)NTOK * 512 * 2);
constexpr size_t OFF_gates = OFF_ycat + al256((size_t)NTOK * 1536 * 2);
constexpr size_t OFF_Cst = OFF_gates + al256((size_t)NTOK * 16 * 4);
constexpr size_t OFF_nst = OFF_Cst + al256((size_t)1024 * 16384 * 2);
constexpr size_t OFF_mst = OFF_nst + al256((size_t)1024 * 128 * 4);
constexpr size_t OFF_cckv = OFF_mst + al256((size_t)1024 * 4);
constexpr size_t OFF_cKa = OFF_cckv + al256((size_t)4096 * 256 * 2);
constexpr size_t OFF_cVaT = OFF_cKa + al256((size_t)64 * 256 * 192 * 2);
constexpr size_t OFF_cKb = OFF_cVaT + al256((size_t)64 * 128 * 256 * 2);
constexpr size_t OFF_cVbT = OFF_cKb + al256((size_t)64 * 256 * 128 * 2);
constexpr size_t OFF_blA = OFF_cVbT + al256((size_t)64 * 128 * 256 * 2);
constexpr size_t OFF_mlA = OFF_blA + 4096;
constexpr size_t OFF_ctr = OFF_mlA + 4096;
constexpr size_t OFF_qc = OFF_ctr + 16384;
constexpr size_t WS_TOTAL = OFF_qc + 4096;
struct P {
  const float *x_prompt, *x_sample, *c_ckv, *c_krope, *c_dk, *c_dv, *st_C, *st_n, *st_m, *c, *c_ctx, *g_norm, *W_mod,
      *b_mod, *W_in, *q_norm, *W_uq, *kv_norm, *W_ukv, *dlam, *dnorm, *mconv, *mgb, *mnorm, *W_out, *g_final;
  float* out;
  char* ws;
  __device__ __forceinline__ bf16* WinT() const { return (bf16*)(ws + OFF_WinT); }
  __device__ __forceinline__ bf16* WuqT() const { return (bf16*)(ws + OFF_WuqT); }
  __device__ __forceinline__ bf16* WukvT() const { return (bf16*)(ws + OFF_WukvT); }
  __device__ __forceinline__ bf16* WukvTp() const { return (bf16*)(ws + OFF_WukvTp); }
  __device__ __forceinline__ bf16* WoutT() const { return (bf16*)(ws + OFF_WoutT); }
  __device__ __forceinline__ float* mod() const { return (float*)(ws + OFF_mod); }
  __device__ __forceinline__ float* ropec() const { return (float*)(ws + OFF_ropec); }
  __device__ __forceinline__ float* ropes() const { return (float*)(ws + OFF_ropes); }
  __device__ __forceinline__ float* lam() const { return (float*)(ws + OFF_lam); }
  __device__ __forceinline__ bf16* hbuf() const { return (bf16*)(ws + OFF_hbuf); }
  __device__ __forceinline__ float* xbuf() const { return (float*)(ws + OFF_xbuf); }
  __device__ __forceinline__ bf16* proj() const { return (bf16*)(ws + OFF_proj); }
  __device__ __forceinline__ bf16* Qa() const { return (bf16*)(ws + OFF_Qa); }
  __device__ __forceinline__ bf16* Ka() const { return (bf16*)(ws + OFF_Ka); }
  __device__ __forceinline__ bf16* VaT() const { return (bf16*)(ws + OFF_VaT); }
  __device__ __forceinline__ bf16* Kb() const { return (bf16*)(ws + OFF_Kb); }
  __device__ __forceinline__ bf16* VbT() const { return (bf16*)(ws + OFF_VbT); }
  __device__ __forceinline__ bf16* VmT() const { return (bf16*)(ws + OFF_VmT); }
  __device__ __forceinline__ bf16* ycat() const { return (bf16*)(ws + OFF_ycat); }
  __device__ __forceinline__ float* gates() const { return (float*)(ws + OFF_gates); }
  __device__ __forceinline__ bf16* Cst() const { return (bf16*)(ws + OFF_Cst); }
  __device__ __forceinline__ float* nst() const { return (float*)(ws + OFF_nst); }
  __device__ __forceinline__ float* mst() const { return (float*)(ws + OFF_mst); }
  __device__ __forceinline__ bf16* cckv() const { return (bf16*)(ws + OFF_cckv); }
  __device__ __forceinline__ bf16* cKa() const { return (bf16*)(ws + OFF_cKa); }
  __device__ __forceinline__ bf16* cVaT() const { return (bf16*)(ws + OFF_cVaT); }
  __device__ __forceinline__ bf16* cKb() const { return (bf16*)(ws + OFF_cKb); }
  __device__ __forceinline__ bf16* cVbT() const { return (bf16*)(ws + OFF_cVbT); }
  __device__ __forceinline__ int* ctr() const { return (int*)(ws + OFF_ctr); }
  __device__ __forceinline__ int* qc() const { return (int*)(ws + OFF_qc); }
  __device__ __forceinline__ float* blA() const { return (float*)(ws + OFF_blA); }
  __device__ __forceinline__ float* mlA() const { return (float*)(ws + OFF_mlA); }
};

DI int tidx() { int t = threadIdx.x; asm volatile("" : "+v"(t)); return t; }
DI void tidx_init() {}
DI int wave_of(int tid) { return __builtin_amdgcn_readfirstlane(tid >> 6); }
typedef __attribute__((ext_vector_type(2))) __bf16 bf16v2;
typedef __attribute__((ext_vector_type(2))) float f32x2;
DI unsigned pack2(float a, float b) {
  f32x2 v; v[0] = a; v[1] = b;
  return __builtin_bit_cast(unsigned, __builtin_convertvector(v, bf16v2));
}
DI bf16 f2bf(float x) { return (bf16)(pack2(x, 0.f) & 0xffffu); }
DI float bf2f(bf16 b) { return __uint_as_float(((unsigned)b) << 16); }
DI float fexp2(float x) { return __builtin_amdgcn_exp2f(x); }
DI float fexp(float x) { return __builtin_amdgcn_exp2f(x * 1.4426950408889634f); }
DI float bflo(unsigned u) { return __uint_as_float(u << 16); }
DI float bfhi(unsigned u) { return __uint_as_float(u & 0xffff0000u); }
DI float silu_f(float x) { return x * __builtin_amdgcn_rcpf(1.f + fexp(-x)); }
DI float sigmoid_f(float x) { return __builtin_amdgcn_rcpf(1.f + fexp(-x)); }
DI float logsig_f(float x) { return fminf(x, 0.f) - log1pf(fexp(-fabsf(x))); }

struct TokInfo { int lat, b, t, T, tok0, modj; };
DI TokInfo tinfo(int tok) {
  TokInfo r;
  if (tok < 4096) { r.lat = 0; r.b = tok >> 8; r.t = tok & 255; r.T = 256; r.tok0 = tok & ~255; r.modj = 0; }
  else { int u = tok - 4096; r.lat = 1; r.b = u >> 10; r.t = u & 1023; r.T = 1024; r.tok0 = 4096 + (u & ~1023); r.modj = 1 + r.b; }
  return r;
}

struct GR { u32x4 ra0[4], rb0[4], ra1[4], rb1[4]; };
DI void gemm_load2(GR& g, const bf16* __restrict__ A, int lda, const bf16* __restrict__ Bt, int ldb) {
  const int tid = tidx();
  const int lr = tid >> 3, lc = tid & 7;
  const bf16* ap = A + (size_t)lr * lda + lc * 8;
  const bf16* bp = Bt + (size_t)lr * ldb + lc * 8;
  const size_t a32 = (size_t)32 * lda, b32 = (size_t)32 * ldb;
#pragma unroll
  for (int i = 0; i < 4; ++i) { g.ra0[i] = *(const u32x4*)(ap + i * a32); g.rb0[i] = *(const u32x4*)(bp + i * b32); }
#pragma unroll
  for (int i = 0; i < 4; ++i) { g.ra1[i] = *(const u32x4*)(ap + 64 + i * a32); g.rb1[i] = *(const u32x4*)(bp + 64 + i * b32); }
}
template <bool ROWSS>
DI void gemm_core_n(GR& g, const bf16* __restrict__ A, int lda, const bf16* __restrict__ Bt, int ldb,
                    const bf16* __restrict__ An, const bf16* __restrict__ Btn, int K, char* smem, f32x16 (&acc)[2][2]) {
  bf16* sA = (bf16*)smem;
  bf16* sB = sA + 128 * 72;
  float* sRow = (float*)(sB + 128 * 72);
  const int tid = tidx(), lane = tid & 63, w = wave_of(tid);
  const int wm = w >> 1, wn = w & 1, lq = lane & 31, h = lane >> 5;
  const int lr = tid >> 3, lc = tid & 7;
  float ss[4] = {0.f, 0.f, 0.f, 0.f};
#pragma unroll
  for (int i = 0; i < 2; ++i)
#pragma unroll
    for (int j = 0; j < 2; ++j)
#pragma unroll
      for (int r = 0; r < 16; ++r) acc[i][j][r] = 0.f;
  const bf16* ap = A + (size_t)lr * lda + lc * 8;
  const bf16* bp = Bt + (size_t)lr * ldb + lc * 8;
  const bf16* apn = An + (size_t)lr * lda + lc * 8;
  const bf16* bpn = Btn + (size_t)lr * ldb + lc * 8;
  const size_t a32 = (size_t)32 * lda, b32 = (size_t)32 * ldb;
  const int nk = K >> 6;
  auto step = [&](u32x4 (&ra)[4], u32x4 (&rb)[4], int kt) {
    if (kt) __syncthreads();
#pragma unroll
    for (int i = 0; i < 4; ++i) {
      *(u32x4*)(sA + (lr + 32 * i) * 72 + lc * 8) = ra[i];
      *(u32x4*)(sB + (lr + 32 * i) * 72 + lc * 8) = rb[i];
    }
    if (ROWSS) {
#pragma unroll
      for (int i = 0; i < 4; ++i)
#pragma unroll
        for (int e = 0; e < 4; ++e) {
          float a0 = bflo(ra[i][e]), a1 = bfhi(ra[i][e]);
          ss[i] += a0 * a0 + a1 * a1;
        }
    }
    __syncthreads();
    {
      const int kn = kt + 2;
      const bf16* ap2 = (kn < nk) ? ap + (size_t)kn * 64 : apn + (size_t)(kn - nk) * 64;
      const bf16* bp2 = (kn < nk) ? bp + (size_t)kn * 64 : bpn + (size_t)(kn - nk) * 64;
#pragma unroll
      for (int i = 0; i < 4; ++i) { ra[i] = *(const u32x4*)(ap2 + i * a32); rb[i] = *(const u32x4*)(bp2 + i * b32); }
    }
#pragma unroll
    for (int ks = 0; ks < 4; ++ks) {
      bf16x8 af[2], bfr[2];
#pragma unroll
      for (int i = 0; i < 2; ++i) af[i] = *(const bf16x8*)(sA + (wm * 64 + i * 32 + lq) * 72 + ks * 16 + h * 8);
#pragma unroll
      for (int j = 0; j < 2; ++j) bfr[j] = *(const bf16x8*)(sB + (wn * 64 + j * 32 + lq) * 72 + ks * 16 + h * 8);
#pragma unroll
      for (int i = 0; i < 2; ++i)
#pragma unroll
        for (int j = 0; j < 2; ++j) acc[i][j] = MFMA(af[i], bfr[j], acc[i][j]);
    }
  };
  for (int kt = 0; kt < nk; kt += 2) {
    step(g.ra0, g.rb0, kt);
    step(g.ra1, g.rb1, kt + 1);
  }
  if (ROWSS) {
#pragma unroll
    for (int i = 0; i < 4; ++i) {
      float v = ss[i];
      v += __shfl_xor(v, 1); v += __shfl_xor(v, 2); v += __shfl_xor(v, 4);
      if (lc == 0) sRow[lr + 32 * i] = v;
    }
  }
  __syncthreads();
}
template <bool ROWSS>
DI void gemm_core(const bf16* __restrict__ A, int lda, const bf16* __restrict__ Bt, int ldb, int K, char* smem,
                  f32x16 (&acc)[2][2]) {
  GR g;
  gemm_load2(g, A, lda, Bt, ldb);
  gemm_core_n<ROWSS>(g, A, lda, Bt, ldb, A, Bt, K, smem, acc);
}

DI void store_vt4(bf16* VT, size_t idx, float a, float b, float c, float d) {
  u32x2 v; v[0] = pack2(a, b); v[1] = pack2(c, d);
  *(u32x2*)(VT + idx) = v;
}

DI void transpose_tile(const float* __restrict__ src, int N, int Nvalid, bf16* __restrict__ dst, int K, int k0, int n0,
                       const float* __restrict__ gk, bf16* __restrict__ dst2, char* smem) {
  float* t = (float*)smem;
  const int tid = tidx();
#pragma unroll
  for (int i = 0; i < 4; ++i) {
    int idx = tid + 256 * i; int r = idx >> 4, c = (idx & 15) * 4;
    int n = n0 + c;
    f32x4 v = {0.f, 0.f, 0.f, 0.f};
    if (n < Nvalid) v = __builtin_nontemporal_load((const f32x4*)(src + (size_t)(k0 + r) * N + n));
    t[r * 65 + c] = v[0]; t[r * 65 + c + 1] = v[1]; t[r * 65 + c + 2] = v[2]; t[r * 65 + c + 3] = v[3];
  }
  __syncthreads();
  const int c2h = (tid & 31) * 2;
  const float gk0 = gk ? gk[k0 + c2h] : 1.f, gk1 = gk ? gk[k0 + c2h + 1] : 1.f;
#pragma unroll
  for (int i = 0; i < 8; ++i) {
    int idx = tid + 256 * i; int r = idx >> 5, c2 = (idx & 31) * 2;
    float v0 = t[c2 * 65 + r], v1 = t[(c2 + 1) * 65 + r];
    if (dst2) *(unsigned*)(dst2 + (size_t)(n0 + r) * K + k0 + c2) = pack2(v0, v1);
    v0 *= gk0; v1 *= gk1;
    *(unsigned*)(dst + (size_t)(n0 + r) * K + k0 + c2) = pack2(v0, v1);
  }
  __syncthreads();
}

DI void mod_item(const P& p, int it, char* smem) {
  float* sl = (float*)smem;
  float* red = sl + 5 * 1024;
  const int tid = tidx(), lane = tid & 63, w = wave_of(tid);
  const int l = it / 48, n0 = (it % 48) * 64;
  for (int idx = tid; idx < 5120; idx += 256) {
    int j = idx >> 10, k = idx & 1023;
    float cv = (j == 0) ? p.c_ctx[k] : p.c[(j - 1) * 1024 + k];
    sl[idx] = silu_f(cv);
  }
  __syncthreads();
  float a[5] = {0.f, 0.f, 0.f, 0.f, 0.f};
  const float* wp = p.W_mod + (size_t)l * 1024 * 3072 + n0 + lane;
  for (int k = w * 256; k < w * 256 + 256; k += 16) {
    float wv[16];
#pragma unroll
    for (int u = 0; u < 16; ++u) wv[u] = __builtin_nontemporal_load(wp + (size_t)(k + u) * 3072);
#pragma unroll
    for (int u = 0; u < 16; ++u)
#pragma unroll
      for (int j = 0; j < 5; ++j) a[j] += sl[j * 1024 + k + u] * wv[u];
  }
#pragma unroll
  for (int j = 0; j < 5; ++j) red[(w * 5 + j) * 64 + lane] = a[j];
  __syncthreads();
  for (int idx = tid; idx < 320; idx += 256) {
    int j = idx >> 6, c = idx & 63;
    float s = red[(0 * 5 + j) * 64 + c] + red[(1 * 5 + j) * 64 + c] + red[(2 * 5 + j) * 64 + c] + red[(3 * 5 + j) * 64 + c];
    p.mod()[(size_t)(l * 5 + j) * 3072 + n0 + c] = s + p.b_mod[l * 3072 + n0 + c];
  }
  __syncthreads();
}

DI void phase_prepass(const P& p, char* smem) {
  const int G = gridDim.x, B = blockIdx.x, tid = tidx();
  const int N_MOD = 192, N_WIN = 4 * 92 * 16, N_WOUT = 4 * 16 * 24, N_WUQ = 4 * 12 * 6, N_WUKV = 4 * 16 * 4;
  const int total = N_MOD + N_WIN + N_WOUT + N_WUQ + N_WUKV;
  for (int it = B; it < total; it += G) {
    int u = it;
    if (u < N_MOD) { mod_item(p, u, smem); continue; }
    u -= N_MOD;
    if (u < N_WIN) {
      int l = u / (92 * 16), r = u % (92 * 16), nt = r / 16, kt = r % 16;
      transpose_tile(p.W_in + (size_t)l * 1024 * 5840, 5840, 5840, p.WinT() + (size_t)l * NPROJ * 1024, 1024, kt * 64, nt * 64, nullptr, nullptr, smem);
      continue;
    }
    u -= N_WIN;
    if (u < N_WOUT) {
      int l = u / (16 * 24), r = u % (16 * 24), nt = r / 24, kt = r % 24;
      transpose_tile(p.W_out + (size_t)l * 1536 * 1024, 1024, 1024, p.WoutT() + (size_t)l * 1024 * 1536, 1536, kt * 64, nt * 64, nullptr, nullptr, smem);
      continue;
    }
    u -= N_WOUT;
    if (u < N_WUQ) {
      int l = u / 72, r = u % 72, nt = r / 6, kt = r % 6;
      transpose_tile(p.W_uq + (size_t)l * 384 * 768, 768, 768, p.WuqT() + (size_t)l * 768 * 384, 384, kt * 64, nt * 64, p.q_norm + l * 384, nullptr, smem);
      continue;
    }
    u -= N_WUQ;
    {
      int l = u / 64, r = u % 64, nt = r / 4, kt = r % 4;
      transpose_tile(p.W_ukv + (size_t)l * 256 * 1024, 1024, 1024, p.WukvT() + (size_t)l * 1024 * 256, 256, kt * 64, nt * 64, p.kv_norm + l * 256, p.WukvTp() + (size_t)l * 1024 * 256, smem);
    }
  }
  const int gtid = B * 256 + tid, gsz = G * 256;
  for (int idx = gtid; idx < 1024 * 32; idx += gsz) {
    int t = idx >> 5, i = idx & 31;
    float pos = (i < 16) ? (float)(t >> 6) : (float)(t & 63);
    float inv = powf(10000.f, -(float)(i & 15) / 16.f);
    float ang = pos * inv;
    p.ropec()[idx] = cosf(ang); p.ropes()[idx] = sinf(ang);
  }
  if (gtid < 4) {
    int l = gtid; const float* lp = p.dlam + l * 256;
    float s1 = 0.f, s2 = 0.f;
    for (int i = 0; i < 64; ++i) { s1 += lp[i] * lp[64 + i]; s2 += lp[128 + i] * lp[192 + i]; }
    float lam_init = 0.8f - 0.6f * expf(-0.3f * (float)l);
    p.lam()[l] = expf(s1) - expf(s2) + lam_init;
  }
  for (int idx = gtid; idx < 4 * 4 * 256 * 256; idx += gsz) {
    int d = idx & 255, t = (idx >> 8) & 255, b = (idx >> 16) & 3, l = idx >> 18;
    p.cckv()[idx] = f2bf(p.c_ckv[(size_t)((b * 4 + l) * 256 + t) * 256 + d]);
  }
  for (int idx = gtid; idx < 4 * 4 * 4 * 256 * 64; idx += gsz) {
    int r = idx & 63, t = (idx >> 6) & 255, hd = (idx >> 14) & 3, b = (idx >> 16) & 3, l = idx >> 18;
    p.cKa()[(size_t)((((l * 4 + b) * 4 + hd) * 256) + t) * 192 + 128 + r] = f2bf(p.c_krope[(size_t)((b * 4 + l) * 256 + t) * 64 + r]);
  }
  for (int idx = gtid; idx < 4 * 4 * 4 * 256 * 128; idx += gsz) {
    int d = idx & 127, t = (idx >> 7) & 255, hd = (idx >> 15) & 3, b = (idx >> 17) & 3, l = idx >> 19;
    p.cKb()[idx] = f2bf(p.c_dk[(size_t)(((b * 4 + l) * 256 + t) * 4 + hd) * 128 + d]);
  }
  for (int idx = gtid; idx < 4 * 4 * 4 * 128 * 256; idx += gsz) {
    int t = idx & 255, d = (idx >> 8) & 127, hd = (idx >> 15) & 3, b = (idx >> 17) & 3, l = idx >> 19;
    p.cVbT()[idx] = f2bf(p.c_dv[(size_t)(((b * 4 + l) * 256 + t) * 4 + hd) * 128 + d]);
  }
}

DI void norm_row(const P& p, int l, int tok, int mode) {
  const int lane = tidx() & 63;
  TokInfo ti = tinfo(tok);
  const float* x;
  if (mode == 0 && l == 0) x = ti.lat ? (p.x_sample + (size_t)(tok - 4096) * 1024) : (p.x_prompt + (size_t)tok * 1024);
  else x = p.xbuf() + (size_t)tok * 1024;
  f32x4 v[4];
  float ss = 0.f;
#pragma unroll
  for (int i = 0; i < 4; ++i) {
    v[i] = *(const f32x4*)(x + i * 256 + lane * 4);
    ss += v[i][0] * v[i][0] + v[i][1] * v[i][1] + v[i][2] * v[i][2] + v[i][3] * v[i][3];
  }
#pragma unroll
  for (int o = 32; o >= 1; o >>= 1) ss += __shfl_xor(ss, o);
  const float rstd = rsqrtf(ss * (1.f / 1024.f) + EPS);
  if (mode == 0) {
    const float* g = p.g_norm + l * 1024;
    const float* md = p.mod() + (size_t)(l * 5 + ti.modj) * 3072;
#pragma unroll
    for (int i = 0; i < 4; ++i) {
      int c = i * 256 + lane * 4;
      f32x4 gv = *(const f32x4*)(g + c), sh = *(const f32x4*)(md + c), sc = *(const f32x4*)(md + 1024 + c);
      float o0 = v[i][0] * rstd * gv[0] * (1.f + sc[0]) + sh[0];
      float o1 = v[i][1] * rstd * gv[1] * (1.f + sc[1]) + sh[1];
      float o2 = v[i][2] * rstd * gv[2] * (1.f + sc[2]) + sh[2];
      float o3 = v[i][3] * rstd * gv[3] * (1.f + sc[3]) + sh[3];
      u32x2 pk; pk[0] = pack2(o0, o1); pk[1] = pack2(o2, o3);
      *(u32x2*)(p.hbuf() + (size_t)tok * 1024 + c) = pk;
    }
  } else {
    float* o = p.out + (ti.lat ? (O_YS + (size_t)(tok - 4096) * 1024) : (O_YP + (size_t)tok * 1024));
#pragma unroll
    for (int i = 0; i < 4; ++i) {
      int c = i * 256 + lane * 4;
      f32x4 gv = *(const f32x4*)(p.g_final + c);
      f32x4 r; r[0] = v[i][0] * rstd * gv[0]; r[1] = v[i][1] * rstd * gv[1]; r[2] = v[i][2] * rstd * gv[2]; r[3] = v[i][3] * rstd * gv[3];
      *(f32x4*)(o + c) = r;
    }
  }
}

DI void img_put(bf16* img, const f32x16 (&acc)[2][2], int wm, int wn, int lq, int h) {
#pragma unroll
  for (int i = 0; i < 2; ++i)
#pragma unroll
    for (int j = 0; j < 2; ++j)
#pragma unroll
      for (int r = 0; r < 16; ++r)
        img[(wm * 64 + i * 32 + 8 * (r >> 2) + 4 * h + (r & 3)) * 136 + wn * 64 + j * 32 + lq] = f2bf(acc[i][j][r]);
}
DI void img_copy(const bf16* img, int half, bf16* dst, size_t stride, int tid) {
  u32x4 v[4];
#pragma unroll
  for (int i = 0; i < 4; ++i) { int idx = tid + 256 * i; int r = idx >> 3, c16 = idx & 7; v[i] = *(const u32x4*)(img + r * 136 + half * 64 + c16 * 8); }
#pragma unroll
  for (int i = 0; i < 4; ++i) { int idx = tid + 256 * i; int r = idx >> 3, c16 = idx & 7; *(u32x4*)(dst + (size_t)r * stride + c16 * 8) = v[i]; }
}
DI bool inproj_rm(int cb) { return !((cb >= 35 && cb <= 42) || (cb >= 67 && cb <= 74) || cb == 91); }

DI void epi_inproj(const P& p, int l, int m0, int n0, f32x16 (&acc)[2][2], char* smem) {
  const int tid_ = tidx(); const int lane = tid_ & 63, w = wave_of(tid_), wm = w >> 1, wn = w & 1, lq = lane & 31, h = lane >> 5;
  const int mb = m0 + wm * 64, nb = n0 + wn * 64;
  const int cb = nb >> 6;
  bf16* img = (bf16*)smem;
  TokInfo tb = tinfo(mb);
  const bool lat = tb.lat;
  if (!lat && (cb == 10 || (cb >= 27 && cb <= 34))) {
    float* ob = (cb == 10) ? p.out + O_KROPE + (size_t)((tb.b * 4 + l) * 256) * 64
                           : p.out + O_DK + (size_t)((tb.b * 4 + l) * 256) * 512 + (cb - 27) * 64;
    const int ostr = (cb == 10) ? 64 : 512;
#pragma unroll
    for (int i = 0; i < 2; ++i)
#pragma unroll
      for (int j = 0; j < 2; ++j)
#pragma unroll
        for (int r = 0; r < 16; ++r) {
          int tl = tb.t + i * 32 + 8 * (r >> 2) + 4 * h + (r & 3);
          ob[(size_t)tl * ostr + j * 32 + lq] = acc[i][j][r];
        }
  }
  const bool ropeT = lat && (cb == 10 || (cb >= 19 && cb <= 34));
  if (ropeT) {
#pragma unroll
    for (int i = 0; i < 2; ++i) {
      float cs[16], sn[16];
#pragma unroll
      for (int r = 0; r < 16; ++r) {
        int t = tb.t + i * 32 + 8 * (r >> 2) + 4 * h + (r & 3);
        cs[r] = p.ropec()[t * 32 + lq]; sn[r] = p.ropes()[t * 32 + lq];
      }
#pragma unroll
      for (int r = 0; r < 16; ++r) {
        float x1 = acc[i][0][r], x2 = acc[i][1][r];
        acc[i][0][r] = x1 * cs[r] - x2 * sn[r];
        acc[i][1][r] = x1 * sn[r] + x2 * cs[r];
      }
    }
  }
  if (inproj_rm(cb)) {
    img_put(img, acc, wm, wn, lq, h);
  } else if (cb == 91) {
    if (lq < 16) {
      float bias = p.mgb[l * 16 + lq];
#pragma unroll
      for (int i = 0; i < 2; ++i)
#pragma unroll
        for (int r = 0; r < 16; ++r) {
          int row = mb + i * 32 + 8 * (r >> 2) + 4 * h + (r & 3);
          p.gates()[row * 16 + lq] = acc[i][0][r] + bias;
        }
    }
  } else {
    const bool isdv = cb <= 42;
    int cc = isdv ? cb - 35 : cb - 67;
    int hd = cc >> 1, sub = cc & 1;
    bf16* VT = isdv ? p.VbT() : p.VmT();
#pragma unroll
    for (int i = 0; i < 2; ++i)
#pragma unroll
      for (int j = 0; j < 2; ++j) {
        int d = sub * 64 + j * 32 + lq;
#pragma unroll
        for (int g = 0; g < 4; ++g) {
          int tl = tb.t + i * 32 + 8 * g + 4 * h;
          store_vt4(VT, (size_t)tb.tok0 * 512 + (size_t)(hd * 128 + d) * tb.T + tl, acc[i][j][4 * g], acc[i][j][4 * g + 1], acc[i][j][4 * g + 2], acc[i][j][4 * g + 3]);
          if (isdv && !lat) {
#pragma unroll
            for (int jj = 0; jj < 4; ++jj)
              p.out[O_DV + (size_t)((tb.b * 4 + l) * 256 + tl + jj) * 512 + cc * 64 + j * 32 + lq] = acc[i][j][4 * g + jj];
          }
        }
      }
  }
  __syncthreads();
#pragma unroll
  for (int half = 0; half < 2; ++half) {
    const int cbh = (n0 >> 6) + half;
    if (!inproj_rm(cbh)) continue;
    if (cbh == 10) {
#pragma unroll
      for (int hd = 0; hd < 4; ++hd) img_copy(img, half, p.Ka() + (size_t)m0 * 768 + hd * 192 + 128, 768, tid_);
    } else if (cbh >= 27 && cbh <= 34) {
      img_copy(img, half, p.Kb() + (size_t)m0 * 512 + (cbh - 27) * 64, 512, tid_);
    } else {
      img_copy(img, half, p.proj() + (size_t)m0 * NPROJ + cbh * 64, NPROJ, tid_);
    }
  }
  __syncthreads();
}

DI void epi_qa(const P& p, int m0, int n0, f32x16 (&acc)[2][2], const float* sRow) {
  const int tid_ = tidx(); const int lane = tid_ & 63, w = wave_of(tid_), wm = w >> 1, wn = w & 1, lq = lane & 31, h = lane >> 5;
  const int mb = m0 + wm * 64, nb = n0 + wn * 64;
  const int cb = nb >> 6, hd = cb / 3, part = cb % 3;
  TokInfo tb = tinfo(mb);
  const bool dorope = tb.lat && part == 2;
#pragma unroll
  for (int i = 0; i < 2; ++i) {
    float cs[16], sn[16];
#pragma unroll
    for (int r = 0; r < 16; ++r) { cs[r] = 1.f; sn[r] = 0.f; }
    if (dorope) {
#pragma unroll
      for (int r = 0; r < 16; ++r) {
        int t = tb.t + i * 32 + 8 * (r >> 2) + 4 * h + (r & 3);
        cs[r] = p.ropec()[t * 32 + lq]; sn[r] = p.ropes()[t * 32 + lq];
      }
    }
#pragma unroll
    for (int r = 0; r < 16; ++r) {
      int rl = wm * 64 + i * 32 + 8 * (r >> 2) + 4 * h + (r & 3);
      float rstd = rsqrtf(sRow[rl] * (1.f / 384.f) + EPS);
      float x1 = acc[i][0][r] * rstd, x2 = acc[i][1][r] * rstd;
      {
        float y1 = x1 * cs[r] - x2 * sn[r], y2 = x1 * sn[r] + x2 * cs[r];
        x1 = y1; x2 = y2;
      }
      int row = m0 + rl;
      bf16* q = p.Qa() + (size_t)(row * 4 + hd) * 192 + part * 64;
      q[lq] = f2bf(x1); q[32 + lq] = f2bf(x2);
    }
  }
}

DI void epi_kv(const P& p, int m0, int n0, f32x16 (&acc)[2][2], const float* sRow, bool cache) {
  const int tid_ = tidx(); const int lane = tid_ & 63, w = wave_of(tid_), wm = w >> 1, wn = w & 1, lq = lane & 31, h = lane >> 5;
  const int mb = m0 + wm * 64, nb = n0 + wn * 64;
  const int cb = nb >> 6, hd = cb >> 2, part = cb & 3;
  TokInfo tb = tinfo(mb);
#pragma unroll
  for (int i = 0; i < 2; ++i)
#pragma unroll
    for (int j = 0; j < 2; ++j)
#pragma unroll
      for (int g = 0; g < 4; ++g) {
        float v[4];
#pragma unroll
        for (int jj = 0; jj < 4; ++jj) {
          int rl = wm * 64 + i * 32 + 8 * g + 4 * h + jj;
          float rstd = cache ? 1.f : rsqrtf(sRow[rl] * (1.f / 256.f) + EPS);
          v[jj] = acc[i][j][4 * g + jj] * rstd;
        }
        int c = j * 32 + lq;
        int row0 = mb + i * 32 + 8 * g + 4 * h;
        if (part < 2) {
#pragma unroll
          for (int jj = 0; jj < 4; ++jj) {
            int row = row0 + jj;
            if (cache) {
              int lb = row >> 8, t = row & 255;
              p.cKa()[(size_t)((lb * 4 + hd) * 256 + t) * 192 + part * 64 + c] = f2bf(v[jj]);
            } else {
              p.Ka()[(size_t)(row * 4 + hd) * 192 + part * 64 + c] = f2bf(v[jj]);
            }
          }
        } else {
          int d = (part - 2) * 64 + c;
          if (cache) {
            int lb = row0 >> 8, t = row0 & 255;
            store_vt4(p.cVaT(), (size_t)((lb * 4 + hd) * 128 + d) * 256 + t, v[0], v[1], v[2], v[3]);
          } else {
            int tl = tb.t + i * 32 + 8 * g + 4 * h;
            store_vt4(p.VaT(), (size_t)tb.tok0 * 512 + (size_t)(hd * 128 + d) * tb.T + tl, v[0], v[1], v[2], v[3]);
          }
        }
      }
}

DI void epi_out(const P& p, int l, int m0, int n0, f32x16 (&acc)[2][2]) {
  const int tid_ = tidx(); const int lane = tid_ & 63, w = wave_of(tid_), wm = w >> 1, wn = w & 1, lq = lane & 31, h = lane >> 5;
  const int mb = m0 + wm * 64, nb = n0 + wn * 64;
  TokInfo tb = tinfo(mb);
  const float* gate = p.mod() + (size_t)(l * 5 + tb.modj) * 3072 + 2048;
  const float* xsrc = (l == 0) ? (tb.lat ? p.x_sample - (size_t)4096 * 1024 : p.x_prompt) : (const float*)p.xbuf();
#pragma unroll
  for (int i = 0; i < 2; ++i)
#pragma unroll
    for (int j = 0; j < 2; ++j) {
      int col = nb + j * 32 + lq;
      float gv = gate[col];
      float xo[16];
#pragma unroll
      for (int r = 0; r < 16; ++r) {
        int row = mb + i * 32 + 8 * (r >> 2) + 4 * h + (r & 3);
        xo[r] = xsrc[(size_t)row * 1024 + col];
      }
#pragma unroll
      for (int r = 0; r < 16; ++r) {
        int row = mb + i * 32 + 8 * (r >> 2) + 4 * h + (r & 3);
        p.xbuf()[(size_t)row * 1024 + col] = xo[r] + gv * acc[i][j][r];
      }
    }
}

template <int KW, int DQ, int KSPLIT>
DI void attn_pass(const bf16* __restrict__ qptr, int koff, int kh, const bf16* __restrict__ Kmain, int ldk, int Tmain,
                  const bf16* __restrict__ Kc, int ldkc, int Tc, const bf16* __restrict__ VTmain,
                  const bf16* __restrict__ VTc, float c, char* smem, f32x16 (&o)[4], float& lsum, float& m_out) {
  constexpr int KS = KW + 8;
  constexpr int NKB = 2 / KSPLIT;
  bf16* sK = (bf16*)smem;
  bf16* sV = sK + 64 * KS;
  const int tid = tidx(), lane = tid & 63, lq = lane & 31, h = lane >> 5;
  bf16x8 qf[DQ / 16];
#pragma unroll
  for (int ks = 0; ks < DQ / 16; ++ks) qf[ks] = *(const bf16x8*)(qptr + ks * 16 + h * 8);
#pragma unroll
  for (int db = 0; db < 4; ++db)
#pragma unroll
    for (int r = 0; r < 16; ++r) o[db][r] = 0.f;
  lsum = 0.f;
  float m_run = -INFINITY;
  const int nt = (Tmain + Tc) >> 6;
  constexpr int CH = KW / 8, NKL = 64 * CH / 256;
  u32x4 kr[NKL], vr[4];
  auto issue = [&](int kt) {
    const bf16* ksrc; int ld; const bf16* vsrc; int ldv;
    if (kt * 64 < Tmain) { ksrc = Kmain + (size_t)(kt * 64) * ldk; ld = ldk; vsrc = VTmain + kt * 64; ldv = Tmain; }
    else { ksrc = Kc + (size_t)(kt * 64 - Tmain) * ldkc; ld = ldkc; vsrc = VTc + (kt * 64 - Tmain); ldv = Tc; }
#pragma unroll
    for (int i = 0; i < NKL; ++i) {
      int idx = tid + 256 * i; int r = idx / CH, cc = idx % CH;
      kr[i] = *(const u32x4*)(ksrc + (size_t)r * ld + cc * 8);
    }
    if (KSPLIT == 1) {
#pragma unroll
      for (int i = 0; i < 4; ++i) {
        int idx = tid + 256 * i; int r = idx >> 3, cc = idx & 7;
        vr[i] = *(const u32x4*)(vsrc + (size_t)r * ldv + cc * 8);
      }
    }
  };
  issue(0);
  for (int kt = 0; kt < nt; ++kt) {
    __syncthreads();
#pragma unroll
    for (int i = 0; i < NKL; ++i) {
      int idx = tid + 256 * i; int r = idx / CH, cc = idx % CH;
      *(u32x4*)(sK + r * KS + cc * 8) = kr[i];
    }
    if (KSPLIT != 1) {
      const bf16* vsrc; int ldv;
      if (kt * 64 < Tmain) { vsrc = VTmain + kt * 64; ldv = Tmain; } else { vsrc = VTc + (kt * 64 - Tmain); ldv = Tc; }
#pragma unroll
      for (int i = 0; i < 4; ++i) {
        int idx = tid + 256 * i; int r = idx >> 3, cc = idx & 7;
        vr[i] = *(const u32x4*)(vsrc + (size_t)r * ldv + cc * 8);
      }
    }
#pragma unroll
    for (int i = 0; i < 4; ++i) {
      int idx = tid + 256 * i; int r = idx >> 3, cc = idx & 7;
      *(u32x4*)(sV + r * 72 + cc * 8) = vr[i];
    }
    __syncthreads();
    issue((kt + 1 < nt) ? kt + 1 : kt);
    f32x16 s[NKB];
#pragma unroll
    for (int kbi = 0; kbi < NKB; ++kbi)
#pragma unroll
      for (int r = 0; r < 16; ++r) s[kbi][r] = 0.f;
#pragma unroll
    for (int ks = 0; ks < DQ / 16; ++ks)
#pragma unroll
      for (int kbi = 0; kbi < NKB; ++kbi) {
        const int kb = (KSPLIT == 2) ? kh : kbi;
        bf16x8 a = *(const bf16x8*)(sK + (kb * 32 + lq) * KS + koff + ks * 16 + h * 8);
        s[kbi] = MFMA(a, qf[ks], s[kbi]);
      }
    float mx = -INFINITY;
#pragma unroll
    for (int kbi = 0; kbi < NKB; ++kbi)
#pragma unroll
      for (int r = 0; r < 16; ++r) mx = fmaxf(mx, s[kbi][r]);
    mx = fmaxf(mx, __shfl_xor(mx, 32));
    const float m_new = fmaxf(m_run, mx);
    const float alpha = fexp2((m_run - m_new) * c);
    m_run = m_new;
    lsum *= alpha;
#pragma unroll
    for (int db = 0; db < 4; ++db)
#pragma unroll
      for (int r = 0; r < 16; ++r) o[db][r] *= alpha;
    const float mc = m_new * c;
#pragma unroll
    for (int kbi = 0; kbi < NKB; ++kbi)
#pragma unroll
      for (int r = 0; r < 16; ++r) { float pv = fexp2(s[kbi][r] * c - mc); s[kbi][r] = pv; lsum += pv; }
#pragma unroll
    for (int kbi = 0; kbi < NKB; ++kbi) {
      const int kb = (KSPLIT == 2) ? kh : kbi;
#pragma unroll
      for (int s2 = 0; s2 < 2; ++s2) {
        u32x4 pk;
#pragma unroll
        for (int e = 0; e < 4; ++e) pk[e] = pack2(s[kbi][8 * s2 + 2 * e], s[kbi][8 * s2 + 2 * e + 1]);
        bf16x8 pb = __builtin_bit_cast(bf16x8, pk);
#pragma unroll
        for (int db = 0; db < 4; ++db) {
          const bf16* vp = sV + (db * 32 + lq) * 72 + kb * 32 + s2 * 16 + 4 * h;
          u32x2 lo = *(const u32x2*)vp, hi = *(const u32x2*)(vp + 8);
          u32x4 av; av[0] = lo[0]; av[1] = lo[1]; av[2] = hi[0]; av[3] = hi[1];
          o[db] = MFMA(__builtin_bit_cast(bf16x8, av), pb, o[db]);
        }
      }
    }
  }
  lsum += __shfl_xor(lsum, 32);
  m_out = m_run;
}

DI void mla_item(const P& p, int l, int it, char* smem) {
  const int tid = tidx(), lane = tid & 63, w = wave_of(tid), lq = lane & 31, h = lane >> 5;
  int lat, b, hd, qb;
  if (it < 256) { lat = 1; b = it >> 6; hd = (it >> 4) & 3; qb = it & 15; }
  else { int u = it - 256; lat = 0; b = u >> 4; hd = (u >> 2) & 3; qb = u & 3; }
  const int T = lat ? 1024 : 256, tok0 = lat ? 4096 + b * 1024 : b * 256;
  const int qsub = w & 1, kh = w >> 1;
  const int tok = tok0 + qb * 64 + qsub * 32 + lq;
  f32x16 o[4]; float lsum, mrun;
  const float c = 0.07216878364870322f * 1.4426950408889634f;
  attn_pass<192, 192, 2>(p.Qa() + (size_t)(tok * 4 + hd) * 192, 0, kh, p.Ka() + (size_t)(tok0 * 4 + hd) * 192, 768, T,
                 p.cKa() + (size_t)((l * 4 + b) * 4 + hd) * 256 * 192, 192, lat ? 256 : 0,
                 p.VaT() + (size_t)tok0 * 512 + (size_t)hd * 128 * T, p.cVaT() + (size_t)((l * 4 + b) * 4 + hd) * 128 * 256, c, smem, o, lsum, mrun);
  float* ex = (float*)smem;
  float* exm = ex + 2 * 128 * 32;
  float* exl = exm + 64;
  __syncthreads();
  if (kh == 1) {
#pragma unroll
    for (int db = 0; db < 4; ++db)
#pragma unroll
      for (int r = 0; r < 16; ++r) {
        int dv = db * 32 + 8 * (r >> 2) + 4 * h + (r & 3);
        ex[(qsub * 128 + dv) * 32 + lq] = o[db][r];
      }
    if (h == 0) { exm[qsub * 32 + lq] = mrun; exl[qsub * 32 + lq] = lsum; }
  }
  __syncthreads();
  if (kh == 0) {
    const float m1 = exm[qsub * 32 + lq], l1 = exl[qsub * 32 + lq];
    const float mm = fmaxf(mrun, m1);
    const float f0 = fexp2((mrun - mm) * c), f1 = fexp2((m1 - mm) * c);
    const float inv = 1.f / (lsum * f0 + l1 * f1);
    const float g0 = f0 * inv, g1 = f1 * inv;
    u32x2 zz[4][4];
#pragma unroll
    for (int db = 0; db < 4; ++db)
#pragma unroll
      for (int g = 0; g < 4; ++g) zz[db][g] = *(const u32x2*)(p.proj() + (size_t)tok * NPROJ + 704 + hd * 128 + db * 32 + 8 * g + 4 * h);
#pragma unroll
    for (int db = 0; db < 4; ++db)
#pragma unroll
      for (int g = 0; g < 4; ++g) {
        int dv = db * 32 + 8 * g + 4 * h;
        float ov4[4];
#pragma unroll
        for (int jj = 0; jj < 4; ++jj) ov4[jj] = o[db][4 * g + jj] * g0 + ex[(qsub * 128 + dv + jj) * 32 + lq] * g1;
        u32x2 z = zz[db][g];
        float z0 = bflo(z[0]), z1 = bfhi(z[0]), z2 = bflo(z[1]), z3 = bfhi(z[1]);
        u32x2 ov;
        ov[0] = pack2(ov4[0] * silu_f(z0), ov4[1] * silu_f(z1));
        ov[1] = pack2(ov4[2] * silu_f(z2), ov4[3] * silu_f(z3));
        *(u32x2*)(p.ycat() + (size_t)tok * 1536 + hd * 128 + dv) = ov;
      }
  }
}

DI void diff_item(const P& p, int l, int it, char* smem) {
  const int tid = tidx(), lane = tid & 63, w = wave_of(tid), lq = lane & 31, h = lane >> 5;
  int lat, b, hd, qb;
  if (it < 256) { lat = 1; b = it >> 6; hd = (it >> 4) & 3; qb = it & 15; }
  else { int u = it - 256; lat = 0; b = u >> 4; hd = (u >> 2) & 3; qb = u & 3; }
  const int T = lat ? 1024 : 256, tok0 = lat ? 4096 + b * 1024 : b * 256;
  const int map = w >> 1, qsub = w & 1;
  const int tok = tok0 + qb * 64 + qsub * 32 + lq;
  const float c = 0.125f * 1.4426950408889634f;
  const bf16* vt = p.VbT() + (size_t)tok0 * 512 + (size_t)hd * 128 * T;
  const bf16* vtc = p.cVbT() + (size_t)((l * 4 + b) * 4 + hd) * 128 * 256;
  const bf16* kc = p.cKb() + (size_t)((l * 4 + b) * 4 + hd) * 256 * 128;
  f32x16 o[4]; float ls, mdummy;
  attn_pass<128, 64, 1>(p.proj() + (size_t)tok * NPROJ + 1216 + hd * 128 + map * 64, map * 64, 0, p.Kb() + (size_t)(tok0 * 4 + hd) * 128, 512, T, kc, 128,
                     lat ? 256 : 0, vt, vtc, c, smem, o, ls, mdummy);
  float* ex = (float*)smem;
  __syncthreads();
  if (map == 1) {
    const float sc2 = p.lam()[l] / ls;
#pragma unroll
    for (int db = 0; db < 4; ++db)
#pragma unroll
      for (int r = 0; r < 16; ++r) {
        int dv = db * 32 + 8 * (r >> 2) + 4 * h + (r & 3);
        ex[(qsub * 128 + dv) * 32 + lq] = o[db][r] * sc2;
      }
  }
  __syncthreads();
  if (map == 0) {
    const float i1 = 1.f / ls;
    float ss = 0.f;
#pragma unroll
    for (int db = 0; db < 4; ++db)
#pragma unroll
      for (int r = 0; r < 16; ++r) {
        int dv = db * 32 + 8 * (r >> 2) + 4 * h + (r & 3);
        float v = o[db][r] * i1 - ex[(qsub * 128 + dv) * 32 + lq];
        o[db][r] = v; ss += v * v;
      }
    ss += __shfl_xor(ss, 32);
    const float lam_init = 0.8f - 0.6f * fexp(-0.3f * (float)l);
    const float sc = rsqrtf(ss * (1.f / 128.f) + EPS) * (1.f - lam_init);
#pragma unroll
    for (int db = 0; db < 4; ++db) {
      u32x2 zz[4]; f32x4 gg[4];
#pragma unroll
      for (int g = 0; g < 4; ++g) {
        int dv = db * 32 + 8 * g + 4 * h;
        zz[g] = *(const u32x2*)(p.proj() + (size_t)tok * NPROJ + 2752 + hd * 128 + dv);
        gg[g] = *(const f32x4*)(p.dnorm + l * 128 + dv);
      }
#pragma unroll
      for (int g = 0; g < 4; ++g) {
        int dv = db * 32 + 8 * g + 4 * h;
        u32x2 z = zz[g];
        f32x4 gn = gg[g];
        float z0 = bflo(z[0]), z1 = bfhi(z[0]), z2 = bflo(z[1]), z3 = bfhi(z[1]);
        u32x2 ov;
        ov[0] = pack2(o[db][4 * g] * sc * gn[0] * silu_f(z0), o[db][4 * g + 1] * sc * gn[1] * silu_f(z1));
        ov[1] = pack2(o[db][4 * g + 2] * sc * gn[2] * silu_f(z2), o[db][4 * g + 3] * sc * gn[3] * silu_f(z3));
        *(u32x2*)(p.ycat() + (size_t)tok * 1536 + 512 + hd * 128 + dv) = ov;
      }
    }
  }
}

DI void conv8(const P& p, int l, int tok, int t, int T, int col, int wcol, float (&o)[8]) {
  const bf16* base = p.proj() + (size_t)tok * NPROJ + col;
  u32x4 cur = *(const u32x4*)base;
  u32x4 prv = {0u, 0u, 0u, 0u}, nxt = {0u, 0u, 0u, 0u};
  if (t > 0) prv = *(const u32x4*)(base - NPROJ);
  if (t < T - 1) nxt = *(const u32x4*)(base + NPROJ);
  const float* w0 = p.mconv + (size_t)l * 3 * 1024 + wcol;
  f32x4 wa0 = *(const f32x4*)w0, wa1 = *(const f32x4*)(w0 + 4);
  f32x4 wb0 = *(const f32x4*)(w0 + 1024), wb1 = *(const f32x4*)(w0 + 1028);
  f32x4 wc0 = *(const f32x4*)(w0 + 2048), wc1 = *(const f32x4*)(w0 + 2052);
#pragma unroll
  for (int e = 0; e < 4; ++e) {
    float wA0 = e < 2 ? wa0[2 * e] : wa1[2 * e - 4], wA1 = e < 2 ? wa0[2 * e + 1] : wa1[2 * e - 3];
    float wB0 = e < 2 ? wb0[2 * e] : wb1[2 * e - 4], wB1 = e < 2 ? wb0[2 * e + 1] : wb1[2 * e - 3];
    float wC0 = e < 2 ? wc0[2 * e] : wc1[2 * e - 4], wC1 = e < 2 ? wc0[2 * e + 1] : wc1[2 * e - 3];
    float v0 = wA0 * bflo(prv[e]) + wB0 * bflo(cur[e]) + wC0 * bflo(nxt[e]);
    float v1 = wA1 * bfhi(prv[e]) + wB1 * bfhi(cur[e]) + wC1 * bfhi(nxt[e]);
    o[2 * e] = silu_f(v0); o[2 * e + 1] = silu_f(v1);
  }
}

DI float wave_incl_scan_add(float v, int lane) {
#pragma unroll
  for (int o = 1; o < 64; o <<= 1) { float t = __shfl_up(v, o); if (lane >= o) v += t; }
  return v;
}
DI float wave_incl_scan_max(float v, int lane) {
#pragma unroll
  for (int o = 1; o < 64; o <<= 1) { float t = __shfl_up(v, o); if (lane >= o) v = fmaxf(v, t); }
  return v;
}

DI void mlstm_local(const P& p, int l, int slot, char* smem) {
  bf16* vT = (bf16*)smem;
  bf16* kT = vT + 128 * 72;
  float* wbuf = (float*)(kT + 128 * 72);
  const int tid = tidx(), lane = tid & 63, w = wave_of(tid), lq = lane & 31, h = lane >> 5;
  const int cp = slot >> 3, hd = (slot >> 1) & 3, dir = slot & 1;
  const int ctok = cp * 64;
  TokInfo ti = tinfo(ctok);
  const int T = ti.T;
  if (w == 0) {
    const int s = dir ? 63 - lane : lane;
    const int tk = ctok + s;
    const float ig = p.gates()[tk * 16 + dir * 8 + hd];
    const float lf = logsig_f(p.gates()[tk * 16 + dir * 8 + 4 + hd]);
    const float bc = wave_incl_scan_add(lf, lane);
    const float b_last = __shfl(bc, 63);
    const float val = b_last - bc + ig;
    float mx = val;
#pragma unroll
    for (int o = 32; o >= 1; o >>= 1) mx = fmaxf(mx, __shfl_xor(mx, o));
    wbuf[s] = fexp(val - mx);
    if (lane == 0) { p.blA()[slot] = b_last; p.mlA()[slot] = mx; }
  }
  __syncthreads();
  {
    const int s = tid >> 2, chb = (tid & 3) * 32;
    const float ws = wbuf[s];
#pragma unroll 1
    for (int q = 0; q < 4; ++q) {
      float kv[8];
      const int ch = chb + q * 8;
      conv8(p, l, ctok + s, ti.t + s, T, 3776 + hd * 128 + ch, 512 + hd * 128 + ch, kv);
#pragma unroll
      for (int e = 0; e < 8; ++e) kT[(ch + e) * 72 + s] = f2bf(kv[e] * ws);
    }
    const bf16* vsrc = p.VmT() + (size_t)ti.tok0 * 512 + (size_t)hd * 128 * T + ti.t;
#pragma unroll
    for (int i = 0; i < 4; ++i) {
      int idx = tid + 256 * i; int r = idx >> 3, cc = idx & 7;
      *(u32x4*)(vT + r * 72 + cc * 8) = *(const u32x4*)(vsrc + (size_t)r * T + cc * 8);
    }
  }
  __syncthreads();
  f32x16 acc[4];
#pragma unroll
  for (int cb = 0; cb < 4; ++cb)
#pragma unroll
    for (int r = 0; r < 16; ++r) acc[cb][r] = 0.f;
#pragma unroll
  for (int ks = 0; ks < 4; ++ks) {
    bf16x8 a = *(const bf16x8*)(vT + (32 * w + lq) * 72 + ks * 16 + 8 * h);
#pragma unroll
    for (int cb = 0; cb < 4; ++cb) {
      bf16x8 bb = *(const bf16x8*)(kT + (32 * cb + lq) * 72 + ks * 16 + 8 * h);
      acc[cb] = MFMA(a, bb, acc[cb]);
    }
  }
  bf16* cs = p.Cst() + (size_t)slot * 16384;
#pragma unroll
  for (int cb = 0; cb < 4; ++cb)
#pragma unroll
    for (int r = 0; r < 16; ++r) {
      int dvv = 32 * w + 8 * (r >> 2) + 4 * h + (r & 3);
      cs[dvv * 128 + 32 * cb + lq] = f2bf(acc[cb][r]);
    }
  if (tid < 128) {
    float sum = 0.f;
#pragma unroll
    for (int q = 0; q < 8; ++q) {
      u32x4 v = *(const u32x4*)(kT + tid * 72 + q * 8);
#pragma unroll
      for (int e = 0; e < 4; ++e) sum += bflo(v[e]) + bfhi(v[e]);
    }
    p.nst()[slot * 128 + tid] = sum;
  }
}

DI void mlstm_scan(const P& p, int l, int it) {
  const int tid = tidx();
  const int ch = it >> 2, qt = it & 3;
  int lat, b, hd, dir;
  if (ch < 32) { lat = 1; b = ch >> 3; hd = (ch >> 1) & 3; dir = ch & 1; }
  else { int u = ch - 32; lat = 0; b = u >> 3; hd = (u >> 1) & 3; dir = u & 1; }
  const int T = lat ? 1024 : 256, tok0 = lat ? 4096 + b * 1024 : b * 256, nc = T >> 6;
  const int dv0 = 32 * qt + 4 * (tid >> 5), dk0 = 4 * (tid & 31);
  float C[4][4];
  float n_val = 0.f, m_prev = 0.f;
  const bool do_n = (qt == 0) && (tid < 128);
  const size_t sidx = (size_t)((b * 4 + l) * 2 + dir) * 4 + hd;
  if (lat) {
    const float* C0 = p.st_C + sidx * 16384;
#pragma unroll
    for (int j = 0; j < 4; ++j) {
      f32x4 v = *(const f32x4*)(C0 + (size_t)(dk0 + j) * 128 + dv0);
      C[0][j] = v[0]; C[1][j] = v[1]; C[2][j] = v[2]; C[3][j] = v[3];
    }
    if (do_n) n_val = p.st_n[sidx * 128 + tid];
    m_prev = p.st_m[sidx];
  } else {
#pragma unroll
    for (int i = 0; i < 4; ++i)
#pragma unroll
      for (int j = 0; j < 4; ++j) C[i][j] = 0.f;
  }
  u32x2 dnx[4]; float blx, mlx, dnnx = 0.f;
  {
    const int c = dir ? nc - 1 : 0;
    const int slot = ((((tok0 >> 6) + c) * 4 + hd) * 2) + dir;
    const bf16* cs = p.Cst() + (size_t)slot * 16384 + dv0 * 128 + dk0;
#pragma unroll
    for (int i = 0; i < 4; ++i) dnx[i] = *(const u32x2*)(cs + i * 128);
    blx = p.blA()[slot]; mlx = p.mlA()[slot];
    if (do_n) dnnx = p.nst()[slot * 128 + tid];
  }
  for (int ci = 0; ci < nc; ++ci) {
    const int c = dir ? nc - 1 - ci : ci;
    const int slot = ((((tok0 >> 6) + c) * 4 + hd) * 2) + dir;
    bf16* cs = p.Cst() + (size_t)slot * 16384 + dv0 * 128 + dk0;
    u32x2 d[4];
#pragma unroll
    for (int i = 0; i < 4; ++i) d[i] = dnx[i];
    const float bl = blx, ml = mlx;
    const float dn = dnnx;
    {
      const int cn = (ci + 1 < nc) ? (dir ? nc - 2 - ci : ci + 1) : c;
      const int sn = ((((tok0 >> 6) + cn) * 4 + hd) * 2) + dir;
      const bf16* csn = p.Cst() + (size_t)sn * 16384 + dv0 * 128 + dk0;
#pragma unroll
      for (int i = 0; i < 4; ++i) dnx[i] = *(const u32x2*)(csn + i * 128);
      blx = p.blA()[sn]; mlx = p.mlA()[sn];
      if (do_n) dnnx = p.nst()[sn * 128 + tid];
    }
#pragma unroll
    for (int i = 0; i < 4; ++i) {
      u32x2 o; o[0] = pack2(C[i][0], C[i][1]); o[1] = pack2(C[i][2], C[i][3]);
      *(u32x2*)(cs + i * 128) = o;
    }
    if (do_n) p.nst()[slot * 128 + tid] = n_val;
    if (qt == 0 && tid == 0) p.mst()[slot] = m_prev;
    const float m_new = fmaxf(bl + m_prev, ml);
    const float a = fexp(bl + m_prev - m_new), bs = fexp(ml - m_new);
#pragma unroll
    for (int i = 0; i < 4; ++i) {
      C[i][0] = a * C[i][0] + bs * bflo(d[i][0]); C[i][1] = a * C[i][1] + bs * bfhi(d[i][0]);
      C[i][2] = a * C[i][2] + bs * bflo(d[i][1]); C[i][3] = a * C[i][3] + bs * bfhi(d[i][1]);
    }
    n_val = a * n_val + bs * dn;
    m_prev = m_new;
  }
  if (!lat) {
    float* Co = p.out + O_MC + sidx * 16384;
#pragma unroll
    for (int j = 0; j < 4; ++j) {
      f32x4 v; v[0] = C[0][j]; v[1] = C[1][j]; v[2] = C[2][j]; v[3] = C[3][j];
      *(f32x4*)(Co + (size_t)(dk0 + j) * 128 + dv0) = v;
    }
    if (do_n) p.out[O_MN + sidx * 128 + tid] = n_val;
    if (qt == 0 && tid == 0) p.out[O_MM + sidx] = m_prev;
  }
}

DI void mlstm_out(const P& p, int l, int it, char* smem) {
  bf16* sq = (bf16*)smem;
  bf16* sk = sq + 64 * 136;
  bf16* vT = sk + 64 * 136;
  float* bcA = (float*)(vT + 128 * 72);
  float* uA = bcA + 64, *mtA = uA + 64, *nA = mtA + 64  , *ssb = nA + 128  ;
  const int tid = tidx(), lane = tid & 63, w = wave_of(tid), lq = lane & 31, h = lane >> 5;
  const int cp = it >> 2, hd = it & 3;
  const int ctok = cp * 64;
  TokInfo ti = tinfo(ctok);
  const int T = ti.T;
  {
    const int s = tid >> 2, chb = (tid & 3) * 32;
#pragma unroll 1
    for (int q = 0; q < 4; ++q) {
      const int ch = chb + q * 8;
      float v[8];
      conv8(p, l, ctok + s, ti.t + s, T, 3264 + hd * 128 + ch, hd * 128 + ch, v);
      u32x4 pk;
#pragma unroll
      for (int e = 0; e < 4; ++e) pk[e] = pack2(v[2 * e] * 0.08838834764831845f, v[2 * e + 1] * 0.08838834764831845f);
      *(u32x4*)(sq + s * 136 + ch) = pk;
      conv8(p, l, ctok + s, ti.t + s, T, 3776 + hd * 128 + ch, 512 + hd * 128 + ch, v);
#pragma unroll
      for (int e = 0; e < 4; ++e) pk[e] = pack2(v[2 * e], v[2 * e + 1]);
      *(u32x4*)(sk + s * 136 + ch) = pk;
    }
    const bf16* vsrc = p.VmT() + (size_t)ti.tok0 * 512 + (size_t)hd * 128 * T + ti.t;
#pragma unroll
    for (int i = 0; i < 4; ++i) {
      int idx = tid + 256 * i; int r = idx >> 3, cc = idx & 7;
      *(u32x4*)(vT + r * 72 + cc * 8) = *(const u32x4*)(vsrc + (size_t)r * T + cc * 8);
    }
  }
  const int tb = w & 1, dvh = w >> 1;
  const int t = 32 * tb + lq;
  f32x16 hacc[2];
#pragma unroll
  for (int d2 = 0; d2 < 2; ++d2)
#pragma unroll
    for (int r = 0; r < 16; ++r) hacc[d2][r] = 0.f;
  const bf16* sqt = sq + t * 136 + 8 * h;
  for (int dir = 0; dir < 2; ++dir) {
    const int slot = (cp * 4 + hd) * 2 + dir;
    const float m_prev = p.mst()[slot];
    __syncthreads();
    if (w == 0) {
      const int s = dir ? 63 - lane : lane;
      const int tk = ctok + s;
      const float ig = p.gates()[tk * 16 + dir * 8 + hd];
      const float lf = logsig_f(p.gates()[tk * 16 + dir * 8 + 4 + hd]);
      const float bc = wave_incl_scan_add(lf, lane);
      const float u = ig - bc;
      const float pm = wave_incl_scan_max(u, lane);
      bcA[s] = bc; uA[s] = u; mtA[s] = bc + fmaxf(m_prev, pm);
    } else if (w < 3) {
      nA[tid - 64] = p.nst()[slot * 128 + tid - 64];
    }
    __syncthreads();
    const float bc_t = bcA[t], mt = mtA[t];
    const float w_inter = fexp(bc_t + m_prev - mt);
    float den = 0.f;
    const float e0 = bc_t - mt;
    u32x4 pk[2][2];
#pragma unroll
    for (int sb = 0; sb < 2; ++sb) {
      asm volatile("" ::: "memory");
      f32x16 sv;
#pragma unroll
      for (int r = 0; r < 16; ++r) sv[r] = 0.f;
#pragma unroll
      for (int ks = 0; ks < 8; ++ks) {
        bf16x8 a = *(const bf16x8*)(sk + (32 * sb + lq) * 136 + ks * 16 + 8 * h);
        sv = MFMA(a, *(const bf16x8*)(sqt + ks * 16), sv);
      }
#pragma unroll
      for (int r = 0; r < 16; ++r) {
        const int sidx = 32 * sb + 8 * (r >> 2) + 4 * h + (r & 3);
        const bool valid = dir ? (sidx >= t) : (sidx <= t);
        const float wgt = valid ? fexp(e0 + uA[sidx]) : 0.f;
        const float v = sv[r] * wgt;
        sv[r] = v; den += v;
      }
#pragma unroll
      for (int s2 = 0; s2 < 2; ++s2)
#pragma unroll
        for (int e = 0; e < 4; ++e) pk[sb][s2][e] = pack2(sv[8 * s2 + 2 * e], sv[8 * s2 + 2 * e + 1]);
    }
    asm volatile("" ::: "memory");
    den += __shfl_xor(den, 32);
    float qn = 0.f;
#pragma unroll
    for (int ks = 0; ks < 8; ++ks) {
      u32x4 qv = *(const u32x4*)(sqt + ks * 16);
#pragma unroll
      for (int e = 0; e < 4; ++e) {
        qn += bflo(qv[e]) * nA[ks * 16 + 8 * h + 2 * e] + bfhi(qv[e]) * nA[ks * 16 + 8 * h + 2 * e + 1];
      }
    }
    qn += __shfl_xor(qn, 32);
    den += w_inter * qn;
    asm volatile("" ::: "memory");
    const float rden = 1.f / fmaxf(fabsf(den), fexp(-mt));
    const bf16* cs = p.Cst() + (size_t)slot * 16384;
#pragma unroll
    for (int d2 = 0; d2 < 2; ++d2) {
      const int dvb = 2 * dvh + d2;
      f32x16 acc;
#pragma unroll
      for (int r = 0; r < 16; ++r) acc[r] = 0.f;
      bf16x8 cf[8];
#pragma unroll
      for (int ks = 0; ks < 8; ++ks) cf[ks] = *(const bf16x8*)(cs + (dvb * 32 + lq) * 128 + ks * 16 + 8 * h);
      asm volatile("" : "+v"(cf[0]), "+v"(cf[1]), "+v"(cf[2]), "+v"(cf[3]), "+v"(cf[4]), "+v"(cf[5]), "+v"(cf[6]), "+v"(cf[7]));
#pragma unroll
      for (int ks = 0; ks < 8; ++ks) acc = MFMA(cf[ks], *(const bf16x8*)(sqt + ks * 16), acc);
#pragma unroll
      for (int r = 0; r < 16; ++r) acc[r] *= w_inter;
#pragma unroll
      for (int sb = 0; sb < 2; ++sb)
#pragma unroll
        for (int s2 = 0; s2 < 2; ++s2) {
          const bf16* vp = vT + (dvb * 32 + lq) * 72 + sb * 32 + s2 * 16 + 4 * h;
          u32x2 lo = *(const u32x2*)vp, hi = *(const u32x2*)(vp + 8);
          u32x4 av; av[0] = lo[0]; av[1] = lo[1]; av[2] = hi[0]; av[3] = hi[1];
          acc = MFMA(__builtin_bit_cast(bf16x8, av), __builtin_bit_cast(bf16x8, pk[sb][s2]), acc);
        }
#pragma unroll
      for (int r = 0; r < 16; ++r) hacc[d2][r] += acc[r] * rden;
    }
  }
  const int tok = ctok + t;
  float ss = 0.f;
#pragma unroll
  for (int d2 = 0; d2 < 2; ++d2)
#pragma unroll
    for (int g = 0; g < 4; ++g) {
      int dv = (2 * dvh + d2) * 32 + 8 * g + 4 * h;
      u32x2 mo = *(const u32x2*)(p.proj() + (size_t)tok * NPROJ + 4800 + hd * 128 + dv);
      float m0 = bflo(mo[0]), m1 = bfhi(mo[0]), m2 = bflo(mo[1]), m3 = bfhi(mo[1]);
      float v0 = hacc[d2][4 * g] * sigmoid_f(m0), v1 = hacc[d2][4 * g + 1] * sigmoid_f(m1);
      float v2 = hacc[d2][4 * g + 2] * sigmoid_f(m2), v3 = hacc[d2][4 * g + 3] * sigmoid_f(m3);
      hacc[d2][4 * g] = v0; hacc[d2][4 * g + 1] = v1; hacc[d2][4 * g + 2] = v2; hacc[d2][4 * g + 3] = v3;
      ss += v0 * v0 + v1 * v1 + v2 * v2 + v3 * v3;
    }
  ss += __shfl_xor(ss, 32);
  if (h == 0) ssb[dvh * 64 + t] = ss;
  __syncthreads();
  const float rstd = rsqrtf((ssb[t] + ssb[64 + t]) * (1.f / 128.f) + EPS);
  u32x2 zz[2][4]; f32x4 gg[2][4];
#pragma unroll
  for (int d2 = 0; d2 < 2; ++d2)
#pragma unroll
    for (int g = 0; g < 4; ++g) {
      int dv = (2 * dvh + d2) * 32 + 8 * g + 4 * h;
      zz[d2][g] = *(const u32x2*)(p.proj() + (size_t)tok * NPROJ + 5312 + hd * 128 + dv);
      gg[d2][g] = *(const f32x4*)(p.mnorm + l * 512 + hd * 128 + dv);
    }
#pragma unroll
  for (int d2 = 0; d2 < 2; ++d2)
#pragma unroll
    for (int g = 0; g < 4; ++g) {
      int dv = (2 * dvh + d2) * 32 + 8 * g + 4 * h;
      u32x2 z = zz[d2][g];
      f32x4 gn = gg[d2][g];
      float z0 = bflo(z[0]), z1 = bfhi(z[0]), z2 = bflo(z[1]), z3 = bfhi(z[1]);
      u32x2 ov;
      ov[0] = pack2(hacc[d2][4 * g] * rstd * gn[0] * silu_f(z0), hacc[d2][4 * g + 1] * rstd * gn[1] * silu_f(z1));
      ov[1] = pack2(hacc[d2][4 * g + 2] * rstd * gn[2] * silu_f(z2), hacc[d2][4 * g + 3] * rstd * gn[3] * silu_f(z3));
      *(u32x2*)(p.ycat() + (size_t)tok * 1536 + 1024 + hd * 128 + dv) = ov;
    }
}

DI void ckv_fin(const P& p, int l, int tok) {
  const int lane = tidx() & 63;
  const int b = tok >> 8, t = tok & 255;
  float* o = p.out + O_CKV + (size_t)((b * 4 + l) * 256 + t) * 256 + lane * 4;
  u32x2 raw = *(const u32x2*)(p.proj() + (size_t)tok * NPROJ + 384 + lane * 4);
  f32x4 v; v[0] = bflo(raw[0]); v[1] = bfhi(raw[0]); v[2] = bflo(raw[1]); v[3] = bfhi(raw[1]);
  float ss = v[0] * v[0] + v[1] * v[1] + v[2] * v[2] + v[3] * v[3];
#pragma unroll
  for (int of = 32; of >= 1; of >>= 1) ss += __shfl_xor(ss, of);
  const float rstd = rsqrtf(ss * (1.f / 256.f) + EPS);
  f32x4 g = *(const f32x4*)(p.kv_norm + l * 256 + lane * 4);
  v[0] *= rstd * g[0]; v[1] *= rstd * g[1]; v[2] *= rstd * g[2]; v[3] *= rstd * g[3];
  *(f32x4*)o = v;
}

#define XB_TMO      128
#define XB_XCNT(j)  (256  + 64 * (j))
#define XB_XSUB(j)  (1280 + 64 * (j))
#define XB_XGEN(j)  (2304 + 64 * (j))
#define XB_TOP      3328
#define XB_TOPGEN   3392
#define XCD_BAR_WORDS 3456
#define XB_SPIN_CAP (1u << 18)
#define LAS __attribute__((address_space(3)))

__device__ __forceinline__ unsigned xb_ld(unsigned* p)              { return __hip_atomic_load(p, __ATOMIC_RELAXED, __HIP_MEMORY_SCOPE_AGENT); }
__device__ __forceinline__ unsigned xb_add(unsigned* p, unsigned v) { return __hip_atomic_fetch_add(p, v, __ATOMIC_RELAXED, __HIP_MEMORY_SCOPE_AGENT); }
__device__ __forceinline__ unsigned xb_xcc_id() { return (unsigned)__builtin_amdgcn_s_getreg((3 << 11) | 20) & 0xFu; }
#define XB_SPIN(cond, bar) do { unsigned _sp = 0; while (cond) { __builtin_amdgcn_s_sleep(1); \
    if ((++_sp & 255u) == 0u) { if (xb_ld(&(bar)[XB_TMO])) break; if (_sp > XB_SPIN_CAP) { atomicAdd(&(bar)[XB_TMO], 1u); break; } } } } while (0)

struct XcdBarrier {
    unsigned* bar; unsigned x;
    volatile LAS unsigned* st;
};

__device__ __forceinline__ XcdBarrier xcd_barrier_post(unsigned* bar, volatile LAS unsigned* st) {
    XcdBarrier b; b.bar = bar; b.x = xb_xcc_id(); b.st = st;
    if (tidx() == 0) (void)xb_add(&bar[XB_XCNT(b.x)], 1u);
    return b;
}
__device__ __forceinline__ void xcd_barrier_complete(unsigned* bar, unsigned x, unsigned& nloc, unsigned& nx) {
    const unsigned G = gridDim.x * gridDim.y * gridDim.z;
    unsigned sum, cnt, mine, sp = 0u;
    for (;;) {
        sum = 0u; cnt = 0u; mine = 0u;
#pragma unroll
        for (unsigned j = 0; j < 16; ++j) { const unsigned c = xb_ld(&bar[XB_XCNT(j)]); sum += c; cnt += (c > 0u) ? 1u : 0u; mine = (j == x) ? c : mine; }
        if (sum == G) break;
        __builtin_amdgcn_s_sleep(1);
        if ((++sp & 255u) == 0u) { if (xb_ld(&bar[XB_TMO])) break; if (sp > XB_SPIN_CAP) { atomicAdd(&bar[XB_TMO], 1u); break; } }
    }
    nloc = mine > 0u ? mine : 1u; nx = cnt > 0u ? cnt : 1u;
}

__device__ __forceinline__ void xcd_barrier(const XcdBarrier& b) {
    asm volatile("s_waitcnt vmcnt(0)" ::: "memory");
    __syncthreads();
    if (tidx() == 0) {
        unsigned* bar = b.bar;
        __builtin_amdgcn_s_waitcnt(0);
        unsigned nloc = b.st[0], nx = b.st[1];
        if (nloc == 0u) { xcd_barrier_complete(bar, b.x, nloc, nx); b.st[0] = nloc; b.st[1] = nx; }
        const unsigned old = xb_add(&bar[XB_XSUB(b.x)], 1u);
        const unsigned gen = old / nloc;
        if (old + 1u == (gen + 1u) * nloc) {
            __builtin_amdgcn_fence(__ATOMIC_RELEASE, "agent");
            asm volatile("s_waitcnt vmcnt(0)" ::: "memory");
            const unsigned og = xb_add(&bar[XB_TOP], 1u);
            const unsigned tg = og / nx;
            if (og + 1u == (tg + 1u) * nx) xb_add(&bar[XB_TOPGEN], 1u);
            else XB_SPIN(xb_ld(&bar[XB_TOPGEN]) == tg, bar);
            __builtin_amdgcn_fence(__ATOMIC_ACQUIRE, "agent");
            xb_add(&bar[XB_XGEN(b.x)], 1u);
            asm volatile("s_waitcnt vmcnt(0)" ::: "memory");
        } else {
            XB_SPIN(xb_ld(&bar[XB_XGEN(b.x)]) == gen, bar);
            __builtin_amdgcn_fence(__ATOMIC_ACQUIRE, "agent");
            asm volatile("s_waitcnt vmcnt(0)" ::: "memory");
        }
    }
    __syncthreads();
}


DI P launder(const P& p) {
  P q = p;
#define LND(m) { asm volatile("" : "+s"(q.m)); q.m = (decltype(q.m))(__attribute__((address_space(1))) void*)(void*)q.m; }
  LND(x_prompt) LND(x_sample) LND(c_ckv) LND(c_krope) LND(c_dk) LND(c_dv) LND(st_C) LND(st_n) LND(st_m) LND(c) LND(c_ctx)
  LND(g_norm) LND(W_mod) LND(b_mod) LND(W_in) LND(q_norm) LND(W_uq) LND(kv_norm) LND(W_ukv) LND(dlam) LND(dnorm) LND(mconv)
  LND(mgb) LND(mnorm) LND(W_out) LND(g_final) LND(out) LND(ws)
#undef LND
  return q;
}

template <int KIND>
DI void run_phase(const P& p0, int ph, char* smem) {
  const P& p = p0;
  const int G = gridDim.x, B = blockIdx.x, w = wave_of(tidx());
  if ((KIND < 0 || KIND == 0) && ph == 0) { phase_prepass(p, smem); return; }
  if ((KIND < 0 || KIND == 1) && ph == 1) {
    for (int it = B; it < 256 + 2048; it += G) {
      if (it < 256) {
        int mt = it >> 3, nt = it & 7;
        int l = (mt * 128) >> 10;
        f32x16 acc[2][2];
        gemm_core<false>(p.cckv() + (size_t)mt * 128 * 256, 256, p.WukvTp() + (size_t)l * 1024 * 256 + (size_t)nt * 128 * 256, 256, 256, smem, acc);
        epi_kv(p, mt * 128, nt * 128, acc, nullptr, true);
      } else {
        norm_row(p, 0, (it - 256) * 4 + w, 0);
      }
    }
    return;
  }
  const int l = (ph - 2) / 6, sub = (ph - 2) % 6;
  if ((KIND < 0 || KIND == 2) && sub == 0) {
    const int x = B & 7, j = B >> 3, per = G >> 3;
    auto tile_of = [&](int q, int& mt, int& nt) {
      const int r = q >> 6, jj = q & 63;
      const int st = r * 8 + x;
      mt = (st / 6) * 8 + (jj >> 3); nt = (st % 6) * 8 + (jj & 7);
      return nt < 46;
    };
    auto next_valid = [&](int q) { int mt, nt; while (q < 6 * 64 && !tile_of(q, mt, nt)) q += per; return q; };
    const bf16* Ab = p.hbuf();
    const bf16* Wb = p.WinT() + (size_t)l * NPROJ * 1024;
    int q = next_valid(j);
    GR g;
    if (q < 6 * 64) { int mt, nt; tile_of(q, mt, nt); gemm_load2(g, Ab + (size_t)mt * 128 * 1024, 1024, Wb + (size_t)nt * 128 * 1024, 1024); }
    while (q < 6 * 64) {
      int mt, nt; tile_of(q, mt, nt);
      const int qn = next_valid(q + per);
      int mtn = mt, ntn = nt;
      if (qn < 6 * 64) tile_of(qn, mtn, ntn);
      f32x16 acc[2][2];
      gemm_core_n<false>(g, Ab + (size_t)mt * 128 * 1024, 1024, Wb + (size_t)nt * 128 * 1024, 1024,
                         Ab + (size_t)mtn * 128 * 1024, Wb + (size_t)ntn * 128 * 1024, 1024, smem, acc);
      epi_inproj(p, l, mt * 128, nt * 128, acc, smem);
      q = qn;
    }
  } else if ((KIND < 0 || KIND == 3) && sub == 1) {
    const int N_CH = 1024, N_QA = 64 * 6, N_KV = 64 * 8, N_CF = 1024;
    for (int it = B; it < N_CH + N_QA + N_KV + N_CF; it += G) {
      int u = it;
      __syncthreads();
      if (u < N_CH) { mlstm_local(p, l, u, smem); continue; }
      u -= N_CH;
      if (u < N_QA) {
        int mt = u / 6, nt = u % 6;
        f32x16 acc[2][2];
        gemm_core<true>(p.proj() + (size_t)mt * 128 * NPROJ, NPROJ, p.WuqT() + (size_t)l * 768 * 384 + (size_t)nt * 128 * 384, 384, 384, smem, acc);
        epi_qa(p, mt * 128, nt * 128, acc, (const float*)(smem + 2 * 128 * 72 * 2));
        continue;
      }
      u -= N_QA;
      if (u < N_KV) {
        int mt = u >> 3, nt = u & 7;
        f32x16 acc[2][2];
        gemm_core<true>(p.proj() + (size_t)mt * 128 * NPROJ + 384, NPROJ, p.WukvT() + (size_t)l * 1024 * 256 + (size_t)nt * 128 * 256, 256, 256, smem, acc);
        epi_kv(p, mt * 128, nt * 128, acc, (const float*)(smem + 2 * 128 * 72 * 2), false);
        continue;
      }
      u -= N_KV;
      ckv_fin(p, l, u * 4 + w);
    }
  } else if ((KIND < 0 || KIND == 7) && sub == 2) {
    for (int it = B; it < 640; it += G) mlstm_scan(p, l, it);
  } else if ((KIND < 0 || KIND == 4) && sub == 3) {
    const int x = B & 7;
    int* qctr = p.qc() + ph * 8 + x;
    int* sslot = (int*)(smem + SMEM_BYTES - 16);
    for (;;) {
      __syncthreads();
      if (tidx() == 0) *sslot = atomicAdd(qctr, 1);
      __syncthreads();
      const int q = *sslot;
      if (q >= 192) break;
      __syncthreads();
      if (q < 32) { const int pr = 2 * x + (q >> 4); mla_item(p, l, pr * 16 + (q & 15), smem); }
      else if (q < 64) { const int u = q - 32; const int pr = 2 * x + (u >> 4); diff_item(p, l, pr * 16 + (u & 15), smem); }
      else if (q < 128) mlstm_out(p, l, x * 64 + (q - 64), smem);
      else if (q < 160) { const int u = q - 128; const int pr = 8 * x + (u >> 2); mla_item(p, l, 256 + pr * 4 + (u & 3), smem); }
      else { const int u = q - 160; const int pr = 8 * x + (u >> 2); diff_item(p, l, 256 + pr * 4 + (u & 3), smem); }
    }
  } else if ((KIND < 0 || KIND == 5) && sub == 4) {
    const int x = B & 7, j = B >> 3, per = G >> 3;
    for (int q = j; q < 64; q += per) {
      const int mt = x * 8 + (q >> 3), nt = q & 7;
      f32x16 acc[2][2];
      gemm_core<false>(p.ycat() + (size_t)mt * 128 * 1536, 1536, p.WoutT() + (size_t)l * 1024 * 1536 + (size_t)nt * 128 * 1536, 1536, 1536, smem, acc);
      epi_out(p, l, mt * 128, nt * 128, acc);
    }
  } else if ((KIND < 0 || KIND == 6) && sub == 5) {
    for (int it = B; it < 2048; it += G) {
      if (l < 3) norm_row(p, l + 1, it * 4 + w, 0);
      else norm_row(p, 0, it * 4 + w, 1);
    }
  }
}

#if COOP
__global__ void __launch_bounds__(256, 2) mega(P p, int lo, int hi, int coop) {
  __shared__ __attribute__((aligned(16))) char smem[SMEM_BYTES];
  __shared__ uint4 xb_words;
  if (threadIdx.x == 0) xb_words = make_uint4(0u, 0u, 0u, 0u);
  tidx_init();
  XcdBarrier xb = xcd_barrier_post((unsigned*)p.ctr(), (volatile LAS unsigned*)&xb_words);
  for (int ph = lo; ph < hi; ++ph) {
    run_phase<-1>(p, ph, smem);
    if (PROBE_DUP) {
      const int kind = ph < 2 ? ph : 2 + (ph - 2) % 6;
      if ((PROBE_DUP >> kind) & 1) { xcd_barrier(xb); run_phase<-1>(p, ph, smem); }
    }
    if (ph + 1 < hi) xcd_barrier(xb);
  }
  if (coop == 2) cg::this_grid().sync();
}
#endif
template <int KIND>
__global__ void __launch_bounds__(256) phase_k(P p, int ph) {
  __shared__ __attribute__((aligned(16))) char smem[SMEM_BYTES];
  tidx_init();
  run_phase<KIND>(p, ph, smem);
}

extern "C" void kernel_launch(void* const* d_in, const int* in_sizes, int n_in, void* d_out, int out_size, void* d_ws,
                              size_t ws_size, hipStream_t stream) {
  P p{};
  const float** ins = (const float**)&p;
  for (int i = 0; i < 26; ++i) ins[i] = (const float*)d_in[i];
  p.out = (float*)d_out;
  p.ws = (char*)d_ws;
  if (WS_TOTAL > ws_size) { fprintf(stderr, "workspace too small: need %zu have %zu\n", (size_t)WS_TOTAL, ws_size); return; }

#if COOP
  static int grid_blocks = 0;
  if (!grid_blocks) {
    int dev = 0, cus = 0, per_cu = 0;
    (void)hipGetDevice(&dev);
    (void)hipDeviceGetAttribute(&cus, hipDeviceAttributeMultiprocessorCount, dev);
    (void)hipOccupancyMaxActiveBlocksPerMultiprocessor(&per_cu, mega, 256, 0);
    if (per_cu > 2) per_cu = 2;
    grid_blocks = cus * per_cu;
  }
  (void)hipMemsetAsync(p.ws + OFF_ctr, 0, 16384 + 4096, stream);
  int lo = 0, hi = NPHASE, coop = 1;
  void* args[] = {&p, &lo, &hi, &coop};
  hipError_t e = hipLaunchCooperativeKernel((void*)mega, dim3(grid_blocks), dim3(256), args, 0, stream);
  if (e != hipSuccess) fprintf(stderr, "cooperative launch failed: %s (grid %d)\n", hipGetErrorString(e), grid_blocks);
#else
  for (int ph = 0; ph < NPHASE; ++ph) {
    static const int kmap[6] = {2, 3, 7, 4, 5, 6};
    int kind = ph < 2 ? ph : kmap[(ph - 2) % 6];
    switch (kind) {
      case 0: phase_k<0><<<512, 256, 0, stream>>>(p, ph); break;
      case 1: phase_k<1><<<512, 256, 0, stream>>>(p, ph); break;
      case 2: phase_k<2><<<512, 256, 0, stream>>>(p, ph); break;
      case 3: phase_k<3><<<512, 256, 0, stream>>>(p, ph); break;
      case 4: phase_k<4><<<512, 256, 0, stream>>>(p, ph); break;
      case 5: phase_k<5><<<512, 256, 0, stream>>>(p, ph); break;
      case 7: phase_k<7><<<512, 256, 0, stream>>>(p, ph); break;
      default: phase_k<6><<<512, 256, 0, stream>>>(p, ph); break;
    }
  }
#endif
}
```

```cpp
#include <hip/hip_runtime.h>
#include <hip/hip_cooperative_groups.h>
#include <cstdio>
namespace cg = cooperative_groups;

typedef unsigned short bf16;
typedef __attribute__((ext_vector_type(8))) short bf16x8;
typedef __attribute__((ext_vector_type(4))) short s16x4;
typedef __attribute__((ext_vector_type(16))) float f32x16;
typedef __attribute__((ext_vector_type(4))) float f32x4;
typedef __attribute__((ext_vector_type(4))) unsigned u32x4;
typedef __attribute__((ext_vector_type(2))) unsigned u32x2;

#define DI __device__ __forceinline__
#define MFMA(a, b, c) __builtin_amdgcn_mfma_f32_32x32x16_bf16((a), (b), (c), 0, 0, 0)

#ifndef COOP
#define COOP 1
#endif
#define PROBE_DUP 0

constexpr int NTOK = 8192;
constexpr int NPROJ = 5888;
constexpr int NPHASE = 26;
constexpr float EPS = 1e-6f;
constexpr int SMEM_BYTES = 75 * 1024;

constexpr size_t O_YP = 0, O_YS = 4194304, O_CKV = 8388608, O_KROPE = 12582912, O_DK = 13631488,
                 O_DV = 22020096, O_MC = 30408704, O_MN = 38797312, O_MM = 38862848;

constexpr size_t al256(size_t x) { return (x + 255) & ~(size_t)255; }
constexpr size_t OFF_WinT = 0;
constexpr size_t OFF_WuqT = OFF_WinT + al256((size_t)4 * NPROJ * 1024 * 2);
constexpr size_t OFF_WukvT = OFF_WuqT + al256((size_t)4 * 768 * 384 * 2);
constexpr size_t OFF_WukvTp = OFF_WukvT + al256((size_t)4 * 1024 * 256 * 2);
constexpr size_t OFF_WoutT = OFF_WukvTp + al256((size_t)4 * 1024 * 256 * 2);
constexpr size_t OFF_mod = OFF_WoutT + al256((size_t)4 * 1024 * 1536 * 2);
constexpr size_t OFF_ropec = OFF_mod + al256((size_t)4 * 5 * 3072 * 4);
constexpr size_t OFF_ropes = OFF_ropec + al256((size_t)1024 * 32 * 4);
constexpr size_t OFF_lam = OFF_ropes + al256((size_t)1024 * 32 * 4);
constexpr size_t OFF_hbuf = OFF_lam + al256((size_t)256);
constexpr size_t OFF_xbuf = OFF_hbuf + al256((size_t)NTOK * 1024 * 2);
constexpr size_t OFF_proj = OFF_xbuf + al256((size_t)NTOK * 1024 * 4);
constexpr size_t OFF_Qa = OFF_proj + al256((size_t)NTOK * NPROJ * 2);
constexpr size_t OFF_Ka = OFF_Qa + al256((size_t)NTOK * 768 * 2);
constexpr size_t OFF_VaT = OFF_Ka + al256((size_t)NTOK * 768 * 2);
constexpr size_t OFF_Kb = OFF_VaT + al256((size_t)NTOK * 512 * 2);
constexpr size_t OFF_VbT = OFF_Kb + al256((size_t)NTOK * 512 * 2);
constexpr size_t OFF_VmT = OFF_VbT + al256((size_t)NTOK * 512 * 2);
constexpr size_t OFF_ycat = OFF_VmT + al256((size_t)NTOK * 512 * 2);
constexpr size_t OFF_gates = OFF_ycat + al256((size_t)NTOK * 1536 * 2);
constexpr size_t OFF_Cst = OFF_gates + al256((size_t)NTOK * 16 * 4);
constexpr size_t OFF_nst = OFF_Cst + al256((size_t)1024 * 16384 * 2);
constexpr size_t OFF_mst = OFF_nst + al256((size_t)1024 * 128 * 4);
constexpr size_t OFF_cckv = OFF_mst + al256((size_t)1024 * 4);
constexpr size_t OFF_cKa = OFF_cckv + al256((size_t)4096 * 256 * 2);
constexpr size_t OFF_cVaT = OFF_cKa + al256((size_t)64 * 256 * 192 * 2);
constexpr size_t OFF_cKb = OFF_cVaT + al256((size_t)64 * 128 * 256 * 2);
constexpr size_t OFF_cVbT = OFF_cKb + al256((size_t)64 * 256 * 128 * 2);
constexpr size_t OFF_blA = OFF_cVbT + al256((size_t)64 * 128 * 256 * 2);
constexpr size_t OFF_mlA = OFF_blA + 4096;
constexpr size_t OFF_ctr = OFF_mlA + 4096;
constexpr size_t OFF_qc = OFF_ctr + 16384;
constexpr size_t WS_TOTAL = OFF_qc + 4096;
struct P {
  const float *x_prompt, *x_sample, *c_ckv, *c_krope, *c_dk, *c_dv, *st_C, *st_n, *st_m, *c, *c_ctx, *g_norm, *W_mod,
      *b_mod, *W_in, *q_norm, *W_uq, *kv_norm, *W_ukv, *dlam, *dnorm, *mconv, *mgb, *mnorm, *W_out, *g_final;
  float* out;
  char* ws;
  __device__ __forceinline__ bf16* WinT() const { return (bf16*)(ws + OFF_WinT); }
  __device__ __forceinline__ bf16* WuqT() const { return (bf16*)(ws + OFF_WuqT); }
  __device__ __forceinline__ bf16* WukvT() const { return (bf16*)(ws + OFF_WukvT); }
  __device__ __forceinline__ bf16* WukvTp() const { return (bf16*)(ws + OFF_WukvTp); }
  __device__ __forceinline__ bf16* WoutT() const { return (bf16*)(ws + OFF_WoutT); }
  __device__ __forceinline__ float* mod() const { return (float*)(ws + OFF_mod); }
  __device__ __forceinline__ float* ropec() const { return (float*)(ws + OFF_ropec); }
  __device__ __forceinline__ float* ropes() const { return (float*)(ws + OFF_ropes); }
  __device__ __forceinline__ float* lam() const { return (float*)(ws + OFF_lam); }
  __device__ __forceinline__ bf16* hbuf() const { return (bf16*)(ws + OFF_hbuf); }
  __device__ __forceinline__ float* xbuf() const { return (float*)(ws + OFF_xbuf); }
  __device__ __forceinline__ bf16* proj() const { return (bf16*)(ws + OFF_proj); }
  __device__ __forceinline__ bf16* Qa() const { return (bf16*)(ws + OFF_Qa); }
  __device__ __forceinline__ bf16* Ka() const { return (bf16*)(ws + OFF_Ka); }
  __device__ __forceinline__ bf16* VaT() const { return (bf16*)(ws + OFF_VaT); }
  __device__ __forceinline__ bf16* Kb() const { return (bf16*)(ws + OFF_Kb); }
  __device__ __forceinline__ bf16* VbT() const { return (bf16*)(ws + OFF_VbT); }
  __device__ __forceinline__ bf16* VmT() const { return (bf16*)(ws + OFF_VmT); }
  __device__ __forceinline__ bf16* ycat() const { return (bf16*)(ws + OFF_ycat); }
  __device__ __forceinline__ float* gates() const { return (float*)(ws + OFF_gates); }
  __device__ __forceinline__ bf16* Cst() const { return (bf16*)(ws + OFF_Cst); }
  __device__ __forceinline__ float* nst() const { return (float*)(ws + OFF_nst); }
  __device__ __forceinline__ float* mst() const { return (float*)(ws + OFF_mst); }
  __device__ __forceinline__ bf16* cckv() const { return (bf16*)(ws + OFF_cckv); }
  __device__ __forceinline__ bf16* cKa() const { return (bf16*)(ws + OFF_cKa); }
  __device__ __forceinline__ bf16* cVaT() const { return (bf16*)(ws + OFF_cVaT); }
  __device__ __forceinline__ bf16* cKb() const { return (bf16*)(ws + OFF_cKb); }
  __device__ __forceinline__ bf16* cVbT() const { return (bf16*)(ws + OFF_cVbT); }
  __device__ __forceinline__ int* ctr() const { return (int*)(ws + OFF_ctr); }
  __device__ __forceinline__ int* qc() const { return (int*)(ws + OFF_qc); }
  __device__ __forceinline__ float* blA() const { return (float*)(ws + OFF_blA); }
  __device__ __forceinline__ float* mlA() const { return (float*)(ws + OFF_mlA); }
};

DI int tidx() { int t = threadIdx.x; asm volatile("" : "+v"(t)); return t; }
DI void tidx_init() {}
DI int wave_of(int tid) { return __builtin_amdgcn_readfirstlane(tid >> 6); }
typedef __attribute__((ext_vector_type(2))) __bf16 bf16v2;
typedef __attribute__((ext_vector_type(2))) float f32x2;
DI unsigned pack2(float a, float b) {
  f32x2 v; v[0] = a; v[1] = b;
  return __builtin_bit_cast(unsigned, __builtin_convertvector(v, bf16v2));
}
DI bf16 f2bf(float x) { return (bf16)(pack2(x, 0.f) & 0xffffu); }
DI float bf2f(bf16 b) { return __uint_as_float(((unsigned)b) << 16); }
DI float fexp2(float x) { return __builtin_amdgcn_exp2f(x); }
DI float fexp(float x) { return __builtin_amdgcn_exp2f(x * 1.4426950408889634f); }
DI float bflo(unsigned u) { return __uint_as_float(u << 16); }
DI float bfhi(unsigned u) { return __uint_as_float(u & 0xffff0000u); }
DI float silu_f(float x) { return x * __builtin_amdgcn_rcpf(1.f + fexp(-x)); }
DI float sigmoid_f(float x) { return __builtin_amdgcn_rcpf(1.f + fexp(-x)); }
DI float logsig_f(float x) { return fminf(x, 0.f) - log1pf(fexp(-fabsf(x))); }

struct TokInfo { int lat, b, t, T, tok0, modj; };
DI TokInfo tinfo(int tok) {
  TokInfo r;
  if (tok < 4096) { r.lat = 0; r.b = tok >> 8; r.t = tok & 255; r.T = 256; r.tok0 = tok & ~255; r.modj = 0; }
  else { int u = tok - 4096; r.lat = 1; r.b = u >> 10; r.t = u & 1023; r.T = 1024; r.tok0 = 4096 + (u & ~1023); r.modj = 1 + r.b; }
  return r;
}

struct GR { u32x4 ra0[4], rb0[4], ra1[4], rb1[4]; };
DI void gemm_load2(GR& g, const bf16* __restrict__ A, int lda, const bf16* __restrict__ Bt, int ldb) {
  const int tid = tidx();
  const int lr = tid >> 3, lc = tid & 7;
  const bf16* ap = A + (size_t)lr * lda + lc * 8;
  const bf16* bp = Bt + (size_t)lr * ldb + lc * 8;
  const size_t a32 = (size_t)32 * lda, b32 = (size_t)32 * ldb;
#pragma unroll
  for (int i = 0; i < 4; ++i) { g.ra0[i] = *(const u32x4*)(ap + i * a32); g.rb0[i] = *(const u32x4*)(bp + i * b32); }
#pragma unroll
  for (int i = 0; i < 4; ++i) { g.ra1[i] = *(const u32x4*)(ap + 64 + i * a32); g.rb1[i] = *(const u32x4*)(bp + 64 + i * b32); }
}
template <bool ROWSS>
DI void gemm_core_n(GR& g, const bf16* __restrict__ A, int lda, const bf16* __restrict__ Bt, int ldb,
                    const bf16* __restrict__ An, const bf16* __restrict__ Btn, int K, char* smem, f32x16 (&acc)[2][2]) {
  bf16* sA = (bf16*)smem;
  bf16* sB = sA + 128 * 72;
  float* sRow = (float*)(sB + 128 * 72);
  const int tid = tidx(), lane = tid & 63, w = wave_of(tid);
  const int wm = w >> 1, wn = w & 1, lq = lane & 31, h = lane >> 5;
  const int lr = tid >> 3, lc = tid & 7;
  float ss[4] = {0.f, 0.f, 0.f, 0.f};
#pragma unroll
  for (int i = 0; i < 2; ++i)
#pragma unroll
    for (int j = 0; j < 2; ++j)
#pragma unroll
      for (int r = 0; r < 16; ++r) acc[i][j][r] = 0.f;
  const bf16* ap = A + (size_t)lr * lda + lc * 8;
  const bf16* bp = Bt + (size_t)lr * ldb + lc * 8;
  const bf16* apn = An + (size_t)lr * lda + lc * 8;
  const bf16* bpn = Btn + (size_t)lr * ldb + lc * 8;
  const size_t a32 = (size_t)32 * lda, b32 = (size_t)32 * ldb;
  const int nk = K >> 6;
  auto step = [&](u32x4 (&ra)[4], u32x4 (&rb)[4], int kt) {
    if (kt) __syncthreads();
#pragma unroll
    for (int i = 0; i < 4; ++i) {
      *(u32x4*)(sA + (lr + 32 * i) * 72 + lc * 8) = ra[i];
      *(u32x4*)(sB + (lr + 32 * i) * 72 + lc * 8) = rb[i];
    }
    if (ROWSS) {
#pragma unroll
      for (int i = 0; i < 4; ++i)
#pragma unroll
        for (int e = 0; e < 4; ++e) {
          float a0 = bflo(ra[i][e]), a1 = bfhi(ra[i][e]);
          ss[i] += a0 * a0 + a1 * a1;
        }
    }
    __syncthreads();
    {
      const int kn = kt + 2;
      const bf16* ap2 = (kn < nk) ? ap + (size_t)kn * 64 : apn + (size_t)(kn - nk) * 64;
      const bf16* bp2 = (kn < nk) ? bp + (size_t)kn * 64 : bpn + (size_t)(kn - nk) * 64;
#pragma unroll
      for (int i = 0; i < 4; ++i) { ra[i] = *(const u32x4*)(ap2 + i * a32); rb[i] = *(const u32x4*)(bp2 + i * b32); }
    }
#pragma unroll
    for (int ks = 0; ks < 4; ++ks) {
      bf16x8 af[2], bfr[2];
#pragma unroll
      for (int i = 0; i < 2; ++i) af[i] = *(const bf16x8*)(sA + (wm * 64 + i * 32 + lq) * 72 + ks * 16 + h * 8);
#pragma unroll
      for (int j = 0; j < 2; ++j) bfr[j] = *(const bf16x8*)(sB + (wn * 64 + j * 32 + lq) * 72 + ks * 16 + h * 8);
#pragma unroll
      for (int i = 0; i < 2; ++i)
#pragma unroll
        for (int j = 0; j < 2; ++j) acc[i][j] = MFMA(af[i], bfr[j], acc[i][j]);
    }
  };
  for (int kt = 0; kt < nk; kt += 2) {
    step(g.ra0, g.rb0, kt);
    step(g.ra1, g.rb1, kt + 1);
  }
  if (ROWSS) {
#pragma unroll
    for (int i = 0; i < 4; ++i) {
      float v = ss[i];
      v += __shfl_xor(v, 1); v += __shfl_xor(v, 2); v += __shfl_xor(v, 4);
      if (lc == 0) sRow[lr + 32 * i] = v;
    }
  }
  __syncthreads();
}
template <bool ROWSS>
DI void gemm_core(const bf16* __restrict__ A, int lda, const bf16* __restrict__ Bt, int ldb, int K, char* smem,
                  f32x16 (&acc)[2][2]) {
  GR g;
  gemm_load2(g, A, lda, Bt, ldb);
  gemm_core_n<ROWSS>(g, A, lda, Bt, ldb, A, Bt, K, smem, acc);
}

DI void gemm_core_w(const bf16* __restrict__ A, int lda, const bf16* __restrict__ Bt, int ldb, int K, char* smem,
                    f32x16 (&acc)[2][4]) {
  bf16* sA = (bf16*)smem;
  bf16* sB = sA + 128 * 72;
  const int tid = tidx(), lane = tid & 63, w = wave_of(tid);
  const int wm = w >> 1, wn = w & 1, lq = lane & 31, h = lane >> 5;
  const int lr = tid >> 3, lc = tid & 7;
  u32x4 ra[4], rb[8];
#pragma unroll
  for (int i = 0; i < 2; ++i)
#pragma unroll
    for (int j = 0; j < 4; ++j)
#pragma unroll
      for (int r = 0; r < 16; ++r) acc[i][j][r] = 0.f;
  const bf16* ap = A + (size_t)lr * lda + lc * 8;
  const bf16* bp = Bt + (size_t)lr * ldb + lc * 8;
  const size_t a32 = (size_t)32 * lda, b32 = (size_t)32 * ldb;
#pragma unroll
  for (int i = 0; i < 4; ++i) ra[i] = *(const u32x4*)(ap + i * a32);
#pragma unroll
  for (int i = 0; i < 8; ++i) rb[i] = *(const u32x4*)(bp + i * b32);
  const int nk = K >> 6;
  for (int kt = 0; kt < nk; ++kt) {
    if (kt) __syncthreads();
#pragma unroll
    for (int i = 0; i < 4; ++i) *(u32x4*)(sA + (lr + 32 * i) * 72 + lc * 8) = ra[i];
#pragma unroll
    for (int i = 0; i < 8; ++i) *(u32x4*)(sB + (lr + 32 * i) * 72 + lc * 8) = rb[i];
    __syncthreads();
    {
      const int kn = (kt + 1 < nk) ? kt + 1 : kt;
      const bf16* ap2 = ap + (size_t)kn * 64;
      const bf16* bp2 = bp + (size_t)kn * 64;
#pragma unroll
      for (int i = 0; i < 4; ++i) ra[i] = *(const u32x4*)(ap2 + i * a32);
#pragma unroll
      for (int i = 0; i < 8; ++i) rb[i] = *(const u32x4*)(bp2 + i * b32);
    }
#pragma unroll
    for (int ks = 0; ks < 4; ++ks) {
      bf16x8 af[2], bfr[4];
#pragma unroll
      for (int i = 0; i < 2; ++i) af[i] = *(const bf16x8*)(sA + (wm * 64 + i * 32 + lq) * 72 + ks * 16 + h * 8);
#pragma unroll
      for (int j = 0; j < 4; ++j) bfr[j] = *(const bf16x8*)(sB + (wn * 128 + j * 32 + lq) * 72 + ks * 16 + h * 8);
#pragma unroll
      for (int i = 0; i < 2; ++i)
#pragma unroll
        for (int j = 0; j < 4; ++j) acc[i][j] = MFMA(af[i], bfr[j], acc[i][j]);
    }
  }
  __syncthreads();
}

DI void store_vt4(bf16* VT, size_t idx, float a, float b, float c, float d) {
  u32x2 v; v[0] = pack2(a, b); v[1] = pack2(c, d);
  *(u32x2*)(VT + idx) = v;
}

DI void transpose_tile(const float* __restrict__ src, int N, int Nvalid, bf16* __restrict__ dst, int K, int k0, int n0,
                       const float* __restrict__ gk, bf16* __restrict__ dst2, char* smem) {
  float* t = (float*)smem;
  const int tid = tidx();
#pragma unroll
  for (int i = 0; i < 4; ++i) {
    int idx = tid + 256 * i; int r = idx >> 4, c = (idx & 15) * 4;
    int n = n0 + c;
    f32x4 v = {0.f, 0.f, 0.f, 0.f};
    if (n < Nvalid) v = __builtin_nontemporal_load((const f32x4*)(src + (size_t)(k0 + r) * N + n));
    t[r * 65 + c] = v[0]; t[r * 65 + c + 1] = v[1]; t[r * 65 + c + 2] = v[2]; t[r * 65 + c + 3] = v[3];
  }
  __syncthreads();
  const int c2h = (tid & 31) * 2;
  const float gk0 = gk ? gk[k0 + c2h] : 1.f, gk1 = gk ? gk[k0 + c2h + 1] : 1.f;
#pragma unroll
  for (int i = 0; i < 8; ++i) {
    int idx = tid + 256 * i; int r = idx >> 5, c2 = (idx & 31) * 2;
    float v0 = t[c2 * 65 + r], v1 = t[(c2 + 1) * 65 + r];
    if (dst2) *(unsigned*)(dst2 + (size_t)(n0 + r) * K + k0 + c2) = pack2(v0, v1);
    v0 *= gk0; v1 *= gk1;
    *(unsigned*)(dst + (size_t)(n0 + r) * K + k0 + c2) = pack2(v0, v1);
  }
  __syncthreads();
}

DI void mod_item(const P& p, int it, char* smem) {
  float* sl = (float*)smem;
  float* red = sl + 5 * 1024;
  const int tid = tidx(), lane = tid & 63, w = wave_of(tid);
  const int l = it / 48, n0 = (it % 48) * 64;
  for (int idx = tid; idx < 5120; idx += 256) {
    int j = idx >> 10, k = idx & 1023;
    float cv = (j == 0) ? p.c_ctx[k] : p.c[(j - 1) * 1024 + k];
    sl[idx] = silu_f(cv);
  }
  __syncthreads();
  float a[5] = {0.f, 0.f, 0.f, 0.f, 0.f};
  const float* wp = p.W_mod + (size_t)l * 1024 * 3072 + n0 + lane;
  for (int k = w * 256; k < w * 256 + 256; k += 16) {
    float wv[16];
#pragma unroll
    for (int u = 0; u < 16; ++u) wv[u] = __builtin_nontemporal_load(wp + (size_t)(k + u) * 3072);
#pragma unroll
    for (int u = 0; u < 16; ++u)
#pragma unroll
      for (int j = 0; j < 5; ++j) a[j] += sl[j * 1024 + k + u] * wv[u];
  }
#pragma unroll
  for (int j = 0; j < 5; ++j) red[(w * 5 + j) * 64 + lane] = a[j];
  __syncthreads();
  for (int idx = tid; idx < 320; idx += 256) {
    int j = idx >> 6, c = idx & 63;
    float s = red[(0 * 5 + j) * 64 + c] + red[(1 * 5 + j) * 64 + c] + red[(2 * 5 + j) * 64 + c] + red[(3 * 5 + j) * 64 + c];
    p.mod()[(size_t)(l * 5 + j) * 3072 + n0 + c] = s + p.b_mod[l * 3072 + n0 + c];
  }
  __syncthreads();
}

DI void phase_prepass(const P& p, char* smem) {
  const int G = gridDim.x, B = blockIdx.x, tid = tidx();
  const int N_MOD = 192, N_WIN = 4 * 92 * 16, N_WOUT = 4 * 16 * 24, N_WUQ = 4 * 12 * 6, N_WUKV = 4 * 16 * 4;
  const int total = N_MOD + N_WIN + N_WOUT + N_WUQ + N_WUKV;
  for (int it = B; it < total; it += G) {
    int u = it;
    if (u < N_MOD) { mod_item(p, u, smem); continue; }
    u -= N_MOD;
    if (u < N_WIN) {
      int l = u / (92 * 16), r = u % (92 * 16), nt = r / 16, kt = r % 16;
      transpose_tile(p.W_in + (size_t)l * 1024 * 5840, 5840, 5840, p.WinT() + (size_t)l * NPROJ * 1024, 1024, kt * 64, nt * 64, nullptr, nullptr, smem);
      continue;
    }
    u -= N_WIN;
    if (u < N_WOUT) {
      int l = u / (16 * 24), r = u % (16 * 24), nt = r / 24, kt = r % 24;
      transpose_tile(p.W_out + (size_t)l * 1536 * 1024, 1024, 1024, p.WoutT() + (size_t)l * 1024 * 1536, 1536, kt * 64, nt * 64, nullptr, nullptr, smem);
      continue;
    }
    u -= N_WOUT;
    if (u < N_WUQ) {
      int l = u / 72, r = u % 72, nt = r / 6, kt = r % 6;
      transpose_tile(p.W_uq + (size_t)l * 384 * 768, 768, 768, p.WuqT() + (size_t)l * 768 * 384, 384, kt * 64, nt * 64, p.q_norm + l * 384, nullptr, smem);
      continue;
    }
    u -= N_WUQ;
    {
      int l = u / 64, r = u % 64, nt = r / 4, kt = r % 4;
      transpose_tile(p.W_ukv + (size_t)l * 256 * 1024, 1024, 1024, p.WukvT() + (size_t)l * 1024 * 256, 256, kt * 64, nt * 64, p.kv_norm + l * 256, p.WukvTp() + (size_t)l * 1024 * 256, smem);
    }
  }
  const int gtid = B * 256 + tid, gsz = G * 256;
  for (int idx = gtid; idx < 1024 * 32; idx += gsz) {
    int t = idx >> 5, i = idx & 31;
    float pos = (i < 16) ? (float)(t >> 6) : (float)(t & 63);
    float inv = powf(10000.f, -(float)(i & 15) / 16.f);
    float ang = pos * inv;
    p.ropec()[idx] = cosf(ang); p.ropes()[idx] = sinf(ang);
  }
  if (gtid < 4) {
    int l = gtid; const float* lp = p.dlam + l * 256;
    float s1 = 0.f, s2 = 0.f;
    for (int i = 0; i < 64; ++i) { s1 += lp[i] * lp[64 + i]; s2 += lp[128 + i] * lp[192 + i]; }
    float lam_init = 0.8f - 0.6f * expf(-0.3f * (float)l);
    p.lam()[l] = expf(s1) - expf(s2) + lam_init;
  }
  for (int idx = gtid; idx < 4 * 4 * 256 * 256; idx += gsz) {
    int d = idx & 255, t = (idx >> 8) & 255, b = (idx >> 16) & 3, l = idx >> 18;
    p.cckv()[idx] = f2bf(p.c_ckv[(size_t)((b * 4 + l) * 256 + t) * 256 + d]);
  }
  for (int idx = gtid; idx < 4 * 4 * 4 * 256 * 64; idx += gsz) {
    int r = idx & 63, t = (idx >> 6) & 255, hd = (idx >> 14) & 3, b = (idx >> 16) & 3, l = idx >> 18;
    p.cKa()[(size_t)((((l * 4 + b) * 4 + hd) * 256) + t) * 192 + 128 + r] = f2bf(p.c_krope[(size_t)((b * 4 + l) * 256 + t) * 64 + r]);
  }
  for (int idx = gtid; idx < 4 * 4 * 4 * 256 * 128; idx += gsz) {
    int d = idx & 127, t = (idx >> 7) & 255, hd = (idx >> 15) & 3, b = (idx >> 17) & 3, l = idx >> 19;
    p.cKb()[idx] = f2bf(p.c_dk[(size_t)(((b * 4 + l) * 256 + t) * 4 + hd) * 128 + d]);
  }
  for (int idx = gtid; idx < 4 * 4 * 4 * 128 * 256; idx += gsz) {
    int t = idx & 255, d = (idx >> 8) & 127, hd = (idx >> 15) & 3, b = (idx >> 17) & 3, l = idx >> 19;
    p.cVbT()[idx] = f2bf(p.c_dv[(size_t)(((b * 4 + l) * 256 + t) * 4 + hd) * 128 + d]);
  }
}

DI void norm_row(const P& p, int l, int tok, int mode) {
  const int lane = tidx() & 63;
  TokInfo ti = tinfo(tok);
  const float* x;
  if (mode == 0 && l == 0) x = ti.lat ? (p.x_sample + (size_t)(tok - 4096) * 1024) : (p.x_prompt + (size_t)tok * 1024);
  else x = p.xbuf() + (size_t)tok * 1024;
  f32x4 v[4];
  float ss = 0.f;
#pragma unroll
  for (int i = 0; i < 4; ++i) {
    v[i] = *(const f32x4*)(x + i * 256 + lane * 4);
    ss += v[i][0] * v[i][0] + v[i][1] * v[i][1] + v[i][2] * v[i][2] + v[i][3] * v[i][3];
  }
#pragma unroll
  for (int o = 32; o >= 1; o >>= 1) ss += __shfl_xor(ss, o);
  const float rstd = rsqrtf(ss * (1.f / 1024.f) + EPS);
  if (mode == 0) {
    const float* g = p.g_norm + l * 1024;
    const float* md = p.mod() + (size_t)(l * 5 + ti.modj) * 3072;
#pragma unroll
    for (int i = 0; i < 4; ++i) {
      int c = i * 256 + lane * 4;
      f32x4 gv = *(const f32x4*)(g + c), sh = *(const f32x4*)(md + c), sc = *(const f32x4*)(md + 1024 + c);
      float o0 = v[i][0] * rstd * gv[0] * (1.f + sc[0]) + sh[0];
      float o1 = v[i][1] * rstd * gv[1] * (1.f + sc[1]) + sh[1];
      float o2 = v[i][2] * rstd * gv[2] * (1.f + sc[2]) + sh[2];
      float o3 = v[i][3] * rstd * gv[3] * (1.f + sc[3]) + sh[3];
      u32x2 pk; pk[0] = pack2(o0, o1); pk[1] = pack2(o2, o3);
      *(u32x2*)(p.hbuf() + (size_t)tok * 1024 + c) = pk;
    }
  } else {
    float* o = p.out + (ti.lat ? (O_YS + (size_t)(tok - 4096) * 1024) : (O_YP + (size_t)tok * 1024));
#pragma unroll
    for (int i = 0; i < 4; ++i) {
      int c = i * 256 + lane * 4;
      f32x4 gv = *(const f32x4*)(p.g_final + c);
      f32x4 r; r[0] = v[i][0] * rstd * gv[0]; r[1] = v[i][1] * rstd * gv[1]; r[2] = v[i][2] * rstd * gv[2]; r[3] = v[i][3] * rstd * gv[3];
      *(f32x4*)(o + c) = r;
    }
  }
}

DI void img_put(bf16* img, const f32x16 (&acc)[2][2], int wm, int wn, int lq, int h) {
#pragma unroll
  for (int i = 0; i < 2; ++i)
#pragma unroll
    for (int j = 0; j < 2; ++j)
#pragma unroll
      for (int r = 0; r < 16; ++r)
        img[(wm * 64 + i * 32 + 8 * (r >> 2) + 4 * h + (r & 3)) * 136 + wn * 64 + j * 32 + lq] = f2bf(acc[i][j][r]);
}
DI void img_copy(const bf16* img, int half, bf16* dst, size_t stride, int tid) {
  u32x4 v[4];
#pragma unroll
  for (int i = 0; i < 4; ++i) { int idx = tid + 256 * i; int r = idx >> 3, c16 = idx & 7; v[i] = *(const u32x4*)(img + r * 136 + half * 64 + c16 * 8); }
#pragma unroll
  for (int i = 0; i < 4; ++i) { int idx = tid + 256 * i; int r = idx >> 3, c16 = idx & 7; *(u32x4*)(dst + (size_t)r * stride + c16 * 8) = v[i]; }
}
DI bool inproj_rm(int cb) { return !((cb >= 35 && cb <= 42) || (cb >= 67 && cb <= 74) || cb == 91); }

DI void epi_inproj(const P& p, int l, int m0, int n0, f32x16 (&acc)[2][2], char* smem) {
  const int tid_ = tidx(); const int lane = tid_ & 63, w = wave_of(tid_), wm = w >> 1, wn = w & 1, lq = lane & 31, h = lane >> 5;
  const int mb = m0 + wm * 64, nb = n0 + wn * 64;
  const int cb = nb >> 6;
  bf16* img = (bf16*)smem;
  TokInfo tb = tinfo(mb);
  const bool lat = tb.lat;
  if (!lat && (cb == 10 || (cb >= 27 && cb <= 34))) {
    float* ob = (cb == 10) ? p.out + O_KROPE + (size_t)((tb.b * 4 + l) * 256) * 64
                           : p.out + O_DK + (size_t)((tb.b * 4 + l) * 256) * 512 + (cb - 27) * 64;
    const int ostr = (cb == 10) ? 64 : 512;
#pragma unroll
    for (int i = 0; i < 2; ++i)
#pragma unroll
      for (int j = 0; j < 2; ++j)
#pragma unroll
        for (int r = 0; r < 16; ++r) {
          int tl = tb.t + i * 32 + 8 * (r >> 2) + 4 * h + (r & 3);
          ob[(size_t)tl * ostr + j * 32 + lq] = acc[i][j][r];
        }
  }
  const bool ropeT = lat && (cb == 10 || (cb >= 19 && cb <= 34));
  if (ropeT) {
#pragma unroll
    for (int i = 0; i < 2; ++i) {
      float cs[16], sn[16];
#pragma unroll
      for (int r = 0; r < 16; ++r) {
        int t = tb.t + i * 32 + 8 * (r >> 2) + 4 * h + (r & 3);
        cs[r] = p.ropec()[t * 32 + lq]; sn[r] = p.ropes()[t * 32 + lq];
      }
#pragma unroll
      for (int r = 0; r < 16; ++r) {
        float x1 = acc[i][0][r], x2 = acc[i][1][r];
        acc[i][0][r] = x1 * cs[r] - x2 * sn[r];
        acc[i][1][r] = x1 * sn[r] + x2 * cs[r];
      }
    }
  }
  if (inproj_rm(cb)) {
    img_put(img, acc, wm, wn, lq, h);
  } else if (cb == 91) {
    if (lq < 16) {
      float bias = p.mgb[l * 16 + lq];
#pragma unroll
      for (int i = 0; i < 2; ++i)
#pragma unroll
        for (int r = 0; r < 16; ++r) {
          int row = mb + i * 32 + 8 * (r >> 2) + 4 * h + (r & 3);
          p.gates()[row * 16 + lq] = acc[i][0][r] + bias;
        }
    }
  } else {
    const bool isdv = cb <= 42;
    int cc = isdv ? cb - 35 : cb - 67;
    int hd = cc >> 1, sub = cc & 1;
    bf16* VT = isdv ? p.VbT() : p.VmT();
#pragma unroll
    for (int i = 0; i < 2; ++i)
#pragma unroll
      for (int j = 0; j < 2; ++j) {
        int d = sub * 64 + j * 32 + lq;
#pragma unroll
        for (int g = 0; g < 4; ++g) {
          int tl = tb.t + i * 32 + 8 * g + 4 * h;
          store_vt4(VT, (size_t)tb.tok0 * 512 + (size_t)(hd * 128 + d) * tb.T + tl, acc[i][j][4 * g], acc[i][j][4 * g + 1], acc[i][j][4 * g + 2], acc[i][j][4 * g + 3]);
          if (isdv && !lat) {
#pragma unroll
            for (int jj = 0; jj < 4; ++jj)
              p.out[O_DV + (size_t)((tb.b * 4 + l) * 256 + tl + jj) * 512 + cc * 64 + j * 32 + lq] = acc[i][j][4 * g + jj];
          }
        }
      }
  }
  __syncthreads();
#pragma unroll
  for (int half = 0; half < 2; ++half) {
    const int cbh = (n0 >> 6) + half;
    if (!inproj_rm(cbh)) continue;
    if (cbh == 10) {
#pragma unroll
      for (int hd = 0; hd < 4; ++hd) img_copy(img, half, p.Ka() + (size_t)m0 * 768 + hd * 192 + 128, 768, tid_);
    } else if (cbh >= 27 && cbh <= 34) {
      img_copy(img, half, p.Kb() + (size_t)m0 * 512 + (cbh - 27) * 64, 512, tid_);
    } else {
      img_copy(img, half, p.proj() + (size_t)m0 * NPROJ + cbh * 64, NPROJ, tid_);
    }
  }
  __syncthreads();
}

constexpr int IMGW = 264;
DI void img_copy_w(const bf16* img, int half, bf16* dst, size_t stride, int tid) {
  u32x4 v[4];
#pragma unroll
  for (int i = 0; i < 4; ++i) { int idx = tid + 256 * i; int r = idx >> 3, c16 = idx & 7; v[i] = *(const u32x4*)(img + r * IMGW + half * 64 + c16 * 8); }
#pragma unroll
  for (int i = 0; i < 4; ++i) { int idx = tid + 256 * i; int r = idx >> 3, c16 = idx & 7; *(u32x4*)(dst + (size_t)r * stride + c16 * 8) = v[i]; }
}
template <int JP>
DI void epi_inproj_cbw(const P& p, int l, int m0, int cb, int imgcol, f32x16 (&acc)[2][4], bf16* img) {
  const int tid_ = tidx(); const int lane = tid_ & 63, w = wave_of(tid_), wm = w >> 1, lq = lane & 31, h = lane >> 5;
  const int mb = m0 + wm * 64;
  TokInfo tb = tinfo(mb);
  const bool lat = tb.lat;
  if (!lat && (cb == 10 || (cb >= 27 && cb <= 34))) {
    float* ob = (cb == 10) ? p.out + O_KROPE + (size_t)((tb.b * 4 + l) * 256) * 64
                           : p.out + O_DK + (size_t)((tb.b * 4 + l) * 256) * 512 + (cb - 27) * 64;
    const int ostr = (cb == 10) ? 64 : 512;
#pragma unroll
    for (int i = 0; i < 2; ++i)
#pragma unroll
      for (int j = 0; j < 2; ++j)
#pragma unroll
        for (int r = 0; r < 16; ++r) {
          int tl = tb.t + i * 32 + 8 * (r >> 2) + 4 * h + (r & 3);
          ob[(size_t)tl * ostr + j * 32 + lq] = acc[i][2 * JP + j][r];
        }
  }
  if (lat && (cb == 10 || (cb >= 19 && cb <= 34))) {
#pragma unroll
    for (int i = 0; i < 2; ++i) {
      float cs[16], sn[16];
#pragma unroll
      for (int r = 0; r < 16; ++r) {
        int t = tb.t + i * 32 + 8 * (r >> 2) + 4 * h + (r & 3);
        cs[r] = p.ropec()[t * 32 + lq]; sn[r] = p.ropes()[t * 32 + lq];
      }
#pragma unroll
      for (int r = 0; r < 16; ++r) {
        float x1 = acc[i][2 * JP][r], x2 = acc[i][2 * JP + 1][r];
        acc[i][2 * JP][r] = x1 * cs[r] - x2 * sn[r];
        acc[i][2 * JP + 1][r] = x1 * sn[r] + x2 * cs[r];
      }
    }
  }
  if (inproj_rm(cb)) {
#pragma unroll
    for (int i = 0; i < 2; ++i)
#pragma unroll
      for (int j = 0; j < 2; ++j)
#pragma unroll
        for (int r = 0; r < 16; ++r)
          img[(wm * 64 + i * 32 + 8 * (r >> 2) + 4 * h + (r & 3)) * IMGW + imgcol + j * 32 + lq] = f2bf(acc[i][2 * JP + j][r]);
  } else if (cb == 91) {
    if (lq < 16) {
      float bias = p.mgb[l * 16 + lq];
#pragma unroll
      for (int i = 0; i < 2; ++i)
#pragma unroll
        for (int r = 0; r < 16; ++r) {
          int row = mb + i * 32 + 8 * (r >> 2) + 4 * h + (r & 3);
          p.gates()[row * 16 + lq] = acc[i][2 * JP][r] + bias;
        }
    }
  } else {
    const bool isdv = cb <= 42;
    int cc = isdv ? cb - 35 : cb - 67;
    int hd = cc >> 1, sub = cc & 1;
    bf16* VT = isdv ? p.VbT() : p.VmT();
#pragma unroll
    for (int i = 0; i < 2; ++i)
#pragma unroll
      for (int j = 0; j < 2; ++j) {
        int d = sub * 64 + j * 32 + lq;
#pragma unroll
        for (int g = 0; g < 4; ++g) {
          int tl = tb.t + i * 32 + 8 * g + 4 * h;
          store_vt4(VT, (size_t)tb.tok0 * 512 + (size_t)(hd * 128 + d) * tb.T + tl, acc[i][2 * JP + j][4 * g], acc[i][2 * JP + j][4 * g + 1], acc[i][2 * JP + j][4 * g + 2], acc[i][2 * JP + j][4 * g + 3]);
          if (isdv && !lat) {
#pragma unroll
            for (int jj = 0; jj < 4; ++jj)
              p.out[O_DV + (size_t)((tb.b * 4 + l) * 256 + tl + jj) * 512 + cc * 64 + j * 32 + lq] = acc[i][2 * JP + j][4 * g + jj];
          }
        }
      }
  }
}
DI void epi_inproj_w(const P& p, int l, int m0, int n0, f32x16 (&acc)[2][4], char* smem) {
  bf16* img = (bf16*)smem;
  const int tid_ = tidx(); const int wn = wave_of(tid_) & 1;
  const int cb0 = n0 >> 6;
  epi_inproj_cbw<0>(p, l, m0, cb0 + 2 * wn, (2 * wn) * 64, acc, img);
  epi_inproj_cbw<1>(p, l, m0, cb0 + 2 * wn + 1, (2 * wn + 1) * 64, acc, img);
  __syncthreads();
#pragma unroll
  for (int half = 0; half < 4; ++half) {
    const int cbh = cb0 + half;
    if (!inproj_rm(cbh)) continue;
    if (cbh == 10) {
#pragma unroll
      for (int hd = 0; hd < 4; ++hd) img_copy_w(img, half, p.Ka() + (size_t)m0 * 768 + hd * 192 + 128, 768, tid_);
    } else if (cbh >= 27 && cbh <= 34) {
      img_copy_w(img, half, p.Kb() + (size_t)m0 * 512 + (cbh - 27) * 64, 512, tid_);
    } else {
      img_copy_w(img, half, p.proj() + (size_t)m0 * NPROJ + cbh * 64, NPROJ, tid_);
    }
  }
  __syncthreads();
}

DI void epi_qa(const P& p, int m0, int n0, f32x16 (&acc)[2][2], const float* sRow) {
  const int tid_ = tidx(); const int lane = tid_ & 63, w = wave_of(tid_), wm = w >> 1, wn = w & 1, lq = lane & 31, h = lane >> 5;
  const int mb = m0 + wm * 64, nb = n0 + wn * 64;
  const int cb = nb >> 6, hd = cb / 3, part = cb % 3;
  TokInfo tb = tinfo(mb);
  const bool dorope = tb.lat && part == 2;
#pragma unroll
  for (int i = 0; i < 2; ++i) {
    float cs[16], sn[16];
#pragma unroll
    for (int r = 0; r < 16; ++r) { cs[r] = 1.f; sn[r] = 0.f; }
    if (dorope) {
#pragma unroll
      for (int r = 0; r < 16; ++r) {
        int t = tb.t + i * 32 + 8 * (r >> 2) + 4 * h + (r & 3);
        cs[r] = p.ropec()[t * 32 + lq]; sn[r] = p.ropes()[t * 32 + lq];
      }
    }
#pragma unroll
    for (int r = 0; r < 16; ++r) {
      int rl = wm * 64 + i * 32 + 8 * (r >> 2) + 4 * h + (r & 3);
      float rstd = rsqrtf(sRow[rl] * (1.f / 384.f) + EPS);
      float x1 = acc[i][0][r] * rstd, x2 = acc[i][1][r] * rstd;
      {
        float y1 = x1 * cs[r] - x2 * sn[r], y2 = x1 * sn[r] + x2 * cs[r];
        x1 = y1; x2 = y2;
      }
      int row = m0 + rl;
      bf16* q = p.Qa() + (size_t)(row * 4 + hd) * 192 + part * 64;
      q[lq] = f2bf(x1); q[32 + lq] = f2bf(x2);
    }
  }
}

DI void epi_kv(const P& p, int m0, int n0, f32x16 (&acc)[2][2], const float* sRow, bool cache) {
  const int tid_ = tidx(); const int lane = tid_ & 63, w = wave_of(tid_), wm = w >> 1, wn = w & 1, lq = lane & 31, h = lane >> 5;
  const int mb = m0 + wm * 64, nb = n0 + wn * 64;
  const int cb = nb >> 6, hd = cb >> 2, part = cb & 3;
  TokInfo tb = tinfo(mb);
#pragma unroll
  for (int i = 0; i < 2; ++i)
#pragma unroll
    for (int j = 0; j < 2; ++j)
#pragma unroll
      for (int g = 0; g < 4; ++g) {
        float v[4];
#pragma unroll
        for (int jj = 0; jj < 4; ++jj) {
          int rl = wm * 64 + i * 32 + 8 * g + 4 * h + jj;
          float rstd = cache ? 1.f : rsqrtf(sRow[rl] * (1.f / 256.f) + EPS);
          v[jj] = acc[i][j][4 * g + jj] * rstd;
        }
        int c = j * 32 + lq;
        int row0 = mb + i * 32 + 8 * g + 4 * h;
        if (part < 2) {
#pragma unroll
          for (int jj = 0; jj < 4; ++jj) {
            int row = row0 + jj;
            if (cache) {
              int lb = row >> 8, t = row & 255;
              p.cKa()[(size_t)((lb * 4 + hd) * 256 + t) * 192 + part * 64 + c] = f2bf(v[jj]);
            } else {
              p.Ka()[(size_t)(row * 4 + hd) * 192 + part * 64 + c] = f2bf(v[jj]);
            }
          }
        } else {
          int d = (part - 2) * 64 + c;
          if (cache) {
            int lb = row0 >> 8, t = row0 & 255;
            store_vt4(p.cVaT(), (size_t)((lb * 4 + hd) * 128 + d) * 256 + t, v[0], v[1], v[2], v[3]);
          } else {
            int tl = tb.t + i * 32 + 8 * g + 4 * h;
            store_vt4(p.VaT(), (size_t)tb.tok0 * 512 + (size_t)(hd * 128 + d) * tb.T + tl, v[0], v[1], v[2], v[3]);
          }
        }
      }
}

DI void epi_out(const P& p, int l, int m0, int n0, f32x16 (&acc)[2][2]) {
  const int tid_ = tidx(); const int lane = tid_ & 63, w = wave_of(tid_), wm = w >> 1, wn = w & 1, lq = lane & 31, h = lane >> 5;
  const int mb = m0 + wm * 64, nb = n0 + wn * 64;
  TokInfo tb = tinfo(mb);
  const float* gate = p.mod() + (size_t)(l * 5 + tb.modj) * 3072 + 2048;
  const float* xsrc = (l == 0) ? (tb.lat ? p.x_sample - (size_t)4096 * 1024 : p.x_prompt) : (const float*)p.xbuf();
#pragma unroll
  for (int i = 0; i < 2; ++i)
#pragma unroll
    for (int j = 0; j < 2; ++j) {
      int col = nb + j * 32 + lq;
      float gv = gate[col];
      float xo[16];
#pragma unroll
      for (int r = 0; r < 16; ++r) {
        int row = mb + i * 32 + 8 * (r >> 2) + 4 * h + (r & 3);
        xo[r] = xsrc[(size_t)row * 1024 + col];
      }
#pragma unroll
      for (int r = 0; r < 16; ++r) {
        int row = mb + i * 32 + 8 * (r >> 2) + 4 * h + (r & 3);
        p.xbuf()[(size_t)row * 1024 + col] = xo[r] + gv * acc[i][j][r];
      }
    }
}

template <int KW, int DQ, int KSPLIT>
DI void attn_pass(const bf16* __restrict__ qptr, int koff, int kh, const bf16* __restrict__ Kmain, int ldk, int Tmain,
                  const bf16* __restrict__ Kc, int ldkc, int Tc, const bf16* __restrict__ VTmain,
                  const bf16* __restrict__ VTc, float c, char* smem, f32x16 (&o)[4], float& lsum, float& m_out) {
  constexpr int KS = KW + 8;
  constexpr int NKB = 2 / KSPLIT;
  bf16* sK = (bf16*)smem;
  bf16* sV = sK + 64 * KS;
  const int tid = tidx(), lane = tid & 63, lq = lane & 31, h = lane >> 5;
  bf16x8 qf[DQ / 16];
#pragma unroll
  for (int ks = 0; ks < DQ / 16; ++ks) qf[ks] = *(const bf16x8*)(qptr + ks * 16 + h * 8);
#pragma unroll
  for (int db = 0; db < 4; ++db)
#pragma unroll
    for (int r = 0; r < 16; ++r) o[db][r] = 0.f;
  lsum = 0.f;
  float m_run = -INFINITY;
  const int nt = (Tmain + Tc) >> 6;
  constexpr int CH = KW / 8, NKL = 64 * CH / 256;
  u32x4 kr[NKL], vr[4];
  auto issue = [&](int kt) {
    const bf16* ksrc; int ld; const bf16* vsrc; int ldv;
    if (kt * 64 < Tmain) { ksrc = Kmain + (size_t)(kt * 64) * ldk; ld = ldk; vsrc = VTmain + kt * 64; ldv = Tmain; }
    else { ksrc = Kc + (size_t)(kt * 64 - Tmain) * ldkc; ld = ldkc; vsrc = VTc + (kt * 64 - Tmain); ldv = Tc; }
#pragma unroll
    for (int i = 0; i < NKL; ++i) {
      int idx = tid + 256 * i; int r = idx / CH, cc = idx % CH;
      kr[i] = *(const u32x4*)(ksrc + (size_t)r * ld + cc * 8);
    }
    if (KSPLIT == 1) {
#pragma unroll
      for (int i = 0; i < 4; ++i) {
        int idx = tid + 256 * i; int r = idx >> 3, cc = idx & 7;
        vr[i] = *(const u32x4*)(vsrc + (size_t)r * ldv + cc * 8);
      }
    }
  };
  issue(0);
  for (int kt = 0; kt < nt; ++kt) {
    __syncthreads();
#pragma unroll
    for (int i = 0; i < NKL; ++i) {
      int idx = tid + 256 * i; int r = idx / CH, cc = idx % CH;
      *(u32x4*)(sK + r * KS + cc * 8) = kr[i];
    }
    if (KSPLIT != 1) {
      const bf16* vsrc; int ldv;
      if (kt * 64 < Tmain) { vsrc = VTmain + kt * 64; ldv = Tmain; } else { vsrc = VTc + (kt * 64 - Tmain); ldv = Tc; }
#pragma unroll
      for (int i = 0; i < 4; ++i) {
        int idx = tid + 256 * i; int r = idx >> 3, cc = idx & 7;
        vr[i] = *(const u32x4*)(vsrc + (size_t)r * ldv + cc * 8);
      }
    }
#pragma unroll
    for (int i = 0; i < 4; ++i) {
      int idx = tid + 256 * i; int r = idx >> 3, cc = idx & 7;
      *(u32x4*)(sV + r * 72 + cc * 8) = vr[i];
    }
    __syncthreads();
    issue((kt + 1 < nt) ? kt + 1 : kt);
    f32x16 s[NKB];
#pragma unroll
    for (int kbi = 0; kbi < NKB; ++kbi)
#pragma unroll
      for (int r = 0; r < 16; ++r) s[kbi][r] = 0.f;
#pragma unroll
    for (int ks = 0; ks < DQ / 16; ++ks)
#pragma unroll
      for (int kbi = 0; kbi < NKB; ++kbi) {
        const int kb = (KSPLIT == 2) ? kh : kbi;
        bf16x8 a = *(const bf16x8*)(sK + (kb * 32 + lq) * KS + koff + ks * 16 + h * 8);
        s[kbi] = MFMA(a, qf[ks], s[kbi]);
      }
    float mx = -INFINITY;
#pragma unroll
    for (int kbi = 0; kbi < NKB; ++kbi)
#pragma unroll
      for (int r = 0; r < 16; ++r) mx = fmaxf(mx, s[kbi][r]);
    mx = fmaxf(mx, __shfl_xor(mx, 32));
    const float m_new = fmaxf(m_run, mx);
    const float alpha = fexp2((m_run - m_new) * c);
    m_run = m_new;
    lsum *= alpha;
#pragma unroll
    for (int db = 0; db < 4; ++db)
#pragma unroll
      for (int r = 0; r < 16; ++r) o[db][r] *= alpha;
    const float mc = m_new * c;
#pragma unroll
    for (int kbi = 0; kbi < NKB; ++kbi)
#pragma unroll
      for (int r = 0; r < 16; ++r) { float pv = fexp2(s[kbi][r] * c - mc); s[kbi][r] = pv; lsum += pv; }
#pragma unroll
    for (int kbi = 0; kbi < NKB; ++kbi) {
      const int kb = (KSPLIT == 2) ? kh : kbi;
#pragma unroll
      for (int s2 = 0; s2 < 2; ++s2) {
        u32x4 pk;
#pragma unroll
        for (int e = 0; e < 4; ++e) pk[e] = pack2(s[kbi][8 * s2 + 2 * e], s[kbi][8 * s2 + 2 * e + 1]);
        bf16x8 pb = __builtin_bit_cast(bf16x8, pk);
#pragma unroll
        for (int db = 0; db < 4; ++db) {
          const bf16* vp = sV + (db * 32 + lq) * 72 + kb * 32 + s2 * 16 + 4 * h;
          u32x2 lo = *(const u32x2*)vp, hi = *(const u32x2*)(vp + 8);
          u32x4 av; av[0] = lo[0]; av[1] = lo[1]; av[2] = hi[0]; av[3] = hi[1];
          o[db] = MFMA(__builtin_bit_cast(bf16x8, av), pb, o[db]);
        }
      }
    }
  }
  lsum += __shfl_xor(lsum, 32);
  m_out = m_run;
}

DI void mla_item(const P& p, int l, int it, char* smem) {
  const int tid = tidx(), lane = tid & 63, w = wave_of(tid), lq = lane & 31, h = lane >> 5;
  int lat, b, hd, qb;
  if (it < 256) { lat = 1; b = it >> 6; hd = (it >> 4) & 3; qb = it & 15; }
  else { int u = it - 256; lat = 0; b = u >> 4; hd = (u >> 2) & 3; qb = u & 3; }
  const int T = lat ? 1024 : 256, tok0 = lat ? 4096 + b * 1024 : b * 256;
  const int qsub = w & 1, kh = w >> 1;
  const int tok = tok0 + qb * 64 + qsub * 32 + lq;
  f32x16 o[4]; float lsum, mrun;
  const float c = 0.07216878364870322f * 1.4426950408889634f;
  attn_pass<192, 192, 2>(p.Qa() + (size_t)(tok * 4 + hd) * 192, 0, kh, p.Ka() + (size_t)(tok0 * 4 + hd) * 192, 768, T,
                 p.cKa() + (size_t)((l * 4 + b) * 4 + hd) * 256 * 192, 192, lat ? 256 : 0,
                 p.VaT() + (size_t)tok0 * 512 + (size_t)hd * 128 * T, p.cVaT() + (size_t)((l * 4 + b) * 4 + hd) * 128 * 256, c, smem, o, lsum, mrun);
  float* ex = (float*)smem;
  float* exm = ex + 2 * 128 * 32;
  float* exl = exm + 64;
  __syncthreads();
  if (kh == 1) {
#pragma unroll
    for (int db = 0; db < 4; ++db)
#pragma unroll
      for (int r = 0; r < 16; ++r) {
        int dv = db * 32 + 8 * (r >> 2) + 4 * h + (r & 3);
        ex[(qsub * 128 + dv) * 32 + lq] = o[db][r];
      }
    if (h == 0) { exm[qsub * 32 + lq] = mrun; exl[qsub * 32 + lq] = lsum; }
  }
  __syncthreads();
  if (kh == 0) {
    const float m1 = exm[qsub * 32 + lq], l1 = exl[qsub * 32 + lq];
    const float mm = fmaxf(mrun, m1);
    const float f0 = fexp2((mrun - mm) * c), f1 = fexp2((m1 - mm) * c);
    const float inv = 1.f / (lsum * f0 + l1 * f1);
    const float g0 = f0 * inv, g1 = f1 * inv;
    u32x2 zz[4][4];
#pragma unroll
    for (int db = 0; db < 4; ++db)
#pragma unroll
      for (int g = 0; g < 4; ++g) zz[db][g] = *(const u32x2*)(p.proj() + (size_t)tok * NPROJ + 704 + hd * 128 + db * 32 + 8 * g + 4 * h);
#pragma unroll
    for (int db = 0; db < 4; ++db)
#pragma unroll
      for (int g = 0; g < 4; ++g) {
        int dv = db * 32 + 8 * g + 4 * h;
        float ov4[4];
#pragma unroll
        for (int jj = 0; jj < 4; ++jj) ov4[jj] = o[db][4 * g + jj] * g0 + ex[(qsub * 128 + dv + jj) * 32 + lq] * g1;
        u32x2 z = zz[db][g];
        float z0 = bflo(z[0]), z1 = bfhi(z[0]), z2 = bflo(z[1]), z3 = bfhi(z[1]);
        u32x2 ov;
        ov[0] = pack2(ov4[0] * silu_f(z0), ov4[1] * silu_f(z1));
        ov[1] = pack2(ov4[2] * silu_f(z2), ov4[3] * silu_f(z3));
        *(u32x2*)(p.ycat() + (size_t)tok * 1536 + hd * 128 + dv) = ov;
      }
  }
}

DI void diff_item(const P& p, int l, int it, char* smem) {
  const int tid = tidx(), lane = tid & 63, w = wave_of(tid), lq = lane & 31, h = lane >> 5;
  int lat, b, hd, qb;
  if (it < 256) { lat = 1; b = it >> 6; hd = (it >> 4) & 3; qb = it & 15; }
  else { int u = it - 256; lat = 0; b = u >> 4; hd = (u >> 2) & 3; qb = u & 3; }
  const int T = lat ? 1024 : 256, tok0 = lat ? 4096 + b * 1024 : b * 256;
  const int map = w >> 1, qsub = w & 1;
  const int tok = tok0 + qb * 64 + qsub * 32 + lq;
  const float c = 0.125f * 1.4426950408889634f;
  const bf16* vt = p.VbT() + (size_t)tok0 * 512 + (size_t)hd * 128 * T;
  const bf16* vtc = p.cVbT() + (size_t)((l * 4 + b) * 4 + hd) * 128 * 256;
  const bf16* kc = p.cKb() + (size_t)((l * 4 + b) * 4 + hd) * 256 * 128;
  f32x16 o[4]; float ls, mdummy;
  attn_pass<128, 64, 1>(p.proj() + (size_t)tok * NPROJ + 1216 + hd * 128 + map * 64, map * 64, 0, p.Kb() + (size_t)(tok0 * 4 + hd) * 128, 512, T, kc, 128,
                     lat ? 256 : 0, vt, vtc, c, smem, o, ls, mdummy);
  float* ex = (float*)smem;
  __syncthreads();
  if (map == 1) {
    const float sc2 = p.lam()[l] / ls;
#pragma unroll
    for (int db = 0; db < 4; ++db)
#pragma unroll
      for (int r = 0; r < 16; ++r) {
        int dv = db * 32 + 8 * (r >> 2) + 4 * h + (r & 3);
        ex[(qsub * 128 + dv) * 32 + lq] = o[db][r] * sc2;
      }
  }
  __syncthreads();
  if (map == 0) {
    const float i1 = 1.f / ls;
    float ss = 0.f;
#pragma unroll
    for (int db = 0; db < 4; ++db)
#pragma unroll
      for (int r = 0; r < 16; ++r) {
        int dv = db * 32 + 8 * (r >> 2) + 4 * h + (r & 3);
        float v = o[db][r] * i1 - ex[(qsub * 128 + dv) * 32 + lq];
        o[db][r] = v; ss += v * v;
      }
    ss += __shfl_xor(ss, 32);
    const float lam_init = 0.8f - 0.6f * fexp(-0.3f * (float)l);
    const float sc = rsqrtf(ss * (1.f / 128.f) + EPS) * (1.f - lam_init);
#pragma unroll
    for (int db = 0; db < 4; ++db) {
      u32x2 zz[4]; f32x4 gg[4];
#pragma unroll
      for (int g = 0; g < 4; ++g) {
        int dv = db * 32 + 8 * g + 4 * h;
        zz[g] = *(const u32x2*)(p.proj() + (size_t)tok * NPROJ + 2752 + hd * 128 + dv);
        gg[g] = *(const f32x4*)(p.dnorm + l * 128 + dv);
      }
#pragma unroll
      for (int g = 0; g < 4; ++g) {
        int dv = db * 32 + 8 * g + 4 * h;
        u32x2 z = zz[g];
        f32x4 gn = gg[g];
        float z0 = bflo(z[0]), z1 = bfhi(z[0]), z2 = bflo(z[1]), z3 = bfhi(z[1]);
        u32x2 ov;
        ov[0] = pack2(o[db][4 * g] * sc * gn[0] * silu_f(z0), o[db][4 * g + 1] * sc * gn[1] * silu_f(z1));
        ov[1] = pack2(o[db][4 * g + 2] * sc * gn[2] * silu_f(z2), o[db][4 * g + 3] * sc * gn[3] * silu_f(z3));
        *(u32x2*)(p.ycat() + (size_t)tok * 1536 + 512 + hd * 128 + dv) = ov;
      }
    }
  }
}

DI void conv8(const P& p, int l, int tok, int t, int T, int col, int wcol, float (&o)[8]) {
  const bf16* base = p.proj() + (size_t)tok * NPROJ + col;
  u32x4 cur = *(const u32x4*)base;
  u32x4 prv = {0u, 0u, 0u, 0u}, nxt = {0u, 0u, 0u, 0u};
  if (t > 0) prv = *(const u32x4*)(base - NPROJ);
  if (t < T - 1) nxt = *(const u32x4*)(base + NPROJ);
  const float* w0 = p.mconv + (size_t)l * 3 * 1024 + wcol;
  f32x4 wa0 = *(const f32x4*)w0, wa1 = *(const f32x4*)(w0 + 4);
  f32x4 wb0 = *(const f32x4*)(w0 + 1024), wb1 = *(const f32x4*)(w0 + 1028);
  f32x4 wc0 = *(const f32x4*)(w0 + 2048), wc1 = *(const f32x4*)(w0 + 2052);
#pragma unroll
  for (int e = 0; e < 4; ++e) {
    float wA0 = e < 2 ? wa0[2 * e] : wa1[2 * e - 4], wA1 = e < 2 ? wa0[2 * e + 1] : wa1[2 * e - 3];
    float wB0 = e < 2 ? wb0[2 * e] : wb1[2 * e - 4], wB1 = e < 2 ? wb0[2 * e + 1] : wb1[2 * e - 3];
    float wC0 = e < 2 ? wc0[2 * e] : wc1[2 * e - 4], wC1 = e < 2 ? wc0[2 * e + 1] : wc1[2 * e - 3];
    float v0 = wA0 * bflo(prv[e]) + wB0 * bflo(cur[e]) + wC0 * bflo(nxt[e]);
    float v1 = wA1 * bfhi(prv[e]) + wB1 * bfhi(cur[e]) + wC1 * bfhi(nxt[e]);
    o[2 * e] = silu_f(v0); o[2 * e + 1] = silu_f(v1);
  }
}

DI float wave_incl_scan_add(float v, int lane) {
#pragma unroll
  for (int o = 1; o < 64; o <<= 1) { float t = __shfl_up(v, o); if (lane >= o) v += t; }
  return v;
}
DI float wave_incl_scan_max(float v, int lane) {
#pragma unroll
  for (int o = 1; o < 64; o <<= 1) { float t = __shfl_up(v, o); if (lane >= o) v = fmaxf(v, t); }
  return v;
}

DI void mlstm_local(const P& p, int l, int slot, char* smem) {
  bf16* vT = (bf16*)smem;
  bf16* kT = vT + 128 * 72;
  float* wbuf = (float*)(kT + 128 * 72);
  const int tid = tidx(), lane = tid & 63, w = wave_of(tid), lq = lane & 31, h = lane >> 5;
  const int cp = slot >> 3, hd = (slot >> 1) & 3, dir = slot & 1;
  const int ctok = cp * 64;
  TokInfo ti = tinfo(ctok);
  const int T = ti.T;
  if (w == 0) {
    const int s = dir ? 63 - lane : lane;
    const int tk = ctok + s;
    const float ig = p.gates()[tk * 16 + dir * 8 + hd];
    const float lf = logsig_f(p.gates()[tk * 16 + dir * 8 + 4 + hd]);
    const float bc = wave_incl_scan_add(lf, lane);
    const float b_last = __shfl(bc, 63);
    const float val = b_last - bc + ig;
    float mx = val;
#pragma unroll
    for (int o = 32; o >= 1; o >>= 1) mx = fmaxf(mx, __shfl_xor(mx, o));
    wbuf[s] = fexp(val - mx);
    if (lane == 0) { p.blA()[slot] = b_last; p.mlA()[slot] = mx; }
  }
  __syncthreads();
  {
    const int s = tid >> 2, chb = (tid & 3) * 32;
    const float ws = wbuf[s];
#pragma unroll 1
    for (int q = 0; q < 4; ++q) {
      float kv[8];
      const int ch = chb + q * 8;
      conv8(p, l, ctok + s, ti.t + s, T, 3776 + hd * 128 + ch, 512 + hd * 128 + ch, kv);
#pragma unroll
      for (int e = 0; e < 8; ++e) kT[(ch + e) * 72 + s] = f2bf(kv[e] * ws);
    }
    const bf16* vsrc = p.VmT() + (size_t)ti.tok0 * 512 + (size_t)hd * 128 * T + ti.t;
#pragma unroll
    for (int i = 0; i < 4; ++i) {
      int idx = tid + 256 * i; int r = idx >> 3, cc = idx & 7;
      *(u32x4*)(vT + r * 72 + cc * 8) = *(const u32x4*)(vsrc + (size_t)r * T + cc * 8);
    }
  }
  __syncthreads();
  f32x16 acc[4];
#pragma unroll
  for (int cb = 0; cb < 4; ++cb)
#pragma unroll
    for (int r = 0; r < 16; ++r) acc[cb][r] = 0.f;
#pragma unroll
  for (int ks = 0; ks < 4; ++ks) {
    bf16x8 a = *(const bf16x8*)(vT + (32 * w + lq) * 72 + ks * 16 + 8 * h);
#pragma unroll
    for (int cb = 0; cb < 4; ++cb) {
      bf16x8 bb = *(const bf16x8*)(kT + (32 * cb + lq) * 72 + ks * 16 + 8 * h);
      acc[cb] = MFMA(a, bb, acc[cb]);
    }
  }
  bf16* cs = p.Cst() + (size_t)slot * 16384;
#pragma unroll
  for (int cb = 0; cb < 4; ++cb)
#pragma unroll
    for (int r = 0; r < 16; ++r) {
      int dvv = 32 * w + 8 * (r >> 2) + 4 * h + (r & 3);
      cs[dvv * 128 + 32 * cb + lq] = f2bf(acc[cb][r]);
    }
  if (tid < 128) {
    float sum = 0.f;
#pragma unroll
    for (int q = 0; q < 8; ++q) {
      u32x4 v = *(const u32x4*)(kT + tid * 72 + q * 8);
#pragma unroll
      for (int e = 0; e < 4; ++e) sum += bflo(v[e]) + bfhi(v[e]);
    }
    p.nst()[slot * 128 + tid] = sum;
  }
}

DI void mlstm_scan(const P& p, int l, int it) {
  const int tid = tidx();
  const int ch = it >> 2, qt = it & 3;
  int lat, b, hd, dir;
  if (ch < 32) { lat = 1; b = ch >> 3; hd = (ch >> 1) & 3; dir = ch & 1; }
  else { int u = ch - 32; lat = 0; b = u >> 3; hd = (u >> 1) & 3; dir = u & 1; }
  const int T = lat ? 1024 : 256, tok0 = lat ? 4096 + b * 1024 : b * 256, nc = T >> 6;
  const int dv0 = 32 * qt + 4 * (tid >> 5), dk0 = 4 * (tid & 31);
  float C[4][4];
  float n_val = 0.f, m_prev = 0.f;
  const bool do_n = (qt == 0) && (tid < 128);
  const size_t sidx = (size_t)((b * 4 + l) * 2 + dir) * 4 + hd;
  if (lat) {
    const float* C0 = p.st_C + sidx * 16384;
#pragma unroll
    for (int j = 0; j < 4; ++j) {
      f32x4 v = *(const f32x4*)(C0 + (size_t)(dk0 + j) * 128 + dv0);
      C[0][j] = v[0]; C[1][j] = v[1]; C[2][j] = v[2]; C[3][j] = v[3];
    }
    if (do_n) n_val = p.st_n[sidx * 128 + tid];
    m_prev = p.st_m[sidx];
  } else {
#pragma unroll
    for (int i = 0; i < 4; ++i)
#pragma unroll
      for (int j = 0; j < 4; ++j) C[i][j] = 0.f;
  }
  u32x2 dnx[4]; float blx, mlx, dnnx = 0.f;
  {
    const int c = dir ? nc - 1 : 0;
    const int slot = ((((tok0 >> 6) + c) * 4 + hd) * 2) + dir;
    const bf16* cs = p.Cst() + (size_t)slot * 16384 + dv0 * 128 + dk0;
#pragma unroll
    for (int i = 0; i < 4; ++i) dnx[i] = *(const u32x2*)(cs + i * 128);
    blx = p.blA()[slot]; mlx = p.mlA()[slot];
    if (do_n) dnnx = p.nst()[slot * 128 + tid];
  }
  for (int ci = 0; ci < nc; ++ci) {
    const int c = dir ? nc - 1 - ci : ci;
    const int slot = ((((tok0 >> 6) + c) * 4 + hd) * 2) + dir;
    bf16* cs = p.Cst() + (size_t)slot * 16384 + dv0 * 128 + dk0;
    u32x2 d[4];
#pragma unroll
    for (int i = 0; i < 4; ++i) d[i] = dnx[i];
    const float bl = blx, ml = mlx;
    const float dn = dnnx;
    {
      const int cn = (ci + 1 < nc) ? (dir ? nc - 2 - ci : ci + 1) : c;
      const int sn = ((((tok0 >> 6) + cn) * 4 + hd) * 2) + dir;
      const bf16* csn = p.Cst() + (size_t)sn * 16384 + dv0 * 128 + dk0;
#pragma unroll
      for (int i = 0; i < 4; ++i) dnx[i] = *(const u32x2*)(csn + i * 128);
      blx = p.blA()[sn]; mlx = p.mlA()[sn];
      if (do_n) dnnx = p.nst()[sn * 128 + tid];
    }
#pragma unroll
    for (int i = 0; i < 4; ++i) {
      u32x2 o; o[0] = pack2(C[i][0], C[i][1]); o[1] = pack2(C[i][2], C[i][3]);
      *(u32x2*)(cs + i * 128) = o;
    }
    if (do_n) p.nst()[slot * 128 + tid] = n_val;
    if (qt == 0 && tid == 0) p.mst()[slot] = m_prev;
    const float m_new = fmaxf(bl + m_prev, ml);
    const float a = fexp(bl + m_prev - m_new), bs = fexp(ml - m_new);
#pragma unroll
    for (int i = 0; i < 4; ++i) {
      C[i][0] = a * C[i][0] + bs * bflo(d[i][0]); C[i][1] = a * C[i][1] + bs * bfhi(d[i][0]);
      C[i][2] = a * C[i][2] + bs * bflo(d[i][1]); C[i][3] = a * C[i][3] + bs * bfhi(d[i][1]);
    }
    n_val = a * n_val + bs * dn;
    m_prev = m_new;
  }
  if (!lat) {
    float* Co = p.out + O_MC + sidx * 16384;
#pragma unroll
    for (int j = 0; j < 4; ++j) {
      f32x4 v; v[0] = C[0][j]; v[1] = C[1][j]; v[2] = C[2][j]; v[3] = C[3][j];
      *(f32x4*)(Co + (size_t)(dk0 + j) * 128 + dv0) = v;
    }
    if (do_n) p.out[O_MN + sidx * 128 + tid] = n_val;
    if (qt == 0 && tid == 0) p.out[O_MM + sidx] = m_prev;
  }
}

DI void mlstm_out(const P& p, int l, int it, char* smem) {
  bf16* sq = (bf16*)smem;
  bf16* sk = sq + 64 * 136;
  bf16* vT = sk + 64 * 136;
  float* bcA = (float*)(vT + 128 * 72);
  float* uA = bcA + 64, *mtA = uA + 64, *nA = mtA + 64  , *ssb = nA + 128  ;
  const int tid = tidx(), lane = tid & 63, w = wave_of(tid), lq = lane & 31, h = lane >> 5;
  const int cp = it >> 2, hd = it & 3;
  const int ctok = cp * 64;
  TokInfo ti = tinfo(ctok);
  const int T = ti.T;
  {
    const int s = tid >> 2, chb = (tid & 3) * 32;
#pragma unroll 1
    for (int q = 0; q < 4; ++q) {
      const int ch = chb + q * 8;
      float v[8];
      conv8(p, l, ctok + s, ti.t + s, T, 3264 + hd * 128 + ch, hd * 128 + ch, v);
      u32x4 pk;
#pragma unroll
      for (int e = 0; e < 4; ++e) pk[e] = pack2(v[2 * e] * 0.08838834764831845f, v[2 * e + 1] * 0.08838834764831845f);
      *(u32x4*)(sq + s * 136 + ch) = pk;
      conv8(p, l, ctok + s, ti.t + s, T, 3776 + hd * 128 + ch, 512 + hd * 128 + ch, v);
#pragma unroll
      for (int e = 0; e < 4; ++e) pk[e] = pack2(v[2 * e], v[2 * e + 1]);
      *(u32x4*)(sk + s * 136 + ch) = pk;
    }
    const bf16* vsrc = p.VmT() + (size_t)ti.tok0 * 512 + (size_t)hd * 128 * T + ti.t;
#pragma unroll
    for (int i = 0; i < 4; ++i) {
      int idx = tid + 256 * i; int r = idx >> 3, cc = idx & 7;
      *(u32x4*)(vT + r * 72 + cc * 8) = *(const u32x4*)(vsrc + (size_t)r * T + cc * 8);
    }
  }
  const int tb = w & 1, dvh = w >> 1;
  const int t = 32 * tb + lq;
  f32x16 hacc[2];
#pragma unroll
  for (int d2 = 0; d2 < 2; ++d2)
#pragma unroll
    for (int r = 0; r < 16; ++r) hacc[d2][r] = 0.f;
  const bf16* sqt = sq + t * 136 + 8 * h;
  for (int dir = 0; dir < 2; ++dir) {
    const int slot = (cp * 4 + hd) * 2 + dir;
    const float m_prev = p.mst()[slot];
    __syncthreads();
    if (w == 0) {
      const int s = dir ? 63 - lane : lane;
      const int tk = ctok + s;
      const float ig = p.gates()[tk * 16 + dir * 8 + hd];
      const float lf = logsig_f(p.gates()[tk * 16 + dir * 8 + 4 + hd]);
      const float bc = wave_incl_scan_add(lf, lane);
      const float u = ig - bc;
      const float pm = wave_incl_scan_max(u, lane);
      bcA[s] = bc; uA[s] = u; mtA[s] = bc + fmaxf(m_prev, pm);
    } else if (w < 3) {
      nA[tid - 64] = p.nst()[slot * 128 + tid - 64];
    }
    __syncthreads();
    const float bc_t = bcA[t], mt = mtA[t];
    const float w_inter = fexp(bc_t + m_prev - mt);
    float den = 0.f;
    const float e0 = bc_t - mt;
    u32x4 pk[2][2];
#pragma unroll
    for (int sb = 0; sb < 2; ++sb) {
      asm volatile("" ::: "memory");
      f32x16 sv;
#pragma unroll
      for (int r = 0; r < 16; ++r) sv[r] = 0.f;
#pragma unroll
      for (int ks = 0; ks < 8; ++ks) {
        bf16x8 a = *(const bf16x8*)(sk + (32 * sb + lq) * 136 + ks * 16 + 8 * h);
        sv = MFMA(a, *(const bf16x8*)(sqt + ks * 16), sv);
      }
#pragma unroll
      for (int r = 0; r < 16; ++r) {
        const int sidx = 32 * sb + 8 * (r >> 2) + 4 * h + (r & 3);
        const bool valid = dir ? (sidx >= t) : (sidx <= t);
        const float wgt = valid ? fexp(e0 + uA[sidx]) : 0.f;
        const float v = sv[r] * wgt;
        sv[r] = v; den += v;
      }
#pragma unroll
      for (int s2 = 0; s2 < 2; ++s2)
#pragma unroll
        for (int e = 0; e < 4; ++e) pk[sb][s2][e] = pack2(sv[8 * s2 + 2 * e], sv[8 * s2 + 2 * e + 1]);
    }
    asm volatile("" ::: "memory");
    den += __shfl_xor(den, 32);
    float qn = 0.f;
#pragma unroll
    for (int ks = 0; ks < 8; ++ks) {
      u32x4 qv = *(const u32x4*)(sqt + ks * 16);
#pragma unroll
      for (int e = 0; e < 4; ++e) {
        qn += bflo(qv[e]) * nA[ks * 16 + 8 * h + 2 * e] + bfhi(qv[e]) * nA[ks * 16 + 8 * h + 2 * e + 1];
      }
    }
    qn += __shfl_xor(qn, 32);
    den += w_inter * qn;
    asm volatile("" ::: "memory");
    const float rden = 1.f / fmaxf(fabsf(den), fexp(-mt));
    const bf16* cs = p.Cst() + (size_t)slot * 16384;
#pragma unroll
    for (int d2 = 0; d2 < 2; ++d2) {
      const int dvb = 2 * dvh + d2;
      f32x16 acc;
#pragma unroll
      for (int r = 0; r < 16; ++r) acc[r] = 0.f;
      bf16x8 cf[8];
#pragma unroll
      for (int ks = 0; ks < 8; ++ks) cf[ks] = *(const bf16x8*)(cs + (dvb * 32 + lq) * 128 + ks * 16 + 8 * h);
      asm volatile("" : "+v"(cf[0]), "+v"(cf[1]), "+v"(cf[2]), "+v"(cf[3]), "+v"(cf[4]), "+v"(cf[5]), "+v"(cf[6]), "+v"(cf[7]));
#pragma unroll
      for (int ks = 0; ks < 8; ++ks) acc = MFMA(cf[ks], *(const bf16x8*)(sqt + ks * 16), acc);
#pragma unroll
      for (int r = 0; r < 16; ++r) acc[r] *= w_inter;
#pragma unroll
      for (int sb = 0; sb < 2; ++sb)
#pragma unroll
        for (int s2 = 0; s2 < 2; ++s2) {
          const bf16* vp = vT + (dvb * 32 + lq) * 72 + sb * 32 + s2 * 16 + 4 * h;
          u32x2 lo = *(const u32x2*)vp, hi = *(const u32x2*)(vp + 8);
          u32x4 av; av[0] = lo[0]; av[1] = lo[1]; av[2] = hi[0]; av[3] = hi[1];
          acc = MFMA(__builtin_bit_cast(bf16x8, av), __builtin_bit_cast(bf16x8, pk[sb][s2]), acc);
        }
#pragma unroll
      for (int r = 0; r < 16; ++r) hacc[d2][r] += acc[r] * rden;
    }
  }
  const int tok = ctok + t;
  float ss = 0.f;
#pragma unroll
  for (int d2 = 0; d2 < 2; ++d2)
#pragma unroll
    for (int g = 0; g < 4; ++g) {
      int dv = (2 * dvh + d2) * 32 + 8 * g + 4 * h;
      u32x2 mo = *(const u32x2*)(p.proj() + (size_t)tok * NPROJ + 4800 + hd * 128 + dv);
      float m0 = bflo(mo[0]), m1 = bfhi(mo[0]), m2 = bflo(mo[1]), m3 = bfhi(mo[1]);
      float v0 = hacc[d2][4 * g] * sigmoid_f(m0), v1 = hacc[d2][4 * g + 1] * sigmoid_f(m1);
      float v2 = hacc[d2][4 * g + 2] * sigmoid_f(m2), v3 = hacc[d2][4 * g + 3] * sigmoid_f(m3);
      hacc[d2][4 * g] = v0; hacc[d2][4 * g + 1] = v1; hacc[d2][4 * g + 2] = v2; hacc[d2][4 * g + 3] = v3;
      ss += v0 * v0 + v1 * v1 + v2 * v2 + v3 * v3;
    }
  ss += __shfl_xor(ss, 32);
  if (h == 0) ssb[dvh * 64 + t] = ss;
  __syncthreads();
  const float rstd = rsqrtf((ssb[t] + ssb[64 + t]) * (1.f / 128.f) + EPS);
  u32x2 zz[2][4]; f32x4 gg[2][4];
#pragma unroll
  for (int d2 = 0; d2 < 2; ++d2)
#pragma unroll
    for (int g = 0; g < 4; ++g) {
      int dv = (2 * dvh + d2) * 32 + 8 * g + 4 * h;
      zz[d2][g] = *(const u32x2*)(p.proj() + (size_t)tok * NPROJ + 5312 + hd * 128 + dv);
      gg[d2][g] = *(const f32x4*)(p.mnorm + l * 512 + hd * 128 + dv);
    }
#pragma unroll
  for (int d2 = 0; d2 < 2; ++d2)
#pragma unroll
    for (int g = 0; g < 4; ++g) {
      int dv = (2 * dvh + d2) * 32 + 8 * g + 4 * h;
      u32x2 z = zz[d2][g];
      f32x4 gn = gg[d2][g];
      float z0 = bflo(z[0]), z1 = bfhi(z[0]), z2 = bflo(z[1]), z3 = bfhi(z[1]);
      u32x2 ov;
      ov[0] = pack2(hacc[d2][4 * g] * rstd * gn[0] * silu_f(z0), hacc[d2][4 * g + 1] * rstd * gn[1] * silu_f(z1));
      ov[1] = pack2(hacc[d2][4 * g + 2] * rstd * gn[2] * silu_f(z2), hacc[d2][4 * g + 3] * rstd * gn[3] * silu_f(z3));
      *(u32x2*)(p.ycat() + (size_t)tok * 1536 + 1024 + hd * 128 + dv) = ov;
    }
}

DI void ckv_fin(const P& p, int l, int tok) {
  const int lane = tidx() & 63;
  const int b = tok >> 8, t = tok & 255;
  float* o = p.out + O_CKV + (size_t)((b * 4 + l) * 256 + t) * 256 + lane * 4;
  u32x2 raw = *(const u32x2*)(p.proj() + (size_t)tok * NPROJ + 384 + lane * 4);
  f32x4 v; v[0] = bflo(raw[0]); v[1] = bfhi(raw[0]); v[2] = bflo(raw[1]); v[3] = bfhi(raw[1]);
  float ss = v[0] * v[0] + v[1] * v[1] + v[2] * v[2] + v[3] * v[3];
#pragma unroll
  for (int of = 32; of >= 1; of >>= 1) ss += __shfl_xor(ss, of);
  const float rstd = rsqrtf(ss * (1.f / 256.f) + EPS);
  f32x4 g = *(const f32x4*)(p.kv_norm + l * 256 + lane * 4);
  v[0] *= rstd * g[0]; v[1] *= rstd * g[1]; v[2] *= rstd * g[2]; v[3] *= rstd * g[3];
  *(f32x4*)o = v;
}

#define XB_TMO      128
#define XB_XCNT(j)  (256  + 64 * (j))
#define XB_XSUB(j)  (1280 + 64 * (j))
#define XB_XGEN(j)  (2304 + 64 * (j))
#define XB_TOP      3328
#define XB_TOPGEN   3392
#define XCD_BAR_WORDS 3456
#define XB_SPIN_CAP (1u << 18)
#define LAS __attribute__((address_space(3)))

__device__ __forceinline__ unsigned xb_ld(unsigned* p)              { return __hip_atomic_load(p, __ATOMIC_RELAXED, __HIP_MEMORY_SCOPE_AGENT); }
__device__ __forceinline__ unsigned xb_add(unsigned* p, unsigned v) { return __hip_atomic_fetch_add(p, v, __ATOMIC_RELAXED, __HIP_MEMORY_SCOPE_AGENT); }
__device__ __forceinline__ unsigned xb_xcc_id() { return (unsigned)__builtin_amdgcn_s_getreg((3 << 11) | 20) & 0xFu; }
#define XB_SPIN(cond, bar) do { unsigned _sp = 0; while (cond) { __builtin_amdgcn_s_sleep(1); \
    if ((++_sp & 255u) == 0u) { if (xb_ld(&(bar)[XB_TMO])) break; if (_sp > XB_SPIN_CAP) { atomicAdd(&(bar)[XB_TMO], 1u); break; } } } } while (0)

struct XcdBarrier {
    unsigned* bar; unsigned x;
    volatile LAS unsigned* st;
};

__device__ __forceinline__ XcdBarrier xcd_barrier_post(unsigned* bar, volatile LAS unsigned* st) {
    XcdBarrier b; b.bar = bar; b.x = xb_xcc_id(); b.st = st;
    if (tidx() == 0) (void)xb_add(&bar[XB_XCNT(b.x)], 1u);
    return b;
}
__device__ __forceinline__ void xcd_barrier_complete(unsigned* bar, unsigned x, unsigned& nloc, unsigned& nx) {
    const unsigned G = gridDim.x * gridDim.y * gridDim.z;
    unsigned sum, cnt, mine, sp = 0u;
    for (;;) {
        sum = 0u; cnt = 0u; mine = 0u;
#pragma unroll
        for (unsigned j = 0; j < 16; ++j) { const unsigned c = xb_ld(&bar[XB_XCNT(j)]); sum += c; cnt += (c > 0u) ? 1u : 0u; mine = (j == x) ? c : mine; }
        if (sum == G) break;
        __builtin_amdgcn_s_sleep(1);
        if ((++sp & 255u) == 0u) { if (xb_ld(&bar[XB_TMO])) break; if (sp > XB_SPIN_CAP) { atomicAdd(&bar[XB_TMO], 1u); break; } }
    }
    nloc = mine > 0u ? mine : 1u; nx = cnt > 0u ? cnt : 1u;
}

__device__ __forceinline__ void xcd_barrier(const XcdBarrier& b) {
    asm volatile("s_waitcnt vmcnt(0)" ::: "memory");
    __syncthreads();
    if (tidx() == 0) {
        unsigned* bar = b.bar;
        __builtin_amdgcn_s_waitcnt(0);
        unsigned nloc = b.st[0], nx = b.st[1];
        if (nloc == 0u) { xcd_barrier_complete(bar, b.x, nloc, nx); b.st[0] = nloc; b.st[1] = nx; }
        const unsigned old = xb_add(&bar[XB_XSUB(b.x)], 1u);
        const unsigned gen = old / nloc;
        if (old + 1u == (gen + 1u) * nloc) {
            __builtin_amdgcn_fence(__ATOMIC_RELEASE, "agent");
            asm volatile("s_waitcnt vmcnt(0)" ::: "memory");
            const unsigned og = xb_add(&bar[XB_TOP], 1u);
            const unsigned tg = og / nx;
            if (og + 1u == (tg + 1u) * nx) xb_add(&bar[XB_TOPGEN], 1u);
            else XB_SPIN(xb_ld(&bar[XB_TOPGEN]) == tg, bar);
            __builtin_amdgcn_fence(__ATOMIC_ACQUIRE, "agent");
            xb_add(&bar[XB_XGEN(b.x)], 1u);
            asm volatile("s_waitcnt vmcnt(0)" ::: "memory");
        } else {
            XB_SPIN(xb_ld(&bar[XB_XGEN(b.x)]) == gen, bar);
            __builtin_amdgcn_fence(__ATOMIC_ACQUIRE, "agent");
            asm volatile("s_waitcnt vmcnt(0)" ::: "memory");
        }
    }
    __syncthreads();
}


DI P launder(const P& p) {
  P q = p;
#define LND(m) { asm volatile("" : "+s"(q.m)); q.m = (decltype(q.m))(__attribute__((address_space(1))) void*)(void*)q.m; }
  LND(x_prompt) LND(x_sample) LND(c_ckv) LND(c_krope) LND(c_dk) LND(c_dv) LND(st_C) LND(st_n) LND(st_m) LND(c) LND(c_ctx)
  LND(g_norm) LND(W_mod) LND(b_mod) LND(W_in) LND(q_norm) LND(W_uq) LND(kv_norm) LND(W_ukv) LND(dlam) LND(dnorm) LND(mconv)
  LND(mgb) LND(mnorm) LND(W_out) LND(g_final) LND(out) LND(ws)
#undef LND
  return q;
}

template <int KIND>
DI void run_phase(const P& p0, int ph, char* smem) {
  const P& p = p0;
  const int G = gridDim.x, B = blockIdx.x, w = wave_of(tidx());
  if ((KIND < 0 || KIND == 0) && ph == 0) { phase_prepass(p, smem); return; }
  if ((KIND < 0 || KIND == 1) && ph == 1) {
    for (int it = B; it < 256 + 2048; it += G) {
      if (it < 256) {
        int mt = it >> 3, nt = it & 7;
        int l = (mt * 128) >> 10;
        f32x16 acc[2][2];
        gemm_core<false>(p.cckv() + (size_t)mt * 128 * 256, 256, p.WukvTp() + (size_t)l * 1024 * 256 + (size_t)nt * 128 * 256, 256, 256, smem, acc);
        epi_kv(p, mt * 128, nt * 128, acc, nullptr, true);
      } else {
        norm_row(p, 0, (it - 256) * 4 + w, 0);
      }
    }
    return;
  }
  const int l = (ph - 2) / 6, sub = (ph - 2) % 6;
  if ((KIND < 0 || KIND == 2) && sub == 0) {
    const int x = B & 7, j = B >> 3, per = G >> 3;
    const bf16* Ab = p.hbuf();
    const bf16* Wb = p.WinT() + (size_t)l * NPROJ * 1024;
    for (int q = j; q < 3 * 64; q += per) {
      const int r = q >> 6, jj = q & 63;
      const int st = r * 8 + x;
      const int mt = (st / 3) * 8 + (jj >> 3), nt = (st % 3) * 8 + (jj & 7);
      if (nt >= 23) continue;
      f32x16 acc[2][4];
      gemm_core_w(Ab + (size_t)mt * 128 * 1024, 1024, Wb + (size_t)nt * 256 * 1024, 1024, 1024, smem, acc);
      epi_inproj_w(p, l, mt * 128, nt * 256, acc, smem);
    }
  } else if ((KIND < 0 || KIND == 3) && sub == 1) {
    const int N_CH = 1024, N_QA = 64 * 6, N_KV = 64 * 8, N_CF = 1024;
    for (int it = B; it < N_CH + N_QA + N_KV + N_CF; it += G) {
      int u = it;
      __syncthreads();
      if (u < N_CH) { mlstm_local(p, l, u, smem); continue; }
      u -= N_CH;
      if (u < N_QA) {
        int mt = u / 6, nt = u % 6;
        f32x16 acc[2][2];
        gemm_core<true>(p.proj() + (size_t)mt * 128 * NPROJ, NPROJ, p.WuqT() + (size_t)l * 768 * 384 + (size_t)nt * 128 * 384, 384, 384, smem, acc);
        epi_qa(p, mt * 128, nt * 128, acc, (const float*)(smem + 2 * 128 * 72 * 2));
        continue;
      }
      u -= N_QA;
      if (u < N_KV) {
        int mt = u >> 3, nt = u & 7;
        f32x16 acc[2][2];
        gemm_core<true>(p.proj() + (size_t)mt * 128 * NPROJ + 384, NPROJ, p.WukvT() + (size_t)l * 1024 * 256 + (size_t)nt * 128 * 256, 256, 256, smem, acc);
        epi_kv(p, mt * 128, nt * 128, acc, (const float*)(smem + 2 * 128 * 72 * 2), false);
        continue;
      }
      u -= N_KV;
      ckv_fin(p, l, u * 4 + w);
    }
  } else if ((KIND < 0 || KIND == 7) && sub == 2) {
    for (int it = B; it < 640; it += G) mlstm_scan(p, l, it);
  } else if ((KIND < 0 || KIND == 4) && sub == 3) {
    const int x = B & 7;
    int* qctr = p.qc() + ph * 8 + x;
    int* sslot = (int*)(smem + SMEM_BYTES - 16);
    for (;;) {
      __syncthreads();
      if (tidx() == 0) *sslot = atomicAdd(qctr, 1);
      __syncthreads();
      const int q = *sslot;
      if (q >= 192) break;
      __syncthreads();
      if (q < 32) { const int pr = 2 * x + (q >> 4); mla_item(p, l, pr * 16 + (q & 15), smem); }
      else if (q < 64) { const int u = q - 32; const int pr = 2 * x + (u >> 4); diff_item(p, l, pr * 16 + (u & 15), smem); }
      else if (q < 128) mlstm_out(p, l, x * 64 + (q - 64), smem);
      else if (q < 160) { const int u = q - 128; const int pr = 8 * x + (u >> 2); mla_item(p, l, 256 + pr * 4 + (u & 3), smem); }
      else { const int u = q - 160; const int pr = 8 * x + (u >> 2); diff_item(p, l, 256 + pr * 4 + (u & 3), smem); }
    }
  } else if ((KIND < 0 || KIND == 5) && sub == 4) {
    const int x = B & 7, j = B >> 3, per = G >> 3;
    for (int q = j; q < 64; q += per) {
      const int mt = x * 8 + (q >> 3), nt = q & 7;
      f32x16 acc[2][2];
      gemm_core<false>(p.ycat() + (size_t)mt * 128 * 1536, 1536, p.WoutT() + (size_t)l * 1024 * 1536 + (size_t)nt * 128 * 1536, 1536, 1536, smem, acc);
      epi_out(p, l, mt * 128, nt * 128, acc);
    }
  } else if ((KIND < 0 || KIND == 6) && sub == 5) {
    for (int it = B; it < 2048; it += G) {
      if (l < 3) norm_row(p, l + 1, it * 4 + w, 0);
      else norm_row(p, 0, it * 4 + w, 1);
    }
  }
}

#if COOP
__global__ void __launch_bounds__(256, 2) mega(P p, int lo, int hi, int coop) {
  __shared__ __attribute__((aligned(16))) char smem[SMEM_BYTES];
  __shared__ uint4 xb_words;
  if (threadIdx.x == 0) xb_words = make_uint4(0u, 0u, 0u, 0u);
  tidx_init();
  XcdBarrier xb = xcd_barrier_post((unsigned*)p.ctr(), (volatile LAS unsigned*)&xb_words);
  for (int ph = lo; ph < hi; ++ph) {
    run_phase<-1>(p, ph, smem);
    if (PROBE_DUP) {
      const int kind = ph < 2 ? ph : 2 + (ph - 2) % 6;
      if ((PROBE_DUP >> kind) & 1) { xcd_barrier(xb); run_phase<-1>(p, ph, smem); }
    }
    if (ph + 1 < hi) xcd_barrier(xb);
  }
  if (coop == 2) cg::this_grid().sync();
}
#endif
template <int KIND>
__global__ void __launch_bounds__(256) phase_k(P p, int ph) {
  __shared__ __attribute__((aligned(16))) char smem[SMEM_BYTES];
  tidx_init();
  run_phase<KIND>(p, ph, smem);
}

extern "C" void kernel_launch(void* const* d_in, const int* in_sizes, int n_in, void* d_out, int out_size, void* d_ws,
                              size_t ws_size, hipStream_t stream) {
  P p{};
  const float** ins = (const float**)&p;
  for (int i = 0; i < 26; ++i) ins[i] = (const float*)d_in[i];
  p.out = (float*)d_out;
  p.ws = (char*)d_ws;
  if (WS_TOTAL > ws_size) { fprintf(stderr, "workspace too small: need %zu have %zu\n", (size_t)WS_TOTAL, ws_size); return; }

#if COOP
  static int grid_blocks = 0;
  if (!grid_blocks) {
    int dev = 0, cus = 0, per_cu = 0;
    (void)hipGetDevice(&dev);
    (void)hipDeviceGetAttribute(&cus, hipDeviceAttributeMultiprocessorCount, dev);
    (void)hipOccupancyMaxActiveBlocksPerMultiprocessor(&per_cu, mega, 256, 0);
    if (per_cu > 2) per_cu = 2;
    grid_blocks = cus * per_cu;
  }
  (void)hipMemsetAsync(p.ws + OFF_ctr, 0, 16384 + 4096, stream);
  int lo = 0, hi = NPHASE, coop = 1;
  void* args[] = {&p, &lo, &hi, &coop};
  hipError_t e = hipLaunchCooperativeKernel((void*)mega, dim3(grid_blocks), dim3(256), args, 0, stream);
  if (e != hipSuccess) fprintf(stderr, "cooperative launch failed: %s (grid %d)\n", hipGetErrorString(e), grid_blocks);
#else
  for (int ph = 0; ph < NPHASE; ++ph) {
    static const int kmap[6] = {2, 3, 7, 4, 5, 6};
    int kind = ph < 2 ? ph : kmap[(ph - 2) % 6];
    switch (kind) {
      case 0: phase_k<0><<<512, 256, 0, stream>>>(p, ph); break;
      case 1: phase_k<1><<<512, 256, 0, stream>>>(p, ph); break;
      case 2: phase_k<2><<<512, 256, 0, stream>>>(p, ph); break;
      case 3: phase_k<3><<<512, 256, 0, stream>>>(p, ph); break;
      case 4: phase_k<4><<<512, 256, 0, stream>>>(p, ph); break;
      case 5: phase_k<5><<<512, 256, 0, stream>>>(p, ph); break;
      case 7: phase_k<7><<<512, 256, 0, stream>>>(p, ph); break;
      default: phase_k<6><<<512, 256, 0, stream>>>(p, ph); break;
    }
  }
#endif
}
```

```cpp
#include <hip/hip_runtime.h>
#include <hip/hip_cooperative_groups.h>
#include <cstdio>
namespace cg = cooperative_groups;

typedef unsigned short bf16;
typedef __attribute__((ext_vector_type(8))) short bf16x8;
typedef __attribute__((ext_vector_type(4))) short s16x4;
typedef __attribute__((ext_vector_type(16))) float f32x16;
typedef __attribute__((ext_vector_type(4))) float f32x4;
typedef __attribute__((ext_vector_type(4))) unsigned u32x4;
typedef __attribute__((ext_vector_type(2))) unsigned u32x2;

#define DI __device__ __forceinline__
#define MFMA(a, b, c) __builtin_amdgcn_mfma_f32_32x32x16_bf16((a), (b), (c), 0, 0, 0)

#ifndef COOP
#define COOP 1
#endif
#define PROBE_DUP 0

constexpr int NTOK = 8192;
constexpr int NPROJ = 5888;
constexpr int NPHASE = 26;
constexpr float EPS = 1e-6f;
constexpr int SMEM_BYTES = 75 * 1024;

constexpr size_t O_YP = 0, O_YS = 4194304, O_CKV = 8388608, O_KROPE = 12582912, O_DK = 13631488,
                 O_DV = 22020096, O_MC = 30408704, O_MN = 38797312, O_MM = 38862848;

constexpr size_t al256(size_t x) { return (x + 255) & ~(size_t)255; }
constexpr size_t OFF_WinT = 0;
constexpr size_t OFF_WuqT = OFF_WinT + al256((size_t)4 * NPROJ * 1024 * 2);
constexpr size_t OFF_WukvT = OFF_WuqT + al256((size_t)4 * 768 * 384 * 2);
constexpr size_t OFF_WukvTp = OFF_WukvT + al256((size_t)4 * 1024 * 256 * 2);
constexpr size_t OFF_WoutT = OFF_WukvTp + al256((size_t)4 * 1024 * 256 * 2);
constexpr size_t OFF_mod = OFF_WoutT + al256((size_t)4 * 1024 * 1536 * 2);
constexpr size_t OFF_ropec = OFF_mod + al256((size_t)4 * 5 * 3072 * 4);
constexpr size_t OFF_ropes = OFF_ropec + al256((size_t)1024 * 32 * 4);
constexpr size_t OFF_lam = OFF_ropes + al256((size_t)1024 * 32 * 4);
constexpr size_t OFF_hbuf = OFF_lam + al256((size_t)256);
constexpr size_t OFF_xbuf = OFF_hbuf + al256((size_t)NTOK * 1024 * 2);
constexpr size_t OFF_proj = OFF_xbuf + al256((size_t)NTOK * 1024 * 4);
constexpr size_t OFF_Qa = OFF_proj + al256((size_t)NTOK * NPROJ * 2);
constexpr size_t OFF_Ka = OFF_Qa + al256((size_t)NTOK * 768 * 2);
constexpr size_t OFF_VaT = OFF_Ka + al256((size_t)NTOK * 768 * 2);
constexpr size_t OFF_Kb = OFF_VaT + al256((size_t)NTOK * 512 * 2);
constexpr size_t OFF_VbT = OFF_Kb + al256((size_t)NTOK * 512 * 2);
constexpr size_t OFF_VmT = OFF_VbT + al256((size_t)NTOK * 512 * 2);
constexpr size_t OFF_ycat = OFF_VmT + al256((size_t)NTOK * 512 * 2);
constexpr size_t OFF_gates = OFF_ycat + al256((size_t)NTOK * 1536 * 2);
constexpr size_t OFF_Cst = OFF_gates + al256((size_t)NTOK * 16 * 4);
constexpr size_t OFF_nst = OFF_Cst + al256((size_t)1024 * 16384 * 2);
constexpr size_t OFF_mst = OFF_nst + al256((size_t)1024 * 128 * 4);
constexpr size_t OFF_cckv = OFF_mst + al256((size_t)1024 * 4);
constexpr size_t OFF_cKa = OFF_cckv + al256((size_t)4096 * 256 * 2);
constexpr size_t OFF_cVaT = OFF_cKa + al256((size_t)64 * 256 * 192 * 2);
constexpr size_t OFF_cKb = OFF_cVaT + al256((size_t)64 * 128 * 256 * 2);
constexpr size_t OFF_cVbT = OFF_cKb + al256((size_t)64 * 256 * 128 * 2);
constexpr size_t OFF_blA = OFF_cVbT + al256((size_t)64 * 128 * 256 * 2);
constexpr size_t OFF_mlA = OFF_blA + 4096;
constexpr size_t OFF_ctr = OFF_mlA + 4096;
constexpr size_t OFF_qc = OFF_ctr + 16384;
constexpr size_t WS_TOTAL = OFF_qc + 4096;
struct P {
  const float *x_prompt, *x_sample, *c_ckv, *c_krope, *c_dk, *c_dv, *st_C, *st_n, *st_m, *c, *c_ctx, *g_norm, *W_mod,
      *b_mod, *W_in, *q_norm, *W_uq, *kv_norm, *W_ukv, *dlam, *dnorm, *mconv, *mgb, *mnorm, *W_out, *g_final;
  float* out;
  char* ws;
  __device__ __forceinline__ bf16* WinT() const { return (bf16*)(ws + OFF_WinT); }
  __device__ __forceinline__ bf16* WuqT() const { return (bf16*)(ws + OFF_WuqT); }
  __device__ __forceinline__ bf16* WukvT() const { return (bf16*)(ws + OFF_WukvT); }
  __device__ __forceinline__ bf16* WukvTp() const { return (bf16*)(ws + OFF_WukvTp); }
  __device__ __forceinline__ bf16* WoutT() const { return (bf16*)(ws + OFF_WoutT); }
  __device__ __forceinline__ float* mod() const { return (float*)(ws + OFF_mod); }
  __device__ __forceinline__ float* ropec() const { return (float*)(ws + OFF_ropec); }
  __device__ __forceinline__ float* ropes() const { return (float*)(ws + OFF_ropes); }
  __device__ __forceinline__ float* lam() const { return (float*)(ws + OFF_lam); }
  __device__ __forceinline__ bf16* hbuf() const { return (bf16*)(ws + OFF_hbuf); }
  __device__ __forceinline__ float* xbuf() const { return (float*)(ws + OFF_xbuf); }
  __device__ __forceinline__ bf16* proj() const { return (bf16*)(ws + OFF_proj); }
  __device__ __forceinline__ bf16* Qa() const { return (bf16*)(ws + OFF_Qa); }
  __device__ __forceinline__ bf16* Ka() const { return (bf16*)(ws + OFF_Ka); }
  __device__ __forceinline__ bf16* VaT() const { return (bf16*)(ws + OFF_VaT); }
  __device__ __forceinline__ bf16* Kb() const { return (bf16*)(ws + OFF_Kb); }
  __device__ __forceinline__ bf16* VbT() const { return (bf16*)(ws + OFF_VbT); }
  __device__ __forceinline__ bf16* VmT() const { return (bf16*)(ws + OFF_VmT); }
  __device__ __forceinline__ bf16* ycat() const { return (bf16*)(ws + OFF_ycat); }
  __device__ __forceinline__ float* gates() const { return (float*)(ws + OFF_gates); }
  __device__ __forceinline__ bf16* Cst() const { return (bf16*)(ws + OFF_Cst); }
  __device__ __forceinline__ float* nst() const { return (float*)(ws + OFF_nst); }
  __device__ __forceinline__ float* mst() const { return (float*)(ws + OFF_mst); }
  __device__ __forceinline__ bf16* cckv() const { return (bf16*)(ws + OFF_cckv); }
  __device__ __forceinline__ bf16* cKa() const { return (bf16*)(ws + OFF_cKa); }
  __device__ __forceinline__ bf16* cVaT() const { return (bf16*)(ws + OFF_cVaT); }
  __device__ __forceinline__ bf16* cKb() const { return (bf16*)(ws + OFF_cKb); }
  __device__ __forceinline__ bf16* cVbT() const { return (bf16*)(ws + OFF_cVbT); }
  __device__ __forceinline__ int* ctr() const { return (int*)(ws + OFF_ctr); }
  __device__ __forceinline__ int* qc() const { return (int*)(ws + OFF_qc); }
  __device__ __forceinline__ float* blA() const { return (float*)(ws + OFF_blA); }
  __device__ __forceinline__ float* mlA() const { return (float*)(ws + OFF_mlA); }
};

DI int tidx() { int t = threadIdx.x; asm volatile("" : "+v"(t)); return t; }
DI void tidx_init() {}
DI int wave_of(int tid) { return __builtin_amdgcn_readfirstlane(tid >> 6); }
typedef __attribute__((ext_vector_type(2))) __bf16 bf16v2;
typedef __attribute__((ext_vector_type(2))) float f32x2;
DI unsigned pack2(float a, float b) {
  f32x2 v; v[0] = a; v[1] = b;
  return __builtin_bit_cast(unsigned, __builtin_convertvector(v, bf16v2));
}
DI bf16 f2bf(float x) { return (bf16)(pack2(x, 0.f) & 0xffffu); }
DI float bf2f(bf16 b) { return __uint_as_float(((unsigned)b) << 16); }
DI float fexp2(float x) { return __builtin_amdgcn_exp2f(x); }
DI float fexp(float x) { return __builtin_amdgcn_exp2f(x * 1.4426950408889634f); }
DI float bflo(unsigned u) { return __uint_as_float(u << 16); }
DI float bfhi(unsigned u) { return __uint_as_float(u & 0xffff0000u); }
DI float silu_f(float x) { return x * __builtin_amdgcn_rcpf(1.f + fexp(-x)); }
DI float sigmoid_f(float x) { return __builtin_amdgcn_rcpf(1.f + fexp(-x)); }
DI float logsig_f(float x) { return fminf(x, 0.f) - log1pf(fexp(-fabsf(x))); }

struct TokInfo { int lat, b, t, T, tok0, modj; };
DI TokInfo tinfo(int tok) {
  TokInfo r;
  if (tok < 4096) { r.lat = 0; r.b = tok >> 8; r.t = tok & 255; r.T = 256; r.tok0 = tok & ~255; r.modj = 0; }
  else { int u = tok - 4096; r.lat = 1; r.b = u >> 10; r.t = u & 1023; r.T = 1024; r.tok0 = 4096 + (u & ~1023); r.modj = 1 + r.b; }
  return r;
}

struct GR { u32x4 ra0[4], rb0[4], ra1[4], rb1[4]; };
DI void gemm_load2(GR& g, const bf16* __restrict__ A, int lda, const bf16* __restrict__ Bt, int ldb) {
  const int tid = tidx();
  const int lr = tid >> 3, lc = tid & 7;
  const bf16* ap = A + (size_t)lr * lda + lc * 8;
  const bf16* bp = Bt + (size_t)lr * ldb + lc * 8;
  const size_t a32 = (size_t)32 * lda, b32 = (size_t)32 * ldb;
#pragma unroll
  for (int i = 0; i < 4; ++i) { g.ra0[i] = *(const u32x4*)(ap + i * a32); g.rb0[i] = *(const u32x4*)(bp + i * b32); }
#pragma unroll
  for (int i = 0; i < 4; ++i) { g.ra1[i] = *(const u32x4*)(ap + 64 + i * a32); g.rb1[i] = *(const u32x4*)(bp + 64 + i * b32); }
}
template <bool ROWSS>
DI void gemm_core_n(GR& g, const bf16* __restrict__ A, int lda, const bf16* __restrict__ Bt, int ldb,
                    const bf16* __restrict__ An, const bf16* __restrict__ Btn, int K, char* smem, f32x16 (&acc)[2][2]) {
  bf16* sA = (bf16*)smem;
  bf16* sB = sA + 128 * 72;
  float* sRow = (float*)(sB + 128 * 72);
  const int tid = tidx(), lane = tid & 63, w = wave_of(tid);
  const int wm = w >> 1, wn = w & 1, lq = lane & 31, h = lane >> 5;
  const int lr = tid >> 3, lc = tid & 7;
  float ss[4] = {0.f, 0.f, 0.f, 0.f};
#pragma unroll
  for (int i = 0; i < 2; ++i)
#pragma unroll
    for (int j = 0; j < 2; ++j)
#pragma unroll
      for (int r = 0; r < 16; ++r) acc[i][j][r] = 0.f;
  const bf16* ap = A + (size_t)lr * lda + lc * 8;
  const bf16* bp = Bt + (size_t)lr * ldb + lc * 8;
  const bf16* apn = An + (size_t)lr * lda + lc * 8;
  const bf16* bpn = Btn + (size_t)lr * ldb + lc * 8;
  const size_t a32 = (size_t)32 * lda, b32 = (size_t)32 * ldb;
  const int nk = K >> 6;
  auto step = [&](u32x4 (&ra)[4], u32x4 (&rb)[4], int kt) {
    if (kt) __syncthreads();
#pragma unroll
    for (int i = 0; i < 4; ++i) {
      *(u32x4*)(sA + (lr + 32 * i) * 72 + lc * 8) = ra[i];
      *(u32x4*)(sB + (lr + 32 * i) * 72 + lc * 8) = rb[i];
    }
    if (ROWSS) {
#pragma unroll
      for (int i = 0; i < 4; ++i)
#pragma unroll
        for (int e = 0; e < 4; ++e) {
          float a0 = bflo(ra[i][e]), a1 = bfhi(ra[i][e]);
          ss[i] += a0 * a0 + a1 * a1;
        }
    }
    __syncthreads();
    {
      const int kn = kt + 2;
      const bf16* ap2 = (kn < nk) ? ap + (size_t)kn * 64 : apn + (size_t)(kn - nk) * 64;
      const bf16* bp2 = (kn < nk) ? bp + (size_t)kn * 64 : bpn + (size_t)(kn - nk) * 64;
#pragma unroll
      for (int i = 0; i < 4; ++i) { ra[i] = *(const u32x4*)(ap2 + i * a32); rb[i] = *(const u32x4*)(bp2 + i * b32); }
    }
#pragma unroll
    for (int ks = 0; ks < 4; ++ks) {
      bf16x8 af[2], bfr[2];
#pragma unroll
      for (int i = 0; i < 2; ++i) af[i] = *(const bf16x8*)(sA + (wm * 64 + i * 32 + lq) * 72 + ks * 16 + h * 8);
#pragma unroll
      for (int j = 0; j < 2; ++j) bfr[j] = *(const bf16x8*)(sB + (wn * 64 + j * 32 + lq) * 72 + ks * 16 + h * 8);
#pragma unroll
      for (int i = 0; i < 2; ++i)
#pragma unroll
        for (int j = 0; j < 2; ++j) acc[i][j] = MFMA(af[i], bfr[j], acc[i][j]);
    }
  };
  for (int kt = 0; kt < nk; kt += 2) {
    step(g.ra0, g.rb0, kt);
    step(g.ra1, g.rb1, kt + 1);
  }
  if (ROWSS) {
#pragma unroll
    for (int i = 0; i < 4; ++i) {
      float v = ss[i];
      v += __shfl_xor(v, 1); v += __shfl_xor(v, 2); v += __shfl_xor(v, 4);
      if (lc == 0) sRow[lr + 32 * i] = v;
    }
  }
  __syncthreads();
}
template <bool ROWSS>
DI void gemm_core(const bf16* __restrict__ A, int lda, const bf16* __restrict__ Bt, int ldb, int K, char* smem,
                  f32x16 (&acc)[2][2]) {
  GR g;
  gemm_load2(g, A, lda, Bt, ldb);
  gemm_core_n<ROWSS>(g, A, lda, Bt, ldb, A, Bt, K, smem, acc);
}

DI void gemm_core_w(const bf16* __restrict__ A, int lda, const bf16* __restrict__ Bt, int ldb, int K, char* smem,
                    f32x16 (&acc)[2][4]) {
  bf16* sA = (bf16*)smem;
  bf16* sB = sA + 128 * 72;
  const int tid = tidx(), lane = tid & 63, w = wave_of(tid);
  const int wm = w >> 1, wn = w & 1, lq = lane & 31, h = lane >> 5;
  const int lr = tid >> 3, lc = tid & 7;
  u32x4 ra[4], rb[8];
#pragma unroll
  for (int i = 0; i < 2; ++i)
#pragma unroll
    for (int j = 0; j < 4; ++j)
#pragma unroll
      for (int r = 0; r < 16; ++r) acc[i][j][r] = 0.f;
  const bf16* ap = A + (size_t)lr * lda + lc * 8;
  const bf16* bp = Bt + (size_t)lr * ldb + lc * 8;
  const size_t a32 = (size_t)32 * lda, b32 = (size_t)32 * ldb;
#pragma unroll
  for (int i = 0; i < 4; ++i) ra[i] = *(const u32x4*)(ap + i * a32);
#pragma unroll
  for (int i = 0; i < 8; ++i) rb[i] = *(const u32x4*)(bp + i * b32);
  const int nk = K >> 6;
  for (int kt = 0; kt < nk; ++kt) {
    if (kt) __syncthreads();
#pragma unroll
    for (int i = 0; i < 4; ++i) *(u32x4*)(sA + (lr + 32 * i) * 72 + lc * 8) = ra[i];
#pragma unroll
    for (int i = 0; i < 8; ++i) *(u32x4*)(sB + (lr + 32 * i) * 72 + lc * 8) = rb[i];
    __syncthreads();
    {
      const int kn = (kt + 1 < nk) ? kt + 1 : kt;
      const bf16* ap2 = ap + (size_t)kn * 64;
      const bf16* bp2 = bp + (size_t)kn * 64;
#pragma unroll
      for (int i = 0; i < 4; ++i) ra[i] = *(const u32x4*)(ap2 + i * a32);
#pragma unroll
      for (int i = 0; i < 8; ++i) rb[i] = *(const u32x4*)(bp2 + i * b32);
    }
#pragma unroll
    for (int ks = 0; ks < 4; ++ks) {
      bf16x8 af[2], bfr[4];
#pragma unroll
      for (int i = 0; i < 2; ++i) af[i] = *(const bf16x8*)(sA + (wm * 64 + i * 32 + lq) * 72 + ks * 16 + h * 8);
#pragma unroll
      for (int j = 0; j < 4; ++j) bfr[j] = *(const bf16x8*)(sB + (wn * 128 + j * 32 + lq) * 72 + ks * 16 + h * 8);
#pragma unroll
      for (int i = 0; i < 2; ++i)
#pragma unroll
        for (int j = 0; j < 4; ++j) acc[i][j] = MFMA(af[i], bfr[j], acc[i][j]);
    }
  }
  __syncthreads();
}

DI void store_vt4(bf16* VT, size_t idx, float a, float b, float c, float d) {
  u32x2 v; v[0] = pack2(a, b); v[1] = pack2(c, d);
  *(u32x2*)(VT + idx) = v;
}

DI void transpose_tile(const float* __restrict__ src, int N, int Nvalid, bf16* __restrict__ dst, int K, int k0, int n0,
                       const float* __restrict__ gk, bf16* __restrict__ dst2, char* smem) {
  float* t = (float*)smem;
  const int tid = tidx();
#pragma unroll
  for (int i = 0; i < 4; ++i) {
    int idx = tid + 256 * i; int r = idx >> 4, c = (idx & 15) * 4;
    int n = n0 + c;
    f32x4 v = {0.f, 0.f, 0.f, 0.f};
    if (n < Nvalid) v = __builtin_nontemporal_load((const f32x4*)(src + (size_t)(k0 + r) * N + n));
    t[r * 65 + c] = v[0]; t[r * 65 + c + 1] = v[1]; t[r * 65 + c + 2] = v[2]; t[r * 65 + c + 3] = v[3];
  }
  __syncthreads();
  const int c2h = (tid & 31) * 2;
  const float gk0 = gk ? gk[k0 + c2h] : 1.f, gk1 = gk ? gk[k0 + c2h + 1] : 1.f;
#pragma unroll
  for (int i = 0; i < 8; ++i) {
    int idx = tid + 256 * i; int r = idx >> 5, c2 = (idx & 31) * 2;
    float v0 = t[c2 * 65 + r], v1 = t[(c2 + 1) * 65 + r];
    if (dst2) *(unsigned*)(dst2 + (size_t)(n0 + r) * K + k0 + c2) = pack2(v0, v1);
    v0 *= gk0; v1 *= gk1;
    *(unsigned*)(dst + (size_t)(n0 + r) * K + k0 + c2) = pack2(v0, v1);
  }
  __syncthreads();
}

DI void mod_item(const P& p, int it, char* smem) {
  float* sl = (float*)smem;
  float* red = sl + 5 * 1024;
  const int tid = tidx(), lane = tid & 63, w = wave_of(tid);
  const int l = it / 48, n0 = (it % 48) * 64;
  for (int idx = tid; idx < 5120; idx += 256) {
    int j = idx >> 10, k = idx & 1023;
    float cv = (j == 0) ? p.c_ctx[k] : p.c[(j - 1) * 1024 + k];
    sl[idx] = silu_f(cv);
  }
  __syncthreads();
  float a[5] = {0.f, 0.f, 0.f, 0.f, 0.f};
  const float* wp = p.W_mod + (size_t)l * 1024 * 3072 + n0 + lane;
  for (int k = w * 256; k < w * 256 + 256; k += 16) {
    float wv[16];
#pragma unroll
    for (int u = 0; u < 16; ++u) wv[u] = __builtin_nontemporal_load(wp + (size_t)(k + u) * 3072);
#pragma unroll
    for (int u = 0; u < 16; ++u)
#pragma unroll
      for (int j = 0; j < 5; ++j) a[j] += sl[j * 1024 + k + u] * wv[u];
  }
#pragma unroll
  for (int j = 0; j < 5; ++j) red[(w * 5 + j) * 64 + lane] = a[j];
  __syncthreads();
  for (int idx = tid; idx < 320; idx += 256) {
    int j = idx >> 6, c = idx & 63;
    float s = red[(0 * 5 + j) * 64 + c] + red[(1 * 5 + j) * 64 + c] + red[(2 * 5 + j) * 64 + c] + red[(3 * 5 + j) * 64 + c];
    p.mod()[(size_t)(l * 5 + j) * 3072 + n0 + c] = s + p.b_mod[l * 3072 + n0 + c];
  }
  __syncthreads();
}

DI void phase_prepass(const P& p, char* smem) {
  const int G = gridDim.x, B = blockIdx.x, tid = tidx();
  const int N_MOD = 192, N_WIN = 4 * 92 * 16, N_WOUT = 4 * 16 * 24, N_WUQ = 4 * 12 * 6, N_WUKV = 4 * 16 * 4;
  const int total = N_MOD + N_WIN + N_WOUT + N_WUQ + N_WUKV;
  for (int it = B; it < total; it += G) {
    int u = it;
    if (u < N_MOD) { mod_item(p, u, smem); continue; }
    u -= N_MOD;
    if (u < N_WIN) {
      int l = u / (92 * 16), r = u % (92 * 16), nt = r / 16, kt = r % 16;
      transpose_tile(p.W_in + (size_t)l * 1024 * 5840, 5840, 5840, p.WinT() + (size_t)l * NPROJ * 1024, 1024, kt * 64, nt * 64, nullptr, nullptr, smem);
      continue;
    }
    u -= N_WIN;
    if (u < N_WOUT) {
      int l = u / (16 * 24), r = u % (16 * 24), nt = r / 24, kt = r % 24;
      transpose_tile(p.W_out + (size_t)l * 1536 * 1024, 1024, 1024, p.WoutT() + (size_t)l * 1024 * 1536, 1536, kt * 64, nt * 64, nullptr, nullptr, smem);
      continue;
    }
    u -= N_WOUT;
    if (u < N_WUQ) {
      int l = u / 72, r = u % 72, nt = r / 6, kt = r % 6;
      transpose_tile(p.W_uq + (size_t)l * 384 * 768, 768, 768, p.WuqT() + (size_t)l * 768 * 384, 384, kt * 64, nt * 64, p.q_norm + l * 384, nullptr, smem);
      continue;
    }
    u -= N_WUQ;
    {
      int l = u / 64, r = u % 64, nt = r / 4, kt = r % 4;
      transpose_tile(p.W_ukv + (size_t)l * 256 * 1024, 1024, 1024, p.WukvT() + (size_t)l * 1024 * 256, 256, kt * 64, nt * 64, p.kv_norm + l * 256, p.WukvTp() + (size_t)l * 1024 * 256, smem);
    }
  }
  const int gtid = B * 256 + tid, gsz = G * 256;
  for (int idx = gtid; idx < 1024 * 32; idx += gsz) {
    int t = idx >> 5, i = idx & 31;
    float pos = (i < 16) ? (float)(t >> 6) : (float)(t & 63);
    float inv = powf(10000.f, -(float)(i & 15) / 16.f);
    float ang = pos * inv;
    p.ropec()[idx] = cosf(ang); p.ropes()[idx] = sinf(ang);
  }
  if (gtid < 4) {
    int l = gtid; const float* lp = p.dlam + l * 256;
    float s1 = 0.f, s2 = 0.f;
    for (int i = 0; i < 64; ++i) { s1 += lp[i] * lp[64 + i]; s2 += lp[128 + i] * lp[192 + i]; }
    float lam_init = 0.8f - 0.6f * expf(-0.3f * (float)l);
    p.lam()[l] = expf(s1) - expf(s2) + lam_init;
  }
  for (int idx = gtid; idx < 4 * 4 * 256 * 256; idx += gsz) {
    int d = idx & 255, t = (idx >> 8) & 255, b = (idx >> 16) & 3, l = idx >> 18;
    p.cckv()[idx] = f2bf(p.c_ckv[(size_t)((b * 4 + l) * 256 + t) * 256 + d]);
  }
  for (int idx = gtid; idx < 4 * 4 * 4 * 256 * 64; idx += gsz) {
    int r = idx & 63, t = (idx >> 6) & 255, hd = (idx >> 14) & 3, b = (idx >> 16) & 3, l = idx >> 18;
    p.cKa()[(size_t)((((l * 4 + b) * 4 + hd) * 256) + t) * 192 + 128 + r] = f2bf(p.c_krope[(size_t)((b * 4 + l) * 256 + t) * 64 + r]);
  }
  for (int idx = gtid; idx < 4 * 4 * 4 * 256 * 128; idx += gsz) {
    int d = idx & 127, t = (idx >> 7) & 255, hd = (idx >> 15) & 3, b = (idx >> 17) & 3, l = idx >> 19;
    p.cKb()[idx] = f2bf(p.c_dk[(size_t)(((b * 4 + l) * 256 + t) * 4 + hd) * 128 + d]);
  }
  for (int idx = gtid; idx < 4 * 4 * 4 * 128 * 256; idx += gsz) {
    int t = idx & 255, d = (idx >> 8) & 127, hd = (idx >> 15) & 3, b = (idx >> 17) & 3, l = idx >> 19;
    p.cVbT()[idx] = f2bf(p.c_dv[(size_t)(((b * 4 + l) * 256 + t) * 4 + hd) * 128 + d]);
  }
}

DI void norm_row(const P& p, int l, int tok, int mode) {
  const int lane = tidx() & 63;
  TokInfo ti = tinfo(tok);
  const float* x;
  if (mode == 0 && l == 0) x = ti.lat ? (p.x_sample + (size_t)(tok - 4096) * 1024) : (p.x_prompt + (size_t)tok * 1024);
  else x = p.xbuf() + (size_t)tok * 1024;
  f32x4 v[4];
  float ss = 0.f;
#pragma unroll
  for (int i = 0; i < 4; ++i) {
    v[i] = *(const f32x4*)(x + i * 256 + lane * 4);
    ss += v[i][0] * v[i][0] + v[i][1] * v[i][1] + v[i][2] * v[i][2] + v[i][3] * v[i][3];
  }
#pragma unroll
  for (int o = 32; o >= 1; o >>= 1) ss += __shfl_xor(ss, o);
  const float rstd = rsqrtf(ss * (1.f / 1024.f) + EPS);
  if (mode == 0) {
    const float* g = p.g_norm + l * 1024;
    const float* md = p.mod() + (size_t)(l * 5 + ti.modj) * 3072;
#pragma unroll
    for (int i = 0; i < 4; ++i) {
      int c = i * 256 + lane * 4;
      f32x4 gv = *(const f32x4*)(g + c), sh = *(const f32x4*)(md + c), sc = *(const f32x4*)(md + 1024 + c);
      float o0 = v[i][0] * rstd * gv[0] * (1.f + sc[0]) + sh[0];
      float o1 = v[i][1] * rstd * gv[1] * (1.f + sc[1]) + sh[1];
      float o2 = v[i][2] * rstd * gv[2] * (1.f + sc[2]) + sh[2];
      float o3 = v[i][3] * rstd * gv[3] * (1.f + sc[3]) + sh[3];
      u32x2 pk; pk[0] = pack2(o0, o1); pk[1] = pack2(o2, o3);
      *(u32x2*)(p.hbuf() + (size_t)tok * 1024 + c) = pk;
    }
  } else {
    float* o = p.out + (ti.lat ? (O_YS + (size_t)(tok - 4096) * 1024) : (O_YP + (size_t)tok * 1024));
#pragma unroll
    for (int i = 0; i < 4; ++i) {
      int c = i * 256 + lane * 4;
      f32x4 gv = *(const f32x4*)(p.g_final + c);
      f32x4 r; r[0] = v[i][0] * rstd * gv[0]; r[1] = v[i][1] * rstd * gv[1]; r[2] = v[i][2] * rstd * gv[2]; r[3] = v[i][3] * rstd * gv[3];
      *(f32x4*)(o + c) = r;
    }
  }
}

DI void img_put(bf16* img, const f32x16 (&acc)[2][2], int wm, int wn, int lq, int h) {
#pragma unroll
  for (int i = 0; i < 2; ++i)
#pragma unroll
    for (int j = 0; j < 2; ++j)
#pragma unroll
      for (int r = 0; r < 16; ++r)
        img[(wm * 64 + i * 32 + 8 * (r >> 2) + 4 * h + (r & 3)) * 136 + wn * 64 + j * 32 + lq] = f2bf(acc[i][j][r]);
}
DI void img_copy(const bf16* img, int half, bf16* dst, size_t stride, int tid) {
  u32x4 v[4];
#pragma unroll
  for (int i = 0; i < 4; ++i) { int idx = tid + 256 * i; int r = idx >> 3, c16 = idx & 7; v[i] = *(const u32x4*)(img + r * 136 + half * 64 + c16 * 8); }
#pragma unroll
  for (int i = 0; i < 4; ++i) { int idx = tid + 256 * i; int r = idx >> 3, c16 = idx & 7; *(u32x4*)(dst + (size_t)r * stride + c16 * 8) = v[i]; }
}
DI bool inproj_rm(int cb) { return !((cb >= 35 && cb <= 42) || (cb >= 67 && cb <= 74) || cb == 91); }

DI void epi_inproj(const P& p, int l, int m0, int n0, f32x16 (&acc)[2][2], char* smem) {
  const int tid_ = tidx(); const int lane = tid_ & 63, w = wave_of(tid_), wm = w >> 1, wn = w & 1, lq = lane & 31, h = lane >> 5;
  const int mb = m0 + wm * 64, nb = n0 + wn * 64;
  const int cb = nb >> 6;
  bf16* img = (bf16*)smem;
  TokInfo tb = tinfo(mb);
  const bool lat = tb.lat;
  if (!lat && (cb == 10 || (cb >= 27 && cb <= 34))) {
    float* ob = (cb == 10) ? p.out + O_KROPE + (size_t)((tb.b * 4 + l) * 256) * 64
                           : p.out + O_DK + (size_t)((tb.b * 4 + l) * 256) * 512 + (cb - 27) * 64;
    const int ostr = (cb == 10) ? 64 : 512;
#pragma unroll
    for (int i = 0; i < 2; ++i)
#pragma unroll
      for (int j = 0; j < 2; ++j)
#pragma unroll
        for (int r = 0; r < 16; ++r) {
          int tl = tb.t + i * 32 + 8 * (r >> 2) + 4 * h + (r & 3);
          ob[(size_t)tl * ostr + j * 32 + lq] = acc[i][j][r];
        }
  }
  const bool ropeT = lat && (cb == 10 || (cb >= 19 && cb <= 34));
  if (ropeT) {
#pragma unroll
    for (int i = 0; i < 2; ++i) {
      float cs[16], sn[16];
#pragma unroll
      for (int r = 0; r < 16; ++r) {
        int t = tb.t + i * 32 + 8 * (r >> 2) + 4 * h + (r & 3);
        cs[r] = p.ropec()[t * 32 + lq]; sn[r] = p.ropes()[t * 32 + lq];
      }
#pragma unroll
      for (int r = 0; r < 16; ++r) {
        float x1 = acc[i][0][r], x2 = acc[i][1][r];
        acc[i][0][r] = x1 * cs[r] - x2 * sn[r];
        acc[i][1][r] = x1 * sn[r] + x2 * cs[r];
      }
    }
  }
  if (inproj_rm(cb)) {
    img_put(img, acc, wm, wn, lq, h);
  } else if (cb == 91) {
    if (lq < 16) {
      float bias = p.mgb[l * 16 + lq];
#pragma unroll
      for (int i = 0; i < 2; ++i)
#pragma unroll
        for (int r = 0; r < 16; ++r) {
          int row = mb + i * 32 + 8 * (r >> 2) + 4 * h + (r & 3);
          p.gates()[row * 16 + lq] = acc[i][0][r] + bias;
        }
    }
  } else {
    const bool isdv = cb <= 42;
    int cc = isdv ? cb - 35 : cb - 67;
    int hd = cc >> 1, sub = cc & 1;
    bf16* VT = isdv ? p.VbT() : p.VmT();
#pragma unroll
    for (int i = 0; i < 2; ++i)
#pragma unroll
      for (int j = 0; j < 2; ++j) {
        int d = sub * 64 + j * 32 + lq;
#pragma unroll
        for (int g = 0; g < 4; ++g) {
          int tl = tb.t + i * 32 + 8 * g + 4 * h;
          store_vt4(VT, (size_t)tb.tok0 * 512 + (size_t)(hd * 128 + d) * tb.T + tl, acc[i][j][4 * g], acc[i][j][4 * g + 1], acc[i][j][4 * g + 2], acc[i][j][4 * g + 3]);
          if (isdv && !lat) {
#pragma unroll
            for (int jj = 0; jj < 4; ++jj)
              p.out[O_DV + (size_t)((tb.b * 4 + l) * 256 + tl + jj) * 512 + cc * 64 + j * 32 + lq] = acc[i][j][4 * g + jj];
          }
        }
      }
  }
  __syncthreads();
#pragma unroll
  for (int half = 0; half < 2; ++half) {
    const int cbh = (n0 >> 6) + half;
    if (!inproj_rm(cbh)) continue;
    if (cbh == 10) {
#pragma unroll
      for (int hd = 0; hd < 4; ++hd) img_copy(img, half, p.Ka() + (size_t)m0 * 768 + hd * 192 + 128, 768, tid_);
    } else if (cbh >= 27 && cbh <= 34) {
      img_copy(img, half, p.Kb() + (size_t)m0 * 512 + (cbh - 27) * 64, 512, tid_);
    } else {
      img_copy(img, half, p.proj() + (size_t)m0 * NPROJ + cbh * 64, NPROJ, tid_);
    }
  }
  __syncthreads();
}

constexpr int IMGW = 264;
DI void img_copy_w(const bf16* img, int half, bf16* dst, size_t stride, int tid) {
  u32x4 v[4];
#pragma unroll
  for (int i = 0; i < 4; ++i) { int idx = tid + 256 * i; int r = idx >> 3, c16 = idx & 7; v[i] = *(const u32x4*)(img + r * IMGW + half * 64 + c16 * 8); }
#pragma unroll
  for (int i = 0; i < 4; ++i) { int idx = tid + 256 * i; int r = idx >> 3, c16 = idx & 7; *(u32x4*)(dst + (size_t)r * stride + c16 * 8) = v[i]; }
}
template <int JP>
DI void epi_inproj_cbw(const P& p, int l, int m0, int cb, int imgcol, f32x16 (&acc)[2][4], bf16* img) {
  const int tid_ = tidx(); const int lane = tid_ & 63, w = wave_of(tid_), wm = w >> 1, lq = lane & 31, h = lane >> 5;
  const int mb = m0 + wm * 64;
  TokInfo tb = tinfo(mb);
  const bool lat = tb.lat;
  if (!lat && (cb == 10 || (cb >= 27 && cb <= 34))) {
    float* ob = (cb == 10) ? p.out + O_KROPE + (size_t)((tb.b * 4 + l) * 256) * 64
                           : p.out + O_DK + (size_t)((tb.b * 4 + l) * 256) * 512 + (cb - 27) * 64;
    const int ostr = (cb == 10) ? 64 : 512;
#pragma unroll
    for (int i = 0; i < 2; ++i)
#pragma unroll
      for (int j = 0; j < 2; ++j)
#pragma unroll
        for (int r = 0; r < 16; ++r) {
          int tl = tb.t + i * 32 + 8 * (r >> 2) + 4 * h + (r & 3);
          ob[(size_t)tl * ostr + j * 32 + lq] = acc[i][2 * JP + j][r];
        }
  }
  if (lat && (cb == 10 || (cb >= 19 && cb <= 34))) {
#pragma unroll
    for (int i = 0; i < 2; ++i) {
      float cs[16], sn[16];
#pragma unroll
      for (int r = 0; r < 16; ++r) {
        int t = tb.t + i * 32 + 8 * (r >> 2) + 4 * h + (r & 3);
        cs[r] = p.ropec()[t * 32 + lq]; sn[r] = p.ropes()[t * 32 + lq];
      }
#pragma unroll
      for (int r = 0; r < 16; ++r) {
        float x1 = acc[i][2 * JP][r], x2 = acc[i][2 * JP + 1][r];
        acc[i][2 * JP][r] = x1 * cs[r] - x2 * sn[r];
        acc[i][2 * JP + 1][r] = x1 * sn[r] + x2 * cs[r];
      }
    }
  }
  if (inproj_rm(cb)) {
#pragma unroll
    for (int i = 0; i < 2; ++i)
#pragma unroll
      for (int j = 0; j < 2; ++j)
#pragma unroll
        for (int r = 0; r < 16; ++r)
          img[(wm * 64 + i * 32 + 8 * (r >> 2) + 4 * h + (r & 3)) * IMGW + imgcol + j * 32 + lq] = f2bf(acc[i][2 * JP + j][r]);
  } else if (cb == 91) {
    if (lq < 16) {
      float bias = p.mgb[l * 16 + lq];
#pragma unroll
      for (int i = 0; i < 2; ++i)
#pragma unroll
        for (int r = 0; r < 16; ++r) {
          int row = mb + i * 32 + 8 * (r >> 2) + 4 * h + (r & 3);
          p.gates()[row * 16 + lq] = acc[i][2 * JP][r] + bias;
        }
    }
  } else {
    const bool isdv = cb <= 42;
    int cc = isdv ? cb - 35 : cb - 67;
    int hd = cc >> 1, sub = cc & 1;
    bf16* VT = isdv ? p.VbT() : p.VmT();
#pragma unroll
    for (int i = 0; i < 2; ++i)
#pragma unroll
      for (int j = 0; j < 2; ++j) {
        int d = sub * 64 + j * 32 + lq;
#pragma unroll
        for (int g = 0; g < 4; ++g) {
          int tl = tb.t + i * 32 + 8 * g + 4 * h;
          store_vt4(VT, (size_t)tb.tok0 * 512 + (size_t)(hd * 128 + d) * tb.T + tl, acc[i][2 * JP + j][4 * g], acc[i][2 * JP + j][4 * g + 1], acc[i][2 * JP + j][4 * g + 2], acc[i][2 * JP + j][4 * g + 3]);
          if (isdv && !lat) {
#pragma unroll
            for (int jj = 0; jj < 4; ++jj)
              p.out[O_DV + (size_t)((tb.b * 4 + l) * 256 + tl + jj) * 512 + cc * 64 + j * 32 + lq] = acc[i][2 * JP + j][4 * g + jj];
          }
        }
      }
  }
}
DI void epi_inproj_w(const P& p, int l, int m0, int n0, f32x16 (&acc)[2][4], char* smem) {
  bf16* img = (bf16*)smem;
  const int tid_ = tidx(); const int wn = wave_of(tid_) & 1;
  const int cb0 = n0 >> 6;
  epi_inproj_cbw<0>(p, l, m0, cb0 + 2 * wn, (2 * wn) * 64, acc, img);
  epi_inproj_cbw<1>(p, l, m0, cb0 + 2 * wn + 1, (2 * wn + 1) * 64, acc, img);
  __syncthreads();
#pragma unroll
  for (int half = 0; half < 4; ++half) {
    const int cbh = cb0 + half;
    if (!inproj_rm(cbh)) continue;
    if (cbh == 10) {
#pragma unroll
      for (int hd = 0; hd < 4; ++hd) img_copy_w(img, half, p.Ka() + (size_t)m0 * 768 + hd * 192 + 128, 768, tid_);
    } else if (cbh >= 27 && cbh <= 34) {
      img_copy_w(img, half, p.Kb() + (size_t)m0 * 512 + (cbh - 27) * 64, 512, tid_);
    } else {
      img_copy_w(img, half, p.proj() + (size_t)m0 * NPROJ + cbh * 64, NPROJ, tid_);
    }
  }
  __syncthreads();
}

DI void epi_qa(const P& p, int m0, int n0, f32x16 (&acc)[2][2], const float* sRow) {
  const int tid_ = tidx(); const int lane = tid_ & 63, w = wave_of(tid_), wm = w >> 1, wn = w & 1, lq = lane & 31, h = lane >> 5;
  const int mb = m0 + wm * 64, nb = n0 + wn * 64;
  const int cb = nb >> 6, hd = cb / 3, part = cb % 3;
  TokInfo tb = tinfo(mb);
  const bool dorope = tb.lat && part == 2;
#pragma unroll
  for (int i = 0; i < 2; ++i) {
    float cs[16], sn[16];
#pragma unroll
    for (int r = 0; r < 16; ++r) { cs[r] = 1.f; sn[r] = 0.f; }
    if (dorope) {
#pragma unroll
      for (int r = 0; r < 16; ++r) {
        int t = tb.t + i * 32 + 8 * (r >> 2) + 4 * h + (r & 3);
        cs[r] = p.ropec()[t * 32 + lq]; sn[r] = p.ropes()[t * 32 + lq];
      }
    }
#pragma unroll
    for (int r = 0; r < 16; ++r) {
      int rl = wm * 64 + i * 32 + 8 * (r >> 2) + 4 * h + (r & 3);
      float rstd = rsqrtf(sRow[rl] * (1.f / 384.f) + EPS);
      float x1 = acc[i][0][r] * rstd, x2 = acc[i][1][r] * rstd;
      {
        float y1 = x1 * cs[r] - x2 * sn[r], y2 = x1 * sn[r] + x2 * cs[r];
        x1 = y1; x2 = y2;
      }
      int row = m0 + rl;
      bf16* q = p.Qa() + (size_t)(row * 4 + hd) * 192 + part * 64;
      q[lq] = f2bf(x1); q[32 + lq] = f2bf(x2);
    }
  }
}

DI void epi_kv(const P& p, int m0, int n0, f32x16 (&acc)[2][2], const float* sRow, bool cache) {
  const int tid_ = tidx(); const int lane = tid_ & 63, w = wave_of(tid_), wm = w >> 1, wn = w & 1, lq = lane & 31, h = lane >> 5;
  const int mb = m0 + wm * 64, nb = n0 + wn * 64;
  const int cb = nb >> 6, hd = cb >> 2, part = cb & 3;
  TokInfo tb = tinfo(mb);
#pragma unroll
  for (int i = 0; i < 2; ++i)
#pragma unroll
    for (int j = 0; j < 2; ++j)
#pragma unroll
      for (int g = 0; g < 4; ++g) {
        float v[4];
#pragma unroll
        for (int jj = 0; jj < 4; ++jj) {
          int rl = wm * 64 + i * 32 + 8 * g + 4 * h + jj;
          float rstd = cache ? 1.f : rsqrtf(sRow[rl] * (1.f / 256.f) + EPS);
          v[jj] = acc[i][j][4 * g + jj] * rstd;
        }
        int c = j * 32 + lq;
        int row0 = mb + i * 32 + 8 * g + 4 * h;
        if (part < 2) {
#pragma unroll
          for (int jj = 0; jj < 4; ++jj) {
            int row = row0 + jj;
            if (cache) {
              int lb = row >> 8, t = row & 255;
              p.cKa()[(size_t)((lb * 4 + hd) * 256 + t) * 192 + part * 64 + c] = f2bf(v[jj]);
            } else {
              p.Ka()[(size_t)(row * 4 + hd) * 192 + part * 64 + c] = f2bf(v[jj]);
            }
          }
        } else {
          int d = (part - 2) * 64 + c;
          if (cache) {
            int lb = row0 >> 8, t = row0 & 255;
            store_vt4(p.cVaT(), (size_t)((lb * 4 + hd) * 128 + d) * 256 + t, v[0], v[1], v[2], v[3]);
          } else {
            int tl = tb.t + i * 32 + 8 * g + 4 * h;
            store_vt4(p.VaT(), (size_t)tb.tok0 * 512 + (size_t)(hd * 128 + d) * tb.T + tl, v[0], v[1], v[2], v[3]);
          }
        }
      }
}

DI void epi_out(const P& p, int l, int m0, int n0, f32x16 (&acc)[2][2]) {
  const int tid_ = tidx(); const int lane = tid_ & 63, w = wave_of(tid_), wm = w >> 1, wn = w & 1, lq = lane & 31, h = lane >> 5;
  const int mb = m0 + wm * 64, nb = n0 + wn * 64;
  TokInfo tb = tinfo(mb);
  const float* gate = p.mod() + (size_t)(l * 5 + tb.modj) * 3072 + 2048;
  const float* xsrc = (l == 0) ? (tb.lat ? p.x_sample - (size_t)4096 * 1024 : p.x_prompt) : (const float*)p.xbuf();
#pragma unroll
  for (int i = 0; i < 2; ++i)
#pragma unroll
    for (int j = 0; j < 2; ++j) {
      int col = nb + j * 32 + lq;
      float gv = gate[col];
      float xo[16];
#pragma unroll
      for (int r = 0; r < 16; ++r) {
        int row = mb + i * 32 + 8 * (r >> 2) + 4 * h + (r & 3);
        xo[r] = xsrc[(size_t)row * 1024 + col];
      }
#pragma unroll
      for (int r = 0; r < 16; ++r) {
        int row = mb + i * 32 + 8 * (r >> 2) + 4 * h + (r & 3);
        p.xbuf()[(size_t)row * 1024 + col] = xo[r] + gv * acc[i][j][r];
      }
    }
}

template <int KW, int DQ, int KSPLIT>
DI void attn_pass(const bf16* __restrict__ qptr, int koff, int kh, const bf16* __restrict__ Kmain, int ldk, int Tmain,
                  const bf16* __restrict__ Kc, int ldkc, int Tc, const bf16* __restrict__ VTmain,
                  const bf16* __restrict__ VTc, float c, char* smem, f32x16 (&o)[4], float& lsum, float& m_out) {
  constexpr int KS = KW + 8;
  constexpr int NKB = 2 / KSPLIT;
  bf16* sK = (bf16*)smem;
  bf16* sV = sK + 64 * KS;
  const int tid = tidx(), lane = tid & 63, lq = lane & 31, h = lane >> 5;
  bf16x8 qf[DQ / 16];
#pragma unroll
  for (int ks = 0; ks < DQ / 16; ++ks) qf[ks] = *(const bf16x8*)(qptr + ks * 16 + h * 8);
#pragma unroll
  for (int db = 0; db < 4; ++db)
#pragma unroll
    for (int r = 0; r < 16; ++r) o[db][r] = 0.f;
  lsum = 0.f;
  float m_run = -INFINITY;
  const int nt = (Tmain + Tc) >> 6;
  constexpr int CH = KW / 8, NKL = 64 * CH / 256;
  u32x4 kr[NKL], vr[4];
  auto issue = [&](int kt) {
    const bf16* ksrc; int ld; const bf16* vsrc; int ldv;
    if (kt * 64 < Tmain) { ksrc = Kmain + (size_t)(kt * 64) * ldk; ld = ldk; vsrc = VTmain + kt * 64; ldv = Tmain; }
    else { ksrc = Kc + (size_t)(kt * 64 - Tmain) * ldkc; ld = ldkc; vsrc = VTc + (kt * 64 - Tmain); ldv = Tc; }
#pragma unroll
    for (int i = 0; i < NKL; ++i) {
      int idx = tid + 256 * i; int r = idx / CH, cc = idx % CH;
      kr[i] = *(const u32x4*)(ksrc + (size_t)r * ld + cc * 8);
    }
    if (KSPLIT == 1) {
#pragma unroll
      for (int i = 0; i < 4; ++i) {
        int idx = tid + 256 * i; int r = idx >> 3, cc = idx & 7;
        vr[i] = *(const u32x4*)(vsrc + (size_t)r * ldv + cc * 8);
      }
    }
  };
  issue(0);
  for (int kt = 0; kt < nt; ++kt) {
    __syncthreads();
#pragma unroll
    for (int i = 0; i < NKL; ++i) {
      int idx = tid + 256 * i; int r = idx / CH, cc = idx % CH;
      *(u32x4*)(sK + r * KS + cc * 8) = kr[i];
    }
    if (KSPLIT != 1) {
      const bf16* vsrc; int ldv;
      if (kt * 64 < Tmain) { vsrc = VTmain + kt * 64; ldv = Tmain; } else { vsrc = VTc + (kt * 64 - Tmain); ldv = Tc; }
#pragma unroll
      for (int i = 0; i < 4; ++i) {
        int idx = tid + 256 * i; int r = idx >> 3, cc = idx & 7;
        vr[i] = *(const u32x4*)(vsrc + (size_t)r * ldv + cc * 8);
      }
    }
#pragma unroll
    for (int i = 0; i < 4; ++i) {
      int idx = tid + 256 * i; int r = idx >> 3, cc = idx & 7;
      *(u32x4*)(sV + r * 72 + cc * 8) = vr[i];
    }
    __syncthreads();
    issue((kt + 1 < nt) ? kt + 1 : kt);
    f32x16 s[NKB];
#pragma unroll
    for (int kbi = 0; kbi < NKB; ++kbi)
#pragma unroll
      for (int r = 0; r < 16; ++r) s[kbi][r] = 0.f;
#pragma unroll
    for (int ks = 0; ks < DQ / 16; ++ks)
#pragma unroll
      for (int kbi = 0; kbi < NKB; ++kbi) {
        const int kb = (KSPLIT == 2) ? kh : kbi;
        bf16x8 a = *(const bf16x8*)(sK + (kb * 32 + lq) * KS + koff + ks * 16 + h * 8);
        s[kbi] = MFMA(a, qf[ks], s[kbi]);
      }
    float mx = -INFINITY;
#pragma unroll
    for (int kbi = 0; kbi < NKB; ++kbi)
#pragma unroll
      for (int r = 0; r < 16; ++r) mx = fmaxf(mx, s[kbi][r]);
    mx = fmaxf(mx, __shfl_xor(mx, 32));
    const float m_new = fmaxf(m_run, mx);
    const float alpha = fexp2((m_run - m_new) * c);
    m_run = m_new;
    lsum *= alpha;
#pragma unroll
    for (int db = 0; db < 4; ++db)
#pragma unroll
      for (int r = 0; r < 16; ++r) o[db][r] *= alpha;
    const float mc = m_new * c;
#pragma unroll
    for (int kbi = 0; kbi < NKB; ++kbi)
#pragma unroll
      for (int r = 0; r < 16; ++r) { float pv = fexp2(s[kbi][r] * c - mc); s[kbi][r] = pv; lsum += pv; }
#pragma unroll
    for (int kbi = 0; kbi < NKB; ++kbi) {
      const int kb = (KSPLIT == 2) ? kh : kbi;
#pragma unroll
      for (int s2 = 0; s2 < 2; ++s2) {
        u32x4 pk;
#pragma unroll
        for (int e = 0; e < 4; ++e) pk[e] = pack2(s[kbi][8 * s2 + 2 * e], s[kbi][8 * s2 + 2 * e + 1]);
        bf16x8 pb = __builtin_bit_cast(bf16x8, pk);
#pragma unroll
        for (int db = 0; db < 4; ++db) {
          const bf16* vp = sV + (db * 32 + lq) * 72 + kb * 32 + s2 * 16 + 4 * h;
          u32x2 lo = *(const u32x2*)vp, hi = *(const u32x2*)(vp + 8);
          u32x4 av; av[0] = lo[0]; av[1] = lo[1]; av[2] = hi[0]; av[3] = hi[1];
          o[db] = MFMA(__builtin_bit_cast(bf16x8, av), pb, o[db]);
        }
      }
    }
  }
  lsum += __shfl_xor(lsum, 32);
  m_out = m_run;
}

DI void mla_item(const P& p, int l, int it, char* smem) {
  const int tid = tidx(), lane = tid & 63, w = wave_of(tid), lq = lane & 31, h = lane >> 5;
  int lat, b, hd, qb;
  if (it < 256) { lat = 1; b = it >> 6; hd = (it >> 4) & 3; qb = it & 15; }
  else { int u = it - 256; lat = 0; b = u >> 4; hd = (u >> 2) & 3; qb = u & 3; }
  const int T = lat ? 1024 : 256, tok0 = lat ? 4096 + b * 1024 : b * 256;
  const int qsub = w & 1, kh = w >> 1;
  const int tok = tok0 + qb * 64 + qsub * 32 + lq;
  f32x16 o[4]; float lsum, mrun;
  const float c = 0.07216878364870322f * 1.4426950408889634f;
  attn_pass<192, 192, 2>(p.Qa() + (size_t)(tok * 4 + hd) * 192, 0, kh, p.Ka() + (size_t)(tok0 * 4 + hd) * 192, 768, T,
                 p.cKa() + (size_t)((l * 4 + b) * 4 + hd) * 256 * 192, 192, lat ? 256 : 0,
                 p.VaT() + (size_t)tok0 * 512 + (size_t)hd * 128 * T, p.cVaT() + (size_t)((l * 4 + b) * 4 + hd) * 128 * 256, c, smem, o, lsum, mrun);
  float* ex = (float*)smem;
  float* exm = ex + 2 * 128 * 32;
  float* exl = exm + 64;
  __syncthreads();
  if (kh == 1) {
#pragma unroll
    for (int db = 0; db < 4; ++db)
#pragma unroll
      for (int r = 0; r < 16; ++r) {
        int dv = db * 32 + 8 * (r >> 2) + 4 * h + (r & 3);
        ex[(qsub * 128 + dv) * 32 + lq] = o[db][r];
      }
    if (h == 0) { exm[qsub * 32 + lq] = mrun; exl[qsub * 32 + lq] = lsum; }
  }
  __syncthreads();
  if (kh == 0) {
    const float m1 = exm[qsub * 32 + lq], l1 = exl[qsub * 32 + lq];
    const float mm = fmaxf(mrun, m1);
    const float f0 = fexp2((mrun - mm) * c), f1 = fexp2((m1 - mm) * c);
    const float inv = 1.f / (lsum * f0 + l1 * f1);
    const float g0 = f0 * inv, g1 = f1 * inv;
    u32x2 zz[4][4];
#pragma unroll
    for (int db = 0; db < 4; ++db)
#pragma unroll
      for (int g = 0; g < 4; ++g) zz[db][g] = *(const u32x2*)(p.proj() + (size_t)tok * NPROJ + 704 + hd * 128 + db * 32 + 8 * g + 4 * h);
#pragma unroll
    for (int db = 0; db < 4; ++db)
#pragma unroll
      for (int g = 0; g < 4; ++g) {
        int dv = db * 32 + 8 * g + 4 * h;
        float ov4[4];
#pragma unroll
        for (int jj = 0; jj < 4; ++jj) ov4[jj] = o[db][4 * g + jj] * g0 + ex[(qsub * 128 + dv + jj) * 32 + lq] * g1;
        u32x2 z = zz[db][g];
        float z0 = bflo(z[0]), z1 = bfhi(z[0]), z2 = bflo(z[1]), z3 = bfhi(z[1]);
        u32x2 ov;
        ov[0] = pack2(ov4[0] * silu_f(z0), ov4[1] * silu_f(z1));
        ov[1] = pack2(ov4[2] * silu_f(z2), ov4[3] * silu_f(z3));
        *(u32x2*)(p.ycat() + (size_t)tok * 1536 + hd * 128 + dv) = ov;
      }
  }
}

DI void diff_item(const P& p, int l, int it, char* smem) {
  const int tid = tidx(), lane = tid & 63, w = wave_of(tid), lq = lane & 31, h = lane >> 5;
  int lat, b, hd, qb;
  if (it < 256) { lat = 1; b = it >> 6; hd = (it >> 4) & 3; qb = it & 15; }
  else { int u = it - 256; lat = 0; b = u >> 4; hd = (u >> 2) & 3; qb = u & 3; }
  const int T = lat ? 1024 : 256, tok0 = lat ? 4096 + b * 1024 : b * 256;
  const int map = w >> 1, qsub = w & 1;
  const int tok = tok0 + qb * 64 + qsub * 32 + lq;
  const float c = 0.125f * 1.4426950408889634f;
  const bf16* vt = p.VbT() + (size_t)tok0 * 512 + (size_t)hd * 128 * T;
  const bf16* vtc = p.cVbT() + (size_t)((l * 4 + b) * 4 + hd) * 128 * 256;
  const bf16* kc = p.cKb() + (size_t)((l * 4 + b) * 4 + hd) * 256 * 128;
  f32x16 o[4]; float ls, mdummy;
  attn_pass<128, 64, 1>(p.proj() + (size_t)tok * NPROJ + 1216 + hd * 128 + map * 64, map * 64, 0, p.Kb() + (size_t)(tok0 * 4 + hd) * 128, 512, T, kc, 128,
                     lat ? 256 : 0, vt, vtc, c, smem, o, ls, mdummy);
  float* ex = (float*)smem;
  __syncthreads();
  if (map == 1) {
    const float sc2 = p.lam()[l] / ls;
#pragma unroll
    for (int db = 0; db < 4; ++db)
#pragma unroll
      for (int r = 0; r < 16; ++r) {
        int dv = db * 32 + 8 * (r >> 2) + 4 * h + (r & 3);
        ex[(qsub * 128 + dv) * 32 + lq] = o[db][r] * sc2;
      }
  }
  __syncthreads();
  if (map == 0) {
    const float i1 = 1.f / ls;
    float ss = 0.f;
#pragma unroll
    for (int db = 0; db < 4; ++db)
#pragma unroll
      for (int r = 0; r < 16; ++r) {
        int dv = db * 32 + 8 * (r >> 2) + 4 * h + (r & 3);
        float v = o[db][r] * i1 - ex[(qsub * 128 + dv) * 32 + lq];
        o[db][r] = v; ss += v * v;
      }
    ss += __shfl_xor(ss, 32);
    const float lam_init = 0.8f - 0.6f * fexp(-0.3f * (float)l);
    const float sc = rsqrtf(ss * (1.f / 128.f) + EPS) * (1.f - lam_init);
#pragma unroll
    for (int db = 0; db < 4; ++db) {
      u32x2 zz[4]; f32x4 gg[4];
#pragma unroll
      for (int g = 0; g < 4; ++g) {
        int dv = db * 32 + 8 * g + 4 * h;
        zz[g] = *(const u32x2*)(p.proj() + (size_t)tok * NPROJ + 2752 + hd * 128 + dv);
        gg[g] = *(const f32x4*)(p.dnorm + l * 128 + dv);
      }
#pragma unroll
      for (int g = 0; g < 4; ++g) {
        int dv = db * 32 + 8 * g + 4 * h;
        u32x2 z = zz[g];
        f32x4 gn = gg[g];
        float z0 = bflo(z[0]), z1 = bfhi(z[0]), z2 = bflo(z[1]), z3 = bfhi(z[1]);
        u32x2 ov;
        ov[0] = pack2(o[db][4 * g] * sc * gn[0] * silu_f(z0), o[db][4 * g + 1] * sc * gn[1] * silu_f(z1));
        ov[1] = pack2(o[db][4 * g + 2] * sc * gn[2] * silu_f(z2), o[db][4 * g + 3] * sc * gn[3] * silu_f(z3));
        *(u32x2*)(p.ycat() + (size_t)tok * 1536 + 512 + hd * 128 + dv) = ov;
      }
    }
  }
}

DI void conv8(const P& p, int l, int tok, int t, int T, int col, int wcol, float (&o)[8]) {
  const bf16* base = p.proj() + (size_t)tok * NPROJ + col;
  u32x4 cur = *(const u32x4*)base;
  u32x4 prv = {0u, 0u, 0u, 0u}, nxt = {0u, 0u, 0u, 0u};
  if (t > 0) prv = *(const u32x4*)(base - NPROJ);
  if (t < T - 1) nxt = *(const u32x4*)(base + NPROJ);
  const float* w0 = p.mconv + (size_t)l * 3 * 1024 + wcol;
  f32x4 wa0 = *(const f32x4*)w0, wa1 = *(const f32x4*)(w0 + 4);
  f32x4 wb0 = *(const f32x4*)(w0 + 1024), wb1 = *(const f32x4*)(w0 + 1028);
  f32x4 wc0 = *(const f32x4*)(w0 + 2048), wc1 = *(const f32x4*)(w0 + 2052);
#pragma unroll
  for (int e = 0; e < 4; ++e) {
    float wA0 = e < 2 ? wa0[2 * e] : wa1[2 * e - 4], wA1 = e < 2 ? wa0[2 * e + 1] : wa1[2 * e - 3];
    float wB0 = e < 2 ? wb0[2 * e] : wb1[2 * e - 4], wB1 = e < 2 ? wb0[2 * e + 1] : wb1[2 * e - 3];
    float wC0 = e < 2 ? wc0[2 * e] : wc1[2 * e - 4], wC1 = e < 2 ? wc0[2 * e + 1] : wc1[2 * e - 3];
    float v0 = wA0 * bflo(prv[e]) + wB0 * bflo(cur[e]) + wC0 * bflo(nxt[e]);
    float v1 = wA1 * bfhi(prv[e]) + wB1 * bfhi(cur[e]) + wC1 * bfhi(nxt[e]);
    o[2 * e] = silu_f(v0); o[2 * e + 1] = silu_f(v1);
  }
}

DI float wave_incl_scan_add(float v, int lane) {
#pragma unroll
  for (int o = 1; o < 64; o <<= 1) { float t = __shfl_up(v, o); if (lane >= o) v += t; }
  return v;
}
DI float wave_incl_scan_max(float v, int lane) {
#pragma unroll
  for (int o = 1; o < 64; o <<= 1) { float t = __shfl_up(v, o); if (lane >= o) v = fmaxf(v, t); }
  return v;
}

DI void mlstm_local(const P& p, int l, int slot, char* smem) {
  bf16* vT = (bf16*)smem;
  bf16* kT = vT + 128 * 72;
  float* wbuf = (float*)(kT + 128 * 72);
  const int tid = tidx(), lane = tid & 63, w = wave_of(tid), lq = lane & 31, h = lane >> 5;
  const int cp = slot >> 3, hd = (slot >> 1) & 3, dir = slot & 1;
  const int ctok = cp * 64;
  TokInfo ti = tinfo(ctok);
  const int T = ti.T;
  if (w == 0) {
    const int s = dir ? 63 - lane : lane;
    const int tk = ctok + s;
    const float ig = p.gates()[tk * 16 + dir * 8 + hd];
    const float lf = logsig_f(p.gates()[tk * 16 + dir * 8 + 4 + hd]);
    const float bc = wave_incl_scan_add(lf, lane);
    const float b_last = __shfl(bc, 63);
    const float val = b_last - bc + ig;
    float mx = val;
#pragma unroll
    for (int o = 32; o >= 1; o >>= 1) mx = fmaxf(mx, __shfl_xor(mx, o));
    wbuf[s] = fexp(val - mx);
    if (lane == 0) { p.blA()[slot] = b_last; p.mlA()[slot] = mx; }
  }
  __syncthreads();
  {
    const int s = tid >> 2, chb = (tid & 3) * 32;
    const float ws = wbuf[s];
#pragma unroll 1
    for (int q = 0; q < 4; ++q) {
      float kv[8];
      const int ch = chb + q * 8;
      conv8(p, l, ctok + s, ti.t + s, T, 3776 + hd * 128 + ch, 512 + hd * 128 + ch, kv);
#pragma unroll
      for (int e = 0; e < 8; ++e) kT[(ch + e) * 72 + s] = f2bf(kv[e] * ws);
    }
    const bf16* vsrc = p.VmT() + (size_t)ti.tok0 * 512 + (size_t)hd * 128 * T + ti.t;
#pragma unroll
    for (int i = 0; i < 4; ++i) {
      int idx = tid + 256 * i; int r = idx >> 3, cc = idx & 7;
      *(u32x4*)(vT + r * 72 + cc * 8) = *(const u32x4*)(vsrc + (size_t)r * T + cc * 8);
    }
  }
  __syncthreads();
  f32x16 acc[4];
#pragma unroll
  for (int cb = 0; cb < 4; ++cb)
#pragma unroll
    for (int r = 0; r < 16; ++r) acc[cb][r] = 0.f;
#pragma unroll
  for (int ks = 0; ks < 4; ++ks) {
    bf16x8 a = *(const bf16x8*)(vT + (32 * w + lq) * 72 + ks * 16 + 8 * h);
#pragma unroll
    for (int cb = 0; cb < 4; ++cb) {
      bf16x8 bb = *(const bf16x8*)(kT + (32 * cb + lq) * 72 + ks * 16 + 8 * h);
      acc[cb] = MFMA(a, bb, acc[cb]);
    }
  }
  bf16* cs = p.Cst() + (size_t)slot * 16384;
#pragma unroll
  for (int cb = 0; cb < 4; ++cb)
#pragma unroll
    for (int r = 0; r < 16; ++r) {
      int dvv = 32 * w + 8 * (r >> 2) + 4 * h + (r & 3);
      cs[dvv * 128 + 32 * cb + lq] = f2bf(acc[cb][r]);
    }
  if (tid < 128) {
    float sum = 0.f;
#pragma unroll
    for (int q = 0; q < 8; ++q) {
      u32x4 v = *(const u32x4*)(kT + tid * 72 + q * 8);
#pragma unroll
      for (int e = 0; e < 4; ++e) sum += bflo(v[e]) + bfhi(v[e]);
    }
    p.nst()[slot * 128 + tid] = sum;
  }
}

DI void mlstm_scan(const P& p, int l, int it) {
  const int tid = tidx();
  const int ch = it >> 2, qt = it & 3;
  int lat, b, hd, dir;
  if (ch < 32) { lat = 1; b = ch >> 3; hd = (ch >> 1) & 3; dir = ch & 1; }
  else { int u = ch - 32; lat = 0; b = u >> 3; hd = (u >> 1) & 3; dir = u & 1; }
  const int T = lat ? 1024 : 256, tok0 = lat ? 4096 + b * 1024 : b * 256, nc = T >> 6;
  const int dv0 = 32 * qt + 4 * (tid >> 5), dk0 = 4 * (tid & 31);
  float C[4][4];
  float n_val = 0.f, m_prev = 0.f;
  const bool do_n = (qt == 0) && (tid < 128);
  const size_t sidx = (size_t)((b * 4 + l) * 2 + dir) * 4 + hd;
  if (lat) {
    const float* C0 = p.st_C + sidx * 16384;
#pragma unroll
    for (int j = 0; j < 4; ++j) {
      f32x4 v = *(const f32x4*)(C0 + (size_t)(dk0 + j) * 128 + dv0);
      C[0][j] = v[0]; C[1][j] = v[1]; C[2][j] = v[2]; C[3][j] = v[3];
    }
    if (do_n) n_val = p.st_n[sidx * 128 + tid];
    m_prev = p.st_m[sidx];
  } else {
#pragma unroll
    for (int i = 0; i < 4; ++i)
#pragma unroll
      for (int j = 0; j < 4; ++j) C[i][j] = 0.f;
  }
  u32x2 dnx[4]; float blx, mlx, dnnx = 0.f;
  {
    const int c = dir ? nc - 1 : 0;
    const int slot = ((((tok0 >> 6) + c) * 4 + hd) * 2) + dir;
    const bf16* cs = p.Cst() + (size_t)slot * 16384 + dv0 * 128 + dk0;
#pragma unroll
    for (int i = 0; i < 4; ++i) dnx[i] = *(const u32x2*)(cs + i * 128);
    blx = p.blA()[slot]; mlx = p.mlA()[slot];
    if (do_n) dnnx = p.nst()[slot * 128 + tid];
  }
  for (int ci = 0; ci < nc; ++ci) {
    const int c = dir ? nc - 1 - ci : ci;
    const int slot = ((((tok0 >> 6) + c) * 4 + hd) * 2) + dir;
    bf16* cs = p.Cst() + (size_t)slot * 16384 + dv0 * 128 + dk0;
    u32x2 d[4];
#pragma unroll
    for (int i = 0; i < 4; ++i) d[i] = dnx[i];
    const float bl = blx, ml = mlx;
    const float dn = dnnx;
    {
      const int cn = (ci + 1 < nc) ? (dir ? nc - 2 - ci : ci + 1) : c;
      const int sn = ((((tok0 >> 6) + cn) * 4 + hd) * 2) + dir;
      const bf16* csn = p.Cst() + (size_t)sn * 16384 + dv0 * 128 + dk0;
#pragma unroll
      for (int i = 0; i < 4; ++i) dnx[i] = *(const u32x2*)(csn + i * 128);
      blx = p.blA()[sn]; mlx = p.mlA()[sn];
      if (do_n) dnnx = p.nst()[sn * 128 + tid];
    }
#pragma unroll
    for (int i = 0; i < 4; ++i) {
      u32x2 o; o[0] = pack2(C[i][0], C[i][1]); o[1] = pack2(C[i][2], C[i][3]);
      *(u32x2*)(cs + i * 128) = o;
    }
    if (do_n) p.nst()[slot * 128 + tid] = n_val;
    if (qt == 0 && tid == 0) p.mst()[slot] = m_prev;
    const float m_new = fmaxf(bl + m_prev, ml);
    const float a = fexp(bl + m_prev - m_new), bs = fexp(ml - m_new);
#pragma unroll
    for (int i = 0; i < 4; ++i) {
      C[i][0] = a * C[i][0] + bs * bflo(d[i][0]); C[i][1] = a * C[i][1] + bs * bfhi(d[i][0]);
      C[i][2] = a * C[i][2] + bs * bflo(d[i][1]); C[i][3] = a * C[i][3] + bs * bfhi(d[i][1]);
    }
    n_val = a * n_val + bs * dn;
    m_prev = m_new;
  }
  if (!lat) {
    float* Co = p.out + O_MC + sidx * 16384;
#pragma unroll
    for (int j = 0; j < 4; ++j) {
      f32x4 v; v[0] = C[0][j]; v[1] = C[1][j]; v[2] = C[2][j]; v[3] = C[3][j];
      *(f32x4*)(Co + (size_t)(dk0 + j) * 128 + dv0) = v;
    }
    if (do_n) p.out[O_MN + sidx * 128 + tid] = n_val;
    if (qt == 0 && tid == 0) p.out[O_MM + sidx] = m_prev;
  }
}

DI void mlstm_out(const P& p, int l, int it, char* smem) {
  bf16* sq = (bf16*)smem;
  bf16* sk = sq + 64 * 136;
  bf16* vT = sk + 64 * 136;
  float* bcA2 = (float*)(vT + 128 * 72);
  float* uA2 = bcA2 + 128, *mtA2 = uA2 + 128, *nA2 = mtA2 + 128  , *ssb = nA2 + 256  ;
  const int tid = tidx(), lane = tid & 63, w = wave_of(tid), lq = lane & 31, h = lane >> 5;
  const int cp = it >> 2, hd = it & 3;
  const int ctok = cp * 64;
  TokInfo ti = tinfo(ctok);
  const int T = ti.T;
  const float m_prev0 = p.mst()[(cp * 4 + hd) * 2], m_prev1 = p.mst()[(cp * 4 + hd) * 2 + 1];
  if (w < 2) {
    const int dir = w;
    const float m_prev = dir ? m_prev1 : m_prev0;
    const int s = dir ? 63 - lane : lane;
    const int tk = ctok + s;
    const float ig = p.gates()[tk * 16 + dir * 8 + hd];
    const float lf = logsig_f(p.gates()[tk * 16 + dir * 8 + 4 + hd]);
    const float bc = wave_incl_scan_add(lf, lane);
    const float u = ig - bc;
    const float pm = wave_incl_scan_max(u, lane);
    bcA2[dir * 64 + s] = bc; uA2[dir * 64 + s] = u; mtA2[dir * 64 + s] = bc + fmaxf(m_prev, pm);
  } else {
    const int dir = w - 2;
    const int slot = (cp * 4 + hd) * 2 + dir;
    nA2[dir * 128 + lane] = p.nst()[slot * 128 + lane];
    nA2[dir * 128 + 64 + lane] = p.nst()[slot * 128 + 64 + lane];
  }
  {
    const int s = tid >> 2, chb = (tid & 3) * 32;
#pragma unroll 2
    for (int q = 0; q < 4; ++q) {
      const int ch = chb + q * 8;
      float v[8];
      conv8(p, l, ctok + s, ti.t + s, T, 3264 + hd * 128 + ch, hd * 128 + ch, v);
      u32x4 pk;
#pragma unroll
      for (int e = 0; e < 4; ++e) pk[e] = pack2(v[2 * e] * 0.08838834764831845f, v[2 * e + 1] * 0.08838834764831845f);
      *(u32x4*)(sq + s * 136 + ch) = pk;
      conv8(p, l, ctok + s, ti.t + s, T, 3776 + hd * 128 + ch, 512 + hd * 128 + ch, v);
#pragma unroll
      for (int e = 0; e < 4; ++e) pk[e] = pack2(v[2 * e], v[2 * e + 1]);
      *(u32x4*)(sk + s * 136 + ch) = pk;
    }
    const bf16* vsrc = p.VmT() + (size_t)ti.tok0 * 512 + (size_t)hd * 128 * T + ti.t;
#pragma unroll
    for (int i = 0; i < 4; ++i) {
      int idx = tid + 256 * i; int r = idx >> 3, cc = idx & 7;
      *(u32x4*)(vT + r * 72 + cc * 8) = *(const u32x4*)(vsrc + (size_t)r * T + cc * 8);
    }
  }
  __syncthreads();
  const int tb = w & 1, dvh = w >> 1;
  const int t = 32 * tb + lq;
  f32x16 hacc[2];
#pragma unroll
  for (int d2 = 0; d2 < 2; ++d2)
#pragma unroll
    for (int r = 0; r < 16; ++r) hacc[d2][r] = 0.f;
  const bf16* sqt = sq + t * 136 + 8 * h;
  for (int dir = 0; dir < 2; ++dir) {
    const int slot = (cp * 4 + hd) * 2 + dir;
    const float m_prev = dir ? m_prev1 : m_prev0;
    const float* bcA = bcA2 + dir * 64;
    const float* uA = uA2 + dir * 64;
    const float* mtA = mtA2 + dir * 64;
    const float* nA = nA2 + dir * 128;
    const float bc_t = bcA[t], mt = mtA[t];
    const float w_inter = fexp(bc_t + m_prev - mt);
    float den = 0.f;
    const float e0 = bc_t - mt;
    u32x4 pk[2][2];
#pragma unroll
    for (int sb = 0; sb < 2; ++sb) {
      asm volatile("" ::: "memory");
      f32x16 sv;
#pragma unroll
      for (int r = 0; r < 16; ++r) sv[r] = 0.f;
#pragma unroll
      for (int ks = 0; ks < 8; ++ks) {
        bf16x8 a = *(const bf16x8*)(sk + (32 * sb + lq) * 136 + ks * 16 + 8 * h);
        sv = MFMA(a, *(const bf16x8*)(sqt + ks * 16), sv);
      }
#pragma unroll
      for (int r = 0; r < 16; ++r) {
        const int sidx = 32 * sb + 8 * (r >> 2) + 4 * h + (r & 3);
        const bool valid = dir ? (sidx >= t) : (sidx <= t);
        const float wgt = valid ? fexp(e0 + uA[sidx]) : 0.f;
        const float v = sv[r] * wgt;
        sv[r] = v; den += v;
      }
#pragma unroll
      for (int s2 = 0; s2 < 2; ++s2)
#pragma unroll
        for (int e = 0; e < 4; ++e) pk[sb][s2][e] = pack2(sv[8 * s2 + 2 * e], sv[8 * s2 + 2 * e + 1]);
    }
    asm volatile("" ::: "memory");
    den += __shfl_xor(den, 32);
    float qn = 0.f;
#pragma unroll
    for (int ks = 0; ks < 8; ++ks) {
      u32x4 qv = *(const u32x4*)(sqt + ks * 16);
#pragma unroll
      for (int e = 0; e < 4; ++e) {
        qn += bflo(qv[e]) * nA[ks * 16 + 8 * h + 2 * e] + bfhi(qv[e]) * nA[ks * 16 + 8 * h + 2 * e + 1];
      }
    }
    qn += __shfl_xor(qn, 32);
    den += w_inter * qn;
    asm volatile("" ::: "memory");
    const float rden = 1.f / fmaxf(fabsf(den), fexp(-mt));
    const bf16* cs = p.Cst() + (size_t)slot * 16384;
    bf16x8 cfa[2][8];
#pragma unroll
    for (int d2 = 0; d2 < 2; ++d2)
#pragma unroll
      for (int ks = 0; ks < 8; ++ks) cfa[d2][ks] = *(const bf16x8*)(cs + ((2 * dvh + d2) * 32 + lq) * 128 + ks * 16 + 8 * h);
    asm volatile("" : "+v"(cfa[0][0]), "+v"(cfa[0][1]), "+v"(cfa[0][2]), "+v"(cfa[0][3]), "+v"(cfa[0][4]), "+v"(cfa[0][5]), "+v"(cfa[0][6]), "+v"(cfa[0][7]),
                      "+v"(cfa[1][0]), "+v"(cfa[1][1]), "+v"(cfa[1][2]), "+v"(cfa[1][3]), "+v"(cfa[1][4]), "+v"(cfa[1][5]), "+v"(cfa[1][6]), "+v"(cfa[1][7]));
#pragma unroll
    for (int d2 = 0; d2 < 2; ++d2) {
      const int dvb = 2 * dvh + d2;
      f32x16 acc;
#pragma unroll
      for (int r = 0; r < 16; ++r) acc[r] = 0.f;
#pragma unroll
      for (int ks = 0; ks < 8; ++ks) acc = MFMA(cfa[d2][ks], *(const bf16x8*)(sqt + ks * 16), acc);
#pragma unroll
      for (int r = 0; r < 16; ++r) acc[r] *= w_inter;
#pragma unroll
      for (int sb = 0; sb < 2; ++sb)
#pragma unroll
        for (int s2 = 0; s2 < 2; ++s2) {
          const bf16* vp = vT + (dvb * 32 + lq) * 72 + sb * 32 + s2 * 16 + 4 * h;
          u32x2 lo = *(const u32x2*)vp, hi = *(const u32x2*)(vp + 8);
          u32x4 av; av[0] = lo[0]; av[1] = lo[1]; av[2] = hi[0]; av[3] = hi[1];
          acc = MFMA(__builtin_bit_cast(bf16x8, av), __builtin_bit_cast(bf16x8, pk[sb][s2]), acc);
        }
#pragma unroll
      for (int r = 0; r < 16; ++r) hacc[d2][r] += acc[r] * rden;
    }
  }
  const int tok = ctok + t;
  float ss = 0.f;
#pragma unroll
  for (int d2 = 0; d2 < 2; ++d2)
#pragma unroll
    for (int g = 0; g < 4; ++g) {
      int dv = (2 * dvh + d2) * 32 + 8 * g + 4 * h;
      u32x2 mo = *(const u32x2*)(p.proj() + (size_t)tok * NPROJ + 4800 + hd * 128 + dv);
      float m0 = bflo(mo[0]), m1 = bfhi(mo[0]), m2 = bflo(mo[1]), m3 = bfhi(mo[1]);
      float v0 = hacc[d2][4 * g] * sigmoid_f(m0), v1 = hacc[d2][4 * g + 1] * sigmoid_f(m1);
      float v2 = hacc[d2][4 * g + 2] * sigmoid_f(m2), v3 = hacc[d2][4 * g + 3] * sigmoid_f(m3);
      hacc[d2][4 * g] = v0; hacc[d2][4 * g + 1] = v1; hacc[d2][4 * g + 2] = v2; hacc[d2][4 * g + 3] = v3;
      ss += v0 * v0 + v1 * v1 + v2 * v2 + v3 * v3;
    }
  ss += __shfl_xor(ss, 32);
  if (h == 0) ssb[dvh * 64 + t] = ss;
  __syncthreads();
  const float rstd = rsqrtf((ssb[t] + ssb[64 + t]) * (1.f / 128.f) + EPS);
  u32x2 zz[2][4]; f32x4 gg[2][4];
#pragma unroll
  for (int d2 = 0; d2 < 2; ++d2)
#pragma unroll
    for (int g = 0; g < 4; ++g) {
      int dv = (2 * dvh + d2) * 32 + 8 * g + 4 * h;
      zz[d2][g] = *(const u32x2*)(p.proj() + (size_t)tok * NPROJ + 5312 + hd * 128 + dv);
      gg[d2][g] = *(const f32x4*)(p.mnorm + l * 512 + hd * 128 + dv);
    }
#pragma unroll
  for (int d2 = 0; d2 < 2; ++d2)
#pragma unroll
    for (int g = 0; g < 4; ++g) {
      int dv = (2 * dvh + d2) * 32 + 8 * g + 4 * h;
      u32x2 z = zz[d2][g];
      f32x4 gn = gg[d2][g];
      float z0 = bflo(z[0]), z1 = bfhi(z[0]), z2 = bflo(z[1]), z3 = bfhi(z[1]);
      u32x2 ov;
      ov[0] = pack2(hacc[d2][4 * g] * rstd * gn[0] * silu_f(z0), hacc[d2][4 * g + 1] * rstd * gn[1] * silu_f(z1));
      ov[1] = pack2(hacc[d2][4 * g + 2] * rstd * gn[2] * silu_f(z2), hacc[d2][4 * g + 3] * rstd * gn[3] * silu_f(z3));
      *(u32x2*)(p.ycat() + (size_t)tok * 1536 + 1024 + hd * 128 + dv) = ov;
    }
}

DI void ckv_fin(const P& p, int l, int tok) {
  const int lane = tidx() & 63;
  const int b = tok >> 8, t = tok & 255;
  float* o = p.out + O_CKV + (size_t)((b * 4 + l) * 256 + t) * 256 + lane * 4;
  u32x2 raw = *(const u32x2*)(p.proj() + (size_t)tok * NPROJ + 384 + lane * 4);
  f32x4 v; v[0] = bflo(raw[0]); v[1] = bfhi(raw[0]); v[2] = bflo(raw[1]); v[3] = bfhi(raw[1]);
  float ss = v[0] * v[0] + v[1] * v[1] + v[2] * v[2] + v[3] * v[3];
#pragma unroll
  for (int of = 32; of >= 1; of >>= 1) ss += __shfl_xor(ss, of);
  const float rstd = rsqrtf(ss * (1.f / 256.f) + EPS);
  f32x4 g = *(const f32x4*)(p.kv_norm + l * 256 + lane * 4);
  v[0] *= rstd * g[0]; v[1] *= rstd * g[1]; v[2] *= rstd * g[2]; v[3] *= rstd * g[3];
  *(f32x4*)o = v;
}

#define XB_TMO      128
#define XB_XCNT(j)  (256  + 64 * (j))
#define XB_XSUB(j)  (1280 + 64 * (j))
#define XB_XGEN(j)  (2304 + 64 * (j))
#define XB_TOP      3328
#define XB_TOPGEN   3392
#define XCD_BAR_WORDS 3456
#define XB_SPIN_CAP (1u << 18)
#define LAS __attribute__((address_space(3)))

__device__ __forceinline__ unsigned xb_ld(unsigned* p)              { return __hip_atomic_load(p, __ATOMIC_RELAXED, __HIP_MEMORY_SCOPE_AGENT); }
__device__ __forceinline__ unsigned xb_add(unsigned* p, unsigned v) { return __hip_atomic_fetch_add(p, v, __ATOMIC_RELAXED, __HIP_MEMORY_SCOPE_AGENT); }
__device__ __forceinline__ unsigned xb_xcc_id() { return (unsigned)__builtin_amdgcn_s_getreg((3 << 11) | 20) & 0xFu; }
#define XB_SPIN(cond, bar) do { unsigned _sp = 0; while (cond) { __builtin_amdgcn_s_sleep(1); \
    if ((++_sp & 255u) == 0u) { if (xb_ld(&(bar)[XB_TMO])) break; if (_sp > XB_SPIN_CAP) { atomicAdd(&(bar)[XB_TMO], 1u); break; } } } } while (0)

struct XcdBarrier {
    unsigned* bar; unsigned x;
    volatile LAS unsigned* st;
};

__device__ __forceinline__ XcdBarrier xcd_barrier_post(unsigned* bar, volatile LAS unsigned* st) {
    XcdBarrier b; b.bar = bar; b.x = xb_xcc_id(); b.st = st;
    if (tidx() == 0) (void)xb_add(&bar[XB_XCNT(b.x)], 1u);
    return b;
}
__device__ __forceinline__ void xcd_barrier_complete(unsigned* bar, unsigned x, unsigned& nloc, unsigned& nx) {
    const unsigned G = gridDim.x * gridDim.y * gridDim.z;
    unsigned sum, cnt, mine, sp = 0u;
    for (;;) {
        sum = 0u; cnt = 0u; mine = 0u;
#pragma unroll
        for (unsigned j = 0; j < 16; ++j) { const unsigned c = xb_ld(&bar[XB_XCNT(j)]); sum += c; cnt += (c > 0u) ? 1u : 0u; mine = (j == x) ? c : mine; }
        if (sum == G) break;
        __builtin_amdgcn_s_sleep(1);
        if ((++sp & 255u) == 0u) { if (xb_ld(&bar[XB_TMO])) break; if (sp > XB_SPIN_CAP) { atomicAdd(&bar[XB_TMO], 1u); break; } }
    }
    nloc = mine > 0u ? mine : 1u; nx = cnt > 0u ? cnt : 1u;
}

__device__ __forceinline__ void xcd_barrier(const XcdBarrier& b) {
    asm volatile("s_waitcnt vmcnt(0)" ::: "memory");
    __syncthreads();
    if (tidx() == 0) {
        unsigned* bar = b.bar;
        __builtin_amdgcn_s_waitcnt(0);
        unsigned nloc = b.st[0], nx = b.st[1];
        if (nloc == 0u) { xcd_barrier_complete(bar, b.x, nloc, nx); b.st[0] = nloc; b.st[1] = nx; }
        const unsigned old = xb_add(&bar[XB_XSUB(b.x)], 1u);
        const unsigned gen = old / nloc;
        if (old + 1u == (gen + 1u) * nloc) {
            __builtin_amdgcn_fence(__ATOMIC_RELEASE, "agent");
            asm volatile("s_waitcnt vmcnt(0)" ::: "memory");
            const unsigned og = xb_add(&bar[XB_TOP], 1u);
            const unsigned tg = og / nx;
            if (og + 1u == (tg + 1u) * nx) xb_add(&bar[XB_TOPGEN], 1u);
            else XB_SPIN(xb_ld(&bar[XB_TOPGEN]) == tg, bar);
            __builtin_amdgcn_fence(__ATOMIC_ACQUIRE, "agent");
            xb_add(&bar[XB_XGEN(b.x)], 1u);
            asm volatile("s_waitcnt vmcnt(0)" ::: "memory");
        } else {
            XB_SPIN(xb_ld(&bar[XB_XGEN(b.x)]) == gen, bar);
            __builtin_amdgcn_fence(__ATOMIC_ACQUIRE, "agent");
            asm volatile("s_waitcnt vmcnt(0)" ::: "memory");
        }
    }
    __syncthreads();
}


DI P launder(const P& p) {
  P q = p;
#define LND(m) { asm volatile("" : "+s"(q.m)); q.m = (decltype(q.m))(__attribute__((address_space(1))) void*)(void*)q.m; }
  LND(x_prompt) LND(x_sample) LND(c_ckv) LND(c_krope) LND(c_dk) LND(c_dv) LND(st_C) LND(st_n) LND(st_m) LND(c) LND(c_ctx)
  LND(g_norm) LND(W_mod) LND(b_mod) LND(W_in) LND(q_norm) LND(W_uq) LND(kv_norm) LND(W_ukv) LND(dlam) LND(dnorm) LND(mconv)
  LND(mgb) LND(mnorm) LND(W_out) LND(g_final) LND(out) LND(ws)
#undef LND
  return q;
}

template <int KIND>
DI void run_phase(const P& p0, int ph, char* smem) {
  const P& p = p0;
  const int G = gridDim.x, B = blockIdx.x, w = wave_of(tidx());
  if ((KIND < 0 || KIND == 0) && ph == 0) { phase_prepass(p, smem); return; }
  if ((KIND < 0 || KIND == 1) && ph == 1) {
    for (int it = B; it < 256 + 2048; it += G) {
      if (it < 256) {
        int mt = it >> 3, nt = it & 7;
        int l = (mt * 128) >> 10;
        f32x16 acc[2][2];
        gemm_core<false>(p.cckv() + (size_t)mt * 128 * 256, 256, p.WukvTp() + (size_t)l * 1024 * 256 + (size_t)nt * 128 * 256, 256, 256, smem, acc);
        epi_kv(p, mt * 128, nt * 128, acc, nullptr, true);
      } else {
        norm_row(p, 0, (it - 256) * 4 + w, 0);
      }
    }
    return;
  }
  const int l = (ph - 2) / 6, sub = (ph - 2) % 6;
  if ((KIND < 0 || KIND == 2) && sub == 0) {
    const int x = B & 7, j = B >> 3, per = G >> 3;
    const bf16* Ab = p.hbuf();
    const bf16* Wb = p.WinT() + (size_t)l * NPROJ * 1024;
    for (int q = j; q < 3 * 64; q += per) {
      const int r = q >> 6, jj = q & 63;
      const int st = r * 8 + x;
      const int mt = (st / 3) * 8 + (jj >> 3), nt = (st % 3) * 8 + (jj & 7);
      if (nt >= 23) continue;
      f32x16 acc[2][4];
      gemm_core_w(Ab + (size_t)mt * 128 * 1024, 1024, Wb + (size_t)nt * 256 * 1024, 1024, 1024, smem, acc);
      epi_inproj_w(p, l, mt * 128, nt * 256, acc, smem);
    }
  } else if ((KIND < 0 || KIND == 3) && sub == 1) {
    const int N_CH = 1024, N_QA = 64 * 6, N_KV = 64 * 8, N_CF = 1024;
    for (int it = B; it < N_CH + N_QA + N_KV + N_CF; it += G) {
      int u = it;
      __syncthreads();
      if (u < N_CH) { mlstm_local(p, l, u, smem); continue; }
      u -= N_CH;
      if (u < N_QA) {
        int mt = u / 6, nt = u % 6;
        f32x16 acc[2][2];
        gemm_core<true>(p.proj() + (size_t)mt * 128 * NPROJ, NPROJ, p.WuqT() + (size_t)l * 768 * 384 + (size_t)nt * 128 * 384, 384, 384, smem, acc);
        epi_qa(p, mt * 128, nt * 128, acc, (const float*)(smem + 2 * 128 * 72 * 2));
        continue;
      }
      u -= N_QA;
      if (u < N_KV) {
        int mt = u >> 3, nt = u & 7;
        f32x16 acc[2][2];
        gemm_core<true>(p.proj() + (size_t)mt * 128 * NPROJ + 384, NPROJ, p.WukvT() + (size_t)l * 1024 * 256 + (size_t)nt * 128 * 256, 256, 256, smem, acc);
        epi_kv(p, mt * 128, nt * 128, acc, (const float*)(smem + 2 * 128 * 72 * 2), false);
        continue;
      }
      u -= N_KV;
      ckv_fin(p, l, u * 4 + w);
    }
  } else if ((KIND < 0 || KIND == 7) && sub == 2) {
    for (int it = B; it < 640; it += G) mlstm_scan(p, l, it);
  } else if ((KIND < 0 || KIND == 4) && sub == 3) {
    const int x = B & 7;
    int* qctr = p.qc() + ph * 8 + x;
    int* sslot = (int*)(smem + SMEM_BYTES - 16);
    for (;;) {
      __syncthreads();
      if (tidx() == 0) *sslot = atomicAdd(qctr, 1);
      __syncthreads();
      const int q = *sslot;
      if (q >= 192) break;
      __syncthreads();
      if (q < 32) { const int pr = 2 * x + (q >> 4); mla_item(p, l, pr * 16 + (q & 15), smem); }
      else if (q < 64) { const int u = q - 32; const int pr = 2 * x + (u >> 4); diff_item(p, l, pr * 16 + (u & 15), smem); }
      else if (q < 128) mlstm_out(p, l, x * 64 + (q - 64), smem);
      else if (q < 160) { const int u = q - 128; const int pr = 8 * x + (u >> 2); mla_item(p, l, 256 + pr * 4 + (u & 3), smem); }
      else { const int u = q - 160; const int pr = 8 * x + (u >> 2); diff_item(p, l, 256 + pr * 4 + (u & 3), smem); }
    }
  } else if ((KIND < 0 || KIND == 5) && sub == 4) {
    const int x = B & 7, j = B >> 3, per = G >> 3;
    for (int q = j; q < 64; q += per) {
      const int mt = x * 8 + (q >> 3), nt = q & 7;
      f32x16 acc[2][2];
      gemm_core<false>(p.ycat() + (size_t)mt * 128 * 1536, 1536, p.WoutT() + (size_t)l * 1024 * 1536 + (size_t)nt * 128 * 1536, 1536, 1536, smem, acc);
      epi_out(p, l, mt * 128, nt * 128, acc);
    }
  } else if ((KIND < 0 || KIND == 6) && sub == 5) {
    for (int it = B; it < 2048; it += G) {
      if (l < 3) norm_row(p, l + 1, it * 4 + w, 0);
      else norm_row(p, 0, it * 4 + w, 1);
    }
  }
}

#if COOP
__global__ void __launch_bounds__(256, 2) mega(P p, int lo, int hi, int coop) {
  __shared__ __attribute__((aligned(16))) char smem[SMEM_BYTES];
  __shared__ uint4 xb_words;
  if (threadIdx.x == 0) xb_words = make_uint4(0u, 0u, 0u, 0u);
  tidx_init();
  XcdBarrier xb = xcd_barrier_post((unsigned*)p.ctr(), (volatile LAS unsigned*)&xb_words);
  for (int ph = lo; ph < hi; ++ph) {
    run_phase<-1>(p, ph, smem);
    if (PROBE_DUP) {
      const int kind = ph < 2 ? ph : 2 + (ph - 2) % 6;
      if ((PROBE_DUP >> kind) & 1) { xcd_barrier(xb); run_phase<-1>(p, ph, smem); }
    }
    if (ph + 1 < hi) xcd_barrier(xb);
  }
  if (coop == 2) cg::this_grid().sync();
}
#endif
template <int KIND>
__global__ void __launch_bounds__(256) phase_k(P p, int ph) {
  __shared__ __attribute__((aligned(16))) char smem[SMEM_BYTES];
  tidx_init();
  run_phase<KIND>(p, ph, smem);
}

extern "C" void kernel_launch(void* const* d_in, const int* in_sizes, int n_in, void* d_out, int out_size, void* d_ws,
                              size_t ws_size, hipStream_t stream) {
  P p{};
  const float** ins = (const float**)&p;
  for (int i = 0; i < 26; ++i) ins[i] = (const float*)d_in[i];
  p.out = (float*)d_out;
  p.ws = (char*)d_ws;
  if (WS_TOTAL > ws_size) { fprintf(stderr, "workspace too small: need %zu have %zu\n", (size_t)WS_TOTAL, ws_size); return; }

#if COOP
  static int grid_blocks = 0;
  if (!grid_blocks) {
    int dev = 0, cus = 0, per_cu = 0;
    (void)hipGetDevice(&dev);
    (void)hipDeviceGetAttribute(&cus, hipDeviceAttributeMultiprocessorCount, dev);
    (void)hipOccupancyMaxActiveBlocksPerMultiprocessor(&per_cu, mega, 256, 0);
    if (per_cu > 2) per_cu = 2;
    grid_blocks = cus * per_cu;
  }
  (void)hipMemsetAsync(p.ws + OFF_ctr, 0, 16384 + 4096, stream);
  int lo = 0, hi = NPHASE, coop = 1;
  void* args[] = {&p, &lo, &hi, &coop};
  hipError_t e = hipLaunchCooperativeKernel((void*)mega, dim3(grid_blocks), dim3(256), args, 0, stream);
  if (e != hipSuccess) fprintf(stderr, "cooperative launch failed: %s (grid %d)\n", hipGetErrorString(e), grid_blocks);
#else
  for (int ph = 0; ph < NPHASE; ++ph) {
    static const int kmap[6] = {2, 3, 7, 4, 5, 6};
    int kind = ph < 2 ? ph : kmap[(ph - 2) % 6];
    switch (kind) {
      case 0: phase_k<0><<<512, 256, 0, stream>>>(p, ph); break;
      case 1: phase_k<1><<<512, 256, 0, stream>>>(p, ph); break;
      case 2: phase_k<2><<<512, 256, 0, stream>>>(p, ph); break;
      case 3: phase_k<3><<<512, 256, 0, stream>>>(p, ph); break;
      case 4: phase_k<4><<<512, 256, 0, stream>>>(p, ph); break;
      case 5: phase_k<5><<<512, 256, 0, stream>>>(p, ph); break;
      case 7: phase_k<7><<<512, 256, 0, stream>>>(p, ph); break;
      default: phase_k<6><<<512, 256, 0, stream>>>(p, ph); break;
    }
  }
#endif
}
```

```cpp
#include <hip/hip_runtime.h>
#include <hip/hip_cooperative_groups.h>
#include <cstdio>
namespace cg = cooperative_groups;

typedef unsigned short bf16;
typedef __attribute__((ext_vector_type(8))) short bf16x8;
typedef __attribute__((ext_vector_type(4))) short s16x4;
typedef __attribute__((ext_vector_type(16))) float f32x16;
typedef __attribute__((ext_vector_type(4))) float f32x4;
typedef __attribute__((ext_vector_type(4))) unsigned u32x4;
typedef __attribute__((ext_vector_type(2))) unsigned u32x2;

#define DI __device__ __forceinline__
#define MFMA(a, b, c) __builtin_amdgcn_mfma_f32_32x32x16_bf16((a), (b), (c), 0, 0, 0)

#ifndef COOP
#define COOP 1
#endif
#define PROBE_DUP 0

constexpr int NTOK = 8192;
constexpr int NPROJ = 5888;
constexpr int NPHASE = 26;
constexpr float EPS = 1e-6f;
constexpr int SMEM_BYTES = 75 * 1024;

constexpr size_t O_YP = 0, O_YS = 4194304, O_CKV = 8388608, O_KROPE = 12582912, O_DK = 13631488,
                 O_DV = 22020096, O_MC = 30408704, O_MN = 38797312, O_MM = 38862848;

constexpr size_t al256(size_t x) { return (x + 255) & ~(size_t)255; }
constexpr size_t OFF_WinT = 0;
constexpr size_t OFF_WuqT = OFF_WinT + al256((size_t)4 * NPROJ * 1024 * 2);
constexpr size_t OFF_WukvT = OFF_WuqT + al256((size_t)4 * 768 * 384 * 2);
constexpr size_t OFF_WukvTp = OFF_WukvT + al256((size_t)4 * 1024 * 256 * 2);
constexpr size_t OFF_WoutT = OFF_WukvTp + al256((size_t)4 * 1024 * 256 * 2);
constexpr size_t OFF_mod = OFF_WoutT + al256((size_t)4 * 1024 * 1536 * 2);
constexpr size_t OFF_ropec = OFF_mod + al256((size_t)4 * 5 * 3072 * 4);
constexpr size_t OFF_ropes = OFF_ropec + al256((size_t)1024 * 32 * 4);
constexpr size_t OFF_lam = OFF_ropes + al256((size_t)1024 * 32 * 4);
constexpr size_t OFF_hbuf = OFF_lam + al256((size_t)256);
constexpr size_t OFF_xbuf = OFF_hbuf + al256((size_t)NTOK * 1024 * 2);
constexpr size_t OFF_proj = OFF_xbuf + al256((size_t)NTOK * 1024 * 4);
constexpr size_t OFF_Qa = OFF_proj + al256((size_t)NTOK * NPROJ * 2);
constexpr size_t OFF_Ka = OFF_Qa + al256((size_t)NTOK * 768 * 2);
constexpr size_t OFF_VaT = OFF_Ka + al256((size_t)NTOK * 768 * 2);
constexpr size_t OFF_Kb = OFF_VaT + al256((size_t)NTOK * 512 * 2);
constexpr size_t OFF_VbT = OFF_Kb + al256((size_t)NTOK * 512 * 2);
constexpr size_t OFF_VmT = OFF_VbT + al256((size_t)NTOK * 512 * 2);
constexpr size_t OFF_ycat = OFF_VmT + al256((size_t)NTOK * 512 * 2);
constexpr size_t OFF_gates = OFF_ycat + al256((size_t)NTOK * 1536 * 2);
constexpr size_t OFF_Cst = OFF_gates + al256((size_t)NTOK * 16 * 4);
constexpr size_t OFF_nst = OFF_Cst + al256((size_t)1024 * 16384 * 2);
constexpr size_t OFF_mst = OFF_nst + al256((size_t)1024 * 128 * 4);
constexpr size_t OFF_cckv = OFF_mst + al256((size_t)1024 * 4);
constexpr size_t OFF_cKa = OFF_cckv + al256((size_t)4096 * 256 * 2);
constexpr size_t OFF_cVaT = OFF_cKa + al256((size_t)64 * 256 * 192 * 2);
constexpr size_t OFF_cKb = OFF_cVaT + al256((size_t)64 * 128 * 256 * 2);
constexpr size_t OFF_cVbT = OFF_cKb + al256((size_t)64 * 256 * 128 * 2);
constexpr size_t OFF_blA = OFF_cVbT + al256((size_t)64 * 128 * 256 * 2);
constexpr size_t OFF_mlA = OFF_blA + 4096;
constexpr size_t OFF_ctr = OFF_mlA + 4096;
constexpr size_t OFF_qc = OFF_ctr + 16384;
constexpr size_t WS_TOTAL = OFF_qc + 4096;
struct P {
  const float *x_prompt, *x_sample, *c_ckv, *c_krope, *c_dk, *c_dv, *st_C, *st_n, *st_m, *c, *c_ctx, *g_norm, *W_mod,
      *b_mod, *W_in, *q_norm, *W_uq, *kv_norm, *W_ukv, *dlam, *dnorm, *mconv, *mgb, *mnorm, *W_out, *g_final;
  float* out;
  char* ws;
  __device__ __forceinline__ bf16* WinT() const { return (bf16*)(ws + OFF_WinT); }
  __device__ __forceinline__ bf16* WuqT() const { return (bf16*)(ws + OFF_WuqT); }
  __device__ __forceinline__ bf16* WukvT() const { return (bf16*)(ws + OFF_WukvT); }
  __device__ __forceinline__ bf16* WukvTp() const { return (bf16*)(ws + OFF_WukvTp); }
  __device__ __forceinline__ bf16* WoutT() const { return (bf16*)(ws + OFF_WoutT); }
  __device__ __forceinline__ float* mod() const { return (float*)(ws + OFF_mod); }
  __device__ __forceinline__ float* ropec() const { return (float*)(ws + OFF_ropec); }
  __device__ __forceinline__ float* ropes() const { return (float*)(ws + OFF_ropes); }
  __device__ __forceinline__ float* lam() const { return (float*)(ws + OFF_lam); }
  __device__ __forceinline__ bf16* hbuf() const { return (bf16*)(ws + OFF_hbuf); }
  __device__ __forceinline__ float* xbuf() const { return (float*)(ws + OFF_xbuf); }
  __device__ __forceinline__ bf16* proj() const { return (bf16*)(ws + OFF_proj); }
  __device__ __forceinline__ bf16* Qa() const { return (bf16*)(ws + OFF_Qa); }
  __device__ __forceinline__ bf16* Ka() const { return (bf16*)(ws + OFF_Ka); }
  __device__ __forceinline__ bf16* VaT() const { return (bf16*)(ws + OFF_VaT); }
  __device__ __forceinline__ bf16* Kb() const { return (bf16*)(ws + OFF_Kb); }
  __device__ __forceinline__ bf16* VbT() const { return (bf16*)(ws + OFF_VbT); }
  __device__ __forceinline__ bf16* VmT() const { return (bf16*)(ws + OFF_VmT); }
  __device__ __forceinline__ bf16* ycat() const { return (bf16*)(ws + OFF_ycat); }
  __device__ __forceinline__ float* gates() const { return (float*)(ws + OFF_gates); }
  __device__ __forceinline__ bf16* Cst() const { return (bf16*)(ws + OFF_Cst); }
  __device__ __forceinline__ float* nst() const { return (float*)(ws + OFF_nst); }
  __device__ __forceinline__ float* mst() const { return (float*)(ws + OFF_mst); }
  __device__ __forceinline__ bf16* cckv() const { return (bf16*)(ws + OFF_cckv); }
  __device__ __forceinline__ bf16* cKa() const { return (bf16*)(ws + OFF_cKa); }
  __device__ __forceinline__ bf16* cVaT() const { return (bf16*)(ws + OFF_cVaT); }
  __device__ __forceinline__ bf16* cKb() const { return (bf16*)(ws + OFF_cKb); }
  __device__ __forceinline__ bf16* cVbT() const { return (bf16*)(ws + OFF_cVbT); }
  __device__ __forceinline__ int* ctr() const { return (int*)(ws + OFF_ctr); }
  __device__ __forceinline__ int* qc() const { return (int*)(ws + OFF_qc); }
  __device__ __forceinline__ float* blA() const { return (float*)(ws + OFF_blA); }
  __device__ __forceinline__ float* mlA() const { return (float*)(ws + OFF_mlA); }
};

DI int tidx() { int t = threadIdx.x; asm volatile("" : "+v"(t)); return t; }
DI void tidx_init() {}
DI int wave_of(int tid) { return __builtin_amdgcn_readfirstlane(tid >> 6); }
typedef __attribute__((ext_vector_type(2))) __bf16 bf16v2;
typedef __attribute__((ext_vector_type(2))) float f32x2;
DI unsigned pack2(float a, float b) {
  f32x2 v; v[0] = a; v[1] = b;
  return __builtin_bit_cast(unsigned, __builtin_convertvector(v, bf16v2));
}
DI bf16 f2bf(float x) { return (bf16)(pack2(x, 0.f) & 0xffffu); }
DI float bf2f(bf16 b) { return __uint_as_float(((unsigned)b) << 16); }
DI float fexp2(float x) { return __builtin_amdgcn_exp2f(x); }
DI float fexp(float x) { return __builtin_amdgcn_exp2f(x * 1.4426950408889634f); }
DI float bflo(unsigned u) { return __uint_as_float(u << 16); }
DI float bfhi(unsigned u) { return __uint_as_float(u & 0xffff0000u); }
DI float silu_f(float x) { return x * __builtin_amdgcn_rcpf(1.f + fexp(-x)); }
DI float sigmoid_f(float x) { return __builtin_amdgcn_rcpf(1.f + fexp(-x)); }
DI float logsig_f(float x) { return fminf(x, 0.f) - log1pf(fexp(-fabsf(x))); }

struct TokInfo { int lat, b, t, T, tok0, modj; };
DI TokInfo tinfo(int tok) {
  TokInfo r;
  if (tok < 4096) { r.lat = 0; r.b = tok >> 8; r.t = tok & 255; r.T = 256; r.tok0 = tok & ~255; r.modj = 0; }
  else { int u = tok - 4096; r.lat = 1; r.b = u >> 10; r.t = u & 1023; r.T = 1024; r.tok0 = 4096 + (u & ~1023); r.modj = 1 + r.b; }
  return r;
}

struct GR { u32x4 ra0[4], rb0[4], ra1[4], rb1[4]; };
DI void gemm_load2(GR& g, const bf16* __restrict__ A, int lda, const bf16* __restrict__ Bt, int ldb) {
  const int tid = tidx();
  const int lr = tid >> 3, lc = tid & 7;
  const bf16* ap = A + (size_t)lr * lda + lc * 8;
  const bf16* bp = Bt + (size_t)lr * ldb + lc * 8;
  const size_t a32 = (size_t)32 * lda, b32 = (size_t)32 * ldb;
#pragma unroll
  for (int i = 0; i < 4; ++i) { g.ra0[i] = *(const u32x4*)(ap + i * a32); g.rb0[i] = *(const u32x4*)(bp + i * b32); }
#pragma unroll
  for (int i = 0; i < 4; ++i) { g.ra1[i] = *(const u32x4*)(ap + 64 + i * a32); g.rb1[i] = *(const u32x4*)(bp + 64 + i * b32); }
}
template <bool ROWSS>
DI void gemm_core_n(GR& g, const bf16* __restrict__ A, int lda, const bf16* __restrict__ Bt, int ldb,
                    const bf16* __restrict__ An, const bf16* __restrict__ Btn, int K, char* smem, f32x16 (&acc)[2][2]) {
  bf16* sA = (bf16*)smem;
  bf16* sB = sA + 128 * 72;
  float* sRow = (float*)(sB + 128 * 72);
  const int tid = tidx(), lane = tid & 63, w = wave_of(tid);
  const int wm = w >> 1, wn = w & 1, lq = lane & 31, h = lane >> 5;
  const int lr = tid >> 3, lc = tid & 7;
  float ss[4] = {0.f, 0.f, 0.f, 0.f};
#pragma unroll
  for (int i = 0; i < 2; ++i)
#pragma unroll
    for (int j = 0; j < 2; ++j)
#pragma unroll
      for (int r = 0; r < 16; ++r) acc[i][j][r] = 0.f;
  const bf16* ap = A + (size_t)lr * lda + lc * 8;
  const bf16* bp = Bt + (size_t)lr * ldb + lc * 8;
  const bf16* apn = An + (size_t)lr * lda + lc * 8;
  const bf16* bpn = Btn + (size_t)lr * ldb + lc * 8;
  const size_t a32 = (size_t)32 * lda, b32 = (size_t)32 * ldb;
  const int nk = K >> 6;
  auto step = [&](u32x4 (&ra)[4], u32x4 (&rb)[4], int kt) {
    if (kt) __syncthreads();
#pragma unroll
    for (int i = 0; i < 4; ++i) {
      *(u32x4*)(sA + (lr + 32 * i) * 72 + lc * 8) = ra[i];
      *(u32x4*)(sB + (lr + 32 * i) * 72 + lc * 8) = rb[i];
    }
    if (ROWSS) {
#pragma unroll
      for (int i = 0; i < 4; ++i)
#pragma unroll
        for (int e = 0; e < 4; ++e) {
          float a0 = bflo(ra[i][e]), a1 = bfhi(ra[i][e]);
          ss[i] += a0 * a0 + a1 * a1;
        }
    }
    __syncthreads();
    {
      const int kn = kt + 2;
      const bf16* ap2 = (kn < nk) ? ap + (size_t)kn * 64 : apn + (size_t)(kn - nk) * 64;
      const bf16* bp2 = (kn < nk) ? bp + (size_t)kn * 64 : bpn + (size_t)(kn - nk) * 64;
#pragma unroll
      for (int i = 0; i < 4; ++i) { ra[i] = *(const u32x4*)(ap2 + i * a32); rb[i] = *(const u32x4*)(bp2 + i * b32); }
    }
#pragma unroll
    for (int ks = 0; ks < 4; ++ks) {
      bf16x8 af[2], bfr[2];
#pragma unroll
      for (int i = 0; i < 2; ++i) af[i] = *(const bf16x8*)(sA + (wm * 64 + i * 32 + lq) * 72 + ks * 16 + h * 8);
#pragma unroll
      for (int j = 0; j < 2; ++j) bfr[j] = *(const bf16x8*)(sB + (wn * 64 + j * 32 + lq) * 72 + ks * 16 + h * 8);
#pragma unroll
      for (int i = 0; i < 2; ++i)
#pragma unroll
        for (int j = 0; j < 2; ++j) acc[i][j] = MFMA(af[i], bfr[j], acc[i][j]);
    }
  };
  for (int kt = 0; kt < nk; kt += 2) {
    step(g.ra0, g.rb0, kt);
    step(g.ra1, g.rb1, kt + 1);
  }
  if (ROWSS) {
#pragma unroll
    for (int i = 0; i < 4; ++i) {
      float v = ss[i];
      v += __shfl_xor(v, 1); v += __shfl_xor(v, 2); v += __shfl_xor(v, 4);
      if (lc == 0) sRow[lr + 32 * i] = v;
    }
  }
  __syncthreads();
}
template <bool ROWSS>
DI void gemm_core(const bf16* __restrict__ A, int lda, const bf16* __restrict__ Bt, int ldb, int K, char* smem,
                  f32x16 (&acc)[2][2]) {
  GR g;
  gemm_load2(g, A, lda, Bt, ldb);
  gemm_core_n<ROWSS>(g, A, lda, Bt, ldb, A, Bt, K, smem, acc);
}

template <bool ROWSS = false>
DI void gemm_core_w(const bf16* __restrict__ A, int lda, const bf16* __restrict__ Bt, int ldb, int K, char* smem,
                    f32x16 (&acc)[2][4]) {
  bf16* sA = (bf16*)smem;
  bf16* sB = sA + 128 * 72;
  const int tid = tidx(), lane = tid & 63, w = wave_of(tid);
  const int wm = w >> 1, wn = w & 1, lq = lane & 31, h = lane >> 5;
  const int lr = tid >> 3, lc = tid & 7;
  u32x4 ra[4], rb[8];
  float ssw[4] = {0.f, 0.f, 0.f, 0.f};
#pragma unroll
  for (int i = 0; i < 2; ++i)
#pragma unroll
    for (int j = 0; j < 4; ++j)
#pragma unroll
      for (int r = 0; r < 16; ++r) acc[i][j][r] = 0.f;
  const bf16* ap = A + (size_t)lr * lda + lc * 8;
  const bf16* bp = Bt + (size_t)lr * ldb + lc * 8;
  const size_t a32 = (size_t)32 * lda, b32 = (size_t)32 * ldb;
#pragma unroll
  for (int i = 0; i < 4; ++i) ra[i] = *(const u32x4*)(ap + i * a32);
#pragma unroll
  for (int i = 0; i < 8; ++i) rb[i] = *(const u32x4*)(bp + i * b32);
  const int nk = K >> 6;
  for (int kt = 0; kt < nk; ++kt) {
    if (kt) __syncthreads();
#pragma unroll
    for (int i = 0; i < 4; ++i) *(u32x4*)(sA + (lr + 32 * i) * 72 + lc * 8) = ra[i];
#pragma unroll
    for (int i = 0; i < 8; ++i) *(u32x4*)(sB + (lr + 32 * i) * 72 + lc * 8) = rb[i];
    if (ROWSS) {
#pragma unroll
      for (int i = 0; i < 4; ++i)
#pragma unroll
        for (int e = 0; e < 4; ++e) {
          float a0 = bflo(ra[i][e]), a1 = bfhi(ra[i][e]);
          ssw[i] += a0 * a0 + a1 * a1;
        }
    }
    __syncthreads();
    {
      const int kn = (kt + 1 < nk) ? kt + 1 : kt;
      const bf16* ap2 = ap + (size_t)kn * 64;
      const bf16* bp2 = bp + (size_t)kn * 64;
#pragma unroll
      for (int i = 0; i < 4; ++i) ra[i] = *(const u32x4*)(ap2 + i * a32);
#pragma unroll
      for (int i = 0; i < 8; ++i) rb[i] = *(const u32x4*)(bp2 + i * b32);
    }
#pragma unroll
    for (int ks = 0; ks < 4; ++ks) {
      bf16x8 af[2], bfr[4];
#pragma unroll
      for (int i = 0; i < 2; ++i) af[i] = *(const bf16x8*)(sA + (wm * 64 + i * 32 + lq) * 72 + ks * 16 + h * 8);
#pragma unroll
      for (int j = 0; j < 4; ++j) bfr[j] = *(const bf16x8*)(sB + (wn * 128 + j * 32 + lq) * 72 + ks * 16 + h * 8);
#pragma unroll
      for (int i = 0; i < 2; ++i)
#pragma unroll
        for (int j = 0; j < 4; ++j) acc[i][j] = MFMA(af[i], bfr[j], acc[i][j]);
    }
  }
  if (ROWSS) {
    float* sRow = (float*)(smem + (128 + 256) * 72 * 2);
#pragma unroll
    for (int i = 0; i < 4; ++i) {
      float v = ssw[i];
      v += __shfl_xor(v, 1); v += __shfl_xor(v, 2); v += __shfl_xor(v, 4);
      if (lc == 0) sRow[lr + 32 * i] = v;
    }
  }
  __syncthreads();
}

DI void store_vt4(bf16* VT, size_t idx, float a, float b, float c, float d) {
  u32x2 v; v[0] = pack2(a, b); v[1] = pack2(c, d);
  *(u32x2*)(VT + idx) = v;
}

DI void transpose_tile(const float* __restrict__ src, int N, int Nvalid, bf16* __restrict__ dst, int K, int k0, int n0,
                       const float* __restrict__ gk, bf16* __restrict__ dst2, char* smem) {
  float* t = (float*)smem;
  const int tid = tidx();
#pragma unroll
  for (int i = 0; i < 4; ++i) {
    int idx = tid + 256 * i; int r = idx >> 4, c = (idx & 15) * 4;
    int n = n0 + c;
    f32x4 v = {0.f, 0.f, 0.f, 0.f};
    if (n < Nvalid) v = __builtin_nontemporal_load((const f32x4*)(src + (size_t)(k0 + r) * N + n));
    t[r * 65 + c] = v[0]; t[r * 65 + c + 1] = v[1]; t[r * 65 + c + 2] = v[2]; t[r * 65 + c + 3] = v[3];
  }
  __syncthreads();
  const int c2h = (tid & 31) * 2;
  const float gk0 = gk ? gk[k0 + c2h] : 1.f, gk1 = gk ? gk[k0 + c2h + 1] : 1.f;
#pragma unroll
  for (int i = 0; i < 8; ++i) {
    int idx = tid + 256 * i; int r = idx >> 5, c2 = (idx & 31) * 2;
    float v0 = t[c2 * 65 + r], v1 = t[(c2 + 1) * 65 + r];
    if (dst2) *(unsigned*)(dst2 + (size_t)(n0 + r) * K + k0 + c2) = pack2(v0, v1);
    v0 *= gk0; v1 *= gk1;
    *(unsigned*)(dst + (size_t)(n0 + r) * K + k0 + c2) = pack2(v0, v1);
  }
  __syncthreads();
}

DI void mod_item(const P& p, int it, char* smem) {
  float* sl = (float*)smem;
  float* red = sl + 5 * 1024;
  const int tid = tidx(), lane = tid & 63, w = wave_of(tid);
  const int l = it / 48, n0 = (it % 48) * 64;
  for (int idx = tid; idx < 5120; idx += 256) {
    int j = idx >> 10, k = idx & 1023;
    float cv = (j == 0) ? p.c_ctx[k] : p.c[(j - 1) * 1024 + k];
    sl[idx] = silu_f(cv);
  }
  __syncthreads();
  float a[5] = {0.f, 0.f, 0.f, 0.f, 0.f};
  const float* wp = p.W_mod + (size_t)l * 1024 * 3072 + n0 + lane;
  for (int k = w * 256; k < w * 256 + 256; k += 16) {
    float wv[16];
#pragma unroll
    for (int u = 0; u < 16; ++u) wv[u] = __builtin_nontemporal_load(wp + (size_t)(k + u) * 3072);
#pragma unroll
    for (int u = 0; u < 16; ++u)
#pragma unroll
      for (int j = 0; j < 5; ++j) a[j] += sl[j * 1024 + k + u] * wv[u];
  }
#pragma unroll
  for (int j = 0; j < 5; ++j) red[(w * 5 + j) * 64 + lane] = a[j];
  __syncthreads();
  for (int idx = tid; idx < 320; idx += 256) {
    int j = idx >> 6, c = idx & 63;
    float s = red[(0 * 5 + j) * 64 + c] + red[(1 * 5 + j) * 64 + c] + red[(2 * 5 + j) * 64 + c] + red[(3 * 5 + j) * 64 + c];
    p.mod()[(size_t)(l * 5 + j) * 3072 + n0 + c] = s + p.b_mod[l * 3072 + n0 + c];
  }
  __syncthreads();
}

DI void phase_prepass(const P& p, char* smem) {
  const int G = gridDim.x, B = blockIdx.x, tid = tidx();
  const int N_MOD = 192, N_WIN = 4 * 92 * 16, N_WOUT = 4 * 16 * 24, N_WUQ = 4 * 12 * 6, N_WUKV = 4 * 16 * 4;
  const int total = N_MOD + N_WIN + N_WOUT + N_WUQ + N_WUKV;
  for (int it = B; it < total; it += G) {
    int u = it;
    if (u < N_MOD) { mod_item(p, u, smem); continue; }
    u -= N_MOD;
    if (u < N_WIN) {
      int l = u / (92 * 16), r = u % (92 * 16), nt = r / 16, kt = r % 16;
      transpose_tile(p.W_in + (size_t)l * 1024 * 5840, 5840, 5840, p.WinT() + (size_t)l * NPROJ * 1024, 1024, kt * 64, nt * 64, nullptr, nullptr, smem);
      continue;
    }
    u -= N_WIN;
    if (u < N_WOUT) {
      int l = u / (16 * 24), r = u % (16 * 24), nt = r / 24, kt = r % 24;
      transpose_tile(p.W_out + (size_t)l * 1536 * 1024, 1024, 1024, p.WoutT() + (size_t)l * 1024 * 1536, 1536, kt * 64, nt * 64, nullptr, nullptr, smem);
      continue;
    }
    u -= N_WOUT;
    if (u < N_WUQ) {
      int l = u / 72, r = u % 72, nt = r / 6, kt = r % 6;
      transpose_tile(p.W_uq + (size_t)l * 384 * 768, 768, 768, p.WuqT() + (size_t)l * 768 * 384, 384, kt * 64, nt * 64, p.q_norm + l * 384, nullptr, smem);
      continue;
    }
    u -= N_WUQ;
    {
      int l = u / 64, r = u % 64, nt = r / 4, kt = r % 4;
      transpose_tile(p.W_ukv + (size_t)l * 256 * 1024, 1024, 1024, p.WukvT() + (size_t)l * 1024 * 256, 256, kt * 64, nt * 64, p.kv_norm + l * 256, p.WukvTp() + (size_t)l * 1024 * 256, smem);
    }
  }
  const int gtid = B * 256 + tid, gsz = G * 256;
  for (int idx = gtid; idx < 1024 * 32; idx += gsz) {
    int t = idx >> 5, i = idx & 31;
    float pos = (i < 16) ? (float)(t >> 6) : (float)(t & 63);
    float inv = powf(10000.f, -(float)(i & 15) / 16.f);
    float ang = pos * inv;
    p.ropec()[idx] = cosf(ang); p.ropes()[idx] = sinf(ang);
  }
  if (gtid < 4) {
    int l = gtid; const float* lp = p.dlam + l * 256;
    float s1 = 0.f, s2 = 0.f;
    for (int i = 0; i < 64; ++i) { s1 += lp[i] * lp[64 + i]; s2 += lp[128 + i] * lp[192 + i]; }
    float lam_init = 0.8f - 0.6f * expf(-0.3f * (float)l);
    p.lam()[l] = expf(s1) - expf(s2) + lam_init;
  }
  for (int idx = gtid; idx < 4 * 4 * 256 * 256; idx += gsz) {
    int d = idx & 255, t = (idx >> 8) & 255, b = (idx >> 16) & 3, l = idx >> 18;
    p.cckv()[idx] = f2bf(p.c_ckv[(size_t)((b * 4 + l) * 256 + t) * 256 + d]);
  }
  for (int idx = gtid; idx < 4 * 4 * 4 * 256 * 64; idx += gsz) {
    int r = idx & 63, t = (idx >> 6) & 255, hd = (idx >> 14) & 3, b = (idx >> 16) & 3, l = idx >> 18;
    p.cKa()[(size_t)((((l * 4 + b) * 4 + hd) * 256) + t) * 192 + 128 + r] = f2bf(p.c_krope[(size_t)((b * 4 + l) * 256 + t) * 64 + r]);
  }
  for (int idx = gtid; idx < 4 * 4 * 4 * 256 * 128; idx += gsz) {
    int d = idx & 127, t = (idx >> 7) & 255, hd = (idx >> 15) & 3, b = (idx >> 17) & 3, l = idx >> 19;
    p.cKb()[idx] = f2bf(p.c_dk[(size_t)(((b * 4 + l) * 256 + t) * 4 + hd) * 128 + d]);
  }
  for (int idx = gtid; idx < 4 * 4 * 4 * 128 * 256; idx += gsz) {
    int t = idx & 255, d = (idx >> 8) & 127, hd = (idx >> 15) & 3, b = (idx >> 17) & 3, l = idx >> 19;
    p.cVbT()[idx] = f2bf(p.c_dv[(size_t)(((b * 4 + l) * 256 + t) * 4 + hd) * 128 + d]);
  }
}

DI void norm_row(const P& p, int l, int tok, int mode) {
  const int lane = tidx() & 63;
  TokInfo ti = tinfo(tok);
  const float* x;
  if (mode == 0 && l == 0) x = ti.lat ? (p.x_sample + (size_t)(tok - 4096) * 1024) : (p.x_prompt + (size_t)tok * 1024);
  else x = p.xbuf() + (size_t)tok * 1024;
  f32x4 v[4];
  float ss = 0.f;
#pragma unroll
  for (int i = 0; i < 4; ++i) {
    v[i] = *(const f32x4*)(x + i * 256 + lane * 4);
    ss += v[i][0] * v[i][0] + v[i][1] * v[i][1] + v[i][2] * v[i][2] + v[i][3] * v[i][3];
  }
#pragma unroll
  for (int o = 32; o >= 1; o >>= 1) ss += __shfl_xor(ss, o);
  const float rstd = rsqrtf(ss * (1.f / 1024.f) + EPS);
  if (mode == 0) {
    const float* g = p.g_norm + l * 1024;
    const float* md = p.mod() + (size_t)(l * 5 + ti.modj) * 3072;
#pragma unroll
    for (int i = 0; i < 4; ++i) {
      int c = i * 256 + lane * 4;
      f32x4 gv = *(const f32x4*)(g + c), sh = *(const f32x4*)(md + c), sc = *(const f32x4*)(md + 1024 + c);
      float o0 = v[i][0] * rstd * gv[0] * (1.f + sc[0]) + sh[0];
      float o1 = v[i][1] * rstd * gv[1] * (1.f + sc[1]) + sh[1];
      float o2 = v[i][2] * rstd * gv[2] * (1.f + sc[2]) + sh[2];
      float o3 = v[i][3] * rstd * gv[3] * (1.f + sc[3]) + sh[3];
      u32x2 pk; pk[0] = pack2(o0, o1); pk[1] = pack2(o2, o3);
      *(u32x2*)(p.hbuf() + (size_t)tok * 1024 + c) = pk;
    }
  } else {
    float* o = p.out + (ti.lat ? (O_YS + (size_t)(tok - 4096) * 1024) : (O_YP + (size_t)tok * 1024));
#pragma unroll
    for (int i = 0; i < 4; ++i) {
      int c = i * 256 + lane * 4;
      f32x4 gv = *(const f32x4*)(p.g_final + c);
      f32x4 r; r[0] = v[i][0] * rstd * gv[0]; r[1] = v[i][1] * rstd * gv[1]; r[2] = v[i][2] * rstd * gv[2]; r[3] = v[i][3] * rstd * gv[3];
      *(f32x4*)(o + c) = r;
    }
  }
}

DI void img_put(bf16* img, const f32x16 (&acc)[2][2], int wm, int wn, int lq, int h) {
#pragma unroll
  for (int i = 0; i < 2; ++i)
#pragma unroll
    for (int j = 0; j < 2; ++j)
#pragma unroll
      for (int r = 0; r < 16; ++r)
        img[(wm * 64 + i * 32 + 8 * (r >> 2) + 4 * h + (r & 3)) * 136 + wn * 64 + j * 32 + lq] = f2bf(acc[i][j][r]);
}
DI void img_copy(const bf16* img, int half, bf16* dst, size_t stride, int tid) {
  u32x4 v[4];
#pragma unroll
  for (int i = 0; i < 4; ++i) { int idx = tid + 256 * i; int r = idx >> 3, c16 = idx & 7; v[i] = *(const u32x4*)(img + r * 136 + half * 64 + c16 * 8); }
#pragma unroll
  for (int i = 0; i < 4; ++i) { int idx = tid + 256 * i; int r = idx >> 3, c16 = idx & 7; *(u32x4*)(dst + (size_t)r * stride + c16 * 8) = v[i]; }
}
DI bool inproj_rm(int cb) { return !((cb >= 35 && cb <= 42) || (cb >= 67 && cb <= 74) || cb == 91); }

DI void epi_inproj(const P& p, int l, int m0, int n0, f32x16 (&acc)[2][2], char* smem) {
  const int tid_ = tidx(); const int lane = tid_ & 63, w = wave_of(tid_), wm = w >> 1, wn = w & 1, lq = lane & 31, h = lane >> 5;
  const int mb = m0 + wm * 64, nb = n0 + wn * 64;
  const int cb = nb >> 6;
  bf16* img = (bf16*)smem;
  TokInfo tb = tinfo(mb);
  const bool lat = tb.lat;
  if (!lat && (cb == 10 || (cb >= 27 && cb <= 34))) {
    float* ob = (cb == 10) ? p.out + O_KROPE + (size_t)((tb.b * 4 + l) * 256) * 64
                           : p.out + O_DK + (size_t)((tb.b * 4 + l) * 256) * 512 + (cb - 27) * 64;
    const int ostr = (cb == 10) ? 64 : 512;
#pragma unroll
    for (int i = 0; i < 2; ++i)
#pragma unroll
      for (int j = 0; j < 2; ++j)
#pragma unroll
        for (int r = 0; r < 16; ++r) {
          int tl = tb.t + i * 32 + 8 * (r >> 2) + 4 * h + (r & 3);
          ob[(size_t)tl * ostr + j * 32 + lq] = acc[i][j][r];
        }
  }
  const bool ropeT = lat && (cb == 10 || (cb >= 19 && cb <= 34));
  if (ropeT) {
#pragma unroll
    for (int i = 0; i < 2; ++i) {
      float cs[16], sn[16];
#pragma unroll
      for (int r = 0; r < 16; ++r) {
        int t = tb.t + i * 32 + 8 * (r >> 2) + 4 * h + (r & 3);
        cs[r] = p.ropec()[t * 32 + lq]; sn[r] = p.ropes()[t * 32 + lq];
      }
#pragma unroll
      for (int r = 0; r < 16; ++r) {
        float x1 = acc[i][0][r], x2 = acc[i][1][r];
        acc[i][0][r] = x1 * cs[r] - x2 * sn[r];
        acc[i][1][r] = x1 * sn[r] + x2 * cs[r];
      }
    }
  }
  if (inproj_rm(cb)) {
    img_put(img, acc, wm, wn, lq, h);
  } else if (cb == 91) {
    if (lq < 16) {
      float bias = p.mgb[l * 16 + lq];
#pragma unroll
      for (int i = 0; i < 2; ++i)
#pragma unroll
        for (int r = 0; r < 16; ++r) {
          int row = mb + i * 32 + 8 * (r >> 2) + 4 * h + (r & 3);
          p.gates()[row * 16 + lq] = acc[i][0][r] + bias;
        }
    }
  } else {
    const bool isdv = cb <= 42;
    int cc = isdv ? cb - 35 : cb - 67;
    int hd = cc >> 1, sub = cc & 1;
    bf16* VT = isdv ? p.VbT() : p.VmT();
#pragma unroll
    for (int i = 0; i < 2; ++i)
#pragma unroll
      for (int j = 0; j < 2; ++j) {
        int d = sub * 64 + j * 32 + lq;
#pragma unroll
        for (int g = 0; g < 4; ++g) {
          int tl = tb.t + i * 32 + 8 * g + 4 * h;
          store_vt4(VT, (size_t)tb.tok0 * 512 + (size_t)(hd * 128 + d) * tb.T + tl, acc[i][j][4 * g], acc[i][j][4 * g + 1], acc[i][j][4 * g + 2], acc[i][j][4 * g + 3]);
          if (isdv && !lat) {
#pragma unroll
            for (int jj = 0; jj < 4; ++jj)
              p.out[O_DV + (size_t)((tb.b * 4 + l) * 256 + tl + jj) * 512 + cc * 64 + j * 32 + lq] = acc[i][j][4 * g + jj];
          }
        }
      }
  }
  __syncthreads();
#pragma unroll
  for (int half = 0; half < 2; ++half) {
    const int cbh = (n0 >> 6) + half;
    if (!inproj_rm(cbh)) continue;
    if (cbh == 10) {
#pragma unroll
      for (int hd = 0; hd < 4; ++hd) img_copy(img, half, p.Ka() + (size_t)m0 * 768 + hd * 192 + 128, 768, tid_);
    } else if (cbh >= 27 && cbh <= 34) {
      img_copy(img, half, p.Kb() + (size_t)m0 * 512 + (cbh - 27) * 64, 512, tid_);
    } else {
      img_copy(img, half, p.proj() + (size_t)m0 * NPROJ + cbh * 64, NPROJ, tid_);
    }
  }
  __syncthreads();
}

constexpr int IMGW = 264;
DI void img_copy_w(const bf16* img, int half, bf16* dst, size_t stride, int tid) {
  u32x4 v[4];
#pragma unroll
  for (int i = 0; i < 4; ++i) { int idx = tid + 256 * i; int r = idx >> 3, c16 = idx & 7; v[i] = *(const u32x4*)(img + r * IMGW + half * 64 + c16 * 8); }
#pragma unroll
  for (int i = 0; i < 4; ++i) { int idx = tid + 256 * i; int r = idx >> 3, c16 = idx & 7; *(u32x4*)(dst + (size_t)r * stride + c16 * 8) = v[i]; }
}
template <int JP>
DI void epi_inproj_cbw(const P& p, int l, int m0, int cb, int imgcol, f32x16 (&acc)[2][4], bf16* img) {
  const int tid_ = tidx(); const int lane = tid_ & 63, w = wave_of(tid_), wm = w >> 1, lq = lane & 31, h = lane >> 5;
  const int mb = m0 + wm * 64;
  TokInfo tb = tinfo(mb);
  const bool lat = tb.lat;
  if (!lat && (cb == 10 || (cb >= 27 && cb <= 34))) {
    float* ob = (cb == 10) ? p.out + O_KROPE + (size_t)((tb.b * 4 + l) * 256) * 64
                           : p.out + O_DK + (size_t)((tb.b * 4 + l) * 256) * 512 + (cb - 27) * 64;
    const int ostr = (cb == 10) ? 64 : 512;
#pragma unroll
    for (int i = 0; i < 2; ++i)
#pragma unroll
      for (int j = 0; j < 2; ++j)
#pragma unroll
        for (int r = 0; r < 16; ++r) {
          int tl = tb.t + i * 32 + 8 * (r >> 2) + 4 * h + (r & 3);
          ob[(size_t)tl * ostr + j * 32 + lq] = acc[i][2 * JP + j][r];
        }
  }
  if (lat && (cb == 10 || (cb >= 19 && cb <= 34))) {
#pragma unroll
    for (int i = 0; i < 2; ++i) {
      float cs[16], sn[16];
#pragma unroll
      for (int r = 0; r < 16; ++r) {
        int t = tb.t + i * 32 + 8 * (r >> 2) + 4 * h + (r & 3);
        cs[r] = p.ropec()[t * 32 + lq]; sn[r] = p.ropes()[t * 32 + lq];
      }
#pragma unroll
      for (int r = 0; r < 16; ++r) {
        float x1 = acc[i][2 * JP][r], x2 = acc[i][2 * JP + 1][r];
        acc[i][2 * JP][r] = x1 * cs[r] - x2 * sn[r];
        acc[i][2 * JP + 1][r] = x1 * sn[r] + x2 * cs[r];
      }
    }
  }
  if (inproj_rm(cb)) {
#pragma unroll
    for (int i = 0; i < 2; ++i)
#pragma unroll
      for (int j = 0; j < 2; ++j)
#pragma unroll
        for (int r = 0; r < 16; ++r)
          img[(wm * 64 + i * 32 + 8 * (r >> 2) + 4 * h + (r & 3)) * IMGW + imgcol + j * 32 + lq] = f2bf(acc[i][2 * JP + j][r]);
  } else if (cb == 91) {
    if (lq < 16) {
      float bias = p.mgb[l * 16 + lq];
#pragma unroll
      for (int i = 0; i < 2; ++i)
#pragma unroll
        for (int r = 0; r < 16; ++r) {
          int row = mb + i * 32 + 8 * (r >> 2) + 4 * h + (r & 3);
          p.gates()[row * 16 + lq] = acc[i][2 * JP][r] + bias;
        }
    }
  } else {
    const bool isdv = cb <= 42;
    int cc = isdv ? cb - 35 : cb - 67;
    int hd = cc >> 1, sub = cc & 1;
    bf16* VT = isdv ? p.VbT() : p.VmT();
#pragma unroll
    for (int i = 0; i < 2; ++i)
#pragma unroll
      for (int j = 0; j < 2; ++j) {
        int d = sub * 64 + j * 32 + lq;
#pragma unroll
        for (int g = 0; g < 4; ++g) {
          int tl = tb.t + i * 32 + 8 * g + 4 * h;
          store_vt4(VT, (size_t)tb.tok0 * 512 + (size_t)(hd * 128 + d) * tb.T + tl, acc[i][2 * JP + j][4 * g], acc[i][2 * JP + j][4 * g + 1], acc[i][2 * JP + j][4 * g + 2], acc[i][2 * JP + j][4 * g + 3]);
          if (isdv && !lat) {
#pragma unroll
            for (int jj = 0; jj < 4; ++jj)
              p.out[O_DV + (size_t)((tb.b * 4 + l) * 256 + tl + jj) * 512 + cc * 64 + j * 32 + lq] = acc[i][2 * JP + j][4 * g + jj];
          }
        }
      }
  }
}
DI void epi_inproj_w(const P& p, int l, int m0, int n0, f32x16 (&acc)[2][4], char* smem) {
  bf16* img = (bf16*)smem;
  const int tid_ = tidx(); const int wn = wave_of(tid_) & 1;
  const int cb0 = n0 >> 6;
  epi_inproj_cbw<0>(p, l, m0, cb0 + 2 * wn, (2 * wn) * 64, acc, img);
  epi_inproj_cbw<1>(p, l, m0, cb0 + 2 * wn + 1, (2 * wn + 1) * 64, acc, img);
  __syncthreads();
#pragma unroll
  for (int half = 0; half < 4; ++half) {
    const int cbh = cb0 + half;
    if (!inproj_rm(cbh)) continue;
    if (cbh == 10) {
#pragma unroll
      for (int hd = 0; hd < 4; ++hd) img_copy_w(img, half, p.Ka() + (size_t)m0 * 768 + hd * 192 + 128, 768, tid_);
    } else if (cbh >= 27 && cbh <= 34) {
      img_copy_w(img, half, p.Kb() + (size_t)m0 * 512 + (cbh - 27) * 64, 512, tid_);
    } else {
      img_copy_w(img, half, p.proj() + (size_t)m0 * NPROJ + cbh * 64, NPROJ, tid_);
    }
  }
  __syncthreads();
}

DI void epi_qa(const P& p, int m0, int n0, f32x16 (&acc)[2][2], const float* sRow) {
  const int tid_ = tidx(); const int lane = tid_ & 63, w = wave_of(tid_), wm = w >> 1, wn = w & 1, lq = lane & 31, h = lane >> 5;
  const int mb = m0 + wm * 64, nb = n0 + wn * 64;
  const int cb = nb >> 6, hd = cb / 3, part = cb % 3;
  TokInfo tb = tinfo(mb);
  const bool dorope = tb.lat && part == 2;
#pragma unroll
  for (int i = 0; i < 2; ++i) {
    float cs[16], sn[16];
#pragma unroll
    for (int r = 0; r < 16; ++r) { cs[r] = 1.f; sn[r] = 0.f; }
    if (dorope) {
#pragma unroll
      for (int r = 0; r < 16; ++r) {
        int t = tb.t + i * 32 + 8 * (r >> 2) + 4 * h + (r & 3);
        cs[r] = p.ropec()[t * 32 + lq]; sn[r] = p.ropes()[t * 32 + lq];
      }
    }
#pragma unroll
    for (int r = 0; r < 16; ++r) {
      int rl = wm * 64 + i * 32 + 8 * (r >> 2) + 4 * h + (r & 3);
      float rstd = rsqrtf(sRow[rl] * (1.f / 384.f) + EPS);
      float x1 = acc[i][0][r] * rstd, x2 = acc[i][1][r] * rstd;
      {
        float y1 = x1 * cs[r] - x2 * sn[r], y2 = x1 * sn[r] + x2 * cs[r];
        x1 = y1; x2 = y2;
      }
      int row = m0 + rl;
      bf16* q = p.Qa() + (size_t)(row * 4 + hd) * 192 + part * 64;
      q[lq] = f2bf(x1); q[32 + lq] = f2bf(x2);
    }
  }
}

DI void epi_kv(const P& p, int m0, int n0, f32x16 (&acc)[2][2], const float* sRow, bool cache) {
  const int tid_ = tidx(); const int lane = tid_ & 63, w = wave_of(tid_), wm = w >> 1, wn = w & 1, lq = lane & 31, h = lane >> 5;
  const int mb = m0 + wm * 64, nb = n0 + wn * 64;
  const int cb = nb >> 6, hd = cb >> 2, part = cb & 3;
  TokInfo tb = tinfo(mb);
#pragma unroll
  for (int i = 0; i < 2; ++i)
#pragma unroll
    for (int j = 0; j < 2; ++j)
#pragma unroll
      for (int g = 0; g < 4; ++g) {
        float v[4];
#pragma unroll
        for (int jj = 0; jj < 4; ++jj) {
          int rl = wm * 64 + i * 32 + 8 * g + 4 * h + jj;
          float rstd = cache ? 1.f : rsqrtf(sRow[rl] * (1.f / 256.f) + EPS);
          v[jj] = acc[i][j][4 * g + jj] * rstd;
        }
        int c = j * 32 + lq;
        int row0 = mb + i * 32 + 8 * g + 4 * h;
        if (part < 2) {
#pragma unroll
          for (int jj = 0; jj < 4; ++jj) {
            int row = row0 + jj;
            if (cache) {
              int lb = row >> 8, t = row & 255;
              p.cKa()[(size_t)((lb * 4 + hd) * 256 + t) * 192 + part * 64 + c] = f2bf(v[jj]);
            } else {
              p.Ka()[(size_t)(row * 4 + hd) * 192 + part * 64 + c] = f2bf(v[jj]);
            }
          }
        } else {
          int d = (part - 2) * 64 + c;
          if (cache) {
            int lb = row0 >> 8, t = row0 & 255;
            store_vt4(p.cVaT(), (size_t)((lb * 4 + hd) * 128 + d) * 256 + t, v[0], v[1], v[2], v[3]);
          } else {
            int tl = tb.t + i * 32 + 8 * g + 4 * h;
            store_vt4(p.VaT(), (size_t)tb.tok0 * 512 + (size_t)(hd * 128 + d) * tb.T + tl, v[0], v[1], v[2], v[3]);
          }
        }
      }
}

template <int JP>
DI void epi_qa_w(const P& p, int m0, int n0, f32x16 (&acc)[2][4], const float* sRow) {
  const int tid_ = tidx(); const int lane = tid_ & 63, w = wave_of(tid_), wm = w >> 1, wn = w & 1, lq = lane & 31, h = lane >> 5;
  const int mb = m0 + wm * 64;
  const int cb = (n0 >> 6) + 2 * wn + JP, hd = cb / 3, part = cb % 3;
  TokInfo tb = tinfo(mb);
  const bool dorope = tb.lat && part == 2;
#pragma unroll
  for (int i = 0; i < 2; ++i) {
    float cs[16], sn[16];
#pragma unroll
    for (int r = 0; r < 16; ++r) { cs[r] = 1.f; sn[r] = 0.f; }
    if (dorope) {
#pragma unroll
      for (int r = 0; r < 16; ++r) {
        int t = tb.t + i * 32 + 8 * (r >> 2) + 4 * h + (r & 3);
        cs[r] = p.ropec()[t * 32 + lq]; sn[r] = p.ropes()[t * 32 + lq];
      }
    }
#pragma unroll
    for (int r = 0; r < 16; ++r) {
      int rl = wm * 64 + i * 32 + 8 * (r >> 2) + 4 * h + (r & 3);
      float rstd = rsqrtf(sRow[rl] * (1.f / 384.f) + EPS);
      float x1 = acc[i][2 * JP][r] * rstd, x2 = acc[i][2 * JP + 1][r] * rstd;
      float y1 = x1 * cs[r] - x2 * sn[r], y2 = x1 * sn[r] + x2 * cs[r];
      int row = m0 + rl;
      bf16* q = p.Qa() + (size_t)(row * 4 + hd) * 192 + part * 64;
      q[lq] = f2bf(y1); q[32 + lq] = f2bf(y2);
    }
  }
}
template <int JP>
DI void epi_kv_w(const P& p, int m0, int n0, f32x16 (&acc)[2][4], const float* sRow) {
  const int tid_ = tidx(); const int lane = tid_ & 63, w = wave_of(tid_), wm = w >> 1, wn = w & 1, lq = lane & 31, h = lane >> 5;
  const int mb = m0 + wm * 64;
  const int cb = (n0 >> 6) + 2 * wn + JP, hd = cb >> 2, part = cb & 3;
  TokInfo tb = tinfo(mb);
#pragma unroll
  for (int i = 0; i < 2; ++i)
#pragma unroll
    for (int j = 0; j < 2; ++j)
#pragma unroll
      for (int g = 0; g < 4; ++g) {
        float v[4];
#pragma unroll
        for (int jj = 0; jj < 4; ++jj) {
          int rl = wm * 64 + i * 32 + 8 * g + 4 * h + jj;
          float rstd = rsqrtf(sRow[rl] * (1.f / 256.f) + EPS);
          v[jj] = acc[i][2 * JP + j][4 * g + jj] * rstd;
        }
        int c = j * 32 + lq;
        int row0 = mb + i * 32 + 8 * g + 4 * h;
        if (part < 2) {
#pragma unroll
          for (int jj = 0; jj < 4; ++jj) p.Ka()[(size_t)((row0 + jj) * 4 + hd) * 192 + part * 64 + c] = f2bf(v[jj]);
        } else {
          int d = (part - 2) * 64 + c;
          int tl = tb.t + i * 32 + 8 * g + 4 * h;
          store_vt4(p.VaT(), (size_t)tb.tok0 * 512 + (size_t)(hd * 128 + d) * tb.T + tl, v[0], v[1], v[2], v[3]);
        }
      }
}

DI void epi_out(const P& p, int l, int m0, int n0, f32x16 (&acc)[2][2]) {
  const int tid_ = tidx(); const int lane = tid_ & 63, w = wave_of(tid_), wm = w >> 1, wn = w & 1, lq = lane & 31, h = lane >> 5;
  const int mb = m0 + wm * 64, nb = n0 + wn * 64;
  TokInfo tb = tinfo(mb);
  const float* gate = p.mod() + (size_t)(l * 5 + tb.modj) * 3072 + 2048;
  const float* xsrc = (l == 0) ? (tb.lat ? p.x_sample - (size_t)4096 * 1024 : p.x_prompt) : (const float*)p.xbuf();
#pragma unroll
  for (int i = 0; i < 2; ++i)
#pragma unroll
    for (int j = 0; j < 2; ++j) {
      int col = nb + j * 32 + lq;
      float gv = gate[col];
      float xo[16];
#pragma unroll
      for (int r = 0; r < 16; ++r) {
        int row = mb + i * 32 + 8 * (r >> 2) + 4 * h + (r & 3);
        xo[r] = xsrc[(size_t)row * 1024 + col];
      }
#pragma unroll
      for (int r = 0; r < 16; ++r) {
        int row = mb + i * 32 + 8 * (r >> 2) + 4 * h + (r & 3);
        p.xbuf()[(size_t)row * 1024 + col] = xo[r] + gv * acc[i][j][r];
      }
    }
}

template <int KW, int DQ, int KSPLIT>
DI void attn_pass(const bf16* __restrict__ qptr, int koff, int kh, const bf16* __restrict__ Kmain, int ldk, int Tmain,
                  const bf16* __restrict__ Kc, int ldkc, int Tc, const bf16* __restrict__ VTmain,
                  const bf16* __restrict__ VTc, float c, char* smem, f32x16 (&o)[4], float& lsum, float& m_out) {
  constexpr int KS = KW + 8;
  constexpr int NKB = 2 / KSPLIT;
  bf16* sK = (bf16*)smem;
  bf16* sV = sK + 64 * KS;
  const int tid = tidx(), lane = tid & 63, lq = lane & 31, h = lane >> 5;
  bf16x8 qf[DQ / 16];
#pragma unroll
  for (int ks = 0; ks < DQ / 16; ++ks) qf[ks] = *(const bf16x8*)(qptr + ks * 16 + h * 8);
#pragma unroll
  for (int db = 0; db < 4; ++db)
#pragma unroll
    for (int r = 0; r < 16; ++r) o[db][r] = 0.f;
  lsum = 0.f;
  float m_run = -INFINITY;
  const int nt = (Tmain + Tc) >> 6;
  constexpr int CH = KW / 8, NKL = 64 * CH / 256;
  u32x4 kr[NKL], vr[4];
  auto issue = [&](int kt) {
    const bf16* ksrc; int ld; const bf16* vsrc; int ldv;
    if (kt * 64 < Tmain) { ksrc = Kmain + (size_t)(kt * 64) * ldk; ld = ldk; vsrc = VTmain + kt * 64; ldv = Tmain; }
    else { ksrc = Kc + (size_t)(kt * 64 - Tmain) * ldkc; ld = ldkc; vsrc = VTc + (kt * 64 - Tmain); ldv = Tc; }
#pragma unroll
    for (int i = 0; i < NKL; ++i) {
      int idx = tid + 256 * i; int r = idx / CH, cc = idx % CH;
      kr[i] = *(const u32x4*)(ksrc + (size_t)r * ld + cc * 8);
    }
    if (KSPLIT == 1) {
#pragma unroll
      for (int i = 0; i < 4; ++i) {
        int idx = tid + 256 * i; int r = idx >> 3, cc = idx & 7;
        vr[i] = *(const u32x4*)(vsrc + (size_t)r * ldv + cc * 8);
      }
    }
  };
  issue(0);
  for (int kt = 0; kt < nt; ++kt) {
    __syncthreads();
#pragma unroll
    for (int i = 0; i < NKL; ++i) {
      int idx = tid + 256 * i; int r = idx / CH, cc = idx % CH;
      *(u32x4*)(sK + r * KS + cc * 8) = kr[i];
    }
    if (KSPLIT != 1) {
      const bf16* vsrc; int ldv;
      if (kt * 64 < Tmain) { vsrc = VTmain + kt * 64; ldv = Tmain; } else { vsrc = VTc + (kt * 64 - Tmain); ldv = Tc; }
#pragma unroll
      for (int i = 0; i < 4; ++i) {
        int idx = tid + 256 * i; int r = idx >> 3, cc = idx & 7;
        vr[i] = *(const u32x4*)(vsrc + (size_t)r * ldv + cc * 8);
      }
    }
#pragma unroll
    for (int i = 0; i < 4; ++i) {
      int idx = tid + 256 * i; int r = idx >> 3, cc = idx & 7;
      *(u32x4*)(sV + r * 72 + cc * 8) = vr[i];
    }
    __syncthreads();
    issue((kt + 1 < nt) ? kt + 1 : kt);
    f32x16 s[NKB];
#pragma unroll
    for (int kbi = 0; kbi < NKB; ++kbi)
#pragma unroll
      for (int r = 0; r < 16; ++r) s[kbi][r] = 0.f;
#pragma unroll
    for (int ks = 0; ks < DQ / 16; ++ks)
#pragma unroll
      for (int kbi = 0; kbi < NKB; ++kbi) {
        const int kb = (KSPLIT == 2) ? kh : kbi;
        bf16x8 a = *(const bf16x8*)(sK + (kb * 32 + lq) * KS + koff + ks * 16 + h * 8);
        s[kbi] = MFMA(a, qf[ks], s[kbi]);
      }
    float mx = -INFINITY;
#pragma unroll
    for (int kbi = 0; kbi < NKB; ++kbi)
#pragma unroll
      for (int r = 0; r < 16; ++r) mx = fmaxf(mx, s[kbi][r]);
    mx = fmaxf(mx, __shfl_xor(mx, 32));
    const float m_new = fmaxf(m_run, mx);
    const float alpha = fexp2((m_run - m_new) * c);
    m_run = m_new;
    lsum *= alpha;
#pragma unroll
    for (int db = 0; db < 4; ++db)
#pragma unroll
      for (int r = 0; r < 16; ++r) o[db][r] *= alpha;
    const float mc = m_new * c;
#pragma unroll
    for (int kbi = 0; kbi < NKB; ++kbi)
#pragma unroll
      for (int r = 0; r < 16; ++r) { float pv = fexp2(s[kbi][r] * c - mc); s[kbi][r] = pv; lsum += pv; }
#pragma unroll
    for (int kbi = 0; kbi < NKB; ++kbi) {
      const int kb = (KSPLIT == 2) ? kh : kbi;
#pragma unroll
      for (int s2 = 0; s2 < 2; ++s2) {
        u32x4 pk;
#pragma unroll
        for (int e = 0; e < 4; ++e) pk[e] = pack2(s[kbi][8 * s2 + 2 * e], s[kbi][8 * s2 + 2 * e + 1]);
        bf16x8 pb = __builtin_bit_cast(bf16x8, pk);
#pragma unroll
        for (int db = 0; db < 4; ++db) {
          const bf16* vp = sV + (db * 32 + lq) * 72 + kb * 32 + s2 * 16 + 4 * h;
          u32x2 lo = *(const u32x2*)vp, hi = *(const u32x2*)(vp + 8);
          u32x4 av; av[0] = lo[0]; av[1] = lo[1]; av[2] = hi[0]; av[3] = hi[1];
          o[db] = MFMA(__builtin_bit_cast(bf16x8, av), pb, o[db]);
        }
      }
    }
  }
  lsum += __shfl_xor(lsum, 32);
  m_out = m_run;
}

DI void mla_item(const P& p, int l, int it, char* smem) {
  const int tid = tidx(), lane = tid & 63, w = wave_of(tid), lq = lane & 31, h = lane >> 5;
  int lat, b, hd, qb;
  if (it < 256) { lat = 1; b = it >> 6; hd = (it >> 4) & 3; qb = it & 15; }
  else { int u = it - 256; lat = 0; b = u >> 4; hd = (u >> 2) & 3; qb = u & 3; }
  const int T = lat ? 1024 : 256, tok0 = lat ? 4096 + b * 1024 : b * 256;
  const int qsub = w & 1, kh = w >> 1;
  const int tok = tok0 + qb * 64 + qsub * 32 + lq;
  f32x16 o[4]; float lsum, mrun;
  const float c = 0.07216878364870322f * 1.4426950408889634f;
  attn_pass<192, 192, 2>(p.Qa() + (size_t)(tok * 4 + hd) * 192, 0, kh, p.Ka() + (size_t)(tok0 * 4 + hd) * 192, 768, T,
                 p.cKa() + (size_t)((l * 4 + b) * 4 + hd) * 256 * 192, 192, lat ? 256 : 0,
                 p.VaT() + (size_t)tok0 * 512 + (size_t)hd * 128 * T, p.cVaT() + (size_t)((l * 4 + b) * 4 + hd) * 128 * 256, c, smem, o, lsum, mrun);
  float* ex = (float*)smem;
  float* exm = ex + 2 * 128 * 32;
  float* exl = exm + 64;
  __syncthreads();
  if (kh == 1) {
#pragma unroll
    for (int db = 0; db < 4; ++db)
#pragma unroll
      for (int r = 0; r < 16; ++r) {
        int dv = db * 32 + 8 * (r >> 2) + 4 * h + (r & 3);
        ex[(qsub * 128 + dv) * 32 + lq] = o[db][r];
      }
    if (h == 0) { exm[qsub * 32 + lq] = mrun; exl[qsub * 32 + lq] = lsum; }
  }
  __syncthreads();
  if (kh == 0) {
    const float m1 = exm[qsub * 32 + lq], l1 = exl[qsub * 32 + lq];
    const float mm = fmaxf(mrun, m1);
    const float f0 = fexp2((mrun - mm) * c), f1 = fexp2((m1 - mm) * c);
    const float inv = 1.f / (lsum * f0 + l1 * f1);
    const float g0 = f0 * inv, g1 = f1 * inv;
    u32x2 zz[4][4];
#pragma unroll
    for (int db = 0; db < 4; ++db)
#pragma unroll
      for (int g = 0; g < 4; ++g) zz[db][g] = *(const u32x2*)(p.proj() + (size_t)tok * NPROJ + 704 + hd * 128 + db * 32 + 8 * g + 4 * h);
#pragma unroll
    for (int db = 0; db < 4; ++db)
#pragma unroll
      for (int g = 0; g < 4; ++g) {
        int dv = db * 32 + 8 * g + 4 * h;
        float ov4[4];
#pragma unroll
        for (int jj = 0; jj < 4; ++jj) ov4[jj] = o[db][4 * g + jj] * g0 + ex[(qsub * 128 + dv + jj) * 32 + lq] * g1;
        u32x2 z = zz[db][g];
        float z0 = bflo(z[0]), z1 = bfhi(z[0]), z2 = bflo(z[1]), z3 = bfhi(z[1]);
        u32x2 ov;
        ov[0] = pack2(ov4[0] * silu_f(z0), ov4[1] * silu_f(z1));
        ov[1] = pack2(ov4[2] * silu_f(z2), ov4[3] * silu_f(z3));
        *(u32x2*)(p.ycat() + (size_t)tok * 1536 + hd * 128 + dv) = ov;
      }
  }
}

DI void diff_item(const P& p, int l, int it, char* smem) {
  const int tid = tidx(), lane = tid & 63, w = wave_of(tid), lq = lane & 31, h = lane >> 5;
  int lat, b, hd, qb;
  if (it < 256) { lat = 1; b = it >> 6; hd = (it >> 4) & 3; qb = it & 15; }
  else { int u = it - 256; lat = 0; b = u >> 4; hd = (u >> 2) & 3; qb = u & 3; }
  const int T = lat ? 1024 : 256, tok0 = lat ? 4096 + b * 1024 : b * 256;
  const int map = w >> 1, qsub = w & 1;
  const int tok = tok0 + qb * 64 + qsub * 32 + lq;
  const float c = 0.125f * 1.4426950408889634f;
  const bf16* vt = p.VbT() + (size_t)tok0 * 512 + (size_t)hd * 128 * T;
  const bf16* vtc = p.cVbT() + (size_t)((l * 4 + b) * 4 + hd) * 128 * 256;
  const bf16* kc = p.cKb() + (size_t)((l * 4 + b) * 4 + hd) * 256 * 128;
  f32x16 o[4]; float ls, mdummy;
  attn_pass<128, 64, 1>(p.proj() + (size_t)tok * NPROJ + 1216 + hd * 128 + map * 64, map * 64, 0, p.Kb() + (size_t)(tok0 * 4 + hd) * 128, 512, T, kc, 128,
                     lat ? 256 : 0, vt, vtc, c, smem, o, ls, mdummy);
  float* ex = (float*)smem;
  __syncthreads();
  if (map == 1) {
    const float sc2 = p.lam()[l] / ls;
#pragma unroll
    for (int db = 0; db < 4; ++db)
#pragma unroll
      for (int r = 0; r < 16; ++r) {
        int dv = db * 32 + 8 * (r >> 2) + 4 * h + (r & 3);
        ex[(qsub * 128 + dv) * 32 + lq] = o[db][r] * sc2;
      }
  }
  __syncthreads();
  if (map == 0) {
    const float i1 = 1.f / ls;
    float ss = 0.f;
#pragma unroll
    for (int db = 0; db < 4; ++db)
#pragma unroll
      for (int r = 0; r < 16; ++r) {
        int dv = db * 32 + 8 * (r >> 2) + 4 * h + (r & 3);
        float v = o[db][r] * i1 - ex[(qsub * 128 + dv) * 32 + lq];
        o[db][r] = v; ss += v * v;
      }
    ss += __shfl_xor(ss, 32);
    const float lam_init = 0.8f - 0.6f * fexp(-0.3f * (float)l);
    const float sc = rsqrtf(ss * (1.f / 128.f) + EPS) * (1.f - lam_init);
#pragma unroll
    for (int db = 0; db < 4; ++db) {
      u32x2 zz[4]; f32x4 gg[4];
#pragma unroll
      for (int g = 0; g < 4; ++g) {
        int dv = db * 32 + 8 * g + 4 * h;
        zz[g] = *(const u32x2*)(p.proj() + (size_t)tok * NPROJ + 2752 + hd * 128 + dv);
        gg[g] = *(const f32x4*)(p.dnorm + l * 128 + dv);
      }
#pragma unroll
      for (int g = 0; g < 4; ++g) {
        int dv = db * 32 + 8 * g + 4 * h;
        u32x2 z = zz[g];
        f32x4 gn = gg[g];
        float z0 = bflo(z[0]), z1 = bfhi(z[0]), z2 = bflo(z[1]), z3 = bfhi(z[1]);
        u32x2 ov;
        ov[0] = pack2(o[db][4 * g] * sc * gn[0] * silu_f(z0), o[db][4 * g + 1] * sc * gn[1] * silu_f(z1));
        ov[1] = pack2(o[db][4 * g + 2] * sc * gn[2] * silu_f(z2), o[db][4 * g + 3] * sc * gn[3] * silu_f(z3));
        *(u32x2*)(p.ycat() + (size_t)tok * 1536 + 512 + hd * 128 + dv) = ov;
      }
    }
  }
}

DI void conv8(const P& p, int l, int tok, int t, int T, int col, int wcol, float (&o)[8]) {
  const bf16* base = p.proj() + (size_t)tok * NPROJ + col;
  u32x4 cur = *(const u32x4*)base;
  u32x4 prv = {0u, 0u, 0u, 0u}, nxt = {0u, 0u, 0u, 0u};
  if (t > 0) prv = *(const u32x4*)(base - NPROJ);
  if (t < T - 1) nxt = *(const u32x4*)(base + NPROJ);
  const float* w0 = p.mconv + (size_t)l * 3 * 1024 + wcol;
  f32x4 wa0 = *(const f32x4*)w0, wa1 = *(const f32x4*)(w0 + 4);
  f32x4 wb0 = *(const f32x4*)(w0 + 1024), wb1 = *(const f32x4*)(w0 + 1028);
  f32x4 wc0 = *(const f32x4*)(w0 + 2048), wc1 = *(const f32x4*)(w0 + 2052);
#pragma unroll
  for (int e = 0; e < 4; ++e) {
    float wA0 = e < 2 ? wa0[2 * e] : wa1[2 * e - 4], wA1 = e < 2 ? wa0[2 * e + 1] : wa1[2 * e - 3];
    float wB0 = e < 2 ? wb0[2 * e] : wb1[2 * e - 4], wB1 = e < 2 ? wb0[2 * e + 1] : wb1[2 * e - 3];
    float wC0 = e < 2 ? wc0[2 * e] : wc1[2 * e - 4], wC1 = e < 2 ? wc0[2 * e + 1] : wc1[2 * e - 3];
    float v0 = wA0 * bflo(prv[e]) + wB0 * bflo(cur[e]) + wC0 * bflo(nxt[e]);
    float v1 = wA1 * bfhi(prv[e]) + wB1 * bfhi(cur[e]) + wC1 * bfhi(nxt[e]);
    o[2 * e] = silu_f(v0); o[2 * e + 1] = silu_f(v1);
  }
}

DI float wave_incl_scan_add(float v, int lane) {
#pragma unroll
  for (int o = 1; o < 64; o <<= 1) { float t = __shfl_up(v, o); if (lane >= o) v += t; }
  return v;
}
DI float wave_incl_scan_max(float v, int lane) {
#pragma unroll
  for (int o = 1; o < 64; o <<= 1) { float t = __shfl_up(v, o); if (lane >= o) v = fmaxf(v, t); }
  return v;
}

DI void mlstm_local(const P& p, int l, int slot, char* smem) {
  bf16* vT = (bf16*)smem;
  bf16* kT = vT + 128 * 72;
  float* wbuf = (float*)(kT + 128 * 72);
  const int tid = tidx(), lane = tid & 63, w = wave_of(tid), lq = lane & 31, h = lane >> 5;
  const int cp = slot >> 3, hd = (slot >> 1) & 3, dir = slot & 1;
  const int ctok = cp * 64;
  TokInfo ti = tinfo(ctok);
  const int T = ti.T;
  if (w == 0) {
    const int s = dir ? 63 - lane : lane;
    const int tk = ctok + s;
    const float ig = p.gates()[tk * 16 + dir * 8 + hd];
    const float lf = logsig_f(p.gates()[tk * 16 + dir * 8 + 4 + hd]);
    const float bc = wave_incl_scan_add(lf, lane);
    const float b_last = __shfl(bc, 63);
    const float val = b_last - bc + ig;
    float mx = val;
#pragma unroll
    for (int o = 32; o >= 1; o >>= 1) mx = fmaxf(mx, __shfl_xor(mx, o));
    wbuf[s] = fexp(val - mx);
    if (lane == 0) { p.blA()[slot] = b_last; p.mlA()[slot] = mx; }
  }
  __syncthreads();
  {
    const int s = tid >> 2, chb = (tid & 3) * 32;
    const float ws = wbuf[s];
#pragma unroll 1
    for (int q = 0; q < 4; ++q) {
      float kv[8];
      const int ch = chb + q * 8;
      conv8(p, l, ctok + s, ti.t + s, T, 3776 + hd * 128 + ch, 512 + hd * 128 + ch, kv);
#pragma unroll
      for (int e = 0; e < 8; ++e) kT[(ch + e) * 72 + s] = f2bf(kv[e] * ws);
    }
    const bf16* vsrc = p.VmT() + (size_t)ti.tok0 * 512 + (size_t)hd * 128 * T + ti.t;
#pragma unroll
    for (int i = 0; i < 4; ++i) {
      int idx = tid + 256 * i; int r = idx >> 3, cc = idx & 7;
      *(u32x4*)(vT + r * 72 + cc * 8) = *(const u32x4*)(vsrc + (size_t)r * T + cc * 8);
    }
  }
  __syncthreads();
  f32x16 acc[4];
#pragma unroll
  for (int cb = 0; cb < 4; ++cb)
#pragma unroll
    for (int r = 0; r < 16; ++r) acc[cb][r] = 0.f;
#pragma unroll
  for (int ks = 0; ks < 4; ++ks) {
    bf16x8 a = *(const bf16x8*)(vT + (32 * w + lq) * 72 + ks * 16 + 8 * h);
#pragma unroll
    for (int cb = 0; cb < 4; ++cb) {
      bf16x8 bb = *(const bf16x8*)(kT + (32 * cb + lq) * 72 + ks * 16 + 8 * h);
      acc[cb] = MFMA(a, bb, acc[cb]);
    }
  }
  bf16* cs = p.Cst() + (size_t)slot * 16384;
#pragma unroll
  for (int cb = 0; cb < 4; ++cb)
#pragma unroll
    for (int r = 0; r < 16; ++r) {
      int dvv = 32 * w + 8 * (r >> 2) + 4 * h + (r & 3);
      cs[dvv * 128 + 32 * cb + lq] = f2bf(acc[cb][r]);
    }
  if (tid < 128) {
    float sum = 0.f;
#pragma unroll
    for (int q = 0; q < 8; ++q) {
      u32x4 v = *(const u32x4*)(kT + tid * 72 + q * 8);
#pragma unroll
      for (int e = 0; e < 4; ++e) sum += bflo(v[e]) + bfhi(v[e]);
    }
    p.nst()[slot * 128 + tid] = sum;
  }
}

DI void mlstm_scan(const P& p, int l, int it) {
  const int tid = tidx();
  const int ch = it >> 2, qt = it & 3;
  int lat, b, hd, dir;
  if (ch < 32) { lat = 1; b = ch >> 3; hd = (ch >> 1) & 3; dir = ch & 1; }
  else { int u = ch - 32; lat = 0; b = u >> 3; hd = (u >> 1) & 3; dir = u & 1; }
  const int T = lat ? 1024 : 256, tok0 = lat ? 4096 + b * 1024 : b * 256, nc = T >> 6;
  const int dv0 = 32 * qt + 4 * (tid >> 5), dk0 = 4 * (tid & 31);
  float C[4][4];
  float n_val = 0.f, m_prev = 0.f;
  const bool do_n = (qt == 0) && (tid < 128);
  const size_t sidx = (size_t)((b * 4 + l) * 2 + dir) * 4 + hd;
  if (lat) {
    const float* C0 = p.st_C + sidx * 16384;
#pragma unroll
    for (int j = 0; j < 4; ++j) {
      f32x4 v = *(const f32x4*)(C0 + (size_t)(dk0 + j) * 128 + dv0);
      C[0][j] = v[0]; C[1][j] = v[1]; C[2][j] = v[2]; C[3][j] = v[3];
    }
    if (do_n) n_val = p.st_n[sidx * 128 + tid];
    m_prev = p.st_m[sidx];
  } else {
#pragma unroll
    for (int i = 0; i < 4; ++i)
#pragma unroll
      for (int j = 0; j < 4; ++j) C[i][j] = 0.f;
  }
  u32x2 dnx[4]; float blx, mlx, dnnx = 0.f;
  {
    const int c = dir ? nc - 1 : 0;
    const int slot = ((((tok0 >> 6) + c) * 4 + hd) * 2) + dir;
    const bf16* cs = p.Cst() + (size_t)slot * 16384 + dv0 * 128 + dk0;
#pragma unroll
    for (int i = 0; i < 4; ++i) dnx[i] = *(const u32x2*)(cs + i * 128);
    blx = p.blA()[slot]; mlx = p.mlA()[slot];
    if (do_n) dnnx = p.nst()[slot * 128 + tid];
  }
  for (int ci = 0; ci < nc; ++ci) {
    const int c = dir ? nc - 1 - ci : ci;
    const int slot = ((((tok0 >> 6) + c) * 4 + hd) * 2) + dir;
    bf16* cs = p.Cst() + (size_t)slot * 16384 + dv0 * 128 + dk0;
    u32x2 d[4];
#pragma unroll
    for (int i = 0; i < 4; ++i) d[i] = dnx[i];
    const float bl = blx, ml = mlx;
    const float dn = dnnx;
    {
      const int cn = (ci + 1 < nc) ? (dir ? nc - 2 - ci : ci + 1) : c;
      const int sn = ((((tok0 >> 6) + cn) * 4 + hd) * 2) + dir;
      const bf16* csn = p.Cst() + (size_t)sn * 16384 + dv0 * 128 + dk0;
#pragma unroll
      for (int i = 0; i < 4; ++i) dnx[i] = *(const u32x2*)(csn + i * 128);
      blx = p.blA()[sn]; mlx = p.mlA()[sn];
      if (do_n) dnnx = p.nst()[sn * 128 + tid];
    }
#pragma unroll
    for (int i = 0; i < 4; ++i) {
      u32x2 o; o[0] = pack2(C[i][0], C[i][1]); o[1] = pack2(C[i][2], C[i][3]);
      *(u32x2*)(cs + i * 128) = o;
    }
    if (do_n) p.nst()[slot * 128 + tid] = n_val;
    if (qt == 0 && tid == 0) p.mst()[slot] = m_prev;
    const float m_new = fmaxf(bl + m_prev, ml);
    const float a = fexp(bl + m_prev - m_new), bs = fexp(ml - m_new);
#pragma unroll
    for (int i = 0; i < 4; ++i) {
      C[i][0] = a * C[i][0] + bs * bflo(d[i][0]); C[i][1] = a * C[i][1] + bs * bfhi(d[i][0]);
      C[i][2] = a * C[i][2] + bs * bflo(d[i][1]); C[i][3] = a * C[i][3] + bs * bfhi(d[i][1]);
    }
    n_val = a * n_val + bs * dn;
    m_prev = m_new;
  }
  if (!lat) {
    float* Co = p.out + O_MC + sidx * 16384;
#pragma unroll
    for (int j = 0; j < 4; ++j) {
      f32x4 v; v[0] = C[0][j]; v[1] = C[1][j]; v[2] = C[2][j]; v[3] = C[3][j];
      *(f32x4*)(Co + (size_t)(dk0 + j) * 128 + dv0) = v;
    }
    if (do_n) p.out[O_MN + sidx * 128 + tid] = n_val;
    if (qt == 0 && tid == 0) p.out[O_MM + sidx] = m_prev;
  }
}

DI void mlstm_out(const P& p, int l, int it, char* smem) {
  bf16* sq = (bf16*)smem;
  bf16* sk = sq + 64 * 136;
  bf16* vT = sk + 64 * 136;
  float* bcA2 = (float*)(vT + 128 * 72);
  float* uA2 = bcA2 + 128, *mtA2 = uA2 + 128, *nA2 = mtA2 + 128  , *ssb = nA2 + 256  ;
  const int tid = tidx(), lane = tid & 63, w = wave_of(tid), lq = lane & 31, h = lane >> 5;
  const int cp = it >> 2, hd = it & 3;
  const int ctok = cp * 64;
  TokInfo ti = tinfo(ctok);
  const int T = ti.T;
  const float m_prev0 = p.mst()[(cp * 4 + hd) * 2], m_prev1 = p.mst()[(cp * 4 + hd) * 2 + 1];
  if (w < 2) {
    const int dir = w;
    const float m_prev = dir ? m_prev1 : m_prev0;
    const int s = dir ? 63 - lane : lane;
    const int tk = ctok + s;
    const float ig = p.gates()[tk * 16 + dir * 8 + hd];
    const float lf = logsig_f(p.gates()[tk * 16 + dir * 8 + 4 + hd]);
    const float bc = wave_incl_scan_add(lf, lane);
    const float u = ig - bc;
    const float pm = wave_incl_scan_max(u, lane);
    bcA2[dir * 64 + s] = bc; uA2[dir * 64 + s] = u; mtA2[dir * 64 + s] = bc + fmaxf(m_prev, pm);
  } else {
    const int dir = w - 2;
    const int slot = (cp * 4 + hd) * 2 + dir;
    nA2[dir * 128 + lane] = p.nst()[slot * 128 + lane];
    nA2[dir * 128 + 64 + lane] = p.nst()[slot * 128 + 64 + lane];
  }
  {
    const int s = tid >> 2, chb = (tid & 3) * 32;
#pragma unroll 2
    for (int q = 0; q < 4; ++q) {
      const int ch = chb + q * 8;
      float v[8];
      conv8(p, l, ctok + s, ti.t + s, T, 3264 + hd * 128 + ch, hd * 128 + ch, v);
      u32x4 pk;
#pragma unroll
      for (int e = 0; e < 4; ++e) pk[e] = pack2(v[2 * e] * 0.08838834764831845f, v[2 * e + 1] * 0.08838834764831845f);
      *(u32x4*)(sq + s * 136 + ch) = pk;
      conv8(p, l, ctok + s, ti.t + s, T, 3776 + hd * 128 + ch, 512 + hd * 128 + ch, v);
#pragma unroll
      for (int e = 0; e < 4; ++e) pk[e] = pack2(v[2 * e], v[2 * e + 1]);
      *(u32x4*)(sk + s * 136 + ch) = pk;
    }
    const bf16* vsrc = p.VmT() + (size_t)ti.tok0 * 512 + (size_t)hd * 128 * T + ti.t;
#pragma unroll
    for (int i = 0; i < 4; ++i) {
      int idx = tid + 256 * i; int r = idx >> 3, cc = idx & 7;
      *(u32x4*)(vT + r * 72 + cc * 8) = *(const u32x4*)(vsrc + (size_t)r * T + cc * 8);
    }
  }
  __syncthreads();
  const int tb = w & 1, dvh = w >> 1;
  const int t = 32 * tb + lq;
  f32x16 hacc[2];
#pragma unroll
  for (int d2 = 0; d2 < 2; ++d2)
#pragma unroll
    for (int r = 0; r < 16; ++r) hacc[d2][r] = 0.f;
  const bf16* sqt = sq + t * 136 + 8 * h;
  for (int dir = 0; dir < 2; ++dir) {
    const int slot = (cp * 4 + hd) * 2 + dir;
    const float m_prev = dir ? m_prev1 : m_prev0;
    const float* bcA = bcA2 + dir * 64;
    const float* uA = uA2 + dir * 64;
    const float* mtA = mtA2 + dir * 64;
    const float* nA = nA2 + dir * 128;
    const float bc_t = bcA[t], mt = mtA[t];
    const float w_inter = fexp(bc_t + m_prev - mt);
    float den = 0.f;
    const float e0 = bc_t - mt;
    u32x4 pk[2][2];
#pragma unroll
    for (int sb = 0; sb < 2; ++sb) {
      asm volatile("" ::: "memory");
      f32x16 sv;
#pragma unroll
      for (int r = 0; r < 16; ++r) sv[r] = 0.f;
#pragma unroll
      for (int ks = 0; ks < 8; ++ks) {
        bf16x8 a = *(const bf16x8*)(sk + (32 * sb + lq) * 136 + ks * 16 + 8 * h);
        sv = MFMA(a, *(const bf16x8*)(sqt + ks * 16), sv);
      }
#pragma unroll
      for (int r = 0; r < 16; ++r) {
        const int sidx = 32 * sb + 8 * (r >> 2) + 4 * h + (r & 3);
        const bool valid = dir ? (sidx >= t) : (sidx <= t);
        const float wgt = valid ? fexp(e0 + uA[sidx]) : 0.f;
        const float v = sv[r] * wgt;
        sv[r] = v; den += v;
      }
#pragma unroll
      for (int s2 = 0; s2 < 2; ++s2)
#pragma unroll
        for (int e = 0; e < 4; ++e) pk[sb][s2][e] = pack2(sv[8 * s2 + 2 * e], sv[8 * s2 + 2 * e + 1]);
    }
    asm volatile("" ::: "memory");
    den += __shfl_xor(den, 32);
    float qn = 0.f;
#pragma unroll
    for (int ks = 0; ks < 8; ++ks) {
      u32x4 qv = *(const u32x4*)(sqt + ks * 16);
#pragma unroll
      for (int e = 0; e < 4; ++e) {
        qn += bflo(qv[e]) * nA[ks * 16 + 8 * h + 2 * e] + bfhi(qv[e]) * nA[ks * 16 + 8 * h + 2 * e + 1];
      }
    }
    qn += __shfl_xor(qn, 32);
    den += w_inter * qn;
    asm volatile("" ::: "memory");
    const float rden = 1.f / fmaxf(fabsf(den), fexp(-mt));
    const bf16* cs = p.Cst() + (size_t)slot * 16384;
    bf16x8 cfa[2][8];
#pragma unroll
    for (int d2 = 0; d2 < 2; ++d2)
#pragma unroll
      for (int ks = 0; ks < 8; ++ks) cfa[d2][ks] = *(const bf16x8*)(cs + ((2 * dvh + d2) * 32 + lq) * 128 + ks * 16 + 8 * h);
    asm volatile("" : "+v"(cfa[0][0]), "+v"(cfa[0][1]), "+v"(cfa[0][2]), "+v"(cfa[0][3]), "+v"(cfa[0][4]), "+v"(cfa[0][5]), "+v"(cfa[0][6]), "+v"(cfa[0][7]),
                      "+v"(cfa[1][0]), "+v"(cfa[1][1]), "+v"(cfa[1][2]), "+v"(cfa[1][3]), "+v"(cfa[1][4]), "+v"(cfa[1][5]), "+v"(cfa[1][6]), "+v"(cfa[1][7]));
#pragma unroll
    for (int d2 = 0; d2 < 2; ++d2) {
      const int dvb = 2 * dvh + d2;
      f32x16 acc;
#pragma unroll
      for (int r = 0; r < 16; ++r) acc[r] = 0.f;
#pragma unroll
      for (int ks = 0; ks < 8; ++ks) acc = MFMA(cfa[d2][ks], *(const bf16x8*)(sqt + ks * 16), acc);
#pragma unroll
      for (int r = 0; r < 16; ++r) acc[r] *= w_inter;
#pragma unroll
      for (int sb = 0; sb < 2; ++sb)
#pragma unroll
        for (int s2 = 0; s2 < 2; ++s2) {
          const bf16* vp = vT + (dvb * 32 + lq) * 72 + sb * 32 + s2 * 16 + 4 * h;
          u32x2 lo = *(const u32x2*)vp, hi = *(const u32x2*)(vp + 8);
          u32x4 av; av[0] = lo[0]; av[1] = lo[1]; av[2] = hi[0]; av[3] = hi[1];
          acc = MFMA(__builtin_bit_cast(bf16x8, av), __builtin_bit_cast(bf16x8, pk[sb][s2]), acc);
        }
#pragma unroll
      for (int r = 0; r < 16; ++r) hacc[d2][r] += acc[r] * rden;
    }
  }
  const int tok = ctok + t;
  float ss = 0.f;
#pragma unroll
  for (int d2 = 0; d2 < 2; ++d2)
#pragma unroll
    for (int g = 0; g < 4; ++g) {
      int dv = (2 * dvh + d2) * 32 + 8 * g + 4 * h;
      u32x2 mo = *(const u32x2*)(p.proj() + (size_t)tok * NPROJ + 4800 + hd * 128 + dv);
      float m0 = bflo(mo[0]), m1 = bfhi(mo[0]), m2 = bflo(mo[1]), m3 = bfhi(mo[1]);
      float v0 = hacc[d2][4 * g] * sigmoid_f(m0), v1 = hacc[d2][4 * g + 1] * sigmoid_f(m1);
      float v2 = hacc[d2][4 * g + 2] * sigmoid_f(m2), v3 = hacc[d2][4 * g + 3] * sigmoid_f(m3);
      hacc[d2][4 * g] = v0; hacc[d2][4 * g + 1] = v1; hacc[d2][4 * g + 2] = v2; hacc[d2][4 * g + 3] = v3;
      ss += v0 * v0 + v1 * v1 + v2 * v2 + v3 * v3;
    }
  ss += __shfl_xor(ss, 32);
  if (h == 0) ssb[dvh * 64 + t] = ss;
  __syncthreads();
  const float rstd = rsqrtf((ssb[t] + ssb[64 + t]) * (1.f / 128.f) + EPS);
  u32x2 zz[2][4]; f32x4 gg[2][4];
#pragma unroll
  for (int d2 = 0; d2 < 2; ++d2)
#pragma unroll
    for (int g = 0; g < 4; ++g) {
      int dv = (2 * dvh + d2) * 32 + 8 * g + 4 * h;
      zz[d2][g] = *(const u32x2*)(p.proj() + (size_t)tok * NPROJ + 5312 + hd * 128 + dv);
      gg[d2][g] = *(const f32x4*)(p.mnorm + l * 512 + hd * 128 + dv);
    }
#pragma unroll
  for (int d2 = 0; d2 < 2; ++d2)
#pragma unroll
    for (int g = 0; g < 4; ++g) {
      int dv = (2 * dvh + d2) * 32 + 8 * g + 4 * h;
      u32x2 z = zz[d2][g];
      f32x4 gn = gg[d2][g];
      float z0 = bflo(z[0]), z1 = bfhi(z[0]), z2 = bflo(z[1]), z3 = bfhi(z[1]);
      u32x2 ov;
      ov[0] = pack2(hacc[d2][4 * g] * rstd * gn[0] * silu_f(z0), hacc[d2][4 * g + 1] * rstd * gn[1] * silu_f(z1));
      ov[1] = pack2(hacc[d2][4 * g + 2] * rstd * gn[2] * silu_f(z2), hacc[d2][4 * g + 3] * rstd * gn[3] * silu_f(z3));
      *(u32x2*)(p.ycat() + (size_t)tok * 1536 + 1024 + hd * 128 + dv) = ov;
    }
}

DI void ckv_fin(const P& p, int l, int tok) {
  const int lane = tidx() & 63;
  const int b = tok >> 8, t = tok & 255;
  float* o = p.out + O_CKV + (size_t)((b * 4 + l) * 256 + t) * 256 + lane * 4;
  u32x2 raw = *(const u32x2*)(p.proj() + (size_t)tok * NPROJ + 384 + lane * 4);
  f32x4 v; v[0] = bflo(raw[0]); v[1] = bfhi(raw[0]); v[2] = bflo(raw[1]); v[3] = bfhi(raw[1]);
  float ss = v[0] * v[0] + v[1] * v[1] + v[2] * v[2] + v[3] * v[3];
#pragma unroll
  for (int of = 32; of >= 1; of >>= 1) ss += __shfl_xor(ss, of);
  const float rstd = rsqrtf(ss * (1.f / 256.f) + EPS);
  f32x4 g = *(const f32x4*)(p.kv_norm + l * 256 + lane * 4);
  v[0] *= rstd * g[0]; v[1] *= rstd * g[1]; v[2] *= rstd * g[2]; v[3] *= rstd * g[3];
  *(f32x4*)o = v;
}

#define XB_TMO      128
#define XB_XCNT(j)  (256  + 64 * (j))
#define XB_XSUB(j)  (1280 + 64 * (j))
#define XB_XGEN(j)  (2304 + 64 * (j))
#define XB_TOP      3328
#define XB_TOPGEN   3392
#define XCD_BAR_WORDS 3456
#define XB_SPIN_CAP (1u << 18)
#define LAS __attribute__((address_space(3)))

__device__ __forceinline__ unsigned xb_ld(unsigned* p)              { return __hip_atomic_load(p, __ATOMIC_RELAXED, __HIP_MEMORY_SCOPE_AGENT); }
__device__ __forceinline__ unsigned xb_add(unsigned* p, unsigned v) { return __hip_atomic_fetch_add(p, v, __ATOMIC_RELAXED, __HIP_MEMORY_SCOPE_AGENT); }
__device__ __forceinline__ unsigned xb_xcc_id() { return (unsigned)__builtin_amdgcn_s_getreg((3 << 11) | 20) & 0xFu; }
#define XB_SPIN(cond, bar) do { unsigned _sp = 0; while (cond) { __builtin_amdgcn_s_sleep(1); \
    if ((++_sp & 255u) == 0u) { if (xb_ld(&(bar)[XB_TMO])) break; if (_sp > XB_SPIN_CAP) { atomicAdd(&(bar)[XB_TMO], 1u); break; } } } } while (0)

struct XcdBarrier {
    unsigned* bar; unsigned x;
    volatile LAS unsigned* st;
};

__device__ __forceinline__ XcdBarrier xcd_barrier_post(unsigned* bar, volatile LAS unsigned* st) {
    XcdBarrier b; b.bar = bar; b.x = xb_xcc_id(); b.st = st;
    if (tidx() == 0) (void)xb_add(&bar[XB_XCNT(b.x)], 1u);
    return b;
}
__device__ __forceinline__ void xcd_barrier_complete(unsigned* bar, unsigned x, unsigned& nloc, unsigned& nx) {
    const unsigned G = gridDim.x * gridDim.y * gridDim.z;
    unsigned sum, cnt, mine, sp = 0u;
    for (;;) {
        sum = 0u; cnt = 0u; mine = 0u;
#pragma unroll
        for (unsigned j = 0; j < 16; ++j) { const unsigned c = xb_ld(&bar[XB_XCNT(j)]); sum += c; cnt += (c > 0u) ? 1u : 0u; mine = (j == x) ? c : mine; }
        if (sum == G) break;
        __builtin_amdgcn_s_sleep(1);
        if ((++sp & 255u) == 0u) { if (xb_ld(&bar[XB_TMO])) break; if (sp > XB_SPIN_CAP) { atomicAdd(&bar[XB_TMO], 1u); break; } }
    }
    nloc = mine > 0u ? mine : 1u; nx = cnt > 0u ? cnt : 1u;
}

__device__ __forceinline__ void xcd_barrier(const XcdBarrier& b) {
    asm volatile("s_waitcnt vmcnt(0)" ::: "memory");
    __syncthreads();
    if (tidx() == 0) {
        unsigned* bar = b.bar;
        __builtin_amdgcn_s_waitcnt(0);
        unsigned nloc = b.st[0], nx = b.st[1];
        if (nloc == 0u) { xcd_barrier_complete(bar, b.x, nloc, nx); b.st[0] = nloc; b.st[1] = nx; }
        const unsigned old = xb_add(&bar[XB_XSUB(b.x)], 1u);
        const unsigned gen = old / nloc;
        if (old + 1u == (gen + 1u) * nloc) {
            __builtin_amdgcn_fence(__ATOMIC_RELEASE, "agent");
            asm volatile("s_waitcnt vmcnt(0)" ::: "memory");
            const unsigned og = xb_add(&bar[XB_TOP], 1u);
            const unsigned tg = og / nx;
            if (og + 1u == (tg + 1u) * nx) xb_add(&bar[XB_TOPGEN], 1u);
            else XB_SPIN(xb_ld(&bar[XB_TOPGEN]) == tg, bar);
            __builtin_amdgcn_fence(__ATOMIC_ACQUIRE, "agent");
            xb_add(&bar[XB_XGEN(b.x)], 1u);
            asm volatile("s_waitcnt vmcnt(0)" ::: "memory");
        } else {
            XB_SPIN(xb_ld(&bar[XB_XGEN(b.x)]) == gen, bar);
            __builtin_amdgcn_fence(__ATOMIC_ACQUIRE, "agent");
            asm volatile("s_waitcnt vmcnt(0)" ::: "memory");
        }
    }
    __syncthreads();
}


DI P launder(const P& p) {
  P q = p;
#define LND(m) { asm volatile("" : "+s"(q.m)); q.m = (decltype(q.m))(__attribute__((address_space(1))) void*)(void*)q.m; }
  LND(x_prompt) LND(x_sample) LND(c_ckv) LND(c_krope) LND(c_dk) LND(c_dv) LND(st_C) LND(st_n) LND(st_m) LND(c) LND(c_ctx)
  LND(g_norm) LND(W_mod) LND(b_mod) LND(W_in) LND(q_norm) LND(W_uq) LND(kv_norm) LND(W_ukv) LND(dlam) LND(dnorm) LND(mconv)
  LND(mgb) LND(mnorm) LND(W_out) LND(g_final) LND(out) LND(ws)
#undef LND
  return q;
}

template <int KIND>
DI void run_phase(const P& p0, int ph, char* smem) {
  const P& p = p0;
  const int G = gridDim.x, B = blockIdx.x, w = wave_of(tidx());
  if ((KIND < 0 || KIND == 0) && ph == 0) { phase_prepass(p, smem); return; }
  if ((KIND < 0 || KIND == 1) && ph == 1) {
    for (int it = B; it < 256 + 2048; it += G) {
      if (it < 256) {
        int mt = it >> 3, nt = it & 7;
        int l = (mt * 128) >> 10;
        f32x16 acc[2][2];
        gemm_core<false>(p.cckv() + (size_t)mt * 128 * 256, 256, p.WukvTp() + (size_t)l * 1024 * 256 + (size_t)nt * 128 * 256, 256, 256, smem, acc);
        epi_kv(p, mt * 128, nt * 128, acc, nullptr, true);
      } else {
        norm_row(p, 0, (it - 256) * 4 + w, 0);
      }
    }
    return;
  }
  const int l = (ph - 2) / 6, sub = (ph - 2) % 6;
  if ((KIND < 0 || KIND == 2) && sub == 0) {
    const int x = B & 7, j = B >> 3, per = G >> 3;
    const bf16* Ab = p.hbuf();
    const bf16* Wb = p.WinT() + (size_t)l * NPROJ * 1024;
    for (int q = j; q < 3 * 64; q += per) {
      const int r = q >> 6, jj = q & 63;
      const int st = r * 8 + x;
      const int mt = (st / 3) * 8 + (jj >> 3), nt = (st % 3) * 8 + (jj & 7);
      if (nt >= 23) continue;
      f32x16 acc[2][4];
      gemm_core_w(Ab + (size_t)mt * 128 * 1024, 1024, Wb + (size_t)nt * 256 * 1024, 1024, 1024, smem, acc);
      epi_inproj_w(p, l, mt * 128, nt * 256, acc, smem);
    }
  } else if ((KIND < 0 || KIND == 3) && sub == 1) {
    const int N_CH = 1024, N_QA = 64 * 3, N_KV = 64 * 4, N_CF = 1024;
    const float* sRowW = (const float*)(smem + (128 + 256) * 72 * 2);
    for (int it = B; it < N_CH + N_QA + N_KV + N_CF; it += G) {
      int u = it;
      __syncthreads();
      if (u < N_CH) { mlstm_local(p, l, u, smem); continue; }
      u -= N_CH;
      if (u < N_QA) {
        int mt = u / 3, nt = u % 3;
        f32x16 acc[2][4];
        gemm_core_w<true>(p.proj() + (size_t)mt * 128 * NPROJ, NPROJ, p.WuqT() + (size_t)l * 768 * 384 + (size_t)nt * 256 * 384, 384, 384, smem, acc);
        epi_qa_w<0>(p, mt * 128, nt * 256, acc, sRowW);
        epi_qa_w<1>(p, mt * 128, nt * 256, acc, sRowW);
        continue;
      }
      u -= N_QA;
      if (u < N_KV) {
        int mt = u >> 2, nt = u & 3;
        f32x16 acc[2][4];
        gemm_core_w<true>(p.proj() + (size_t)mt * 128 * NPROJ + 384, NPROJ, p.WukvT() + (size_t)l * 1024 * 256 + (size_t)nt * 256 * 256, 256, 256, smem, acc);
        epi_kv_w<0>(p, mt * 128, nt * 256, acc, sRowW);
        epi_kv_w<1>(p, mt * 128, nt * 256, acc, sRowW);
        continue;
      }
      u -= N_KV;
      ckv_fin(p, l, u * 4 + w);
    }
  } else if ((KIND < 0 || KIND == 7) && sub == 2) {
    for (int it = B; it < 640; it += G) mlstm_scan(p, l, it);
  } else if ((KIND < 0 || KIND == 4) && sub == 3) {
    const int x = B & 7;
    int* qctr = p.qc() + ph * 8 + x;
    int* sslot = (int*)(smem + SMEM_BYTES - 16);
    for (;;) {
      __syncthreads();
      if (tidx() == 0) *sslot = atomicAdd(qctr, 1);
      __syncthreads();
      const int q = *sslot;
      if (q >= 192) break;
      __syncthreads();
      if (q < 32) { const int pr = 2 * x + (q >> 4); mla_item(p, l, pr * 16 + (q & 15), smem); }
      else if (q < 64) { const int u = q - 32; const int pr = 2 * x + (u >> 4); diff_item(p, l, pr * 16 + (u & 15), smem); }
      else if (q < 128) mlstm_out(p, l, x * 64 + (q - 64), smem);
      else if (q < 160) { const int u = q - 128; const int pr = 8 * x + (u >> 2); mla_item(p, l, 256 + pr * 4 + (u & 3), smem); }
      else { const int u = q - 160; const int pr = 8 * x + (u >> 2); diff_item(p, l, 256 + pr * 4 + (u & 3), smem); }
    }
  } else if ((KIND < 0 || KIND == 5) && sub == 4) {
    const int x = B & 7, j = B >> 3, per = G >> 3;
    for (int q = j; q < 64; q += per) {
      const int mt = x * 8 + (q >> 3), nt = q & 7;
      f32x16 acc[2][2];
      gemm_core<false>(p.ycat() + (size_t)mt * 128 * 1536, 1536, p.WoutT() + (size_t)l * 1024 * 1536 + (size_t)nt * 128 * 1536, 1536, 1536, smem, acc);
      epi_out(p, l, mt * 128, nt * 128, acc);
    }
  } else if ((KIND < 0 || KIND == 6) && sub == 5) {
    for (int it = B; it < 2048; it += G) {
      if (l < 3) norm_row(p, l + 1, it * 4 + w, 0);
      else norm_row(p, 0, it * 4 + w, 1);
    }
  }
}

#if COOP
__global__ void __launch_bounds__(256, 2) mega(P p, int lo, int hi, int coop) {
  __shared__ __attribute__((aligned(16))) char smem[SMEM_BYTES];
  __shared__ uint4 xb_words;
  if (threadIdx.x == 0) xb_words = make_uint4(0u, 0u, 0u, 0u);
  tidx_init();
  XcdBarrier xb = xcd_barrier_post((unsigned*)p.ctr(), (volatile LAS unsigned*)&xb_words);
  for (int ph = lo; ph < hi; ++ph) {
    run_phase<-1>(p, ph, smem);
    if (PROBE_DUP) {
      const int kind = ph < 2 ? ph : 2 + (ph - 2) % 6;
      if ((PROBE_DUP >> kind) & 1) { xcd_barrier(xb); run_phase<-1>(p, ph, smem); }
    }
    if (ph + 1 < hi) xcd_barrier(xb);
  }
  if (coop == 2) cg::this_grid().sync();
}
#endif
template <int KIND>
__global__ void __launch_bounds__(256) phase_k(P p, int ph) {
  __shared__ __attribute__((aligned(16))) char smem[SMEM_BYTES];
  tidx_init();
  run_phase<KIND>(p, ph, smem);
}

extern "C" void kernel_launch(void* const* d_in, const int* in_sizes, int n_in, void* d_out, int out_size, void* d_ws,
                              size_t ws_size, hipStream_t stream) {
  P p{};
  const float** ins = (const float**)&p;
  for (int i = 0; i < 26; ++i) ins[i] = (const float*)d_in[i];
  p.out = (float*)d_out;
  p.ws = (char*)d_ws;
  if (WS_TOTAL > ws_size) { fprintf(stderr, "workspace too small: need %zu have %zu\n", (size_t)WS_TOTAL, ws_size); return; }

#if COOP
  static int grid_blocks = 0;
  if (!grid_blocks) {
    int dev = 0, cus = 0, per_cu = 0;
    (void)hipGetDevice(&dev);
    (void)hipDeviceGetAttribute(&cus, hipDeviceAttributeMultiprocessorCount, dev);
    (void)hipOccupancyMaxActiveBlocksPerMultiprocessor(&per_cu, mega, 256, 0);
    if (per_cu > 2) per_cu = 2;
    grid_blocks = cus * per_cu;
  }
  (void)hipMemsetAsync(p.ws + OFF_ctr, 0, 16384 + 4096, stream);
  int lo = 0, hi = NPHASE, coop = 1;
  void* args[] = {&p, &lo, &hi, &coop};
  hipError_t e = hipLaunchCooperativeKernel((void*)mega, dim3(grid_blocks), dim3(256), args, 0, stream);
  if (e != hipSuccess) fprintf(stderr, "cooperative launch failed: %s (grid %d)\n", hipGetErrorString(e), grid_blocks);
#else
  for (int ph = 0; ph < NPHASE; ++ph) {
    static const int kmap[6] = {2, 3, 7, 4, 5, 6};
    int kind = ph < 2 ? ph : kmap[(ph - 2) % 6];
    switch (kind) {
      case 0: phase_k<0><<<512, 256, 0, stream>>>(p, ph); break;
      case 1: phase_k<1><<<512, 256, 0, stream>>>(p, ph); break;
      case 2: phase_k<2><<<512, 256, 0, stream>>>(p, ph); break;
      case 3: phase_k<3><<<512, 256, 0, stream>>>(p, ph); break;
      case 4: phase_k<4><<<512, 256, 0, stream>>>(p, ph); break;
      case 5: phase_k<5><<<512, 256, 0, stream>>>(p, ph); break;
      case 7: phase_k<7><<<512, 256, 0, stream>>>(p, ph); break;
      default: phase_k<6><<<512, 256, 0, stream>>>(p, ph); break;
    }
  }
#endif
}
```

```cpp
#include <hip/hip_runtime.h>
#include <hip/hip_cooperative_groups.h>
#include <cstdio>
namespace cg = cooperative_groups;

typedef unsigned short bf16;
typedef __attribute__((ext_vector_type(8))) short bf16x8;
typedef __attribute__((ext_vector_type(4))) short s16x4;
typedef __attribute__((ext_vector_type(16))) float f32x16;
typedef __attribute__((ext_vector_type(4))) float f32x4;
typedef __attribute__((ext_vector_type(4))) unsigned u32x4;
typedef __attribute__((ext_vector_type(2))) unsigned u32x2;

#define DI __device__ __forceinline__
#define MFMA(a, b, c) __builtin_amdgcn_mfma_f32_32x32x16_bf16((a), (b), (c), 0, 0, 0)

#ifndef COOP
#define COOP 1
#endif
#define PROBE_DUP 0

constexpr int NTOK = 8192;
constexpr int NPROJ = 5888;
constexpr int NPHASE = 26;
constexpr float EPS = 1e-6f;
constexpr int SMEM_BYTES = 75 * 1024;

constexpr size_t O_YP = 0, O_YS = 4194304, O_CKV = 8388608, O_KROPE = 12582912, O_DK = 13631488,
                 O_DV = 22020096, O_MC = 30408704, O_MN = 38797312, O_MM = 38862848;

constexpr size_t al256(size_t x) { return (x + 255) & ~(size_t)255; }
constexpr size_t OFF_WinT = 0;
constexpr size_t OFF_WuqT = OFF_WinT + al256((size_t)4 * NPROJ * 1024 * 2);
constexpr size_t OFF_WukvT = OFF_WuqT + al256((size_t)4 * 768 * 384 * 2);
constexpr size_t OFF_WukvTp = OFF_WukvT + al256((size_t)4 * 1024 * 256 * 2);
constexpr size_t OFF_WoutT = OFF_WukvTp + al256((size_t)4 * 1024 * 256 * 2);
constexpr size_t OFF_mod = OFF_WoutT + al256((size_t)4 * 1024 * 1536 * 2);
constexpr size_t OFF_ropec = OFF_mod + al256((size_t)4 * 5 * 3072 * 4);
constexpr size_t OFF_ropes = OFF_ropec + al256((size_t)1024 * 32 * 4);
constexpr size_t OFF_lam = OFF_ropes + al256((size_t)1024 * 32 * 4);
constexpr size_t OFF_hbuf = OFF_lam + al256((size_t)256);
constexpr size_t OFF_xbuf = OFF_hbuf + al256((size_t)NTOK * 1024 * 2);
constexpr size_t OFF_proj = OFF_xbuf + al256((size_t)NTOK * 1024 * 4);
constexpr size_t OFF_Qa = OFF_proj + al256((size_t)NTOK * NPROJ * 2);
constexpr size_t OFF_Ka = OFF_Qa + al256((size_t)NTOK * 768 * 2);
constexpr size_t OFF_VaT = OFF_Ka + al256((size_t)NTOK * 768 * 2);
constexpr size_t OFF_Kb = OFF_VaT + al256((size_t)NTOK * 512 * 2);
constexpr size_t OFF_VbT = OFF_Kb + al256((size_t)NTOK * 512 * 2);
constexpr size_t OFF_VmT = OFF_VbT + al256((size_t)NTOK * 512 * 2);
constexpr size_t OFF_ycat = OFF_VmT + al256((size_t)NTOK * 512 * 2);
constexpr size_t OFF_gates = OFF_ycat + al256((size_t)NTOK * 1536 * 2);
constexpr size_t OFF_Cst = OFF_gates + al256((size_t)NTOK * 16 * 4);
constexpr size_t OFF_nst = OFF_Cst + al256((size_t)1024 * 16384 * 2);
constexpr size_t OFF_mst = OFF_nst + al256((size_t)1024 * 128 * 4);
constexpr size_t OFF_cckv = OFF_mst + al256((size_t)1024 * 4);
constexpr size_t OFF_cKa = OFF_cckv + al256((size_t)4096 * 256 * 2);
constexpr size_t OFF_cVaT = OFF_cKa + al256((size_t)64 * 256 * 192 * 2);
constexpr size_t OFF_cKb = OFF_cVaT + al256((size_t)64 * 128 * 256 * 2);
constexpr size_t OFF_cVbT = OFF_cKb + al256((size_t)64 * 256 * 128 * 2);
constexpr size_t OFF_blA = OFF_cVbT + al256((size_t)64 * 128 * 256 * 2);
constexpr size_t OFF_mlA = OFF_blA + 4096;
constexpr size_t OFF_ctr = OFF_mlA + 4096;
constexpr size_t OFF_qc = OFF_ctr + 16384;
constexpr size_t WS_TOTAL = OFF_qc + 4096;
struct P {
  const float *x_prompt, *x_sample, *c_ckv, *c_krope, *c_dk, *c_dv, *st_C, *st_n, *st_m, *c, *c_ctx, *g_norm, *W_mod,
      *b_mod, *W_in, *q_norm, *W_uq, *kv_norm, *W_ukv, *dlam, *dnorm, *mconv, *mgb, *mnorm, *W_out, *g_final;
  float* out;
  char* ws;
  __device__ __forceinline__ bf16* WinT() const { return (bf16*)(ws + OFF_WinT); }
  __device__ __forceinline__ bf16* WuqT() const { return (bf16*)(ws + OFF_WuqT); }
  __device__ __forceinline__ bf16* WukvT() const { return (bf16*)(ws + OFF_WukvT); }
  __device__ __forceinline__ bf16* WukvTp() const { return (bf16*)(ws + OFF_WukvTp); }
  __device__ __forceinline__ bf16* WoutT() const { return (bf16*)(ws + OFF_WoutT); }
  __device__ __forceinline__ float* mod() const { return (float*)(ws + OFF_mod); }
  __device__ __forceinline__ float* ropec() const { return (float*)(ws + OFF_ropec); }
  __device__ __forceinline__ float* ropes() const { return (float*)(ws + OFF_ropes); }
  __device__ __forceinline__ float* lam() const { return (float*)(ws + OFF_lam); }
  __device__ __forceinline__ bf16* hbuf() const { return (bf16*)(ws + OFF_hbuf); }
  __device__ __forceinline__ float* xbuf() const { return (float*)(ws + OFF_xbuf); }
  __device__ __forceinline__ bf16* proj() const { return (bf16*)(ws + OFF_proj); }
  __device__ __forceinline__ bf16* Qa() const { return (bf16*)(ws + OFF_Qa); }
  __device__ __forceinline__ bf16* Ka() const { return (bf16*)(ws + OFF_Ka); }
  __device__ __forceinline__ bf16* VaT() const { return (bf16*)(ws + OFF_VaT); }
  __device__ __forceinline__ bf16* Kb() const { return (bf16*)(ws + OFF_Kb); }
  __device__ __forceinline__ bf16* VbT() const { return (bf16*)(ws + OFF_VbT); }
  __device__ __forceinline__ bf16* VmT() const { return (bf16*)(ws + OFF_VmT); }
  __device__ __forceinline__ bf16* ycat() const { return (bf16*)(ws + OFF_ycat); }
  __device__ __forceinline__ float* gates() const { return (float*)(ws + OFF_gates); }
  __device__ __forceinline__ bf16* Cst() const { return (bf16*)(ws + OFF_Cst); }
  __device__ __forceinline__ float* nst() const { return (float*)(ws + OFF_nst); }
  __device__ __forceinline__ float* mst() const { return (float*)(ws + OFF_mst); }
  __device__ __forceinline__ bf16* cckv() const { return (bf16*)(ws + OFF_cckv); }
  __device__ __forceinline__ bf16* cKa() const { return (bf16*)(ws + OFF_cKa); }
  __device__ __forceinline__ bf16* cVaT() const { return (bf16*)(ws + OFF_cVaT); }
  __device__ __forceinline__ bf16* cKb() const { return (bf16*)(ws + OFF_cKb); }
  __device__ __forceinline__ bf16* cVbT() const { return (bf16*)(ws + OFF_cVbT); }
  __device__ __forceinline__ int* ctr() const { return (int*)(ws + OFF_ctr); }
  __device__ __forceinline__ int* qc() const { return (int*)(ws + OFF_qc); }
  __device__ __forceinline__ float* blA() const { return (float*)(ws + OFF_blA); }
  __device__ __forceinline__ float* mlA() const { return (float*)(ws + OFF_mlA); }
};

DI int tidx() { int t = threadIdx.x; asm volatile("" : "+v"(t)); return t; }
DI void tidx_init() {}
DI int wave_of(int tid) { return __builtin_amdgcn_readfirstlane(tid >> 6); }
typedef __attribute__((ext_vector_type(2))) __bf16 bf16v2;
typedef __attribute__((ext_vector_type(2))) float f32x2;
DI unsigned pack2(float a, float b) {
  f32x2 v; v[0] = a; v[1] = b;
  return __builtin_bit_cast(unsigned, __builtin_convertvector(v, bf16v2));
}
DI bf16 f2bf(float x) { return (bf16)(pack2(x, 0.f) & 0xffffu); }
DI float bf2f(bf16 b) { return __uint_as_float(((unsigned)b) << 16); }
DI float fexp2(float x) { return __builtin_amdgcn_exp2f(x); }
DI float fexp(float x) { return __builtin_amdgcn_exp2f(x * 1.4426950408889634f); }
DI float bflo(unsigned u) { return __uint_as_float(u << 16); }
DI float bfhi(unsigned u) { return __uint_as_float(u & 0xffff0000u); }
DI float silu_f(float x) { return x * __builtin_amdgcn_rcpf(1.f + fexp(-x)); }
DI float sigmoid_f(float x) { return __builtin_amdgcn_rcpf(1.f + fexp(-x)); }
DI float logsig_f(float x) { return fminf(x, 0.f) - log1pf(fexp(-fabsf(x))); }

struct TokInfo { int lat, b, t, T, tok0, modj; };
DI TokInfo tinfo(int tok) {
  TokInfo r;
  if (tok < 4096) { r.lat = 0; r.b = tok >> 8; r.t = tok & 255; r.T = 256; r.tok0 = tok & ~255; r.modj = 0; }
  else { int u = tok - 4096; r.lat = 1; r.b = u >> 10; r.t = u & 1023; r.T = 1024; r.tok0 = 4096 + (u & ~1023); r.modj = 1 + r.b; }
  return r;
}

struct GR { u32x4 ra0[4], rb0[4], ra1[4], rb1[4]; };
DI void gemm_load2(GR& g, const bf16* __restrict__ A, int lda, const bf16* __restrict__ Bt, int ldb) {
  const int tid = tidx();
  const int lr = tid >> 3, lc = tid & 7;
  const bf16* ap = A + (size_t)lr * lda + lc * 8;
  const bf16* bp = Bt + (size_t)lr * ldb + lc * 8;
  const size_t a32 = (size_t)32 * lda, b32 = (size_t)32 * ldb;
#pragma unroll
  for (int i = 0; i < 4; ++i) { g.ra0[i] = *(const u32x4*)(ap + i * a32); g.rb0[i] = *(const u32x4*)(bp + i * b32); }
#pragma unroll
  for (int i = 0; i < 4; ++i) { g.ra1[i] = *(const u32x4*)(ap + 64 + i * a32); g.rb1[i] = *(const u32x4*)(bp + 64 + i * b32); }
}
template <bool ROWSS>
DI void gemm_core_n(GR& g, const bf16* __restrict__ A, int lda, const bf16* __restrict__ Bt, int ldb,
                    const bf16* __restrict__ An, const bf16* __restrict__ Btn, int K, char* smem, f32x16 (&acc)[2][2]) {
  bf16* sA = (bf16*)smem;
  bf16* sB = sA + 128 * 72;
  float* sRow = (float*)(sB + 128 * 72);
  const int tid = tidx(), lane = tid & 63, w = wave_of(tid);
  const int wm = w >> 1, wn = w & 1, lq = lane & 31, h = lane >> 5;
  const int lr = tid >> 3, lc = tid & 7;
  float ss[4] = {0.f, 0.f, 0.f, 0.f};
#pragma unroll
  for (int i = 0; i < 2; ++i)
#pragma unroll
    for (int j = 0; j < 2; ++j)
#pragma unroll
      for (int r = 0; r < 16; ++r) acc[i][j][r] = 0.f;
  const bf16* ap = A + (size_t)lr * lda + lc * 8;
  const bf16* bp = Bt + (size_t)lr * ldb + lc * 8;
  const bf16* apn = An + (size_t)lr * lda + lc * 8;
  const bf16* bpn = Btn + (size_t)lr * ldb + lc * 8;
  const size_t a32 = (size_t)32 * lda, b32 = (size_t)32 * ldb;
  const int nk = K >> 6;
  auto step = [&](u32x4 (&ra)[4], u32x4 (&rb)[4], int kt) {
    if (kt) __syncthreads();
#pragma unroll
    for (int i = 0; i < 4; ++i) {
      *(u32x4*)(sA + (lr + 32 * i) * 72 + lc * 8) = ra[i];
      *(u32x4*)(sB + (lr + 32 * i) * 72 + lc * 8) = rb[i];
    }
    if (ROWSS) {
#pragma unroll
      for (int i = 0; i < 4; ++i)
#pragma unroll
        for (int e = 0; e < 4; ++e) {
          float a0 = bflo(ra[i][e]), a1 = bfhi(ra[i][e]);
          ss[i] += a0 * a0 + a1 * a1;
        }
    }
    __syncthreads();
    {
      const int kn = kt + 2;
      const bf16* ap2 = (kn < nk) ? ap + (size_t)kn * 64 : apn + (size_t)(kn - nk) * 64;
      const bf16* bp2 = (kn < nk) ? bp + (size_t)kn * 64 : bpn + (size_t)(kn - nk) * 64;
#pragma unroll
      for (int i = 0; i < 4; ++i) { ra[i] = *(const u32x4*)(ap2 + i * a32); rb[i] = *(const u32x4*)(bp2 + i * b32); }
    }
#pragma unroll
    for (int ks = 0; ks < 4; ++ks) {
      bf16x8 af[2], bfr[2];
#pragma unroll
      for (int i = 0; i < 2; ++i) af[i] = *(const bf16x8*)(sA + (wm * 64 + i * 32 + lq) * 72 + ks * 16 + h * 8);
#pragma unroll
      for (int j = 0; j < 2; ++j) bfr[j] = *(const bf16x8*)(sB + (wn * 64 + j * 32 + lq) * 72 + ks * 16 + h * 8);
#pragma unroll
      for (int i = 0; i < 2; ++i)
#pragma unroll
        for (int j = 0; j < 2; ++j) acc[i][j] = MFMA(af[i], bfr[j], acc[i][j]);
    }
  };
  for (int kt = 0; kt < nk; kt += 2) {
    step(g.ra0, g.rb0, kt);
    step(g.ra1, g.rb1, kt + 1);
  }
  if (ROWSS) {
#pragma unroll
    for (int i = 0; i < 4; ++i) {
      float v = ss[i];
      v += __shfl_xor(v, 1); v += __shfl_xor(v, 2); v += __shfl_xor(v, 4);
      if (lc == 0) sRow[lr + 32 * i] = v;
    }
  }
  __syncthreads();
}
template <bool ROWSS>
DI void gemm_core(const bf16* __restrict__ A, int lda, const bf16* __restrict__ Bt, int ldb, int K, char* smem,
                  f32x16 (&acc)[2][2]) {
  GR g;
  gemm_load2(g, A, lda, Bt, ldb);
  gemm_core_n<ROWSS>(g, A, lda, Bt, ldb, A, Bt, K, smem, acc);
}

template <bool ROWSS = false>
DI void gemm_core_w(const bf16* __restrict__ A, int lda, const bf16* __restrict__ Bt, int ldb, int K, char* smem,
                    f32x16 (&acc)[2][4]) {
  bf16* sA = (bf16*)smem;
  bf16* sB = sA + 128 * 72;
  const int tid = tidx(), lane = tid & 63, w = wave_of(tid);
  const int wm = w >> 1, wn = w & 1, lq = lane & 31, h = lane >> 5;
  const int lr = tid >> 3, lc = tid & 7;
  u32x4 ra[4], rb[8];
  float ssw[4] = {0.f, 0.f, 0.f, 0.f};
#pragma unroll
  for (int i = 0; i < 2; ++i)
#pragma unroll
    for (int j = 0; j < 4; ++j)
#pragma unroll
      for (int r = 0; r < 16; ++r) acc[i][j][r] = 0.f;
  const bf16* ap = A + (size_t)lr * lda + lc * 8;
  const bf16* bp = Bt + (size_t)lr * ldb + lc * 8;
  const size_t a32 = (size_t)32 * lda, b32 = (size_t)32 * ldb;
#pragma unroll
  for (int i = 0; i < 4; ++i) ra[i] = *(const u32x4*)(ap + i * a32);
#pragma unroll
  for (int i = 0; i < 8; ++i) rb[i] = *(const u32x4*)(bp + i * b32);
  const int nk = K >> 6;
  for (int kt = 0; kt < nk; ++kt) {
    if (kt) __syncthreads();
#pragma unroll
    for (int i = 0; i < 4; ++i) *(u32x4*)(sA + (lr + 32 * i) * 72 + lc * 8) = ra[i];
#pragma unroll
    for (int i = 0; i < 8; ++i) *(u32x4*)(sB + (lr + 32 * i) * 72 + lc * 8) = rb[i];
    if (ROWSS) {
#pragma unroll
      for (int i = 0; i < 4; ++i)
#pragma unroll
        for (int e = 0; e < 4; ++e) {
          float a0 = bflo(ra[i][e]), a1 = bfhi(ra[i][e]);
          ssw[i] += a0 * a0 + a1 * a1;
        }
    }
    __syncthreads();
    {
      const int kn = (kt + 1 < nk) ? kt + 1 : kt;
      const bf16* ap2 = ap + (size_t)kn * 64;
      const bf16* bp2 = bp + (size_t)kn * 64;
#pragma unroll
      for (int i = 0; i < 4; ++i) ra[i] = *(const u32x4*)(ap2 + i * a32);
#pragma unroll
      for (int i = 0; i < 8; ++i) rb[i] = *(const u32x4*)(bp2 + i * b32);
    }
#pragma unroll
    for (int ks = 0; ks < 4; ++ks) {
      bf16x8 af[2], bfr[4];
#pragma unroll
      for (int i = 0; i < 2; ++i) af[i] = *(const bf16x8*)(sA + (wm * 64 + i * 32 + lq) * 72 + ks * 16 + h * 8);
#pragma unroll
      for (int j = 0; j < 4; ++j) bfr[j] = *(const bf16x8*)(sB + (wn * 128 + j * 32 + lq) * 72 + ks * 16 + h * 8);
#pragma unroll
      for (int i = 0; i < 2; ++i)
#pragma unroll
        for (int j = 0; j < 4; ++j) acc[i][j] = MFMA(af[i], bfr[j], acc[i][j]);
    }
  }
  if (ROWSS) {
    float* sRow = (float*)(smem + (128 + 256) * 72 * 2);
#pragma unroll
    for (int i = 0; i < 4; ++i) {
      float v = ssw[i];
      v += __shfl_xor(v, 1); v += __shfl_xor(v, 2); v += __shfl_xor(v, 4);
      if (lc == 0) sRow[lr + 32 * i] = v;
    }
  }
  __syncthreads();
}

DI void store_vt4(bf16* VT, size_t idx, float a, float b, float c, float d) {
  u32x2 v; v[0] = pack2(a, b); v[1] = pack2(c, d);
  *(u32x2*)(VT + idx) = v;
}

DI void transpose_tile(const float* __restrict__ src, int N, int Nvalid, bf16* __restrict__ dst, int K, int k0, int n0,
                       const float* __restrict__ gk, bf16* __restrict__ dst2, char* smem) {
  float* t = (float*)smem;
  const int tid = tidx();
#pragma unroll
  for (int i = 0; i < 4; ++i) {
    int idx = tid + 256 * i; int r = idx >> 4, c = (idx & 15) * 4;
    int n = n0 + c;
    f32x4 v = {0.f, 0.f, 0.f, 0.f};
    if (n < Nvalid) v = __builtin_nontemporal_load((const f32x4*)(src + (size_t)(k0 + r) * N + n));
    t[r * 65 + c] = v[0]; t[r * 65 + c + 1] = v[1]; t[r * 65 + c + 2] = v[2]; t[r * 65 + c + 3] = v[3];
  }
  __syncthreads();
  const int c2h = (tid & 31) * 2;
  const float gk0 = gk ? gk[k0 + c2h] : 1.f, gk1 = gk ? gk[k0 + c2h + 1] : 1.f;
#pragma unroll
  for (int i = 0; i < 8; ++i) {
    int idx = tid + 256 * i; int r = idx >> 5, c2 = (idx & 31) * 2;
    float v0 = t[c2 * 65 + r], v1 = t[(c2 + 1) * 65 + r];
    if (dst2) *(unsigned*)(dst2 + (size_t)(n0 + r) * K + k0 + c2) = pack2(v0, v1);
    v0 *= gk0; v1 *= gk1;
    *(unsigned*)(dst + (size_t)(n0 + r) * K + k0 + c2) = pack2(v0, v1);
  }
  __syncthreads();
}

DI void mod_item(const P& p, int it, char* smem) {
  float* sl = (float*)smem;
  float* red = sl + 5 * 1024;
  const int tid = tidx(), lane = tid & 63, w = wave_of(tid);
  const int l = it / 48, n0 = (it % 48) * 64;
  for (int idx = tid; idx < 5120; idx += 256) {
    int j = idx >> 10, k = idx & 1023;
    float cv = (j == 0) ? p.c_ctx[k] : p.c[(j - 1) * 1024 + k];
    sl[idx] = silu_f(cv);
  }
  __syncthreads();
  float a[5] = {0.f, 0.f, 0.f, 0.f, 0.f};
  const float* wp = p.W_mod + (size_t)l * 1024 * 3072 + n0 + lane;
  for (int k = w * 256; k < w * 256 + 256; k += 16) {
    float wv[16];
#pragma unroll
    for (int u = 0; u < 16; ++u) wv[u] = __builtin_nontemporal_load(wp + (size_t)(k + u) * 3072);
#pragma unroll
    for (int u = 0; u < 16; ++u)
#pragma unroll
      for (int j = 0; j < 5; ++j) a[j] += sl[j * 1024 + k + u] * wv[u];
  }
#pragma unroll
  for (int j = 0; j < 5; ++j) red[(w * 5 + j) * 64 + lane] = a[j];
  __syncthreads();
  for (int idx = tid; idx < 320; idx += 256) {
    int j = idx >> 6, c = idx & 63;
    float s = red[(0 * 5 + j) * 64 + c] + red[(1 * 5 + j) * 64 + c] + red[(2 * 5 + j) * 64 + c] + red[(3 * 5 + j) * 64 + c];
    p.mod()[(size_t)(l * 5 + j) * 3072 + n0 + c] = s + p.b_mod[l * 3072 + n0 + c];
  }
  __syncthreads();
}

DI void phase_prepass(const P& p, char* smem) {
  const int G = gridDim.x, B = blockIdx.x, tid = tidx();
  const int N_MOD = 192, N_WIN = 4 * 92 * 16, N_WOUT = 4 * 16 * 24, N_WUQ = 4 * 12 * 6, N_WUKV = 4 * 16 * 4;
  const int total = N_MOD + N_WIN + N_WOUT + N_WUQ + N_WUKV;
  for (int it = B; it < total; it += G) {
    int u = it;
    if (u < N_MOD) { mod_item(p, u, smem); continue; }
    u -= N_MOD;
    if (u < N_WIN) {
      int l = u / (92 * 16), r = u % (92 * 16), nt = r / 16, kt = r % 16;
      transpose_tile(p.W_in + (size_t)l * 1024 * 5840, 5840, 5840, p.WinT() + (size_t)l * NPROJ * 1024, 1024, kt * 64, nt * 64, nullptr, nullptr, smem);
      continue;
    }
    u -= N_WIN;
    if (u < N_WOUT) {
      int l = u / (16 * 24), r = u % (16 * 24), nt = r / 24, kt = r % 24;
      transpose_tile(p.W_out + (size_t)l * 1536 * 1024, 1024, 1024, p.WoutT() + (size_t)l * 1024 * 1536, 1536, kt * 64, nt * 64, nullptr, nullptr, smem);
      continue;
    }
    u -= N_WOUT;
    if (u < N_WUQ) {
      int l = u / 72, r = u % 72, nt = r / 6, kt = r % 6;
      transpose_tile(p.W_uq + (size_t)l * 384 * 768, 768, 768, p.WuqT() + (size_t)l * 768 * 384, 384, kt * 64, nt * 64, p.q_norm + l * 384, nullptr, smem);
      continue;
    }
    u -= N_WUQ;
    {
      int l = u / 64, r = u % 64, nt = r / 4, kt = r % 4;
      transpose_tile(p.W_ukv + (size_t)l * 256 * 1024, 1024, 1024, p.WukvT() + (size_t)l * 1024 * 256, 256, kt * 64, nt * 64, p.kv_norm + l * 256, p.WukvTp() + (size_t)l * 1024 * 256, smem);
    }
  }
  const int gtid = B * 256 + tid, gsz = G * 256;
  for (int idx = gtid; idx < 1024 * 32; idx += gsz) {
    int t = idx >> 5, i = idx & 31;
    float pos = (i < 16) ? (float)(t >> 6) : (float)(t & 63);
    float inv = powf(10000.f, -(float)(i & 15) / 16.f);
    float ang = pos * inv;
    p.ropec()[idx] = cosf(ang); p.ropes()[idx] = sinf(ang);
  }
  if (gtid < 4) {
    int l = gtid; const float* lp = p.dlam + l * 256;
    float s1 = 0.f, s2 = 0.f;
    for (int i = 0; i < 64; ++i) { s1 += lp[i] * lp[64 + i]; s2 += lp[128 + i] * lp[192 + i]; }
    float lam_init = 0.8f - 0.6f * expf(-0.3f * (float)l);
    p.lam()[l] = expf(s1) - expf(s2) + lam_init;
  }
  for (int idx = gtid; idx < 4 * 4 * 256 * 256; idx += gsz) {
    int d = idx & 255, t = (idx >> 8) & 255, b = (idx >> 16) & 3, l = idx >> 18;
    p.cckv()[idx] = f2bf(p.c_ckv[(size_t)((b * 4 + l) * 256 + t) * 256 + d]);
  }
  for (int idx = gtid; idx < 4 * 4 * 4 * 256 * 64; idx += gsz) {
    int r = idx & 63, t = (idx >> 6) & 255, hd = (idx >> 14) & 3, b = (idx >> 16) & 3, l = idx >> 18;
    p.cKa()[(size_t)((((l * 4 + b) * 4 + hd) * 256) + t) * 192 + 128 + r] = f2bf(p.c_krope[(size_t)((b * 4 + l) * 256 + t) * 64 + r]);
  }
  for (int idx = gtid; idx < 4 * 4 * 4 * 256 * 128; idx += gsz) {
    int d = idx & 127, t = (idx >> 7) & 255, hd = (idx >> 15) & 3, b = (idx >> 17) & 3, l = idx >> 19;
    p.cKb()[idx] = f2bf(p.c_dk[(size_t)(((b * 4 + l) * 256 + t) * 4 + hd) * 128 + d]);
  }
  for (int idx = gtid; idx < 4 * 4 * 4 * 128 * 256; idx += gsz) {
    int t = idx & 255, d = (idx >> 8) & 127, hd = (idx >> 15) & 3, b = (idx >> 17) & 3, l = idx >> 19;
    p.cVbT()[idx] = f2bf(p.c_dv[(size_t)(((b * 4 + l) * 256 + t) * 4 + hd) * 128 + d]);
  }
}

DI void norm_row(const P& p, int l, int tok, int mode) {
  const int lane = tidx() & 63;
  TokInfo ti = tinfo(tok);
  const float* x;
  if (mode == 0 && l == 0) x = ti.lat ? (p.x_sample + (size_t)(tok - 4096) * 1024) : (p.x_prompt + (size_t)tok * 1024);
  else x = p.xbuf() + (size_t)tok * 1024;
  f32x4 v[4];
  float ss = 0.f;
#pragma unroll
  for (int i = 0; i < 4; ++i) {
    v[i] = *(const f32x4*)(x + i * 256 + lane * 4);
    ss += v[i][0] * v[i][0] + v[i][1] * v[i][1] + v[i][2] * v[i][2] + v[i][3] * v[i][3];
  }
#pragma unroll
  for (int o = 32; o >= 1; o >>= 1) ss += __shfl_xor(ss, o);
  const float rstd = rsqrtf(ss * (1.f / 1024.f) + EPS);
  if (mode == 0) {
    const float* g = p.g_norm + l * 1024;
    const float* md = p.mod() + (size_t)(l * 5 + ti.modj) * 3072;
#pragma unroll
    for (int i = 0; i < 4; ++i) {
      int c = i * 256 + lane * 4;
      f32x4 gv = *(const f32x4*)(g + c), sh = *(const f32x4*)(md + c), sc = *(const f32x4*)(md + 1024 + c);
      float o0 = v[i][0] * rstd * gv[0] * (1.f + sc[0]) + sh[0];
      float o1 = v[i][1] * rstd * gv[1] * (1.f + sc[1]) + sh[1];
      float o2 = v[i][2] * rstd * gv[2] * (1.f + sc[2]) + sh[2];
      float o3 = v[i][3] * rstd * gv[3] * (1.f + sc[3]) + sh[3];
      u32x2 pk; pk[0] = pack2(o0, o1); pk[1] = pack2(o2, o3);
      *(u32x2*)(p.hbuf() + (size_t)tok * 1024 + c) = pk;
    }
  } else {
    float* o = p.out + (ti.lat ? (O_YS + (size_t)(tok - 4096) * 1024) : (O_YP + (size_t)tok * 1024));
#pragma unroll
    for (int i = 0; i < 4; ++i) {
      int c = i * 256 + lane * 4;
      f32x4 gv = *(const f32x4*)(p.g_final + c);
      f32x4 r; r[0] = v[i][0] * rstd * gv[0]; r[1] = v[i][1] * rstd * gv[1]; r[2] = v[i][2] * rstd * gv[2]; r[3] = v[i][3] * rstd * gv[3];
      *(f32x4*)(o + c) = r;
    }
  }
}

DI void img_put(bf16* img, const f32x16 (&acc)[2][2], int wm, int wn, int lq, int h) {
#pragma unroll
  for (int i = 0; i < 2; ++i)
#pragma unroll
    for (int j = 0; j < 2; ++j)
#pragma unroll
      for (int r = 0; r < 16; ++r)
        img[(wm * 64 + i * 32 + 8 * (r >> 2) + 4 * h + (r & 3)) * 136 + wn * 64 + j * 32 + lq] = f2bf(acc[i][j][r]);
}
DI void img_copy(const bf16* img, int half, bf16* dst, size_t stride, int tid) {
  u32x4 v[4];
#pragma unroll
  for (int i = 0; i < 4; ++i) { int idx = tid + 256 * i; int r = idx >> 3, c16 = idx & 7; v[i] = *(const u32x4*)(img + r * 136 + half * 64 + c16 * 8); }
#pragma unroll
  for (int i = 0; i < 4; ++i) { int idx = tid + 256 * i; int r = idx >> 3, c16 = idx & 7; *(u32x4*)(dst + (size_t)r * stride + c16 * 8) = v[i]; }
}
DI bool inproj_rm(int cb) { return !((cb >= 35 && cb <= 42) || (cb >= 67 && cb <= 74) || cb == 91); }

DI void epi_inproj(const P& p, int l, int m0, int n0, f32x16 (&acc)[2][2], char* smem) {
  const int tid_ = tidx(); const int lane = tid_ & 63, w = wave_of(tid_), wm = w >> 1, wn = w & 1, lq = lane & 31, h = lane >> 5;
  const int mb = m0 + wm * 64, nb = n0 + wn * 64;
  const int cb = nb >> 6;
  bf16* img = (bf16*)smem;
  TokInfo tb = tinfo(mb);
  const bool lat = tb.lat;
  if (!lat && (cb == 10 || (cb >= 27 && cb <= 34))) {
    float* ob = (cb == 10) ? p.out + O_KROPE + (size_t)((tb.b * 4 + l) * 256) * 64
                           : p.out + O_DK + (size_t)((tb.b * 4 + l) * 256) * 512 + (cb - 27) * 64;
    const int ostr = (cb == 10) ? 64 : 512;
#pragma unroll
    for (int i = 0; i < 2; ++i)
#pragma unroll
      for (int j = 0; j < 2; ++j)
#pragma unroll
        for (int r = 0; r < 16; ++r) {
          int tl = tb.t + i * 32 + 8 * (r >> 2) + 4 * h + (r & 3);
          ob[(size_t)tl * ostr + j * 32 + lq] = acc[i][j][r];
        }
  }
  const bool ropeT = lat && (cb == 10 || (cb >= 19 && cb <= 34));
  if (ropeT) {
#pragma unroll
    for (int i = 0; i < 2; ++i) {
      float cs[16], sn[16];
#pragma unroll
      for (int r = 0; r < 16; ++r) {
        int t = tb.t + i * 32 + 8 * (r >> 2) + 4 * h + (r & 3);
        cs[r] = p.ropec()[t * 32 + lq]; sn[r] = p.ropes()[t * 32 + lq];
      }
#pragma unroll
      for (int r = 0; r < 16; ++r) {
        float x1 = acc[i][0][r], x2 = acc[i][1][r];
        acc[i][0][r] = x1 * cs[r] - x2 * sn[r];
        acc[i][1][r] = x1 * sn[r] + x2 * cs[r];
      }
    }
  }
  if (inproj_rm(cb)) {
    img_put(img, acc, wm, wn, lq, h);
  } else if (cb == 91) {
    if (lq < 16) {
      float bias = p.mgb[l * 16 + lq];
#pragma unroll
      for (int i = 0; i < 2; ++i)
#pragma unroll
        for (int r = 0; r < 16; ++r) {
          int row = mb + i * 32 + 8 * (r >> 2) + 4 * h + (r & 3);
          p.gates()[row * 16 + lq] = acc[i][0][r] + bias;
        }
    }
  } else {
    const bool isdv = cb <= 42;
    int cc = isdv ? cb - 35 : cb - 67;
    int hd = cc >> 1, sub = cc & 1;
    bf16* VT = isdv ? p.VbT() : p.VmT();
#pragma unroll
    for (int i = 0; i < 2; ++i)
#pragma unroll
      for (int j = 0; j < 2; ++j) {
        int d = sub * 64 + j * 32 + lq;
#pragma unroll
        for (int g = 0; g < 4; ++g) {
          int tl = tb.t + i * 32 + 8 * g + 4 * h;
          store_vt4(VT, (size_t)tb.tok0 * 512 + (size_t)(hd * 128 + d) * tb.T + tl, acc[i][j][4 * g], acc[i][j][4 * g + 1], acc[i][j][4 * g + 2], acc[i][j][4 * g + 3]);
          if (isdv && !lat) {
#pragma unroll
            for (int jj = 0; jj < 4; ++jj)
              p.out[O_DV + (size_t)((tb.b * 4 + l) * 256 + tl + jj) * 512 + cc * 64 + j * 32 + lq] = acc[i][j][4 * g + jj];
          }
        }
      }
  }
  __syncthreads();
#pragma unroll
  for (int half = 0; half < 2; ++half) {
    const int cbh = (n0 >> 6) + half;
    if (!inproj_rm(cbh)) continue;
    if (cbh == 10) {
#pragma unroll
      for (int hd = 0; hd < 4; ++hd) img_copy(img, half, p.Ka() + (size_t)m0 * 768 + hd * 192 + 128, 768, tid_);
    } else if (cbh >= 27 && cbh <= 34) {
      img_copy(img, half, p.Kb() + (size_t)m0 * 512 + (cbh - 27) * 64, 512, tid_);
    } else {
      img_copy(img, half, p.proj() + (size_t)m0 * NPROJ + cbh * 64, NPROJ, tid_);
    }
  }
  __syncthreads();
}

constexpr int IMGW = 264;
DI void img_copy_w(const bf16* img, int half, bf16* dst, size_t stride, int tid) {
  u32x4 v[4];
#pragma unroll
  for (int i = 0; i < 4; ++i) { int idx = tid + 256 * i; int r = idx >> 3, c16 = idx & 7; v[i] = *(const u32x4*)(img + r * IMGW + half * 64 + c16 * 8); }
#pragma unroll
  for (int i = 0; i < 4; ++i) { int idx = tid + 256 * i; int r = idx >> 3, c16 = idx & 7; *(u32x4*)(dst + (size_t)r * stride + c16 * 8) = v[i]; }
}
template <int JP>
DI void epi_inproj_cbw(const P& p, int l, int m0, int cb, int imgcol, f32x16 (&acc)[2][4], bf16* img) {
  const int tid_ = tidx(); const int lane = tid_ & 63, w = wave_of(tid_), wm = w >> 1, lq = lane & 31, h = lane >> 5;
  const int mb = m0 + wm * 64;
  TokInfo tb = tinfo(mb);
  const bool lat = tb.lat;
  if (!lat && (cb == 10 || (cb >= 27 && cb <= 34))) {
    float* ob = (cb == 10) ? p.out + O_KROPE + (size_t)((tb.b * 4 + l) * 256) * 64
                           : p.out + O_DK + (size_t)((tb.b * 4 + l) * 256) * 512 + (cb - 27) * 64;
    const int ostr = (cb == 10) ? 64 : 512;
#pragma unroll
    for (int i = 0; i < 2; ++i)
#pragma unroll
      for (int j = 0; j < 2; ++j)
#pragma unroll
        for (int r = 0; r < 16; ++r) {
          int tl = tb.t + i * 32 + 8 * (r >> 2) + 4 * h + (r & 3);
          ob[(size_t)tl * ostr + j * 32 + lq] = acc[i][2 * JP + j][r];
        }
  }
  if (lat && (cb == 10 || (cb >= 19 && cb <= 34))) {
#pragma unroll
    for (int i = 0; i < 2; ++i) {
      float cs[16], sn[16];
#pragma unroll
      for (int r = 0; r < 16; ++r) {
        int t = tb.t + i * 32 + 8 * (r >> 2) + 4 * h + (r & 3);
        cs[r] = p.ropec()[t * 32 + lq]; sn[r] = p.ropes()[t * 32 + lq];
      }
#pragma unroll
      for (int r = 0; r < 16; ++r) {
        float x1 = acc[i][2 * JP][r], x2 = acc[i][2 * JP + 1][r];
        acc[i][2 * JP][r] = x1 * cs[r] - x2 * sn[r];
        acc[i][2 * JP + 1][r] = x1 * sn[r] + x2 * cs[r];
      }
    }
  }
  if (inproj_rm(cb)) {
#pragma unroll
    for (int i = 0; i < 2; ++i)
#pragma unroll
      for (int j = 0; j < 2; ++j)
#pragma unroll
        for (int r = 0; r < 16; ++r)
          img[(wm * 64 + i * 32 + 8 * (r >> 2) + 4 * h + (r & 3)) * IMGW + imgcol + j * 32 + lq] = f2bf(acc[i][2 * JP + j][r]);
  } else if (cb == 91) {
    if (lq < 16) {
      float bias = p.mgb[l * 16 + lq];
#pragma unroll
      for (int i = 0; i < 2; ++i)
#pragma unroll
        for (int r = 0; r < 16; ++r) {
          int row = mb + i * 32 + 8 * (r >> 2) + 4 * h + (r & 3);
          p.gates()[row * 16 + lq] = acc[i][2 * JP][r] + bias;
        }
    }
  } else {
    const bool isdv = cb <= 42;
    int cc = isdv ? cb - 35 : cb - 67;
    int hd = cc >> 1, sub = cc & 1;
    bf16* VT = isdv ? p.VbT() : p.VmT();
#pragma unroll
    for (int i = 0; i < 2; ++i)
#pragma unroll
      for (int j = 0; j < 2; ++j) {
        int d = sub * 64 + j * 32 + lq;
#pragma unroll
        for (int g = 0; g < 4; ++g) {
          int tl = tb.t + i * 32 + 8 * g + 4 * h;
          store_vt4(VT, (size_t)tb.tok0 * 512 + (size_t)(hd * 128 + d) * tb.T + tl, acc[i][2 * JP + j][4 * g], acc[i][2 * JP + j][4 * g + 1], acc[i][2 * JP + j][4 * g + 2], acc[i][2 * JP + j][4 * g + 3]);
          if (isdv && !lat) {
#pragma unroll
            for (int jj = 0; jj < 4; ++jj)
              p.out[O_DV + (size_t)((tb.b * 4 + l) * 256 + tl + jj) * 512 + cc * 64 + j * 32 + lq] = acc[i][2 * JP + j][4 * g + jj];
          }
        }
      }
  }
}
DI void epi_inproj_w(const P& p, int l, int m0, int n0, f32x16 (&acc)[2][4], char* smem) {
  bf16* img = (bf16*)smem;
  const int tid_ = tidx(); const int wn = wave_of(tid_) & 1;
  const int cb0 = n0 >> 6;
  epi_inproj_cbw<0>(p, l, m0, cb0 + 2 * wn, (2 * wn) * 64, acc, img);
  epi_inproj_cbw<1>(p, l, m0, cb0 + 2 * wn + 1, (2 * wn + 1) * 64, acc, img);
  __syncthreads();
#pragma unroll
  for (int half = 0; half < 4; ++half) {
    const int cbh = cb0 + half;
    if (!inproj_rm(cbh)) continue;
    if (cbh == 10) {
#pragma unroll
      for (int hd = 0; hd < 4; ++hd) img_copy_w(img, half, p.Ka() + (size_t)m0 * 768 + hd * 192 + 128, 768, tid_);
    } else if (cbh >= 27 && cbh <= 34) {
      img_copy_w(img, half, p.Kb() + (size_t)m0 * 512 + (cbh - 27) * 64, 512, tid_);
    } else {
      img_copy_w(img, half, p.proj() + (size_t)m0 * NPROJ + cbh * 64, NPROJ, tid_);
    }
  }
  __syncthreads();
}

DI void epi_qa(const P& p, int m0, int n0, f32x16 (&acc)[2][2], const float* sRow) {
  const int tid_ = tidx(); const int lane = tid_ & 63, w = wave_of(tid_), wm = w >> 1, wn = w & 1, lq = lane & 31, h = lane >> 5;
  const int mb = m0 + wm * 64, nb = n0 + wn * 64;
  const int cb = nb >> 6, hd = cb / 3, part = cb % 3;
  TokInfo tb = tinfo(mb);
  const bool dorope = tb.lat && part == 2;
#pragma unroll
  for (int i = 0; i < 2; ++i) {
    float cs[16], sn[16];
#pragma unroll
    for (int r = 0; r < 16; ++r) { cs[r] = 1.f; sn[r] = 0.f; }
    if (dorope) {
#pragma unroll
      for (int r = 0; r < 16; ++r) {
        int t = tb.t + i * 32 + 8 * (r >> 2) + 4 * h + (r & 3);
        cs[r] = p.ropec()[t * 32 + lq]; sn[r] = p.ropes()[t * 32 + lq];
      }
    }
#pragma unroll
    for (int r = 0; r < 16; ++r) {
      int rl = wm * 64 + i * 32 + 8 * (r >> 2) + 4 * h + (r & 3);
      float rstd = rsqrtf(sRow[rl] * (1.f / 384.f) + EPS);
      float x1 = acc[i][0][r] * rstd, x2 = acc[i][1][r] * rstd;
      {
        float y1 = x1 * cs[r] - x2 * sn[r], y2 = x1 * sn[r] + x2 * cs[r];
        x1 = y1; x2 = y2;
      }
      int row = m0 + rl;
      bf16* q = p.Qa() + (size_t)(row * 4 + hd) * 192 + part * 64;
      q[lq] = f2bf(x1); q[32 + lq] = f2bf(x2);
    }
  }
}

DI void epi_kv(const P& p, int m0, int n0, f32x16 (&acc)[2][2], const float* sRow, bool cache) {
  const int tid_ = tidx(); const int lane = tid_ & 63, w = wave_of(tid_), wm = w >> 1, wn = w & 1, lq = lane & 31, h = lane >> 5;
  const int mb = m0 + wm * 64, nb = n0 + wn * 64;
  const int cb = nb >> 6, hd = cb >> 2, part = cb & 3;
  TokInfo tb = tinfo(mb);
#pragma unroll
  for (int i = 0; i < 2; ++i)
#pragma unroll
    for (int j = 0; j < 2; ++j)
#pragma unroll
      for (int g = 0; g < 4; ++g) {
        float v[4];
#pragma unroll
        for (int jj = 0; jj < 4; ++jj) {
          int rl = wm * 64 + i * 32 + 8 * g + 4 * h + jj;
          float rstd = cache ? 1.f : rsqrtf(sRow[rl] * (1.f / 256.f) + EPS);
          v[jj] = acc[i][j][4 * g + jj] * rstd;
        }
        int c = j * 32 + lq;
        int row0 = mb + i * 32 + 8 * g + 4 * h;
        if (part < 2) {
#pragma unroll
          for (int jj = 0; jj < 4; ++jj) {
            int row = row0 + jj;
            if (cache) {
              int lb = row >> 8, t = row & 255;
              p.cKa()[(size_t)((lb * 4 + hd) * 256 + t) * 192 + part * 64 + c] = f2bf(v[jj]);
            } else {
              p.Ka()[(size_t)(row * 4 + hd) * 192 + part * 64 + c] = f2bf(v[jj]);
            }
          }
        } else {
          int d = (part - 2) * 64 + c;
          if (cache) {
            int lb = row0 >> 8, t = row0 & 255;
            store_vt4(p.cVaT(), (size_t)((lb * 4 + hd) * 128 + d) * 256 + t, v[0], v[1], v[2], v[3]);
          } else {
            int tl = tb.t + i * 32 + 8 * g + 4 * h;
            store_vt4(p.VaT(), (size_t)tb.tok0 * 512 + (size_t)(hd * 128 + d) * tb.T + tl, v[0], v[1], v[2], v[3]);
          }
        }
      }
}

template <int JP>
DI void epi_qa_w(const P& p, int m0, int n0, f32x16 (&acc)[2][4], const float* sRow) {
  const int tid_ = tidx(); const int lane = tid_ & 63, w = wave_of(tid_), wm = w >> 1, wn = w & 1, lq = lane & 31, h = lane >> 5;
  const int mb = m0 + wm * 64;
  const int cb = (n0 >> 6) + 2 * wn + JP, hd = cb / 3, part = cb % 3;
  TokInfo tb = tinfo(mb);
  const bool dorope = tb.lat && part == 2;
#pragma unroll
  for (int i = 0; i < 2; ++i) {
    float cs[16], sn[16];
#pragma unroll
    for (int r = 0; r < 16; ++r) { cs[r] = 1.f; sn[r] = 0.f; }
    if (dorope) {
#pragma unroll
      for (int r = 0; r < 16; ++r) {
        int t = tb.t + i * 32 + 8 * (r >> 2) + 4 * h + (r & 3);
        cs[r] = p.ropec()[t * 32 + lq]; sn[r] = p.ropes()[t * 32 + lq];
      }
    }
#pragma unroll
    for (int r = 0; r < 16; ++r) {
      int rl = wm * 64 + i * 32 + 8 * (r >> 2) + 4 * h + (r & 3);
      float rstd = rsqrtf(sRow[rl] * (1.f / 384.f) + EPS);
      float x1 = acc[i][2 * JP][r] * rstd, x2 = acc[i][2 * JP + 1][r] * rstd;
      float y1 = x1 * cs[r] - x2 * sn[r], y2 = x1 * sn[r] + x2 * cs[r];
      int row = m0 + rl;
      bf16* q = p.Qa() + (size_t)(row * 4 + hd) * 192 + part * 64;
      q[lq] = f2bf(y1); q[32 + lq] = f2bf(y2);
    }
  }
}
template <int JP>
DI void epi_kv_w(const P& p, int m0, int n0, f32x16 (&acc)[2][4], const float* sRow) {
  const int tid_ = tidx(); const int lane = tid_ & 63, w = wave_of(tid_), wm = w >> 1, wn = w & 1, lq = lane & 31, h = lane >> 5;
  const int mb = m0 + wm * 64;
  const int cb = (n0 >> 6) + 2 * wn + JP, hd = cb >> 2, part = cb & 3;
  TokInfo tb = tinfo(mb);
#pragma unroll
  for (int i = 0; i < 2; ++i)
#pragma unroll
    for (int j = 0; j < 2; ++j)
#pragma unroll
      for (int g = 0; g < 4; ++g) {
        float v[4];
#pragma unroll
        for (int jj = 0; jj < 4; ++jj) {
          int rl = wm * 64 + i * 32 + 8 * g + 4 * h + jj;
          float rstd = rsqrtf(sRow[rl] * (1.f / 256.f) + EPS);
          v[jj] = acc[i][2 * JP + j][4 * g + jj] * rstd;
        }
        int c = j * 32 + lq;
        int row0 = mb + i * 32 + 8 * g + 4 * h;
        if (part < 2) {
#pragma unroll
          for (int jj = 0; jj < 4; ++jj) p.Ka()[(size_t)((row0 + jj) * 4 + hd) * 192 + part * 64 + c] = f2bf(v[jj]);
        } else {
          int d = (part - 2) * 64 + c;
          int tl = tb.t + i * 32 + 8 * g + 4 * h;
          store_vt4(p.VaT(), (size_t)tb.tok0 * 512 + (size_t)(hd * 128 + d) * tb.T + tl, v[0], v[1], v[2], v[3]);
        }
      }
}

DI void epi_out(const P& p, int l, int m0, int n0, f32x16 (&acc)[2][2]) {
  const int tid_ = tidx(); const int lane = tid_ & 63, w = wave_of(tid_), wm = w >> 1, wn = w & 1, lq = lane & 31, h = lane >> 5;
  const int mb = m0 + wm * 64, nb = n0 + wn * 64;
  TokInfo tb = tinfo(mb);
  const float* gate = p.mod() + (size_t)(l * 5 + tb.modj) * 3072 + 2048;
  const float* xsrc = (l == 0) ? (tb.lat ? p.x_sample - (size_t)4096 * 1024 : p.x_prompt) : (const float*)p.xbuf();
#pragma unroll
  for (int i = 0; i < 2; ++i)
#pragma unroll
    for (int j = 0; j < 2; ++j) {
      int col = nb + j * 32 + lq;
      float gv = gate[col];
      float xo[16];
#pragma unroll
      for (int r = 0; r < 16; ++r) {
        int row = mb + i * 32 + 8 * (r >> 2) + 4 * h + (r & 3);
        xo[r] = xsrc[(size_t)row * 1024 + col];
      }
#pragma unroll
      for (int r = 0; r < 16; ++r) {
        int row = mb + i * 32 + 8 * (r >> 2) + 4 * h + (r & 3);
        p.xbuf()[(size_t)row * 1024 + col] = xo[r] + gv * acc[i][j][r];
      }
    }
}

template <int KW, int DQ, int KSPLIT>
DI void attn_pass(const bf16* __restrict__ qptr, int koff, int kh, const bf16* __restrict__ Kmain, int ldk, int Tmain,
                  const bf16* __restrict__ Kc, int ldkc, int Tc, const bf16* __restrict__ VTmain,
                  const bf16* __restrict__ VTc, float c, char* smem, f32x16 (&o)[4], float& lsum, float& m_out) {
  constexpr int KS = KW + 8;
  constexpr int NKB = 2 / KSPLIT;
  bf16* sK = (bf16*)smem;
  bf16* sV = sK + 64 * KS;
  const int tid = tidx(), lane = tid & 63, lq = lane & 31, h = lane >> 5;
  constexpr bool QLDS = (KSPLIT == 2);
  constexpr int QS = DQ + 8;
  bf16* sQ = sV + 128 * 72;
  bf16x8 qf[QLDS ? 1 : DQ / 16];
  if (QLDS) {
    constexpr int QCH = DQ / 8;
#pragma unroll
    for (int i = 0; i < 64 * QCH / 256; ++i) {
      int idx = tid + 256 * i; int r = idx / QCH, cc = idx % QCH;
      *(u32x4*)(sQ + r * QS + cc * 8) = *(const u32x4*)(qptr + (size_t)r * 768 + cc * 8);
    }
  } else {
#pragma unroll
    for (int ks = 0; ks < DQ / 16; ++ks) qf[ks] = *(const bf16x8*)(qptr + ks * 16 + h * 8);
  }
  const bf16* sQl = sQ + (((wave_of(tid) & 1) * 32) + lq) * QS + h * 8;
#pragma unroll
  for (int db = 0; db < 4; ++db)
#pragma unroll
    for (int r = 0; r < 16; ++r) o[db][r] = 0.f;
  lsum = 0.f;
  float m_run = -INFINITY;
  const int nt = (Tmain + Tc) >> 6;
  constexpr int CH = KW / 8, NKL = 64 * CH / 256;
  u32x4 kr[NKL], vr[4];
  auto issue = [&](int kt) {
    const bf16* ksrc; int ld; const bf16* vsrc; int ldv;
    if (kt * 64 < Tmain) { ksrc = Kmain + (size_t)(kt * 64) * ldk; ld = ldk; vsrc = VTmain + kt * 64; ldv = Tmain; }
    else { ksrc = Kc + (size_t)(kt * 64 - Tmain) * ldkc; ld = ldkc; vsrc = VTc + (kt * 64 - Tmain); ldv = Tc; }
#pragma unroll
    for (int i = 0; i < NKL; ++i) {
      int idx = tid + 256 * i; int r = idx / CH, cc = idx % CH;
      kr[i] = *(const u32x4*)(ksrc + (size_t)r * ld + cc * 8);
    }
#pragma unroll
    for (int i = 0; i < 4; ++i) {
      int idx = tid + 256 * i; int r = idx >> 3, cc = idx & 7;
      vr[i] = *(const u32x4*)(vsrc + (size_t)r * ldv + cc * 8);
    }
  };
  issue(0);
  for (int kt = 0; kt < nt; ++kt) {
    __syncthreads();
#pragma unroll
    for (int i = 0; i < NKL; ++i) {
      int idx = tid + 256 * i; int r = idx / CH, cc = idx % CH;
      *(u32x4*)(sK + r * KS + cc * 8) = kr[i];
    }
#pragma unroll
    for (int i = 0; i < 4; ++i) {
      int idx = tid + 256 * i; int r = idx >> 3, cc = idx & 7;
      *(u32x4*)(sV + r * 72 + cc * 8) = vr[i];
    }
    __syncthreads();
    issue((kt + 1 < nt) ? kt + 1 : kt);
    f32x16 s[NKB];
#pragma unroll
    for (int kbi = 0; kbi < NKB; ++kbi)
#pragma unroll
      for (int r = 0; r < 16; ++r) s[kbi][r] = 0.f;
#pragma unroll
    for (int ks = 0; ks < DQ / 16; ++ks)
#pragma unroll
      for (int kbi = 0; kbi < NKB; ++kbi) {
        const int kb = (KSPLIT == 2) ? kh : kbi;
        bf16x8 a = *(const bf16x8*)(sK + (kb * 32 + lq) * KS + koff + ks * 16 + h * 8);
        s[kbi] = MFMA(a, QLDS ? *(const bf16x8*)(sQl + ks * 16) : qf[QLDS ? 0 : ks], s[kbi]);
      }
    float mx = -INFINITY;
#pragma unroll
    for (int kbi = 0; kbi < NKB; ++kbi)
#pragma unroll
      for (int r = 0; r < 16; ++r) mx = fmaxf(mx, s[kbi][r]);
    mx = fmaxf(mx, __shfl_xor(mx, 32));
    const float m_new = fmaxf(m_run, mx);
    const float alpha = fexp2((m_run - m_new) * c);
    m_run = m_new;
    lsum *= alpha;
#pragma unroll
    for (int db = 0; db < 4; ++db)
#pragma unroll
      for (int r = 0; r < 16; ++r) o[db][r] *= alpha;
    const float mc = m_new * c;
#pragma unroll
    for (int kbi = 0; kbi < NKB; ++kbi)
#pragma unroll
      for (int r = 0; r < 16; ++r) { float pv = fexp2(s[kbi][r] * c - mc); s[kbi][r] = pv; lsum += pv; }
#pragma unroll
    for (int kbi = 0; kbi < NKB; ++kbi) {
      const int kb = (KSPLIT == 2) ? kh : kbi;
#pragma unroll
      for (int s2 = 0; s2 < 2; ++s2) {
        u32x4 pk;
#pragma unroll
        for (int e = 0; e < 4; ++e) pk[e] = pack2(s[kbi][8 * s2 + 2 * e], s[kbi][8 * s2 + 2 * e + 1]);
        bf16x8 pb = __builtin_bit_cast(bf16x8, pk);
#pragma unroll
        for (int db = 0; db < 4; ++db) {
          const bf16* vp = sV + (db * 32 + lq) * 72 + kb * 32 + s2 * 16 + 4 * h;
          u32x2 lo = *(const u32x2*)vp, hi = *(const u32x2*)(vp + 8);
          u32x4 av; av[0] = lo[0]; av[1] = lo[1]; av[2] = hi[0]; av[3] = hi[1];
          o[db] = MFMA(__builtin_bit_cast(bf16x8, av), pb, o[db]);
        }
      }
    }
  }
  lsum += __shfl_xor(lsum, 32);
  m_out = m_run;
}

DI void mla_item(const P& p, int l, int it, char* smem) {
  const int tid = tidx(), lane = tid & 63, w = wave_of(tid), lq = lane & 31, h = lane >> 5;
  int lat, b, hd, qb;
  if (it < 256) { lat = 1; b = it >> 6; hd = (it >> 4) & 3; qb = it & 15; }
  else { int u = it - 256; lat = 0; b = u >> 4; hd = (u >> 2) & 3; qb = u & 3; }
  const int T = lat ? 1024 : 256, tok0 = lat ? 4096 + b * 1024 : b * 256;
  const int qsub = w & 1, kh = w >> 1;
  const int tok = tok0 + qb * 64 + qsub * 32 + lq;
  f32x16 o[4]; float lsum, mrun;
  const float c = 0.07216878364870322f * 1.4426950408889634f;
  attn_pass<192, 192, 2>(p.Qa() + (size_t)((tok0 + qb * 64) * 4 + hd) * 192, 0, kh, p.Ka() + (size_t)(tok0 * 4 + hd) * 192, 768, T,
                 p.cKa() + (size_t)((l * 4 + b) * 4 + hd) * 256 * 192, 192, lat ? 256 : 0,
                 p.VaT() + (size_t)tok0 * 512 + (size_t)hd * 128 * T, p.cVaT() + (size_t)((l * 4 + b) * 4 + hd) * 128 * 256, c, smem, o, lsum, mrun);
  float* ex = (float*)smem;
  float* exm = ex + 2 * 128 * 32;
  float* exl = exm + 64;
  __syncthreads();
  if (kh == 1) {
#pragma unroll
    for (int db = 0; db < 4; ++db)
#pragma unroll
      for (int r = 0; r < 16; ++r) {
        int dv = db * 32 + 8 * (r >> 2) + 4 * h + (r & 3);
        ex[(qsub * 128 + dv) * 32 + lq] = o[db][r];
      }
    if (h == 0) { exm[qsub * 32 + lq] = mrun; exl[qsub * 32 + lq] = lsum; }
  }
  __syncthreads();
  if (kh == 0) {
    const float m1 = exm[qsub * 32 + lq], l1 = exl[qsub * 32 + lq];
    const float mm = fmaxf(mrun, m1);
    const float f0 = fexp2((mrun - mm) * c), f1 = fexp2((m1 - mm) * c);
    const float inv = 1.f / (lsum * f0 + l1 * f1);
    const float g0 = f0 * inv, g1 = f1 * inv;
    u32x2 zz[4][4];
#pragma unroll
    for (int db = 0; db < 4; ++db)
#pragma unroll
      for (int g = 0; g < 4; ++g) zz[db][g] = *(const u32x2*)(p.proj() + (size_t)tok * NPROJ + 704 + hd * 128 + db * 32 + 8 * g + 4 * h);
#pragma unroll
    for (int db = 0; db < 4; ++db)
#pragma unroll
      for (int g = 0; g < 4; ++g) {
        int dv = db * 32 + 8 * g + 4 * h;
        float ov4[4];
#pragma unroll
        for (int jj = 0; jj < 4; ++jj) ov4[jj] = o[db][4 * g + jj] * g0 + ex[(qsub * 128 + dv + jj) * 32 + lq] * g1;
        u32x2 z = zz[db][g];
        float z0 = bflo(z[0]), z1 = bfhi(z[0]), z2 = bflo(z[1]), z3 = bfhi(z[1]);
        u32x2 ov;
        ov[0] = pack2(ov4[0] * silu_f(z0), ov4[1] * silu_f(z1));
        ov[1] = pack2(ov4[2] * silu_f(z2), ov4[3] * silu_f(z3));
        *(u32x2*)(p.ycat() + (size_t)tok * 1536 + hd * 128 + dv) = ov;
      }
  }
}

DI void diff_item(const P& p, int l, int it, char* smem) {
  const int tid = tidx(), lane = tid & 63, w = wave_of(tid), lq = lane & 31, h = lane >> 5;
  int lat, b, hd, qb;
  if (it < 256) { lat = 1; b = it >> 6; hd = (it >> 4) & 3; qb = it & 15; }
  else { int u = it - 256; lat = 0; b = u >> 4; hd = (u >> 2) & 3; qb = u & 3; }
  const int T = lat ? 1024 : 256, tok0 = lat ? 4096 + b * 1024 : b * 256;
  const int map = w >> 1, qsub = w & 1;
  const int tok = tok0 + qb * 64 + qsub * 32 + lq;
  const float c = 0.125f * 1.4426950408889634f;
  const bf16* vt = p.VbT() + (size_t)tok0 * 512 + (size_t)hd * 128 * T;
  const bf16* vtc = p.cVbT() + (size_t)((l * 4 + b) * 4 + hd) * 128 * 256;
  const bf16* kc = p.cKb() + (size_t)((l * 4 + b) * 4 + hd) * 256 * 128;
  f32x16 o[4]; float ls, mdummy;
  attn_pass<128, 64, 1>(p.proj() + (size_t)tok * NPROJ + 1216 + hd * 128 + map * 64, map * 64, 0, p.Kb() + (size_t)(tok0 * 4 + hd) * 128, 512, T, kc, 128,
                     lat ? 256 : 0, vt, vtc, c, smem, o, ls, mdummy);
  float* ex = (float*)smem;
  __syncthreads();
  if (map == 1) {
    const float sc2 = p.lam()[l] / ls;
#pragma unroll
    for (int db = 0; db < 4; ++db)
#pragma unroll
      for (int r = 0; r < 16; ++r) {
        int dv = db * 32 + 8 * (r >> 2) + 4 * h + (r & 3);
        ex[(qsub * 128 + dv) * 32 + lq] = o[db][r] * sc2;
      }
  }
  __syncthreads();
  if (map == 0) {
    const float i1 = 1.f / ls;
    float ss = 0.f;
#pragma unroll
    for (int db = 0; db < 4; ++db)
#pragma unroll
      for (int r = 0; r < 16; ++r) {
        int dv = db * 32 + 8 * (r >> 2) + 4 * h + (r & 3);
        float v = o[db][r] * i1 - ex[(qsub * 128 + dv) * 32 + lq];
        o[db][r] = v; ss += v * v;
      }
    ss += __shfl_xor(ss, 32);
    const float lam_init = 0.8f - 0.6f * fexp(-0.3f * (float)l);
    const float sc = rsqrtf(ss * (1.f / 128.f) + EPS) * (1.f - lam_init);
#pragma unroll
    for (int db = 0; db < 4; ++db) {
      u32x2 zz[4]; f32x4 gg[4];
#pragma unroll
      for (int g = 0; g < 4; ++g) {
        int dv = db * 32 + 8 * g + 4 * h;
        zz[g] = *(const u32x2*)(p.proj() + (size_t)tok * NPROJ + 2752 + hd * 128 + dv);
        gg[g] = *(const f32x4*)(p.dnorm + l * 128 + dv);
      }
#pragma unroll
      for (int g = 0; g < 4; ++g) {
        int dv = db * 32 + 8 * g + 4 * h;
        u32x2 z = zz[g];
        f32x4 gn = gg[g];
        float z0 = bflo(z[0]), z1 = bfhi(z[0]), z2 = bflo(z[1]), z3 = bfhi(z[1]);
        u32x2 ov;
        ov[0] = pack2(o[db][4 * g] * sc * gn[0] * silu_f(z0), o[db][4 * g + 1] * sc * gn[1] * silu_f(z1));
        ov[1] = pack2(o[db][4 * g + 2] * sc * gn[2] * silu_f(z2), o[db][4 * g + 3] * sc * gn[3] * silu_f(z3));
        *(u32x2*)(p.ycat() + (size_t)tok * 1536 + 512 + hd * 128 + dv) = ov;
      }
    }
  }
}

DI void conv8(const P& p, int l, int tok, int t, int T, int col, int wcol, float (&o)[8]) {
  const bf16* base = p.proj() + (size_t)tok * NPROJ + col;
  u32x4 cur = *(const u32x4*)base;
  u32x4 prv = {0u, 0u, 0u, 0u}, nxt = {0u, 0u, 0u, 0u};
  if (t > 0) prv = *(const u32x4*)(base - NPROJ);
  if (t < T - 1) nxt = *(const u32x4*)(base + NPROJ);
  const float* w0 = p.mconv + (size_t)l * 3 * 1024 + wcol;
  f32x4 wa0 = *(const f32x4*)w0, wa1 = *(const f32x4*)(w0 + 4);
  f32x4 wb0 = *(const f32x4*)(w0 + 1024), wb1 = *(const f32x4*)(w0 + 1028);
  f32x4 wc0 = *(const f32x4*)(w0 + 2048), wc1 = *(const f32x4*)(w0 + 2052);
#pragma unroll
  for (int e = 0; e < 4; ++e) {
    float wA0 = e < 2 ? wa0[2 * e] : wa1[2 * e - 4], wA1 = e < 2 ? wa0[2 * e + 1] : wa1[2 * e - 3];
    float wB0 = e < 2 ? wb0[2 * e] : wb1[2 * e - 4], wB1 = e < 2 ? wb0[2 * e + 1] : wb1[2 * e - 3];
    float wC0 = e < 2 ? wc0[2 * e] : wc1[2 * e - 4], wC1 = e < 2 ? wc0[2 * e + 1] : wc1[2 * e - 3];
    float v0 = wA0 * bflo(prv[e]) + wB0 * bflo(cur[e]) + wC0 * bflo(nxt[e]);
    float v1 = wA1 * bfhi(prv[e]) + wB1 * bfhi(cur[e]) + wC1 * bfhi(nxt[e]);
    o[2 * e] = silu_f(v0); o[2 * e + 1] = silu_f(v1);
  }
}

DI float wave_incl_scan_add(float v, int lane) {
#pragma unroll
  for (int o = 1; o < 64; o <<= 1) { float t = __shfl_up(v, o); if (lane >= o) v += t; }
  return v;
}
DI float wave_incl_scan_max(float v, int lane) {
#pragma unroll
  for (int o = 1; o < 64; o <<= 1) { float t = __shfl_up(v, o); if (lane >= o) v = fmaxf(v, t); }
  return v;
}

DI void mlstm_local(const P& p, int l, int slot, char* smem) {
  bf16* vT = (bf16*)smem;
  bf16* kT = vT + 128 * 72;
  float* wbuf = (float*)(kT + 128 * 72);
  const int tid = tidx(), lane = tid & 63, w = wave_of(tid), lq = lane & 31, h = lane >> 5;
  const int cp = slot >> 3, hd = (slot >> 1) & 3, dir = slot & 1;
  const int ctok = cp * 64;
  TokInfo ti = tinfo(ctok);
  const int T = ti.T;
  if (w == 0) {
    const int s = dir ? 63 - lane : lane;
    const int tk = ctok + s;
    const float ig = p.gates()[tk * 16 + dir * 8 + hd];
    const float lf = logsig_f(p.gates()[tk * 16 + dir * 8 + 4 + hd]);
    const float bc = wave_incl_scan_add(lf, lane);
    const float b_last = __shfl(bc, 63);
    const float val = b_last - bc + ig;
    float mx = val;
#pragma unroll
    for (int o = 32; o >= 1; o >>= 1) mx = fmaxf(mx, __shfl_xor(mx, o));
    wbuf[s] = fexp(val - mx);
    if (lane == 0) { p.blA()[slot] = b_last; p.mlA()[slot] = mx; }
  }
  __syncthreads();
  {
    const int s = tid >> 2, chb = (tid & 3) * 32;
    const float ws = wbuf[s];
#pragma unroll 1
    for (int q = 0; q < 4; ++q) {
      float kv[8];
      const int ch = chb + q * 8;
      conv8(p, l, ctok + s, ti.t + s, T, 3776 + hd * 128 + ch, 512 + hd * 128 + ch, kv);
#pragma unroll
      for (int e = 0; e < 8; ++e) kT[(ch + e) * 72 + s] = f2bf(kv[e] * ws);
    }
    const bf16* vsrc = p.VmT() + (size_t)ti.tok0 * 512 + (size_t)hd * 128 * T + ti.t;
#pragma unroll
    for (int i = 0; i < 4; ++i) {
      int idx = tid + 256 * i; int r = idx >> 3, cc = idx & 7;
      *(u32x4*)(vT + r * 72 + cc * 8) = *(const u32x4*)(vsrc + (size_t)r * T + cc * 8);
    }
  }
  __syncthreads();
  f32x16 acc[4];
#pragma unroll
  for (int cb = 0; cb < 4; ++cb)
#pragma unroll
    for (int r = 0; r < 16; ++r) acc[cb][r] = 0.f;
#pragma unroll
  for (int ks = 0; ks < 4; ++ks) {
    bf16x8 a = *(const bf16x8*)(vT + (32 * w + lq) * 72 + ks * 16 + 8 * h);
#pragma unroll
    for (int cb = 0; cb < 4; ++cb) {
      bf16x8 bb = *(const bf16x8*)(kT + (32 * cb + lq) * 72 + ks * 16 + 8 * h);
      acc[cb] = MFMA(a, bb, acc[cb]);
    }
  }
  bf16* cs = p.Cst() + (size_t)slot * 16384;
#pragma unroll
  for (int cb = 0; cb < 4; ++cb)
#pragma unroll
    for (int r = 0; r < 16; ++r) {
      int dvv = 32 * w + 8 * (r >> 2) + 4 * h + (r & 3);
      cs[dvv * 128 + 32 * cb + lq] = f2bf(acc[cb][r]);
    }
  if (tid < 128) {
    float sum = 0.f;
#pragma unroll
    for (int q = 0; q < 8; ++q) {
      u32x4 v = *(const u32x4*)(kT + tid * 72 + q * 8);
#pragma unroll
      for (int e = 0; e < 4; ++e) sum += bflo(v[e]) + bfhi(v[e]);
    }
    p.nst()[slot * 128 + tid] = sum;
  }
}

DI void mlstm_scan(const P& p, int l, int it) {
  const int tid = tidx();
  const int ch = it >> 2, qt = it & 3;
  int lat, b, hd, dir;
  if (ch < 32) { lat = 1; b = ch >> 3; hd = (ch >> 1) & 3; dir = ch & 1; }
  else { int u = ch - 32; lat = 0; b = u >> 3; hd = (u >> 1) & 3; dir = u & 1; }
  const int T = lat ? 1024 : 256, tok0 = lat ? 4096 + b * 1024 : b * 256, nc = T >> 6;
  const int dv0 = 32 * qt + 4 * (tid >> 5), dk0 = 4 * (tid & 31);
  float C[4][4];
  float n_val = 0.f, m_prev = 0.f;
  const bool do_n = (qt == 0) && (tid < 128);
  const size_t sidx = (size_t)((b * 4 + l) * 2 + dir) * 4 + hd;
  if (lat) {
    const float* C0 = p.st_C + sidx * 16384;
#pragma unroll
    for (int j = 0; j < 4; ++j) {
      f32x4 v = *(const f32x4*)(C0 + (size_t)(dk0 + j) * 128 + dv0);
      C[0][j] = v[0]; C[1][j] = v[1]; C[2][j] = v[2]; C[3][j] = v[3];
    }
    if (do_n) n_val = p.st_n[sidx * 128 + tid];
    m_prev = p.st_m[sidx];
  } else {
#pragma unroll
    for (int i = 0; i < 4; ++i)
#pragma unroll
      for (int j = 0; j < 4; ++j) C[i][j] = 0.f;
  }
  u32x2 dnx[4]; float blx, mlx, dnnx = 0.f;
  {
    const int c = dir ? nc - 1 : 0;
    const int slot = ((((tok0 >> 6) + c) * 4 + hd) * 2) + dir;
    const bf16* cs = p.Cst() + (size_t)slot * 16384 + dv0 * 128 + dk0;
#pragma unroll
    for (int i = 0; i < 4; ++i) dnx[i] = *(const u32x2*)(cs + i * 128);
    blx = p.blA()[slot]; mlx = p.mlA()[slot];
    if (do_n) dnnx = p.nst()[slot * 128 + tid];
  }
  for (int ci = 0; ci < nc; ++ci) {
    const int c = dir ? nc - 1 - ci : ci;
    const int slot = ((((tok0 >> 6) + c) * 4 + hd) * 2) + dir;
    bf16* cs = p.Cst() + (size_t)slot * 16384 + dv0 * 128 + dk0;
    u32x2 d[4];
#pragma unroll
    for (int i = 0; i < 4; ++i) d[i] = dnx[i];
    const float bl = blx, ml = mlx;
    const float dn = dnnx;
    {
      const int cn = (ci + 1 < nc) ? (dir ? nc - 2 - ci : ci + 1) : c;
      const int sn = ((((tok0 >> 6) + cn) * 4 + hd) * 2) + dir;
      const bf16* csn = p.Cst() + (size_t)sn * 16384 + dv0 * 128 + dk0;
#pragma unroll
      for (int i = 0; i < 4; ++i) dnx[i] = *(const u32x2*)(csn + i * 128);
      blx = p.blA()[sn]; mlx = p.mlA()[sn];
      if (do_n) dnnx = p.nst()[sn * 128 + tid];
    }
#pragma unroll
    for (int i = 0; i < 4; ++i) {
      u32x2 o; o[0] = pack2(C[i][0], C[i][1]); o[1] = pack2(C[i][2], C[i][3]);
      *(u32x2*)(cs + i * 128) = o;
    }
    if (do_n) p.nst()[slot * 128 + tid] = n_val;
    if (qt == 0 && tid == 0) p.mst()[slot] = m_prev;
    const float m_new = fmaxf(bl + m_prev, ml);
    const float a = fexp(bl + m_prev - m_new), bs = fexp(ml - m_new);
#pragma unroll
    for (int i = 0; i < 4; ++i) {
      C[i][0] = a * C[i][0] + bs * bflo(d[i][0]); C[i][1] = a * C[i][1] + bs * bfhi(d[i][0]);
      C[i][2] = a * C[i][2] + bs * bflo(d[i][1]); C[i][3] = a * C[i][3] + bs * bfhi(d[i][1]);
    }
    n_val = a * n_val + bs * dn;
    m_prev = m_new;
  }
  if (!lat) {
    float* Co = p.out + O_MC + sidx * 16384;
#pragma unroll
    for (int j = 0; j < 4; ++j) {
      f32x4 v; v[0] = C[0][j]; v[1] = C[1][j]; v[2] = C[2][j]; v[3] = C[3][j];
      *(f32x4*)(Co + (size_t)(dk0 + j) * 128 + dv0) = v;
    }
    if (do_n) p.out[O_MN + sidx * 128 + tid] = n_val;
    if (qt == 0 && tid == 0) p.out[O_MM + sidx] = m_prev;
  }
}

DI void mlstm_out(const P& p, int l, int it, char* smem) {
  bf16* sq = (bf16*)smem;
  bf16* sk = sq + 64 * 136;
  bf16* vT = sk + 64 * 136;
  float* bcA2 = (float*)(vT + 128 * 72);
  float* uA2 = bcA2 + 128, *mtA2 = uA2 + 128, *nA2 = mtA2 + 128  , *ssb = nA2 + 256  ;
  const int tid = tidx(), lane = tid & 63, w = wave_of(tid), lq = lane & 31, h = lane >> 5;
  const int cp = it >> 2, hd = it & 3;
  const int ctok = cp * 64;
  TokInfo ti = tinfo(ctok);
  const int T = ti.T;
  const float m_prev0 = p.mst()[(cp * 4 + hd) * 2], m_prev1 = p.mst()[(cp * 4 + hd) * 2 + 1];
  if (w < 2) {
    const int dir = w;
    const float m_prev = dir ? m_prev1 : m_prev0;
    const int s = dir ? 63 - lane : lane;
    const int tk = ctok + s;
    const float ig = p.gates()[tk * 16 + dir * 8 + hd];
    const float lf = logsig_f(p.gates()[tk * 16 + dir * 8 + 4 + hd]);
    const float bc = wave_incl_scan_add(lf, lane);
    const float u = ig - bc;
    const float pm = wave_incl_scan_max(u, lane);
    bcA2[dir * 64 + s] = bc; uA2[dir * 64 + s] = u; mtA2[dir * 64 + s] = bc + fmaxf(m_prev, pm);
  } else {
    const int dir = w - 2;
    const int slot = (cp * 4 + hd) * 2 + dir;
    nA2[dir * 128 + lane] = p.nst()[slot * 128 + lane];
    nA2[dir * 128 + 64 + lane] = p.nst()[slot * 128 + 64 + lane];
  }
  {
    const int s = tid >> 2, chb = (tid & 3) * 32;
#pragma unroll 2
    for (int q = 0; q < 4; ++q) {
      const int ch = chb + q * 8;
      float v[8];
      conv8(p, l, ctok + s, ti.t + s, T, 3264 + hd * 128 + ch, hd * 128 + ch, v);
      u32x4 pk;
#pragma unroll
      for (int e = 0; e < 4; ++e) pk[e] = pack2(v[2 * e] * 0.08838834764831845f, v[2 * e + 1] * 0.08838834764831845f);
      *(u32x4*)(sq + s * 136 + ch) = pk;
      conv8(p, l, ctok + s, ti.t + s, T, 3776 + hd * 128 + ch, 512 + hd * 128 + ch, v);
#pragma unroll
      for (int e = 0; e < 4; ++e) pk[e] = pack2(v[2 * e], v[2 * e + 1]);
      *(u32x4*)(sk + s * 136 + ch) = pk;
    }
    const bf16* vsrc = p.VmT() + (size_t)ti.tok0 * 512 + (size_t)hd * 128 * T + ti.t;
#pragma unroll
    for (int i = 0; i < 4; ++i) {
      int idx = tid + 256 * i; int r = idx >> 3, cc = idx & 7;
      *(u32x4*)(vT + r * 72 + cc * 8) = *(const u32x4*)(vsrc + (size_t)r * T + cc * 8);
    }
  }
  __syncthreads();
  const int tb = w & 1, dvh = w >> 1;
  const int t = 32 * tb + lq;
  f32x16 hacc[2];
#pragma unroll
  for (int d2 = 0; d2 < 2; ++d2)
#pragma unroll
    for (int r = 0; r < 16; ++r) hacc[d2][r] = 0.f;
  const bf16* sqt = sq + t * 136 + 8 * h;
  for (int dir = 0; dir < 2; ++dir) {
    const int slot = (cp * 4 + hd) * 2 + dir;
    const float m_prev = dir ? m_prev1 : m_prev0;
    const float* bcA = bcA2 + dir * 64;
    const float* uA = uA2 + dir * 64;
    const float* mtA = mtA2 + dir * 64;
    const float* nA = nA2 + dir * 128;
    const float bc_t = bcA[t], mt = mtA[t];
    const float w_inter = fexp(bc_t + m_prev - mt);
    float den = 0.f;
    const float e0 = bc_t - mt;
    u32x4 pk[2][2];
#pragma unroll
    for (int sb = 0; sb < 2; ++sb) {
      asm volatile("" ::: "memory");
      f32x16 sv;
#pragma unroll
      for (int r = 0; r < 16; ++r) sv[r] = 0.f;
#pragma unroll
      for (int ks = 0; ks < 8; ++ks) {
        bf16x8 a = *(const bf16x8*)(sk + (32 * sb + lq) * 136 + ks * 16 + 8 * h);
        sv = MFMA(a, *(const bf16x8*)(sqt + ks * 16), sv);
      }
#pragma unroll
      for (int r = 0; r < 16; ++r) {
        const int sidx = 32 * sb + 8 * (r >> 2) + 4 * h + (r & 3);
        const bool valid = dir ? (sidx >= t) : (sidx <= t);
        const float wgt = valid ? fexp(e0 + uA[sidx]) : 0.f;
        const float v = sv[r] * wgt;
        sv[r] = v; den += v;
      }
#pragma unroll
      for (int s2 = 0; s2 < 2; ++s2)
#pragma unroll
        for (int e = 0; e < 4; ++e) pk[sb][s2][e] = pack2(sv[8 * s2 + 2 * e], sv[8 * s2 + 2 * e + 1]);
    }
    asm volatile("" ::: "memory");
    den += __shfl_xor(den, 32);
    float qn = 0.f;
#pragma unroll
    for (int ks = 0; ks < 8; ++ks) {
      u32x4 qv = *(const u32x4*)(sqt + ks * 16);
#pragma unroll
      for (int e = 0; e < 4; ++e) {
        qn += bflo(qv[e]) * nA[ks * 16 + 8 * h + 2 * e] + bfhi(qv[e]) * nA[ks * 16 + 8 * h + 2 * e + 1];
      }
    }
    qn += __shfl_xor(qn, 32);
    den += w_inter * qn;
    asm volatile("" ::: "memory");
    const float rden = 1.f / fmaxf(fabsf(den), fexp(-mt));
    const bf16* cs = p.Cst() + (size_t)slot * 16384;
    bf16x8 cfa[2][8];
#pragma unroll
    for (int d2 = 0; d2 < 2; ++d2)
#pragma unroll
      for (int ks = 0; ks < 8; ++ks) cfa[d2][ks] = *(const bf16x8*)(cs + ((2 * dvh + d2) * 32 + lq) * 128 + ks * 16 + 8 * h);
    asm volatile("" : "+v"(cfa[0][0]), "+v"(cfa[0][1]), "+v"(cfa[0][2]), "+v"(cfa[0][3]), "+v"(cfa[0][4]), "+v"(cfa[0][5]), "+v"(cfa[0][6]), "+v"(cfa[0][7]),
                      "+v"(cfa[1][0]), "+v"(cfa[1][1]), "+v"(cfa[1][2]), "+v"(cfa[1][3]), "+v"(cfa[1][4]), "+v"(cfa[1][5]), "+v"(cfa[1][6]), "+v"(cfa[1][7]));
#pragma unroll
    for (int d2 = 0; d2 < 2; ++d2) {
      const int dvb = 2 * dvh + d2;
      f32x16 acc;
#pragma unroll
      for (int r = 0; r < 16; ++r) acc[r] = 0.f;
#pragma unroll
      for (int ks = 0; ks < 8; ++ks) acc = MFMA(cfa[d2][ks], *(const bf16x8*)(sqt + ks * 16), acc);
#pragma unroll
      for (int r = 0; r < 16; ++r) acc[r] *= w_inter;
#pragma unroll
      for (int sb = 0; sb < 2; ++sb)
#pragma unroll
        for (int s2 = 0; s2 < 2; ++s2) {
          const bf16* vp = vT + (dvb * 32 + lq) * 72 + sb * 32 + s2 * 16 + 4 * h;
          u32x2 lo = *(const u32x2*)vp, hi = *(const u32x2*)(vp + 8);
          u32x4 av; av[0] = lo[0]; av[1] = lo[1]; av[2] = hi[0]; av[3] = hi[1];
          acc = MFMA(__builtin_bit_cast(bf16x8, av), __builtin_bit_cast(bf16x8, pk[sb][s2]), acc);
        }
#pragma unroll
      for (int r = 0; r < 16; ++r) hacc[d2][r] += acc[r] * rden;
    }
  }
  const int tok = ctok + t;
  float ss = 0.f;
#pragma unroll
  for (int d2 = 0; d2 < 2; ++d2)
#pragma unroll
    for (int g = 0; g < 4; ++g) {
      int dv = (2 * dvh + d2) * 32 + 8 * g + 4 * h;
      u32x2 mo = *(const u32x2*)(p.proj() + (size_t)tok * NPROJ + 4800 + hd * 128 + dv);
      float m0 = bflo(mo[0]), m1 = bfhi(mo[0]), m2 = bflo(mo[1]), m3 = bfhi(mo[1]);
      float v0 = hacc[d2][4 * g] * sigmoid_f(m0), v1 = hacc[d2][4 * g + 1] * sigmoid_f(m1);
      float v2 = hacc[d2][4 * g + 2] * sigmoid_f(m2), v3 = hacc[d2][4 * g + 3] * sigmoid_f(m3);
      hacc[d2][4 * g] = v0; hacc[d2][4 * g + 1] = v1; hacc[d2][4 * g + 2] = v2; hacc[d2][4 * g + 3] = v3;
      ss += v0 * v0 + v1 * v1 + v2 * v2 + v3 * v3;
    }
  ss += __shfl_xor(ss, 32);
  if (h == 0) ssb[dvh * 64 + t] = ss;
  __syncthreads();
  const float rstd = rsqrtf((ssb[t] + ssb[64 + t]) * (1.f / 128.f) + EPS);
  u32x2 zz[2][4]; f32x4 gg[2][4];
#pragma unroll
  for (int d2 = 0; d2 < 2; ++d2)
#pragma unroll
    for (int g = 0; g < 4; ++g) {
      int dv = (2 * dvh + d2) * 32 + 8 * g + 4 * h;
      zz[d2][g] = *(const u32x2*)(p.proj() + (size_t)tok * NPROJ + 5312 + hd * 128 + dv);
      gg[d2][g] = *(const f32x4*)(p.mnorm + l * 512 + hd * 128 + dv);
    }
#pragma unroll
  for (int d2 = 0; d2 < 2; ++d2)
#pragma unroll
    for (int g = 0; g < 4; ++g) {
      int dv = (2 * dvh + d2) * 32 + 8 * g + 4 * h;
      u32x2 z = zz[d2][g];
      f32x4 gn = gg[d2][g];
      float z0 = bflo(z[0]), z1 = bfhi(z[0]), z2 = bflo(z[1]), z3 = bfhi(z[1]);
      u32x2 ov;
      ov[0] = pack2(hacc[d2][4 * g] * rstd * gn[0] * silu_f(z0), hacc[d2][4 * g + 1] * rstd * gn[1] * silu_f(z1));
      ov[1] = pack2(hacc[d2][4 * g + 2] * rstd * gn[2] * silu_f(z2), hacc[d2][4 * g + 3] * rstd * gn[3] * silu_f(z3));
      *(u32x2*)(p.ycat() + (size_t)tok * 1536 + 1024 + hd * 128 + dv) = ov;
    }
}

DI void ckv_fin(const P& p, int l, int tok) {
  const int lane = tidx() & 63;
  const int b = tok >> 8, t = tok & 255;
  float* o = p.out + O_CKV + (size_t)((b * 4 + l) * 256 + t) * 256 + lane * 4;
  u32x2 raw = *(const u32x2*)(p.proj() + (size_t)tok * NPROJ + 384 + lane * 4);
  f32x4 v; v[0] = bflo(raw[0]); v[1] = bfhi(raw[0]); v[2] = bflo(raw[1]); v[3] = bfhi(raw[1]);
  float ss = v[0] * v[0] + v[1] * v[1] + v[2] * v[2] + v[3] * v[3];
#pragma unroll
  for (int of = 32; of >= 1; of >>= 1) ss += __shfl_xor(ss, of);
  const float rstd = rsqrtf(ss * (1.f / 256.f) + EPS);
  f32x4 g = *(const f32x4*)(p.kv_norm + l * 256 + lane * 4);
  v[0] *= rstd * g[0]; v[1] *= rstd * g[1]; v[2] *= rstd * g[2]; v[3] *= rstd * g[3];
  *(f32x4*)o = v;
}

#define XB_TMO      128
#define XB_XCNT(j)  (256  + 64 * (j))
#define XB_XSUB(j)  (1280 + 64 * (j))
#define XB_XGEN(j)  (2304 + 64 * (j))
#define XB_TOP      3328
#define XB_TOPGEN   3392
#define XCD_BAR_WORDS 3456
#define XB_SPIN_CAP (1u << 18)
#define LAS __attribute__((address_space(3)))

__device__ __forceinline__ unsigned xb_ld(unsigned* p)              { return __hip_atomic_load(p, __ATOMIC_RELAXED, __HIP_MEMORY_SCOPE_AGENT); }
__device__ __forceinline__ unsigned xb_add(unsigned* p, unsigned v) { return __hip_atomic_fetch_add(p, v, __ATOMIC_RELAXED, __HIP_MEMORY_SCOPE_AGENT); }
__device__ __forceinline__ unsigned xb_xcc_id() { return (unsigned)__builtin_amdgcn_s_getreg((3 << 11) | 20) & 0xFu; }
#define XB_SPIN(cond, bar) do { unsigned _sp = 0; while (cond) { __builtin_amdgcn_s_sleep(1); \
    if ((++_sp & 255u) == 0u) { if (xb_ld(&(bar)[XB_TMO])) break; if (_sp > XB_SPIN_CAP) { atomicAdd(&(bar)[XB_TMO], 1u); break; } } } } while (0)

struct XcdBarrier {
    unsigned* bar; unsigned x;
    volatile LAS unsigned* st;
};

__device__ __forceinline__ XcdBarrier xcd_barrier_post(unsigned* bar, volatile LAS unsigned* st) {
    XcdBarrier b; b.bar = bar; b.x = xb_xcc_id(); b.st = st;
    if (tidx() == 0) (void)xb_add(&bar[XB_XCNT(b.x)], 1u);
    return b;
}
__device__ __forceinline__ void xcd_barrier_complete(unsigned* bar, unsigned x, unsigned& nloc, unsigned& nx) {
    const unsigned G = gridDim.x * gridDim.y * gridDim.z;
    unsigned sum, cnt, mine, sp = 0u;
    for (;;) {
        sum = 0u; cnt = 0u; mine = 0u;
#pragma unroll
        for (unsigned j = 0; j < 16; ++j) { const unsigned c = xb_ld(&bar[XB_XCNT(j)]); sum += c; cnt += (c > 0u) ? 1u : 0u; mine = (j == x) ? c : mine; }
        if (sum == G) break;
        __builtin_amdgcn_s_sleep(1);
        if ((++sp & 255u) == 0u) { if (xb_ld(&bar[XB_TMO])) break; if (sp > XB_SPIN_CAP) { atomicAdd(&bar[XB_TMO], 1u); break; } }
    }
    nloc = mine > 0u ? mine : 1u; nx = cnt > 0u ? cnt : 1u;
}

__device__ __forceinline__ void xcd_barrier(const XcdBarrier& b) {
    asm volatile("s_waitcnt vmcnt(0)" ::: "memory");
    __syncthreads();
    if (tidx() == 0) {
        unsigned* bar = b.bar;
        __builtin_amdgcn_s_waitcnt(0);
        unsigned nloc = b.st[0], nx = b.st[1];
        if (nloc == 0u) { xcd_barrier_complete(bar, b.x, nloc, nx); b.st[0] = nloc; b.st[1] = nx; }
        const unsigned old = xb_add(&bar[XB_XSUB(b.x)], 1u);
        const unsigned gen = old / nloc;
        if (old + 1u == (gen + 1u) * nloc) {
            __builtin_amdgcn_fence(__ATOMIC_RELEASE, "agent");
            asm volatile("s_waitcnt vmcnt(0)" ::: "memory");
            const unsigned og = xb_add(&bar[XB_TOP], 1u);
            const unsigned tg = og / nx;
            if (og + 1u == (tg + 1u) * nx) xb_add(&bar[XB_TOPGEN], 1u);
            else XB_SPIN(xb_ld(&bar[XB_TOPGEN]) == tg, bar);
            __builtin_amdgcn_fence(__ATOMIC_ACQUIRE, "agent");
            xb_add(&bar[XB_XGEN(b.x)], 1u);
            asm volatile("s_waitcnt vmcnt(0)" ::: "memory");
        } else {
            XB_SPIN(xb_ld(&bar[XB_XGEN(b.x)]) == gen, bar);
            __builtin_amdgcn_fence(__ATOMIC_ACQUIRE, "agent");
            asm volatile("s_waitcnt vmcnt(0)" ::: "memory");
        }
    }
    __syncthreads();
}


DI P launder(const P& p) {
  P q = p;
#define LND(m) { asm volatile("" : "+s"(q.m)); q.m = (decltype(q.m))(__attribute__((address_space(1))) void*)(void*)q.m; }
  LND(x_prompt) LND(x_sample) LND(c_ckv) LND(c_krope) LND(c_dk) LND(c_dv) LND(st_C) LND(st_n) LND(st_m) LND(c) LND(c_ctx)
  LND(g_norm) LND(W_mod) LND(b_mod) LND(W_in) LND(q_norm) LND(W_uq) LND(kv_norm) LND(W_ukv) LND(dlam) LND(dnorm) LND(mconv)
  LND(mgb) LND(mnorm) LND(W_out) LND(g_final) LND(out) LND(ws)
#undef LND
  return q;
}

template <int KIND>
DI void run_phase(const P& p0, int ph, char* smem) {
  const P& p = p0;
  const int G = gridDim.x, B = blockIdx.x, w = wave_of(tidx());
  if ((KIND < 0 || KIND == 0) && ph == 0) { phase_prepass(p, smem); return; }
  if ((KIND < 0 || KIND == 1) && ph == 1) {
    for (int it = B; it < 256 + 2048; it += G) {
      if (it < 256) {
        int mt = it >> 3, nt = it & 7;
        int l = (mt * 128) >> 10;
        f32x16 acc[2][2];
        gemm_core<false>(p.cckv() + (size_t)mt * 128 * 256, 256, p.WukvTp() + (size_t)l * 1024 * 256 + (size_t)nt * 128 * 256, 256, 256, smem, acc);
        epi_kv(p, mt * 128, nt * 128, acc, nullptr, true);
      } else {
        norm_row(p, 0, (it - 256) * 4 + w, 0);
      }
    }
    return;
  }
  const int l = (ph - 2) / 6, sub = (ph - 2) % 6;
  if ((KIND < 0 || KIND == 2) && sub == 0) {
    const int x = B & 7, j = B >> 3, per = G >> 3;
    const bf16* Ab = p.hbuf();
    const bf16* Wb = p.WinT() + (size_t)l * NPROJ * 1024;
    for (int q = j; q < 3 * 64; q += per) {
      const int r = q >> 6, jj = q & 63;
      const int st = r * 8 + x;
      const int mt = (st / 3) * 8 + (jj >> 3), nt = (st % 3) * 8 + (jj & 7);
      if (nt >= 23) continue;
      f32x16 acc[2][4];
      gemm_core_w(Ab + (size_t)mt * 128 * 1024, 1024, Wb + (size_t)nt * 256 * 1024, 1024, 1024, smem, acc);
      epi_inproj_w(p, l, mt * 128, nt * 256, acc, smem);
    }
  } else if ((KIND < 0 || KIND == 3) && sub == 1) {
    const int N_CH = 1024, N_QA = 64 * 3, N_KV = 64 * 4, N_CF = 1024;
    const float* sRowW = (const float*)(smem + (128 + 256) * 72 * 2);
    for (int it = B; it < N_CH + N_QA + N_KV + N_CF; it += G) {
      int u = it;
      __syncthreads();
      if (u < N_CH) { mlstm_local(p, l, u, smem); continue; }
      u -= N_CH;
      if (u < N_QA) {
        int mt = u / 3, nt = u % 3;
        f32x16 acc[2][4];
        gemm_core_w<true>(p.proj() + (size_t)mt * 128 * NPROJ, NPROJ, p.WuqT() + (size_t)l * 768 * 384 + (size_t)nt * 256 * 384, 384, 384, smem, acc);
        epi_qa_w<0>(p, mt * 128, nt * 256, acc, sRowW);
        epi_qa_w<1>(p, mt * 128, nt * 256, acc, sRowW);
        continue;
      }
      u -= N_QA;
      if (u < N_KV) {
        int mt = u >> 2, nt = u & 3;
        f32x16 acc[2][4];
        gemm_core_w<true>(p.proj() + (size_t)mt * 128 * NPROJ + 384, NPROJ, p.WukvT() + (size_t)l * 1024 * 256 + (size_t)nt * 256 * 256, 256, 256, smem, acc);
        epi_kv_w<0>(p, mt * 128, nt * 256, acc, sRowW);
        epi_kv_w<1>(p, mt * 128, nt * 256, acc, sRowW);
        continue;
      }
      u -= N_KV;
      ckv_fin(p, l, u * 4 + w);
    }
  } else if ((KIND < 0 || KIND == 7) && sub == 2) {
    for (int it = B; it < 640; it += G) mlstm_scan(p, l, it);
  } else if ((KIND < 0 || KIND == 4) && sub == 3) {
    const int x = B & 7;
    int* qctr = p.qc() + ph * 8 + x;
    int* sslot = (int*)(smem + SMEM_BYTES - 16);
    for (;;) {
      __syncthreads();
      if (tidx() == 0) *sslot = atomicAdd(qctr, 1);
      __syncthreads();
      const int q = *sslot;
      if (q >= 192) break;
      __syncthreads();
      if (q < 32) { const int pr = 2 * x + (q >> 4); mla_item(p, l, pr * 16 + (q & 15), smem); }
      else if (q < 64) { const int u = q - 32; const int pr = 2 * x + (u >> 4); diff_item(p, l, pr * 16 + (u & 15), smem); }
      else if (q < 128) mlstm_out(p, l, x * 64 + (q - 64), smem);
      else if (q < 160) { const int u = q - 128; const int pr = 8 * x + (u >> 2); mla_item(p, l, 256 + pr * 4 + (u & 3), smem); }
      else { const int u = q - 160; const int pr = 8 * x + (u >> 2); diff_item(p, l, 256 + pr * 4 + (u & 3), smem); }
    }
  } else if ((KIND < 0 || KIND == 5) && sub == 4) {
    const int x = B & 7, j = B >> 3, per = G >> 3;
    for (int q = j; q < 64; q += per) {
      const int mt = x * 8 + (q >> 3), nt = q & 7;
      f32x16 acc[2][2];
      gemm_core<false>(p.ycat() + (size_t)mt * 128 * 1536, 1536, p.WoutT() + (size_t)l * 1024 * 1536 + (size_t)nt * 128 * 1536, 1536, 1536, smem, acc);
      epi_out(p, l, mt * 128, nt * 128, acc);
    }
  } else if ((KIND < 0 || KIND == 6) && sub == 5) {
    for (int it = B; it < 2048; it += G) {
      if (l < 3) norm_row(p, l + 1, it * 4 + w, 0);
      else norm_row(p, 0, it * 4 + w, 1);
    }
  }
}

#if COOP
__global__ void __launch_bounds__(256, 2) mega(P p, int lo, int hi, int coop) {
  __shared__ __attribute__((aligned(16))) char smem[SMEM_BYTES];
  __shared__ uint4 xb_words;
  if (threadIdx.x == 0) xb_words = make_uint4(0u, 0u, 0u, 0u);
  tidx_init();
  XcdBarrier xb = xcd_barrier_post((unsigned*)p.ctr(), (volatile LAS unsigned*)&xb_words);
  for (int ph = lo; ph < hi; ++ph) {
    run_phase<-1>(p, ph, smem);
    if (PROBE_DUP) {
      const int kind = ph < 2 ? ph : 2 + (ph - 2) % 6;
      if ((PROBE_DUP >> kind) & 1) { xcd_barrier(xb); run_phase<-1>(p, ph, smem); }
    }
    if (ph + 1 < hi) xcd_barrier(xb);
  }
  if (coop == 2) cg::this_grid().sync();
}
#endif
template <int KIND>
__global__ void __launch_bounds__(256) phase_k(P p, int ph) {
  __shared__ __attribute__((aligned(16))) char smem[SMEM_BYTES];
  tidx_init();
  run_phase<KIND>(p, ph, smem);
}

extern "C" void kernel_launch(void* const* d_in, const int* in_sizes, int n_in, void* d_out, int out_size, void* d_ws,
                              size_t ws_size, hipStream_t stream) {
  P p{};
  const float** ins = (const float**)&p;
  for (int i = 0; i < 26; ++i) ins[i] = (const float*)d_in[i];
  p.out = (float*)d_out;
  p.ws = (char*)d_ws;
  if (WS_TOTAL > ws_size) { fprintf(stderr, "workspace too small: need %zu have %zu\n", (size_t)WS_TOTAL, ws_size); return; }

#if COOP
  static int grid_blocks = 0;
  if (!grid_blocks) {
    int dev = 0, cus = 0, per_cu = 0;
    (void)hipGetDevice(&dev);
    (void)hipDeviceGetAttribute(&cus, hipDeviceAttributeMultiprocessorCount, dev);
    (void)hipOccupancyMaxActiveBlocksPerMultiprocessor(&per_cu, mega, 256, 0);
    if (per_cu > 2) per_cu = 2;
    grid_blocks = cus * per_cu;
  }
  (void)hipMemsetAsync(p.ws + OFF_ctr, 0, 16384 + 4096, stream);
  int lo = 0, hi = NPHASE, coop = 1;
  void* args[] = {&p, &lo, &hi, &coop};
  hipError_t e = hipLaunchCooperativeKernel((void*)mega, dim3(grid_blocks), dim3(256), args, 0, stream);
  if (e != hipSuccess) fprintf(stderr, "cooperative launch failed: %s (grid %d)\n", hipGetErrorString(e), grid_blocks);
#else
  for (int ph = 0; ph < NPHASE; ++ph) {
    static const int kmap[6] = {2, 3, 7, 4, 5, 6};
    int kind = ph < 2 ? ph : kmap[(ph - 2) % 6];
    switch (kind) {
      case 0: phase_k<0><<<512, 256, 0, stream>>>(p, ph); break;
      case 1: phase_k<1><<<512, 256, 0, stream>>>(p, ph); break;
      case 2: phase_k<2><<<512, 256, 0, stream>>>(p, ph); break;
      case 3: phase_k<3><<<512, 256, 0, stream>>>(p, ph); break;
      case 4: phase_k<4><<<512, 256, 0, stream>>>(p, ph); break;
      case 5: phase_k<5><<<512, 256, 0, stream>>>(p, ph); break;
      case 7: phase_k<7><<<512, 256, 0, stream>>>(p, ph); break;
      default: phase_k<6><<<512, 256, 0, stream>>>(p, ph); break;
    }
  }
#endif
}
```

```cpp
#include <hip/hip_runtime.h>
#include <hip/hip_cooperative_groups.h>
#include <cstdio>
namespace cg = cooperative_groups;

typedef unsigned short bf16;
typedef __attribute__((ext_vector_type(8))) short bf16x8;
typedef __attribute__((ext_vector_type(4))) short s16x4;
typedef __attribute__((ext_vector_type(16))) float f32x16;
typedef __attribute__((ext_vector_type(4))) float f32x4;
typedef __attribute__((ext_vector_type(4))) unsigned u32x4;
typedef __attribute__((ext_vector_type(2))) unsigned u32x2;

#define DI __device__ __forceinline__
#define MFMA(a, b, c) __builtin_amdgcn_mfma_f32_32x32x16_bf16((a), (b), (c), 0, 0, 0)

#ifndef COOP
#define COOP 1
#endif
#define PROBE_DUP 0

constexpr int NTOK = 8192;
constexpr int NPROJ = 5888;
constexpr int NPHASE = 26;
constexpr float EPS = 1e-6f;
constexpr int SMEM_BYTES = 75 * 1024;

constexpr size_t O_YP = 0, O_YS = 4194304, O_CKV = 8388608, O_KROPE = 12582912, O_DK = 13631488,
                 O_DV = 22020096, O_MC = 30408704, O_MN = 38797312, O_MM = 38862848;

constexpr size_t al256(size_t x) { return (x + 255) & ~(size_t)255; }
constexpr size_t OFF_WinT = 0;
constexpr size_t OFF_WuqT = OFF_WinT + al256((size_t)4 * NPROJ * 1024 * 2);
constexpr size_t OFF_WukvT = OFF_WuqT + al256((size_t)4 * 768 * 384 * 2);
constexpr size_t OFF_WukvTp = OFF_WukvT + al256((size_t)4 * 1024 * 256 * 2);
constexpr size_t OFF_WoutT = OFF_WukvTp + al256((size_t)4 * 1024 * 256 * 2);
constexpr size_t OFF_mod = OFF_WoutT + al256((size_t)4 * 1024 * 1536 * 2);
constexpr size_t OFF_ropec = OFF_mod + al256((size_t)4 * 5 * 3072 * 4);
constexpr size_t OFF_ropes = OFF_ropec + al256((size_t)1024 * 32 * 4);
constexpr size_t OFF_lam = OFF_ropes + al256((size_t)1024 * 32 * 4);
constexpr size_t OFF_hbuf = OFF_lam + al256((size_t)256);
constexpr size_t OFF_xbuf = OFF_hbuf + al256((size_t)NTOK * 1024 * 2);
constexpr size_t OFF_proj = OFF_xbuf + al256((size_t)NTOK * 1024 * 4);
constexpr size_t OFF_Qa = OFF_proj + al256((size_t)NTOK * NPROJ * 2);
constexpr size_t OFF_Ka = OFF_Qa + al256((size_t)NTOK * 768 * 2);
constexpr size_t OFF_VaT = OFF_Ka + al256((size_t)NTOK * 768 * 2);
constexpr size_t OFF_Kb = OFF_VaT + al256((size_t)NTOK * 512 * 2);
constexpr size_t OFF_VbT = OFF_Kb + al256((size_t)NTOK * 512 * 2);
constexpr size_t OFF_VmT = OFF_VbT + al256((size_t)NTOK * 512 * 2);
constexpr size_t OFF_ycat = OFF_VmT + al256((size_t)NTOK * 512 * 2);
constexpr size_t OFF_gates = OFF_ycat + al256((size_t)NTOK * 1536 * 2);
constexpr size_t OFF_Cst = OFF_gates + al256((size_t)NTOK * 16 * 4);
constexpr size_t OFF_nst = OFF_Cst + al256((size_t)1024 * 16384 * 2);
constexpr size_t OFF_mst = OFF_nst + al256((size_t)1024 * 128 * 4);
constexpr size_t OFF_cckv = OFF_mst + al256((size_t)1024 * 4);
constexpr size_t OFF_cKa = OFF_cckv + al256((size_t)4096 * 256 * 2);
constexpr size_t OFF_cVaT = OFF_cKa + al256((size_t)64 * 256 * 192 * 2);
constexpr size_t OFF_cKb = OFF_cVaT + al256((size_t)64 * 128 * 256 * 2);
constexpr size_t OFF_cVbT = OFF_cKb + al256((size_t)64 * 256 * 128 * 2);
constexpr size_t OFF_blA = OFF_cVbT + al256((size_t)64 * 128 * 256 * 2);
constexpr size_t OFF_mlA = OFF_blA + 4096;
constexpr size_t OFF_ctr = OFF_mlA + 4096;
constexpr size_t OFF_qc = OFF_ctr + 16384;
constexpr size_t WS_TOTAL = OFF_qc + 4096;
struct P {
  const float *x_prompt, *x_sample, *c_ckv, *c_krope, *c_dk, *c_dv, *st_C, *st_n, *st_m, *c, *c_ctx, *g_norm, *W_mod,
      *b_mod, *W_in, *q_norm, *W_uq, *kv_norm, *W_ukv, *dlam, *dnorm, *mconv, *mgb, *mnorm, *W_out, *g_final;
  float* out;
  char* ws;
  __device__ __forceinline__ bf16* WinT() const { return (bf16*)(ws + OFF_WinT); }
  __device__ __forceinline__ bf16* WuqT() const { return (bf16*)(ws + OFF_WuqT); }
  __device__ __forceinline__ bf16* WukvT() const { return (bf16*)(ws + OFF_WukvT); }
  __device__ __forceinline__ bf16* WukvTp() const { return (bf16*)(ws + OFF_WukvTp); }
  __device__ __forceinline__ bf16* WoutT() const { return (bf16*)(ws + OFF_WoutT); }
  __device__ __forceinline__ float* mod() const { return (float*)(ws + OFF_mod); }
  __device__ __forceinline__ float* ropec() const { return (float*)(ws + OFF_ropec); }
  __device__ __forceinline__ float* ropes() const { return (float*)(ws + OFF_ropes); }
  __device__ __forceinline__ float* lam() const { return (float*)(ws + OFF_lam); }
  __device__ __forceinline__ bf16* hbuf() const { return (bf16*)(ws + OFF_hbuf); }
  __device__ __forceinline__ float* xbuf() const { return (float*)(ws + OFF_xbuf); }
  __device__ __forceinline__ bf16* proj() const { return (bf16*)(ws + OFF_proj); }
  __device__ __forceinline__ bf16* Qa() const { return (bf16*)(ws + OFF_Qa); }
  __device__ __forceinline__ bf16* Ka() const { return (bf16*)(ws + OFF_Ka); }
  __device__ __forceinline__ bf16* VaT() const { return (bf16*)(ws + OFF_VaT); }
  __device__ __forceinline__ bf16* Kb() const { return (bf16*)(ws + OFF_Kb); }
  __device__ __forceinline__ bf16* VbT() const { return (bf16*)(ws + OFF_VbT); }
  __device__ __forceinline__ bf16* VmT() const { return (bf16*)(ws + OFF_VmT); }
  __device__ __forceinline__ bf16* ycat() const { return (bf16*)(ws + OFF_ycat); }
  __device__ __forceinline__ float* gates() const { return (float*)(ws + OFF_gates); }
  __device__ __forceinline__ bf16* Cst() const { return (bf16*)(ws + OFF_Cst); }
  __device__ __forceinline__ float* nst() const { return (float*)(ws + OFF_nst); }
  __device__ __forceinline__ float* mst() const { return (float*)(ws + OFF_mst); }
  __device__ __forceinline__ bf16* cckv() const { return (bf16*)(ws + OFF_cckv); }
  __device__ __forceinline__ bf16* cKa() const { return (bf16*)(ws + OFF_cKa); }
  __device__ __forceinline__ bf16* cVaT() const { return (bf16*)(ws + OFF_cVaT); }
  __device__ __forceinline__ bf16* cKb() const { return (bf16*)(ws + OFF_cKb); }
  __device__ __forceinline__ bf16* cVbT() const { return (bf16*)(ws + OFF_cVbT); }
  __device__ __forceinline__ int* ctr() const { return (int*)(ws + OFF_ctr); }
  __device__ __forceinline__ int* qc() const { return (int*)(ws + OFF_qc); }
  __device__ __forceinline__ float* blA() const { return (float*)(ws + OFF_blA); }
  __device__ __forceinline__ float* mlA() const { return (float*)(ws + OFF_mlA); }
};

DI int tidx() { int t = threadIdx.x; asm volatile("" : "+v"(t)); return t; }
DI void tidx_init() {}
DI int wave_of(int tid) { return __builtin_amdgcn_readfirstlane(tid >> 6); }
typedef __attribute__((ext_vector_type(2))) __bf16 bf16v2;
typedef __attribute__((ext_vector_type(2))) float f32x2;
DI unsigned pack2(float a, float b) {
  f32x2 v; v[0] = a; v[1] = b;
  return __builtin_bit_cast(unsigned, __builtin_convertvector(v, bf16v2));
}
DI bf16 f2bf(float x) { return (bf16)(pack2(x, 0.f) & 0xffffu); }
DI float bf2f(bf16 b) { return __uint_as_float(((unsigned)b) << 16); }
DI float fexp2(float x) { return __builtin_amdgcn_exp2f(x); }
DI float fexp(float x) { return __builtin_amdgcn_exp2f(x * 1.4426950408889634f); }
DI float bflo(unsigned u) { return __uint_as_float(u << 16); }
DI float bfhi(unsigned u) { return __uint_as_float(u & 0xffff0000u); }
DI float silu_f(float x) { return x * __builtin_amdgcn_rcpf(1.f + fexp(-x)); }
DI float sigmoid_f(float x) { return __builtin_amdgcn_rcpf(1.f + fexp(-x)); }
DI float logsig_f(float x) { return fminf(x, 0.f) - log1pf(fexp(-fabsf(x))); }

struct TokInfo { int lat, b, t, T, tok0, modj; };
DI TokInfo tinfo(int tok) {
  TokInfo r;
  if (tok < 4096) { r.lat = 0; r.b = tok >> 8; r.t = tok & 255; r.T = 256; r.tok0 = tok & ~255; r.modj = 0; }
  else { int u = tok - 4096; r.lat = 1; r.b = u >> 10; r.t = u & 1023; r.T = 1024; r.tok0 = 4096 + (u & ~1023); r.modj = 1 + r.b; }
  return r;
}

struct GR { u32x4 ra0[4], rb0[4], ra1[4], rb1[4]; };
DI void gemm_load2(GR& g, const bf16* __restrict__ A, int lda, const bf16* __restrict__ Bt, int ldb) {
  const int tid = tidx();
  const int lr = tid >> 3, lc = tid & 7;
  const bf16* ap = A + (size_t)lr * lda + lc * 8;
  const bf16* bp = Bt + (size_t)lr * ldb + lc * 8;
  const size_t a32 = (size_t)32 * lda, b32 = (size_t)32 * ldb;
#pragma unroll
  for (int i = 0; i < 4; ++i) { g.ra0[i] = *(const u32x4*)(ap + i * a32); g.rb0[i] = *(const u32x4*)(bp + i * b32); }
#pragma unroll
  for (int i = 0; i < 4; ++i) { g.ra1[i] = *(const u32x4*)(ap + 64 + i * a32); g.rb1[i] = *(const u32x4*)(bp + 64 + i * b32); }
}
template <bool ROWSS>
DI void gemm_core_n(GR& g, const bf16* __restrict__ A, int lda, const bf16* __restrict__ Bt, int ldb,
                    const bf16* __restrict__ An, const bf16* __restrict__ Btn, int K, char* smem, f32x16 (&acc)[2][2]) {
  bf16* sA = (bf16*)smem;
  bf16* sB = sA + 128 * 72;
  float* sRow = (float*)(sB + 128 * 72);
  const int tid = tidx(), lane = tid & 63, w = wave_of(tid);
  const int wm = w >> 1, wn = w & 1, lq = lane & 31, h = lane >> 5;
  const int lr = tid >> 3, lc = tid & 7;
  float ss[4] = {0.f, 0.f, 0.f, 0.f};
#pragma unroll
  for (int i = 0; i < 2; ++i)
#pragma unroll
    for (int j = 0; j < 2; ++j)
#pragma unroll
      for (int r = 0; r < 16; ++r) acc[i][j][r] = 0.f;
  const bf16* ap = A + (size_t)lr * lda + lc * 8;
  const bf16* bp = Bt + (size_t)lr * ldb + lc * 8;
  const bf16* apn = An + (size_t)lr * lda + lc * 8;
  const bf16* bpn = Btn + (size_t)lr * ldb + lc * 8;
  const size_t a32 = (size_t)32 * lda, b32 = (size_t)32 * ldb;
  const int nk = K >> 6;
  auto step = [&](u32x4 (&ra)[4], u32x4 (&rb)[4], int kt) {
    if (kt) __syncthreads();
#pragma unroll
    for (int i = 0; i < 4; ++i) {
      *(u32x4*)(sA + (lr + 32 * i) * 72 + lc * 8) = ra[i];
      *(u32x4*)(sB + (lr + 32 * i) * 72 + lc * 8) = rb[i];
    }
    if (ROWSS) {
#pragma unroll
      for (int i = 0; i < 4; ++i)
#pragma unroll
        for (int e = 0; e < 4; ++e) {
          float a0 = bflo(ra[i][e]), a1 = bfhi(ra[i][e]);
          ss[i] += a0 * a0 + a1 * a1;
        }
    }
    __syncthreads();
    {
      const int kn = kt + 2;
      const bf16* ap2 = (kn < nk) ? ap + (size_t)kn * 64 : apn + (size_t)(kn - nk) * 64;
      const bf16* bp2 = (kn < nk) ? bp + (size_t)kn * 64 : bpn + (size_t)(kn - nk) * 64;
#pragma unroll
      for (int i = 0; i < 4; ++i) { ra[i] = *(const u32x4*)(ap2 + i * a32); rb[i] = *(const u32x4*)(bp2 + i * b32); }
    }
#pragma unroll
    for (int ks = 0; ks < 4; ++ks) {
      bf16x8 af[2], bfr[2];
#pragma unroll
      for (int i = 0; i < 2; ++i) af[i] = *(const bf16x8*)(sA + (wm * 64 + i * 32 + lq) * 72 + ks * 16 + h * 8);
#pragma unroll
      for (int j = 0; j < 2; ++j) bfr[j] = *(const bf16x8*)(sB + (wn * 64 + j * 32 + lq) * 72 + ks * 16 + h * 8);
#pragma unroll
      for (int i = 0; i < 2; ++i)
#pragma unroll
        for (int j = 0; j < 2; ++j) acc[i][j] = MFMA(af[i], bfr[j], acc[i][j]);
    }
  };
  for (int kt = 0; kt < nk; kt += 2) {
    step(g.ra0, g.rb0, kt);
    step(g.ra1, g.rb1, kt + 1);
  }
  if (ROWSS) {
#pragma unroll
    for (int i = 0; i < 4; ++i) {
      float v = ss[i];
      v += __shfl_xor(v, 1); v += __shfl_xor(v, 2); v += __shfl_xor(v, 4);
      if (lc == 0) sRow[lr + 32 * i] = v;
    }
  }
  __syncthreads();
}
template <bool ROWSS>
DI void gemm_core(const bf16* __restrict__ A, int lda, const bf16* __restrict__ Bt, int ldb, int K, char* smem,
                  f32x16 (&acc)[2][2]) {
  GR g;
  gemm_load2(g, A, lda, Bt, ldb);
  gemm_core_n<ROWSS>(g, A, lda, Bt, ldb, A, Bt, K, smem, acc);
}

template <bool ROWSS = false>
DI void gemm_core_w(const bf16* __restrict__ A, int lda, const bf16* __restrict__ Bt, int ldb, int K, char* smem,
                    f32x16 (&acc)[2][4]) {
  bf16* sA = (bf16*)smem;
  bf16* sB = sA + 128 * 72;
  const int tid = tidx(), lane = tid & 63, w = wave_of(tid);
  const int wm = w >> 1, wn = w & 1, lq = lane & 31, h = lane >> 5;
  const int lr = tid >> 3, lc = tid & 7;
  u32x4 ra[4], rb[8];
  float ssw[4] = {0.f, 0.f, 0.f, 0.f};
#pragma unroll
  for (int i = 0; i < 2; ++i)
#pragma unroll
    for (int j = 0; j < 4; ++j)
#pragma unroll
      for (int r = 0; r < 16; ++r) acc[i][j][r] = 0.f;
  const bf16* ap = A + (size_t)lr * lda + lc * 8;
  const bf16* bp = Bt + (size_t)lr * ldb + lc * 8;
  const size_t a32 = (size_t)32 * lda, b32 = (size_t)32 * ldb;
#pragma unroll
  for (int i = 0; i < 4; ++i) ra[i] = *(const u32x4*)(ap + i * a32);
#pragma unroll
  for (int i = 0; i < 8; ++i) rb[i] = *(const u32x4*)(bp + i * b32);
  const int nk = K >> 6;
  for (int kt = 0; kt < nk; ++kt) {
    if (kt) __syncthreads();
#pragma unroll
    for (int i = 0; i < 4; ++i) *(u32x4*)(sA + (lr + 32 * i) * 72 + lc * 8) = ra[i];
#pragma unroll
    for (int i = 0; i < 8; ++i) *(u32x4*)(sB + (lr + 32 * i) * 72 + lc * 8) = rb[i];
    if (ROWSS) {
#pragma unroll
      for (int i = 0; i < 4; ++i)
#pragma unroll
        for (int e = 0; e < 4; ++e) {
          float a0 = bflo(ra[i][e]), a1 = bfhi(ra[i][e]);
          ssw[i] += a0 * a0 + a1 * a1;
        }
    }
    __syncthreads();
    {
      const int kn = (kt + 1 < nk) ? kt + 1 : kt;
      const bf16* ap2 = ap + (size_t)kn * 64;
      const bf16* bp2 = bp + (size_t)kn * 64;
#pragma unroll
      for (int i = 0; i < 4; ++i) ra[i] = *(const u32x4*)(ap2 + i * a32);
#pragma unroll
      for (int i = 0; i < 8; ++i) rb[i] = *(const u32x4*)(bp2 + i * b32);
    }
#pragma unroll
    for (int ks = 0; ks < 4; ++ks) {
      bf16x8 af[2], bfr[4];
#pragma unroll
      for (int i = 0; i < 2; ++i) af[i] = *(const bf16x8*)(sA + (wm * 64 + i * 32 + lq) * 72 + ks * 16 + h * 8);
#pragma unroll
      for (int j = 0; j < 4; ++j) bfr[j] = *(const bf16x8*)(sB + (wn * 128 + j * 32 + lq) * 72 + ks * 16 + h * 8);
#pragma unroll
      for (int i = 0; i < 2; ++i)
#pragma unroll
        for (int j = 0; j < 4; ++j) acc[i][j] = MFMA(af[i], bfr[j], acc[i][j]);
    }
  }
  if (ROWSS) {
    float* sRow = (float*)(smem + (128 + 256) * 72 * 2);
#pragma unroll
    for (int i = 0; i < 4; ++i) {
      float v = ssw[i];
      v += __shfl_xor(v, 1); v += __shfl_xor(v, 2); v += __shfl_xor(v, 4);
      if (lc == 0) sRow[lr + 32 * i] = v;
    }
  }
  __syncthreads();
}

DI void store_vt4(bf16* VT, size_t idx, float a, float b, float c, float d) {
  u32x2 v; v[0] = pack2(a, b); v[1] = pack2(c, d);
  *(u32x2*)(VT + idx) = v;
}

DI void transpose_tile(const float* __restrict__ src, int N, int Nvalid, bf16* __restrict__ dst, int K, int k0, int n0,
                       const float* __restrict__ gk, bf16* __restrict__ dst2, char* smem) {
  float* t = (float*)smem;
  const int tid = tidx();
  f32x4 tv[4];
#pragma unroll
  for (int i = 0; i < 4; ++i) {
    int idx = tid + 256 * i; int r = idx >> 4, c = (idx & 15) * 4;
    int n = n0 + c;
    tv[i] = f32x4{0.f, 0.f, 0.f, 0.f};
    if (n < Nvalid) tv[i] = __builtin_nontemporal_load((const f32x4*)(src + (size_t)(k0 + r) * N + n));
  }
#pragma unroll
  for (int i = 0; i < 4; ++i) {
    int idx = tid + 256 * i; int r = idx >> 4, c = (idx & 15) * 4;
    t[r * 65 + c] = tv[i][0]; t[r * 65 + c + 1] = tv[i][1]; t[r * 65 + c + 2] = tv[i][2]; t[r * 65 + c + 3] = tv[i][3];
  }
  __syncthreads();
  const int c2h = (tid & 31) * 2;
  const float gk0 = gk ? gk[k0 + c2h] : 1.f, gk1 = gk ? gk[k0 + c2h + 1] : 1.f;
#pragma unroll
  for (int i = 0; i < 8; ++i) {
    int idx = tid + 256 * i; int r = idx >> 5, c2 = (idx & 31) * 2;
    float v0 = t[c2 * 65 + r], v1 = t[(c2 + 1) * 65 + r];
    if (dst2) *(unsigned*)(dst2 + (size_t)(n0 + r) * K + k0 + c2) = pack2(v0, v1);
    v0 *= gk0; v1 *= gk1;
    *(unsigned*)(dst + (size_t)(n0 + r) * K + k0 + c2) = pack2(v0, v1);
  }
  __syncthreads();
}

DI void mod_item(const P& p, int it, char* smem) {
  float* sl = (float*)smem;
  float* red = sl + 5 * 1024;
  const int tid = tidx(), lane = tid & 63, w = wave_of(tid);
  const int l = it / 48, n0 = (it % 48) * 64;
  {
    float cvv[20];
#pragma unroll
    for (int i = 0; i < 20; ++i) {
      int idx = tid + 256 * i; int j = idx >> 10, k = idx & 1023;
      cvv[i] = (j == 0) ? p.c_ctx[k] : p.c[(j - 1) * 1024 + k];
    }
#pragma unroll
    for (int i = 0; i < 20; ++i) sl[tid + 256 * i] = silu_f(cvv[i]);
  }
  __syncthreads();
  float a[5] = {0.f, 0.f, 0.f, 0.f, 0.f};
  const float* wp = p.W_mod + (size_t)l * 1024 * 3072 + n0 + lane;
  for (int k = w * 256; k < w * 256 + 256; k += 16) {
    float wv[16];
#pragma unroll
    for (int u = 0; u < 16; ++u) wv[u] = __builtin_nontemporal_load(wp + (size_t)(k + u) * 3072);
#pragma unroll
    for (int u = 0; u < 16; ++u)
#pragma unroll
      for (int j = 0; j < 5; ++j) a[j] += sl[j * 1024 + k + u] * wv[u];
  }
#pragma unroll
  for (int j = 0; j < 5; ++j) red[(w * 5 + j) * 64 + lane] = a[j];
  __syncthreads();
  for (int idx = tid; idx < 320; idx += 256) {
    int j = idx >> 6, c = idx & 63;
    float s = red[(0 * 5 + j) * 64 + c] + red[(1 * 5 + j) * 64 + c] + red[(2 * 5 + j) * 64 + c] + red[(3 * 5 + j) * 64 + c];
    p.mod()[(size_t)(l * 5 + j) * 3072 + n0 + c] = s + p.b_mod[l * 3072 + n0 + c];
  }
  __syncthreads();
}

DI void phase_prepass(const P& p, char* smem) {
  const int G = gridDim.x, B = blockIdx.x, tid = tidx();
  const int N_MOD = 192, N_WIN = 4 * 92 * 16, N_WOUT = 4 * 16 * 24, N_WUQ = 4 * 12 * 6, N_WUKV = 4 * 16 * 4;
  const int total = N_MOD + N_WIN + N_WOUT + N_WUQ + N_WUKV;
  for (int it = B; it < total; it += G) {
    int u = it;
    if (u < N_MOD) { mod_item(p, u, smem); continue; }
    u -= N_MOD;
    if (u < N_WIN) {
      int l = u / (92 * 16), r = u % (92 * 16), nt = r / 16, kt = r % 16;
      transpose_tile(p.W_in + (size_t)l * 1024 * 5840, 5840, 5840, p.WinT() + (size_t)l * NPROJ * 1024, 1024, kt * 64, nt * 64, nullptr, nullptr, smem);
      continue;
    }
    u -= N_WIN;
    if (u < N_WOUT) {
      int l = u / (16 * 24), r = u % (16 * 24), nt = r / 24, kt = r % 24;
      transpose_tile(p.W_out + (size_t)l * 1536 * 1024, 1024, 1024, p.WoutT() + (size_t)l * 1024 * 1536, 1536, kt * 64, nt * 64, nullptr, nullptr, smem);
      continue;
    }
    u -= N_WOUT;
    if (u < N_WUQ) {
      int l = u / 72, r = u % 72, nt = r / 6, kt = r % 6;
      transpose_tile(p.W_uq + (size_t)l * 384 * 768, 768, 768, p.WuqT() + (size_t)l * 768 * 384, 384, kt * 64, nt * 64, p.q_norm + l * 384, nullptr, smem);
      continue;
    }
    u -= N_WUQ;
    {
      int l = u / 64, r = u % 64, nt = r / 4, kt = r % 4;
      transpose_tile(p.W_ukv + (size_t)l * 256 * 1024, 1024, 1024, p.WukvT() + (size_t)l * 1024 * 256, 256, kt * 64, nt * 64, p.kv_norm + l * 256, p.WukvTp() + (size_t)l * 1024 * 256, smem);
    }
  }
  const int gtid = B * 256 + tid, gsz = G * 256;
  for (int idx = gtid; idx < 1024 * 32; idx += gsz) {
    int t = idx >> 5, i = idx & 31;
    float pos = (i < 16) ? (float)(t >> 6) : (float)(t & 63);
    float inv = powf(10000.f, -(float)(i & 15) / 16.f);
    float ang = pos * inv;
    p.ropec()[idx] = cosf(ang); p.ropes()[idx] = sinf(ang);
  }
  if (gtid < 4) {
    int l = gtid; const float* lp = p.dlam + l * 256;
    float s1 = 0.f, s2 = 0.f;
    for (int i = 0; i < 64; ++i) { s1 += lp[i] * lp[64 + i]; s2 += lp[128 + i] * lp[192 + i]; }
    float lam_init = 0.8f - 0.6f * expf(-0.3f * (float)l);
    p.lam()[l] = expf(s1) - expf(s2) + lam_init;
  }
  for (int idx = gtid; idx < 4 * 4 * 256 * 256; idx += gsz) {
    int d = idx & 255, t = (idx >> 8) & 255, b = (idx >> 16) & 3, l = idx >> 18;
    p.cckv()[idx] = f2bf(p.c_ckv[(size_t)((b * 4 + l) * 256 + t) * 256 + d]);
  }
  for (int idx = gtid; idx < 4 * 4 * 4 * 256 * 64; idx += gsz) {
    int r = idx & 63, t = (idx >> 6) & 255, hd = (idx >> 14) & 3, b = (idx >> 16) & 3, l = idx >> 18;
    p.cKa()[(size_t)((((l * 4 + b) * 4 + hd) * 256) + t) * 192 + 128 + r] = f2bf(p.c_krope[(size_t)((b * 4 + l) * 256 + t) * 64 + r]);
  }
  for (int idx = gtid; idx < 4 * 4 * 4 * 256 * 128; idx += gsz) {
    int d = idx & 127, t = (idx >> 7) & 255, hd = (idx >> 15) & 3, b = (idx >> 17) & 3, l = idx >> 19;
    p.cKb()[idx] = f2bf(p.c_dk[(size_t)(((b * 4 + l) * 256 + t) * 4 + hd) * 128 + d]);
  }
  for (int idx = gtid; idx < 4 * 4 * 4 * 128 * 256; idx += gsz) {
    int t = idx & 255, d = (idx >> 8) & 127, hd = (idx >> 15) & 3, b = (idx >> 17) & 3, l = idx >> 19;
    p.cVbT()[idx] = f2bf(p.c_dv[(size_t)(((b * 4 + l) * 256 + t) * 4 + hd) * 128 + d]);
  }
}

DI void norm_row(const P& p, int l, int tok, int mode) {
  const int lane = tidx() & 63;
  TokInfo ti = tinfo(tok);
  const float* x;
  if (mode == 0 && l == 0) x = ti.lat ? (p.x_sample + (size_t)(tok - 4096) * 1024) : (p.x_prompt + (size_t)tok * 1024);
  else x = p.xbuf() + (size_t)tok * 1024;
  f32x4 v[4];
  float ss = 0.f;
#pragma unroll
  for (int i = 0; i < 4; ++i) {
    v[i] = *(const f32x4*)(x + i * 256 + lane * 4);
    ss += v[i][0] * v[i][0] + v[i][1] * v[i][1] + v[i][2] * v[i][2] + v[i][3] * v[i][3];
  }
#pragma unroll
  for (int o = 32; o >= 1; o >>= 1) ss += __shfl_xor(ss, o);
  const float rstd = rsqrtf(ss * (1.f / 1024.f) + EPS);
  if (mode == 0) {
    const float* g = p.g_norm + l * 1024;
    const float* md = p.mod() + (size_t)(l * 5 + ti.modj) * 3072;
#pragma unroll
    for (int i = 0; i < 4; ++i) {
      int c = i * 256 + lane * 4;
      f32x4 gv = *(const f32x4*)(g + c), sh = *(const f32x4*)(md + c), sc = *(const f32x4*)(md + 1024 + c);
      float o0 = v[i][0] * rstd * gv[0] * (1.f + sc[0]) + sh[0];
      float o1 = v[i][1] * rstd * gv[1] * (1.f + sc[1]) + sh[1];
      float o2 = v[i][2] * rstd * gv[2] * (1.f + sc[2]) + sh[2];
      float o3 = v[i][3] * rstd * gv[3] * (1.f + sc[3]) + sh[3];
      u32x2 pk; pk[0] = pack2(o0, o1); pk[1] = pack2(o2, o3);
      *(u32x2*)(p.hbuf() + (size_t)tok * 1024 + c) = pk;
    }
  } else {
    float* o = p.out + (ti.lat ? (O_YS + (size_t)(tok - 4096) * 1024) : (O_YP + (size_t)tok * 1024));
#pragma unroll
    for (int i = 0; i < 4; ++i) {
      int c = i * 256 + lane * 4;
      f32x4 gv = *(const f32x4*)(p.g_final + c);
      f32x4 r; r[0] = v[i][0] * rstd * gv[0]; r[1] = v[i][1] * rstd * gv[1]; r[2] = v[i][2] * rstd * gv[2]; r[3] = v[i][3] * rstd * gv[3];
      *(f32x4*)(o + c) = r;
    }
  }
}

DI void img_put(bf16* img, const f32x16 (&acc)[2][2], int wm, int wn, int lq, int h) {
#pragma unroll
  for (int i = 0; i < 2; ++i)
#pragma unroll
    for (int j = 0; j < 2; ++j)
#pragma unroll
      for (int r = 0; r < 16; ++r)
        img[(wm * 64 + i * 32 + 8 * (r >> 2) + 4 * h + (r & 3)) * 136 + wn * 64 + j * 32 + lq] = f2bf(acc[i][j][r]);
}
DI void img_copy(const bf16* img, int half, bf16* dst, size_t stride, int tid) {
  u32x4 v[4];
#pragma unroll
  for (int i = 0; i < 4; ++i) { int idx = tid + 256 * i; int r = idx >> 3, c16 = idx & 7; v[i] = *(const u32x4*)(img + r * 136 + half * 64 + c16 * 8); }
#pragma unroll
  for (int i = 0; i < 4; ++i) { int idx = tid + 256 * i; int r = idx >> 3, c16 = idx & 7; *(u32x4*)(dst + (size_t)r * stride + c16 * 8) = v[i]; }
}
DI bool inproj_rm(int cb) { return !((cb >= 35 && cb <= 42) || (cb >= 67 && cb <= 74) || cb == 91); }

DI void epi_inproj(const P& p, int l, int m0, int n0, f32x16 (&acc)[2][2], char* smem) {
  const int tid_ = tidx(); const int lane = tid_ & 63, w = wave_of(tid_), wm = w >> 1, wn = w & 1, lq = lane & 31, h = lane >> 5;
  const int mb = m0 + wm * 64, nb = n0 + wn * 64;
  const int cb = nb >> 6;
  bf16* img = (bf16*)smem;
  TokInfo tb = tinfo(mb);
  const bool lat = tb.lat;
  if (!lat && (cb == 10 || (cb >= 27 && cb <= 34))) {
    float* ob = (cb == 10) ? p.out + O_KROPE + (size_t)((tb.b * 4 + l) * 256) * 64
                           : p.out + O_DK + (size_t)((tb.b * 4 + l) * 256) * 512 + (cb - 27) * 64;
    const int ostr = (cb == 10) ? 64 : 512;
#pragma unroll
    for (int i = 0; i < 2; ++i)
#pragma unroll
      for (int j = 0; j < 2; ++j)
#pragma unroll
        for (int r = 0; r < 16; ++r) {
          int tl = tb.t + i * 32 + 8 * (r >> 2) + 4 * h + (r & 3);
          ob[(size_t)tl * ostr + j * 32 + lq] = acc[i][j][r];
        }
  }
  const bool ropeT = lat && (cb == 10 || (cb >= 19 && cb <= 34));
  if (ropeT) {
#pragma unroll
    for (int i = 0; i < 2; ++i) {
      float cs[16], sn[16];
#pragma unroll
      for (int r = 0; r < 16; ++r) {
        int t = tb.t + i * 32 + 8 * (r >> 2) + 4 * h + (r & 3);
        cs[r] = p.ropec()[t * 32 + lq]; sn[r] = p.ropes()[t * 32 + lq];
      }
#pragma unroll
      for (int r = 0; r < 16; ++r) {
        float x1 = acc[i][0][r], x2 = acc[i][1][r];
        acc[i][0][r] = x1 * cs[r] - x2 * sn[r];
        acc[i][1][r] = x1 * sn[r] + x2 * cs[r];
      }
    }
  }
  if (inproj_rm(cb)) {
    img_put(img, acc, wm, wn, lq, h);
  } else if (cb == 91) {
    if (lq < 16) {
      float bias = p.mgb[l * 16 + lq];
#pragma unroll
      for (int i = 0; i < 2; ++i)
#pragma unroll
        for (int r = 0; r < 16; ++r) {
          int row = mb + i * 32 + 8 * (r >> 2) + 4 * h + (r & 3);
          p.gates()[row * 16 + lq] = acc[i][0][r] + bias;
        }
    }
  } else {
    const bool isdv = cb <= 42;
    int cc = isdv ? cb - 35 : cb - 67;
    int hd = cc >> 1, sub = cc & 1;
    bf16* VT = isdv ? p.VbT() : p.VmT();
#pragma unroll
    for (int i = 0; i < 2; ++i)
#pragma unroll
      for (int j = 0; j < 2; ++j) {
        int d = sub * 64 + j * 32 + lq;
#pragma unroll
        for (int g = 0; g < 4; ++g) {
          int tl = tb.t + i * 32 + 8 * g + 4 * h;
          store_vt4(VT, (size_t)tb.tok0 * 512 + (size_t)(hd * 128 + d) * tb.T + tl, acc[i][j][4 * g], acc[i][j][4 * g + 1], acc[i][j][4 * g + 2], acc[i][j][4 * g + 3]);
          if (isdv && !lat) {
#pragma unroll
            for (int jj = 0; jj < 4; ++jj)
              p.out[O_DV + (size_t)((tb.b * 4 + l) * 256 + tl + jj) * 512 + cc * 64 + j * 32 + lq] = acc[i][j][4 * g + jj];
          }
        }
      }
  }
  __syncthreads();
#pragma unroll
  for (int half = 0; half < 2; ++half) {
    const int cbh = (n0 >> 6) + half;
    if (!inproj_rm(cbh)) continue;
    if (cbh == 10) {
#pragma unroll
      for (int hd = 0; hd < 4; ++hd) img_copy(img, half, p.Ka() + (size_t)m0 * 768 + hd * 192 + 128, 768, tid_);
    } else if (cbh >= 27 && cbh <= 34) {
      img_copy(img, half, p.Kb() + (size_t)m0 * 512 + (cbh - 27) * 64, 512, tid_);
    } else {
      img_copy(img, half, p.proj() + (size_t)m0 * NPROJ + cbh * 64, NPROJ, tid_);
    }
  }
  __syncthreads();
}

constexpr int IMGW = 264;
DI void img_copy_w(const bf16* img, int half, bf16* dst, size_t stride, int tid) {
  u32x4 v[4];
#pragma unroll
  for (int i = 0; i < 4; ++i) { int idx = tid + 256 * i; int r = idx >> 3, c16 = idx & 7; v[i] = *(const u32x4*)(img + r * IMGW + half * 64 + c16 * 8); }
#pragma unroll
  for (int i = 0; i < 4; ++i) { int idx = tid + 256 * i; int r = idx >> 3, c16 = idx & 7; *(u32x4*)(dst + (size_t)r * stride + c16 * 8) = v[i]; }
}
template <int JP>
DI void epi_inproj_cbw(const P& p, int l, int m0, int cb, int imgcol, f32x16 (&acc)[2][4], bf16* img) {
  const int tid_ = tidx(); const int lane = tid_ & 63, w = wave_of(tid_), wm = w >> 1, lq = lane & 31, h = lane >> 5;
  const int mb = m0 + wm * 64;
  TokInfo tb = tinfo(mb);
  const bool lat = tb.lat;
  if (!lat && (cb == 10 || (cb >= 27 && cb <= 34))) {
    float* ob = (cb == 10) ? p.out + O_KROPE + (size_t)((tb.b * 4 + l) * 256) * 64
                           : p.out + O_DK + (size_t)((tb.b * 4 + l) * 256) * 512 + (cb - 27) * 64;
    const int ostr = (cb == 10) ? 64 : 512;
#pragma unroll
    for (int i = 0; i < 2; ++i)
#pragma unroll
      for (int j = 0; j < 2; ++j)
#pragma unroll
        for (int r = 0; r < 16; ++r) {
          int tl = tb.t + i * 32 + 8 * (r >> 2) + 4 * h + (r & 3);
          ob[(size_t)tl * ostr + j * 32 + lq] = acc[i][2 * JP + j][r];
        }
  }
  if (lat && (cb == 10 || (cb >= 19 && cb <= 34))) {
#pragma unroll
    for (int i = 0; i < 2; ++i) {
      float cs[16], sn[16];
#pragma unroll
      for (int r = 0; r < 16; ++r) {
        int t = tb.t + i * 32 + 8 * (r >> 2) + 4 * h + (r & 3);
        cs[r] = p.ropec()[t * 32 + lq]; sn[r] = p.ropes()[t * 32 + lq];
      }
#pragma unroll
      for (int r = 0; r < 16; ++r) {
        float x1 = acc[i][2 * JP][r], x2 = acc[i][2 * JP + 1][r];
        acc[i][2 * JP][r] = x1 * cs[r] - x2 * sn[r];
        acc[i][2 * JP + 1][r] = x1 * sn[r] + x2 * cs[r];
      }
    }
  }
  if (inproj_rm(cb)) {
#pragma unroll
    for (int i = 0; i < 2; ++i)
#pragma unroll
      for (int j = 0; j < 2; ++j)
#pragma unroll
        for (int r = 0; r < 16; ++r)
          img[(wm * 64 + i * 32 + 8 * (r >> 2) + 4 * h + (r & 3)) * IMGW + imgcol + j * 32 + lq] = f2bf(acc[i][2 * JP + j][r]);
  } else if (cb == 91) {
    if (lq < 16) {
      float bias = p.mgb[l * 16 + lq];
#pragma unroll
      for (int i = 0; i < 2; ++i)
#pragma unroll
        for (int r = 0; r < 16; ++r) {
          int row = mb + i * 32 + 8 * (r >> 2) + 4 * h + (r & 3);
          p.gates()[row * 16 + lq] = acc[i][2 * JP][r] + bias;
        }
    }
  } else {
    const bool isdv = cb <= 42;
    int cc = isdv ? cb - 35 : cb - 67;
    int hd = cc >> 1, sub = cc & 1;
    bf16* VT = isdv ? p.VbT() : p.VmT();
#pragma unroll
    for (int i = 0; i < 2; ++i)
#pragma unroll
      for (int j = 0; j < 2; ++j) {
        int d = sub * 64 + j * 32 + lq;
#pragma unroll
        for (int g = 0; g < 4; ++g) {
          int tl = tb.t + i * 32 + 8 * g + 4 * h;
          store_vt4(VT, (size_t)tb.tok0 * 512 + (size_t)(hd * 128 + d) * tb.T + tl, acc[i][2 * JP + j][4 * g], acc[i][2 * JP + j][4 * g + 1], acc[i][2 * JP + j][4 * g + 2], acc[i][2 * JP + j][4 * g + 3]);
          if (isdv && !lat) {
#pragma unroll
            for (int jj = 0; jj < 4; ++jj)
              p.out[O_DV + (size_t)((tb.b * 4 + l) * 256 + tl + jj) * 512 + cc * 64 + j * 32 + lq] = acc[i][2 * JP + j][4 * g + jj];
          }
        }
      }
  }
}
DI void epi_inproj_w(const P& p, int l, int m0, int n0, f32x16 (&acc)[2][4], char* smem) {
  bf16* img = (bf16*)smem;
  const int tid_ = tidx(); const int wn = wave_of(tid_) & 1;
  const int cb0 = n0 >> 6;
  epi_inproj_cbw<0>(p, l, m0, cb0 + 2 * wn, (2 * wn) * 64, acc, img);
  epi_inproj_cbw<1>(p, l, m0, cb0 + 2 * wn + 1, (2 * wn + 1) * 64, acc, img);
  __syncthreads();
#pragma unroll
  for (int half = 0; half < 4; ++half) {
    const int cbh = cb0 + half;
    if (!inproj_rm(cbh)) continue;
    if (cbh == 10) {
#pragma unroll
      for (int hd = 0; hd < 4; ++hd) img_copy_w(img, half, p.Ka() + (size_t)m0 * 768 + hd * 192 + 128, 768, tid_);
    } else if (cbh >= 27 && cbh <= 34) {
      img_copy_w(img, half, p.Kb() + (size_t)m0 * 512 + (cbh - 27) * 64, 512, tid_);
    } else {
      img_copy_w(img, half, p.proj() + (size_t)m0 * NPROJ + cbh * 64, NPROJ, tid_);
    }
  }
  __syncthreads();
}

DI void epi_qa(const P& p, int m0, int n0, f32x16 (&acc)[2][2], const float* sRow) {
  const int tid_ = tidx(); const int lane = tid_ & 63, w = wave_of(tid_), wm = w >> 1, wn = w & 1, lq = lane & 31, h = lane >> 5;
  const int mb = m0 + wm * 64, nb = n0 + wn * 64;
  const int cb = nb >> 6, hd = cb / 3, part = cb % 3;
  TokInfo tb = tinfo(mb);
  const bool dorope = tb.lat && part == 2;
#pragma unroll
  for (int i = 0; i < 2; ++i) {
    float cs[16], sn[16];
#pragma unroll
    for (int r = 0; r < 16; ++r) { cs[r] = 1.f; sn[r] = 0.f; }
    if (dorope) {
#pragma unroll
      for (int r = 0; r < 16; ++r) {
        int t = tb.t + i * 32 + 8 * (r >> 2) + 4 * h + (r & 3);
        cs[r] = p.ropec()[t * 32 + lq]; sn[r] = p.ropes()[t * 32 + lq];
      }
    }
#pragma unroll
    for (int r = 0; r < 16; ++r) {
      int rl = wm * 64 + i * 32 + 8 * (r >> 2) + 4 * h + (r & 3);
      float rstd = rsqrtf(sRow[rl] * (1.f / 384.f) + EPS);
      float x1 = acc[i][0][r] * rstd, x2 = acc[i][1][r] * rstd;
      {
        float y1 = x1 * cs[r] - x2 * sn[r], y2 = x1 * sn[r] + x2 * cs[r];
        x1 = y1; x2 = y2;
      }
      int row = m0 + rl;
      bf16* q = p.Qa() + (size_t)(row * 4 + hd) * 192 + part * 64;
      q[lq] = f2bf(x1); q[32 + lq] = f2bf(x2);
    }
  }
}

DI void epi_kv(const P& p, int m0, int n0, f32x16 (&acc)[2][2], const float* sRow, bool cache) {
  const int tid_ = tidx(); const int lane = tid_ & 63, w = wave_of(tid_), wm = w >> 1, wn = w & 1, lq = lane & 31, h = lane >> 5;
  const int mb = m0 + wm * 64, nb = n0 + wn * 64;
  const int cb = nb >> 6, hd = cb >> 2, part = cb & 3;
  TokInfo tb = tinfo(mb);
#pragma unroll
  for (int i = 0; i < 2; ++i)
#pragma unroll
    for (int j = 0; j < 2; ++j)
#pragma unroll
      for (int g = 0; g < 4; ++g) {
        float v[4];
#pragma unroll
        for (int jj = 0; jj < 4; ++jj) {
          int rl = wm * 64 + i * 32 + 8 * g + 4 * h + jj;
          float rstd = cache ? 1.f : rsqrtf(sRow[rl] * (1.f / 256.f) + EPS);
          v[jj] = acc[i][j][4 * g + jj] * rstd;
        }
        int c = j * 32 + lq;
        int row0 = mb + i * 32 + 8 * g + 4 * h;
        if (part < 2) {
#pragma unroll
          for (int jj = 0; jj < 4; ++jj) {
            int row = row0 + jj;
            if (cache) {
              int lb = row >> 8, t = row & 255;
              p.cKa()[(size_t)((lb * 4 + hd) * 256 + t) * 192 + part * 64 + c] = f2bf(v[jj]);
            } else {
              p.Ka()[(size_t)(row * 4 + hd) * 192 + part * 64 + c] = f2bf(v[jj]);
            }
          }
        } else {
          int d = (part - 2) * 64 + c;
          if (cache) {
            int lb = row0 >> 8, t = row0 & 255;
            store_vt4(p.cVaT(), (size_t)((lb * 4 + hd) * 128 + d) * 256 + t, v[0], v[1], v[2], v[3]);
          } else {
            int tl = tb.t + i * 32 + 8 * g + 4 * h;
            store_vt4(p.VaT(), (size_t)tb.tok0 * 512 + (size_t)(hd * 128 + d) * tb.T + tl, v[0], v[1], v[2], v[3]);
          }
        }
      }
}

template <int JP>
DI void epi_qa_w(const P& p, int m0, int n0, f32x16 (&acc)[2][4], const float* sRow) {
  const int tid_ = tidx(); const int lane = tid_ & 63, w = wave_of(tid_), wm = w >> 1, wn = w & 1, lq = lane & 31, h = lane >> 5;
  const int mb = m0 + wm * 64;
  const int cb = (n0 >> 6) + 2 * wn + JP, hd = cb / 3, part = cb % 3;
  TokInfo tb = tinfo(mb);
  const bool dorope = tb.lat && part == 2;
#pragma unroll
  for (int i = 0; i < 2; ++i) {
    float cs[16], sn[16];
#pragma unroll
    for (int r = 0; r < 16; ++r) { cs[r] = 1.f; sn[r] = 0.f; }
    if (dorope) {
#pragma unroll
      for (int r = 0; r < 16; ++r) {
        int t = tb.t + i * 32 + 8 * (r >> 2) + 4 * h + (r & 3);
        cs[r] = p.ropec()[t * 32 + lq]; sn[r] = p.ropes()[t * 32 + lq];
      }
    }
#pragma unroll
    for (int r = 0; r < 16; ++r) {
      int rl = wm * 64 + i * 32 + 8 * (r >> 2) + 4 * h + (r & 3);
      float rstd = rsqrtf(sRow[rl] * (1.f / 384.f) + EPS);
      float x1 = acc[i][2 * JP][r] * rstd, x2 = acc[i][2 * JP + 1][r] * rstd;
      float y1 = x1 * cs[r] - x2 * sn[r], y2 = x1 * sn[r] + x2 * cs[r];
      int row = m0 + rl;
      bf16* q = p.Qa() + (size_t)(row * 4 + hd) * 192 + part * 64;
      q[lq] = f2bf(y1); q[32 + lq] = f2bf(y2);
    }
  }
}
template <int JP>
DI void epi_kv_w(const P& p, int m0, int n0, f32x16 (&acc)[2][4], const float* sRow) {
  const int tid_ = tidx(); const int lane = tid_ & 63, w = wave_of(tid_), wm = w >> 1, wn = w & 1, lq = lane & 31, h = lane >> 5;
  const int mb = m0 + wm * 64;
  const int cb = (n0 >> 6) + 2 * wn + JP, hd = cb >> 2, part = cb & 3;
  TokInfo tb = tinfo(mb);
#pragma unroll
  for (int i = 0; i < 2; ++i)
#pragma unroll
    for (int j = 0; j < 2; ++j)
#pragma unroll
      for (int g = 0; g < 4; ++g) {
        float v[4];
#pragma unroll
        for (int jj = 0; jj < 4; ++jj) {
          int rl = wm * 64 + i * 32 + 8 * g + 4 * h + jj;
          float rstd = rsqrtf(sRow[rl] * (1.f / 256.f) + EPS);
          v[jj] = acc[i][2 * JP + j][4 * g + jj] * rstd;
        }
        int c = j * 32 + lq;
        int row0 = mb + i * 32 + 8 * g + 4 * h;
        if (part < 2) {
#pragma unroll
          for (int jj = 0; jj < 4; ++jj) p.Ka()[(size_t)((row0 + jj) * 4 + hd) * 192 + part * 64 + c] = f2bf(v[jj]);
        } else {
          int d = (part - 2) * 64 + c;
          int tl = tb.t + i * 32 + 8 * g + 4 * h;
          store_vt4(p.VaT(), (size_t)tb.tok0 * 512 + (size_t)(hd * 128 + d) * tb.T + tl, v[0], v[1], v[2], v[3]);
        }
      }
}

DI void epi_out(const P& p, int l, int m0, int n0, f32x16 (&acc)[2][2]) {
  const int tid_ = tidx(); const int lane = tid_ & 63, w = wave_of(tid_), wm = w >> 1, wn = w & 1, lq = lane & 31, h = lane >> 5;
  const int mb = m0 + wm * 64, nb = n0 + wn * 64;
  TokInfo tb = tinfo(mb);
  const float* gate = p.mod() + (size_t)(l * 5 + tb.modj) * 3072 + 2048;
  const float* xsrc = (l == 0) ? (tb.lat ? p.x_sample - (size_t)4096 * 1024 : p.x_prompt) : (const float*)p.xbuf();
#pragma unroll
  for (int i = 0; i < 2; ++i)
#pragma unroll
    for (int j = 0; j < 2; ++j) {
      int col = nb + j * 32 + lq;
      float gv = gate[col];
      float xo[16];
#pragma unroll
      for (int r = 0; r < 16; ++r) {
        int row = mb + i * 32 + 8 * (r >> 2) + 4 * h + (r & 3);
        xo[r] = xsrc[(size_t)row * 1024 + col];
      }
#pragma unroll
      for (int r = 0; r < 16; ++r) {
        int row = mb + i * 32 + 8 * (r >> 2) + 4 * h + (r & 3);
        p.xbuf()[(size_t)row * 1024 + col] = xo[r] + gv * acc[i][j][r];
      }
    }
}

template <int KW, int DQ, int KSPLIT>
DI void attn_pass(const bf16* __restrict__ qptr, int koff, int kh, const bf16* __restrict__ Kmain, int ldk, int Tmain,
                  const bf16* __restrict__ Kc, int ldkc, int Tc, const bf16* __restrict__ VTmain,
                  const bf16* __restrict__ VTc, float c, char* smem, f32x16 (&o)[4], float& lsum, float& m_out) {
  constexpr int KS = KW + 8;
  constexpr int NKB = 2 / KSPLIT;
  bf16* sK = (bf16*)smem;
  bf16* sV = sK + 64 * KS;
  const int tid = tidx(), lane = tid & 63, lq = lane & 31, h = lane >> 5;
  constexpr bool QLDS = (KSPLIT == 2);
  constexpr int QS = DQ + 8;
  bf16* sQ = sV + 128 * 72;
  bf16x8 qf[QLDS ? 1 : DQ / 16];
  if (QLDS) {
    constexpr int QCH = DQ / 8, NQL = 64 * QCH / 256;
    u32x4 tq[NQL];
#pragma unroll
    for (int i = 0; i < NQL; ++i) { int idx = tid + 256 * i; int r = idx / QCH, cc = idx % QCH; tq[i] = *(const u32x4*)(qptr + (size_t)r * 768 + cc * 8); }
#pragma unroll
    for (int i = 0; i < NQL; ++i) { int idx = tid + 256 * i; int r = idx / QCH, cc = idx % QCH; *(u32x4*)(sQ + r * QS + cc * 8) = tq[i]; }
  } else {
#pragma unroll
    for (int ks = 0; ks < DQ / 16; ++ks) qf[ks] = *(const bf16x8*)(qptr + ks * 16 + h * 8);
  }
  const bf16* sQl = sQ + (((wave_of(tid) & 1) * 32) + lq) * QS + h * 8;
#pragma unroll
  for (int db = 0; db < 4; ++db)
#pragma unroll
    for (int r = 0; r < 16; ++r) o[db][r] = 0.f;
  lsum = 0.f;
  float m_run = -INFINITY;
  const int nt = (Tmain + Tc) >> 6;
  constexpr int CH = KW / 8, NKL = 64 * CH / 256;
  u32x4 kr[NKL], vr[4];
  auto issue = [&](int kt) {
    const bf16* ksrc; int ld; const bf16* vsrc; int ldv;
    if (kt * 64 < Tmain) { ksrc = Kmain + (size_t)(kt * 64) * ldk; ld = ldk; vsrc = VTmain + kt * 64; ldv = Tmain; }
    else { ksrc = Kc + (size_t)(kt * 64 - Tmain) * ldkc; ld = ldkc; vsrc = VTc + (kt * 64 - Tmain); ldv = Tc; }
#pragma unroll
    for (int i = 0; i < NKL; ++i) {
      int idx = tid + 256 * i; int r = idx / CH, cc = idx % CH;
      kr[i] = *(const u32x4*)(ksrc + (size_t)r * ld + cc * 8);
    }
#pragma unroll
    for (int i = 0; i < 4; ++i) {
      int idx = tid + 256 * i; int r = idx >> 3, cc = idx & 7;
      vr[i] = *(const u32x4*)(vsrc + (size_t)r * ldv + cc * 8);
    }
  };
  issue(0);
  for (int kt = 0; kt < nt; ++kt) {
    __syncthreads();
#pragma unroll
    for (int i = 0; i < NKL; ++i) {
      int idx = tid + 256 * i; int r = idx / CH, cc = idx % CH;
      *(u32x4*)(sK + r * KS + cc * 8) = kr[i];
    }
#pragma unroll
    for (int i = 0; i < 4; ++i) {
      int idx = tid + 256 * i; int r = idx >> 3, cc = idx & 7;
      *(u32x4*)(sV + r * 72 + cc * 8) = vr[i];
    }
    __syncthreads();
    issue((kt + 1 < nt) ? kt + 1 : kt);
    f32x16 s[NKB];
#pragma unroll
    for (int kbi = 0; kbi < NKB; ++kbi)
#pragma unroll
      for (int r = 0; r < 16; ++r) s[kbi][r] = 0.f;
#pragma unroll
    for (int ks = 0; ks < DQ / 16; ++ks)
#pragma unroll
      for (int kbi = 0; kbi < NKB; ++kbi) {
        const int kb = (KSPLIT == 2) ? kh : kbi;
        bf16x8 a = *(const bf16x8*)(sK + (kb * 32 + lq) * KS + koff + ks * 16 + h * 8);
        s[kbi] = MFMA(a, QLDS ? *(const bf16x8*)(sQl + ks * 16) : qf[QLDS ? 0 : ks], s[kbi]);
      }
    float mx = -INFINITY;
#pragma unroll
    for (int kbi = 0; kbi < NKB; ++kbi)
#pragma unroll
      for (int r = 0; r < 16; ++r) mx = fmaxf(mx, s[kbi][r]);
    mx = fmaxf(mx, __shfl_xor(mx, 32));
    const float m_new = fmaxf(m_run, mx);
    const float alpha = fexp2((m_run - m_new) * c);
    m_run = m_new;
    lsum *= alpha;
#pragma unroll
    for (int db = 0; db < 4; ++db)
#pragma unroll
      for (int r = 0; r < 16; ++r) o[db][r] *= alpha;
    const float mc = m_new * c;
#pragma unroll
    for (int kbi = 0; kbi < NKB; ++kbi)
#pragma unroll
      for (int r = 0; r < 16; ++r) { float pv = fexp2(s[kbi][r] * c - mc); s[kbi][r] = pv; lsum += pv; }
#pragma unroll
    for (int kbi = 0; kbi < NKB; ++kbi) {
      const int kb = (KSPLIT == 2) ? kh : kbi;
#pragma unroll
      for (int s2 = 0; s2 < 2; ++s2) {
        u32x4 pk;
#pragma unroll
        for (int e = 0; e < 4; ++e) pk[e] = pack2(s[kbi][8 * s2 + 2 * e], s[kbi][8 * s2 + 2 * e + 1]);
        bf16x8 pb = __builtin_bit_cast(bf16x8, pk);
#pragma unroll
        for (int db = 0; db < 4; ++db) {
          const bf16* vp = sV + (db * 32 + lq) * 72 + kb * 32 + s2 * 16 + 4 * h;
          u32x2 lo = *(const u32x2*)vp, hi = *(const u32x2*)(vp + 8);
          u32x4 av; av[0] = lo[0]; av[1] = lo[1]; av[2] = hi[0]; av[3] = hi[1];
          o[db] = MFMA(__builtin_bit_cast(bf16x8, av), pb, o[db]);
        }
      }
    }
  }
  lsum += __shfl_xor(lsum, 32);
  m_out = m_run;
}

DI void mla_item(const P& p, int l, int it, char* smem) {
  const int tid = tidx(), lane = tid & 63, w = wave_of(tid), lq = lane & 31, h = lane >> 5;
  int lat, b, hd, qb;
  if (it < 256) { lat = 1; b = it >> 6; hd = (it >> 4) & 3; qb = it & 15; }
  else { int u = it - 256; lat = 0; b = u >> 4; hd = (u >> 2) & 3; qb = u & 3; }
  const int T = lat ? 1024 : 256, tok0 = lat ? 4096 + b * 1024 : b * 256;
  const int qsub = w & 1, kh = w >> 1;
  const int tok = tok0 + qb * 64 + qsub * 32 + lq;
  f32x16 o[4]; float lsum, mrun;
  const float c = 0.07216878364870322f * 1.4426950408889634f;
  attn_pass<192, 192, 2>(p.Qa() + (size_t)((tok0 + qb * 64) * 4 + hd) * 192, 0, kh, p.Ka() + (size_t)(tok0 * 4 + hd) * 192, 768, T,
                 p.cKa() + (size_t)((l * 4 + b) * 4 + hd) * 256 * 192, 192, lat ? 256 : 0,
                 p.VaT() + (size_t)tok0 * 512 + (size_t)hd * 128 * T, p.cVaT() + (size_t)((l * 4 + b) * 4 + hd) * 128 * 256, c, smem, o, lsum, mrun);
  float* ex = (float*)smem;
  float* exm = ex + 2 * 128 * 32;
  float* exl = exm + 64;
  __syncthreads();
  if (kh == 1) {
#pragma unroll
    for (int db = 0; db < 4; ++db)
#pragma unroll
      for (int r = 0; r < 16; ++r) {
        int dv = db * 32 + 8 * (r >> 2) + 4 * h + (r & 3);
        ex[(qsub * 128 + dv) * 32 + lq] = o[db][r];
      }
    if (h == 0) { exm[qsub * 32 + lq] = mrun; exl[qsub * 32 + lq] = lsum; }
  }
  __syncthreads();
  if (kh == 0) {
    const float m1 = exm[qsub * 32 + lq], l1 = exl[qsub * 32 + lq];
    const float mm = fmaxf(mrun, m1);
    const float f0 = fexp2((mrun - mm) * c), f1 = fexp2((m1 - mm) * c);
    const float inv = 1.f / (lsum * f0 + l1 * f1);
    const float g0 = f0 * inv, g1 = f1 * inv;
    u32x2 zz[4][4];
#pragma unroll
    for (int db = 0; db < 4; ++db)
#pragma unroll
      for (int g = 0; g < 4; ++g) zz[db][g] = *(const u32x2*)(p.proj() + (size_t)tok * NPROJ + 704 + hd * 128 + db * 32 + 8 * g + 4 * h);
#pragma unroll
    for (int db = 0; db < 4; ++db)
#pragma unroll
      for (int g = 0; g < 4; ++g) {
        int dv = db * 32 + 8 * g + 4 * h;
        float ov4[4];
#pragma unroll
        for (int jj = 0; jj < 4; ++jj) ov4[jj] = o[db][4 * g + jj] * g0 + ex[(qsub * 128 + dv + jj) * 32 + lq] * g1;
        u32x2 z = zz[db][g];
        float z0 = bflo(z[0]), z1 = bfhi(z[0]), z2 = bflo(z[1]), z3 = bfhi(z[1]);
        u32x2 ov;
        ov[0] = pack2(ov4[0] * silu_f(z0), ov4[1] * silu_f(z1));
        ov[1] = pack2(ov4[2] * silu_f(z2), ov4[3] * silu_f(z3));
        *(u32x2*)(p.ycat() + (size_t)tok * 1536 + hd * 128 + dv) = ov;
      }
  }
}

DI void diff_item(const P& p, int l, int it, char* smem) {
  const int tid = tidx(), lane = tid & 63, w = wave_of(tid), lq = lane & 31, h = lane >> 5;
  int lat, b, hd, qb;
  if (it < 256) { lat = 1; b = it >> 6; hd = (it >> 4) & 3; qb = it & 15; }
  else { int u = it - 256; lat = 0; b = u >> 4; hd = (u >> 2) & 3; qb = u & 3; }
  const int T = lat ? 1024 : 256, tok0 = lat ? 4096 + b * 1024 : b * 256;
  const int map = w >> 1, qsub = w & 1;
  const int tok = tok0 + qb * 64 + qsub * 32 + lq;
  const float c = 0.125f * 1.4426950408889634f;
  const bf16* vt = p.VbT() + (size_t)tok0 * 512 + (size_t)hd * 128 * T;
  const bf16* vtc = p.cVbT() + (size_t)((l * 4 + b) * 4 + hd) * 128 * 256;
  const bf16* kc = p.cKb() + (size_t)((l * 4 + b) * 4 + hd) * 256 * 128;
  f32x16 o[4]; float ls, mdummy;
  attn_pass<128, 64, 1>(p.proj() + (size_t)tok * NPROJ + 1216 + hd * 128 + map * 64, map * 64, 0, p.Kb() + (size_t)(tok0 * 4 + hd) * 128, 512, T, kc, 128,
                     lat ? 256 : 0, vt, vtc, c, smem, o, ls, mdummy);
  float* ex = (float*)smem;
  __syncthreads();
  if (map == 1) {
    const float sc2 = p.lam()[l] / ls;
#pragma unroll
    for (int db = 0; db < 4; ++db)
#pragma unroll
      for (int r = 0; r < 16; ++r) {
        int dv = db * 32 + 8 * (r >> 2) + 4 * h + (r & 3);
        ex[(qsub * 128 + dv) * 32 + lq] = o[db][r] * sc2;
      }
  }
  __syncthreads();
  if (map == 0) {
    const float i1 = 1.f / ls;
    float ss = 0.f;
#pragma unroll
    for (int db = 0; db < 4; ++db)
#pragma unroll
      for (int r = 0; r < 16; ++r) {
        int dv = db * 32 + 8 * (r >> 2) + 4 * h + (r & 3);
        float v = o[db][r] * i1 - ex[(qsub * 128 + dv) * 32 + lq];
        o[db][r] = v; ss += v * v;
      }
    ss += __shfl_xor(ss, 32);
    const float lam_init = 0.8f - 0.6f * fexp(-0.3f * (float)l);
    const float sc = rsqrtf(ss * (1.f / 128.f) + EPS) * (1.f - lam_init);
#pragma unroll
    for (int db = 0; db < 4; ++db) {
      u32x2 zz[4]; f32x4 gg[4];
#pragma unroll
      for (int g = 0; g < 4; ++g) {
        int dv = db * 32 + 8 * g + 4 * h;
        zz[g] = *(const u32x2*)(p.proj() + (size_t)tok * NPROJ + 2752 + hd * 128 + dv);
        gg[g] = *(const f32x4*)(p.dnorm + l * 128 + dv);
      }
#pragma unroll
      for (int g = 0; g < 4; ++g) {
        int dv = db * 32 + 8 * g + 4 * h;
        u32x2 z = zz[g];
        f32x4 gn = gg[g];
        float z0 = bflo(z[0]), z1 = bfhi(z[0]), z2 = bflo(z[1]), z3 = bfhi(z[1]);
        u32x2 ov;
        ov[0] = pack2(o[db][4 * g] * sc * gn[0] * silu_f(z0), o[db][4 * g + 1] * sc * gn[1] * silu_f(z1));
        ov[1] = pack2(o[db][4 * g + 2] * sc * gn[2] * silu_f(z2), o[db][4 * g + 3] * sc * gn[3] * silu_f(z3));
        *(u32x2*)(p.ycat() + (size_t)tok * 1536 + 512 + hd * 128 + dv) = ov;
      }
    }
  }
}

DI void conv8(const P& p, int l, int tok, int t, int T, int col, int wcol, float (&o)[8]) {
  const bf16* base = p.proj() + (size_t)tok * NPROJ + col;
  u32x4 cur = *(const u32x4*)base;
  u32x4 prv = {0u, 0u, 0u, 0u}, nxt = {0u, 0u, 0u, 0u};
  if (t > 0) prv = *(const u32x4*)(base - NPROJ);
  if (t < T - 1) nxt = *(const u32x4*)(base + NPROJ);
  const float* w0 = p.mconv + (size_t)l * 3 * 1024 + wcol;
  f32x4 wa0 = *(const f32x4*)w0, wa1 = *(const f32x4*)(w0 + 4);
  f32x4 wb0 = *(const f32x4*)(w0 + 1024), wb1 = *(const f32x4*)(w0 + 1028);
  f32x4 wc0 = *(const f32x4*)(w0 + 2048), wc1 = *(const f32x4*)(w0 + 2052);
#pragma unroll
  for (int e = 0; e < 4; ++e) {
    float wA0 = e < 2 ? wa0[2 * e] : wa1[2 * e - 4], wA1 = e < 2 ? wa0[2 * e + 1] : wa1[2 * e - 3];
    float wB0 = e < 2 ? wb0[2 * e] : wb1[2 * e - 4], wB1 = e < 2 ? wb0[2 * e + 1] : wb1[2 * e - 3];
    float wC0 = e < 2 ? wc0[2 * e] : wc1[2 * e - 4], wC1 = e < 2 ? wc0[2 * e + 1] : wc1[2 * e - 3];
    float v0 = wA0 * bflo(prv[e]) + wB0 * bflo(cur[e]) + wC0 * bflo(nxt[e]);
    float v1 = wA1 * bfhi(prv[e]) + wB1 * bfhi(cur[e]) + wC1 * bfhi(nxt[e]);
    o[2 * e] = silu_f(v0); o[2 * e + 1] = silu_f(v1);
  }
}

DI float wave_incl_scan_add(float v, int lane) {
#pragma unroll
  for (int o = 1; o < 64; o <<= 1) { float t = __shfl_up(v, o); if (lane >= o) v += t; }
  return v;
}
DI float wave_incl_scan_max(float v, int lane) {
#pragma unroll
  for (int o = 1; o < 64; o <<= 1) { float t = __shfl_up(v, o); if (lane >= o) v = fmaxf(v, t); }
  return v;
}

DI void mlstm_local(const P& p, int l, int slot, char* smem) {
  bf16* vT = (bf16*)smem;
  bf16* kT = vT + 128 * 72;
  float* wbuf = (float*)(kT + 128 * 72);
  const int tid = tidx(), lane = tid & 63, w = wave_of(tid), lq = lane & 31, h = lane >> 5;
  const int cp = slot >> 3, hd = (slot >> 1) & 3, dir = slot & 1;
  const int ctok = cp * 64;
  TokInfo ti = tinfo(ctok);
  const int T = ti.T;
  if (w == 0) {
    const int s = dir ? 63 - lane : lane;
    const int tk = ctok + s;
    const float ig = p.gates()[tk * 16 + dir * 8 + hd];
    const float lf = logsig_f(p.gates()[tk * 16 + dir * 8 + 4 + hd]);
    const float bc = wave_incl_scan_add(lf, lane);
    const float b_last = __shfl(bc, 63);
    const float val = b_last - bc + ig;
    float mx = val;
#pragma unroll
    for (int o = 32; o >= 1; o >>= 1) mx = fmaxf(mx, __shfl_xor(mx, o));
    wbuf[s] = fexp(val - mx);
    if (lane == 0) { p.blA()[slot] = b_last; p.mlA()[slot] = mx; }
  }
  __syncthreads();
  {
    const int s = tid >> 2, chb = (tid & 3) * 32;
    const float ws = wbuf[s];
    float kvv[4][8];
#pragma unroll
    for (int q = 0; q < 4; ++q) {
      const int ch = chb + q * 8;
      conv8(p, l, ctok + s, ti.t + s, T, 3776 + hd * 128 + ch, 512 + hd * 128 + ch, kvv[q]);
    }
#pragma unroll
    for (int q = 0; q < 4; ++q) {
      const int ch = chb + q * 8;
#pragma unroll
      for (int e = 0; e < 8; ++e) kT[(ch + e) * 72 + s] = f2bf(kvv[q][e] * ws);
    }
    const bf16* vsrc = p.VmT() + (size_t)ti.tok0 * 512 + (size_t)hd * 128 * T + ti.t;
    u32x4 tvv[4];
#pragma unroll
    for (int i = 0; i < 4; ++i) { int idx = tid + 256 * i; int r = idx >> 3, cc = idx & 7; tvv[i] = *(const u32x4*)(vsrc + (size_t)r * T + cc * 8); }
#pragma unroll
    for (int i = 0; i < 4; ++i) { int idx = tid + 256 * i; int r = idx >> 3, cc = idx & 7; *(u32x4*)(vT + r * 72 + cc * 8) = tvv[i]; }
  }
  __syncthreads();
  f32x16 acc[4];
#pragma unroll
  for (int cb = 0; cb < 4; ++cb)
#pragma unroll
    for (int r = 0; r < 16; ++r) acc[cb][r] = 0.f;
#pragma unroll
  for (int ks = 0; ks < 4; ++ks) {
    bf16x8 a = *(const bf16x8*)(vT + (32 * w + lq) * 72 + ks * 16 + 8 * h);
#pragma unroll
    for (int cb = 0; cb < 4; ++cb) {
      bf16x8 bb = *(const bf16x8*)(kT + (32 * cb + lq) * 72 + ks * 16 + 8 * h);
      acc[cb] = MFMA(a, bb, acc[cb]);
    }
  }
  bf16* cs = p.Cst() + (size_t)slot * 16384;
#pragma unroll
  for (int cb = 0; cb < 4; ++cb)
#pragma unroll
    for (int r = 0; r < 16; ++r) {
      int dvv = 32 * w + 8 * (r >> 2) + 4 * h + (r & 3);
      cs[dvv * 128 + 32 * cb + lq] = f2bf(acc[cb][r]);
    }
  if (tid < 128) {
    float sum = 0.f;
#pragma unroll
    for (int q = 0; q < 8; ++q) {
      u32x4 v = *(const u32x4*)(kT + tid * 72 + q * 8);
#pragma unroll
      for (int e = 0; e < 4; ++e) sum += bflo(v[e]) + bfhi(v[e]);
    }
    p.nst()[slot * 128 + tid] = sum;
  }
}

DI void mlstm_scan(const P& p, int l, int it) {
  const int tid = tidx();
  const int ch = it >> 2, qt = it & 3;
  int lat, b, hd, dir;
  if (ch < 32) { lat = 1; b = ch >> 3; hd = (ch >> 1) & 3; dir = ch & 1; }
  else { int u = ch - 32; lat = 0; b = u >> 3; hd = (u >> 1) & 3; dir = u & 1; }
  const int T = lat ? 1024 : 256, tok0 = lat ? 4096 + b * 1024 : b * 256, nc = T >> 6;
  const int dv0 = 32 * qt + 4 * (tid >> 5), dk0 = 4 * (tid & 31);
  float C[4][4];
  float n_val = 0.f, m_prev = 0.f;
  const bool do_n = (qt == 0) && (tid < 128);
  const size_t sidx = (size_t)((b * 4 + l) * 2 + dir) * 4 + hd;
  if (lat) {
    const float* C0 = p.st_C + sidx * 16384;
#pragma unroll
    for (int j = 0; j < 4; ++j) {
      f32x4 v = *(const f32x4*)(C0 + (size_t)(dk0 + j) * 128 + dv0);
      C[0][j] = v[0]; C[1][j] = v[1]; C[2][j] = v[2]; C[3][j] = v[3];
    }
    if (do_n) n_val = p.st_n[sidx * 128 + tid];
    m_prev = p.st_m[sidx];
  } else {
#pragma unroll
    for (int i = 0; i < 4; ++i)
#pragma unroll
      for (int j = 0; j < 4; ++j) C[i][j] = 0.f;
  }
  u32x2 dnx[4]; float blx, mlx, dnnx = 0.f;
  {
    const int c = dir ? nc - 1 : 0;
    const int slot = ((((tok0 >> 6) + c) * 4 + hd) * 2) + dir;
    const bf16* cs = p.Cst() + (size_t)slot * 16384 + dv0 * 128 + dk0;
#pragma unroll
    for (int i = 0; i < 4; ++i) dnx[i] = *(const u32x2*)(cs + i * 128);
    blx = p.blA()[slot]; mlx = p.mlA()[slot];
    if (do_n) dnnx = p.nst()[slot * 128 + tid];
  }
  for (int ci = 0; ci < nc; ++ci) {
    const int c = dir ? nc - 1 - ci : ci;
    const int slot = ((((tok0 >> 6) + c) * 4 + hd) * 2) + dir;
    bf16* cs = p.Cst() + (size_t)slot * 16384 + dv0 * 128 + dk0;
    u32x2 d[4];
#pragma unroll
    for (int i = 0; i < 4; ++i) d[i] = dnx[i];
    const float bl = blx, ml = mlx;
    const float dn = dnnx;
    {
      const int cn = (ci + 1 < nc) ? (dir ? nc - 2 - ci : ci + 1) : c;
      const int sn = ((((tok0 >> 6) + cn) * 4 + hd) * 2) + dir;
      const bf16* csn = p.Cst() + (size_t)sn * 16384 + dv0 * 128 + dk0;
#pragma unroll
      for (int i = 0; i < 4; ++i) dnx[i] = *(const u32x2*)(csn + i * 128);
      blx = p.blA()[sn]; mlx = p.mlA()[sn];
      if (do_n) dnnx = p.nst()[sn * 128 + tid];
    }
#pragma unroll
    for (int i = 0; i < 4; ++i) {
      u32x2 o; o[0] = pack2(C[i][0], C[i][1]); o[1] = pack2(C[i][2], C[i][3]);
      *(u32x2*)(cs + i * 128) = o;
    }
    if (do_n) p.nst()[slot * 128 + tid] = n_val;
    if (qt == 0 && tid == 0) p.mst()[slot] = m_prev;
    const float m_new = fmaxf(bl + m_prev, ml);
    const float a = fexp(bl + m_prev - m_new), bs = fexp(ml - m_new);
#pragma unroll
    for (int i = 0; i < 4; ++i) {
      C[i][0] = a * C[i][0] + bs * bflo(d[i][0]); C[i][1] = a * C[i][1] + bs * bfhi(d[i][0]);
      C[i][2] = a * C[i][2] + bs * bflo(d[i][1]); C[i][3] = a * C[i][3] + bs * bfhi(d[i][1]);
    }
    n_val = a * n_val + bs * dn;
    m_prev = m_new;
  }
  if (!lat) {
    float* Co = p.out + O_MC + sidx * 16384;
#pragma unroll
    for (int j = 0; j < 4; ++j) {
      f32x4 v; v[0] = C[0][j]; v[1] = C[1][j]; v[2] = C[2][j]; v[3] = C[3][j];
      *(f32x4*)(Co + (size_t)(dk0 + j) * 128 + dv0) = v;
    }
    if (do_n) p.out[O_MN + sidx * 128 + tid] = n_val;
    if (qt == 0 && tid == 0) p.out[O_MM + sidx] = m_prev;
  }
}

DI void mlstm_out(const P& p, int l, int it, char* smem) {
  bf16* sq = (bf16*)smem;
  bf16* sk = sq + 64 * 136;
  bf16* vT = sk + 64 * 136;
  float* bcA2 = (float*)(vT + 128 * 72);
  float* uA2 = bcA2 + 128, *mtA2 = uA2 + 128, *nA2 = mtA2 + 128  , *ssb = nA2 + 256  ;
  const int tid = tidx(), lane = tid & 63, w = wave_of(tid), lq = lane & 31, h = lane >> 5;
  const int cp = it >> 2, hd = it & 3;
  const int ctok = cp * 64;
  TokInfo ti = tinfo(ctok);
  const int T = ti.T;
  const float m_prev0 = p.mst()[(cp * 4 + hd) * 2], m_prev1 = p.mst()[(cp * 4 + hd) * 2 + 1];
  if (w < 2) {
    const int dir = w;
    const float m_prev = dir ? m_prev1 : m_prev0;
    const int s = dir ? 63 - lane : lane;
    const int tk = ctok + s;
    const float ig = p.gates()[tk * 16 + dir * 8 + hd];
    const float lf = logsig_f(p.gates()[tk * 16 + dir * 8 + 4 + hd]);
    const float bc = wave_incl_scan_add(lf, lane);
    const float u = ig - bc;
    const float pm = wave_incl_scan_max(u, lane);
    bcA2[dir * 64 + s] = bc; uA2[dir * 64 + s] = u; mtA2[dir * 64 + s] = bc + fmaxf(m_prev, pm);
  } else {
    const int dir = w - 2;
    const int slot = (cp * 4 + hd) * 2 + dir;
    nA2[dir * 128 + lane] = p.nst()[slot * 128 + lane];
    nA2[dir * 128 + 64 + lane] = p.nst()[slot * 128 + 64 + lane];
  }
  {
    const int s = tid >> 2, chb = (tid & 3) * 32;
#pragma unroll 2
    for (int q = 0; q < 4; ++q) {
      const int ch = chb + q * 8;
      float v[8];
      conv8(p, l, ctok + s, ti.t + s, T, 3264 + hd * 128 + ch, hd * 128 + ch, v);
      u32x4 pk;
#pragma unroll
      for (int e = 0; e < 4; ++e) pk[e] = pack2(v[2 * e] * 0.08838834764831845f, v[2 * e + 1] * 0.08838834764831845f);
      *(u32x4*)(sq + s * 136 + ch) = pk;
      conv8(p, l, ctok + s, ti.t + s, T, 3776 + hd * 128 + ch, 512 + hd * 128 + ch, v);
#pragma unroll
      for (int e = 0; e < 4; ++e) pk[e] = pack2(v[2 * e], v[2 * e + 1]);
      *(u32x4*)(sk + s * 136 + ch) = pk;
    }
    const bf16* vsrc = p.VmT() + (size_t)ti.tok0 * 512 + (size_t)hd * 128 * T + ti.t;
    u32x4 tvv[4];
#pragma unroll
    for (int i = 0; i < 4; ++i) { int idx = tid + 256 * i; int r = idx >> 3, cc = idx & 7; tvv[i] = *(const u32x4*)(vsrc + (size_t)r * T + cc * 8); }
#pragma unroll
    for (int i = 0; i < 4; ++i) { int idx = tid + 256 * i; int r = idx >> 3, cc = idx & 7; *(u32x4*)(vT + r * 72 + cc * 8) = tvv[i]; }
  }
  __syncthreads();
  const int tb = w & 1, dvh = w >> 1;
  const int t = 32 * tb + lq;
  f32x16 hacc[2];
#pragma unroll
  for (int d2 = 0; d2 < 2; ++d2)
#pragma unroll
    for (int r = 0; r < 16; ++r) hacc[d2][r] = 0.f;
  const bf16* sqt = sq + t * 136 + 8 * h;
  for (int dir = 0; dir < 2; ++dir) {
    const int slot = (cp * 4 + hd) * 2 + dir;
    const float m_prev = dir ? m_prev1 : m_prev0;
    const float* bcA = bcA2 + dir * 64;
    const float* uA = uA2 + dir * 64;
    const float* mtA = mtA2 + dir * 64;
    const float* nA = nA2 + dir * 128;
    const float bc_t = bcA[t], mt = mtA[t];
    const float w_inter = fexp(bc_t + m_prev - mt);
    float den = 0.f;
    const float e0 = bc_t - mt;
    u32x4 pk[2][2];
#pragma unroll
    for (int sb = 0; sb < 2; ++sb) {
      asm volatile("" ::: "memory");
      f32x16 sv;
#pragma unroll
      for (int r = 0; r < 16; ++r) sv[r] = 0.f;
#pragma unroll
      for (int ks = 0; ks < 8; ++ks) {
        bf16x8 a = *(const bf16x8*)(sk + (32 * sb + lq) * 136 + ks * 16 + 8 * h);
        sv = MFMA(a, *(const bf16x8*)(sqt + ks * 16), sv);
      }
#pragma unroll
      for (int r = 0; r < 16; ++r) {
        const int sidx = 32 * sb + 8 * (r >> 2) + 4 * h + (r & 3);
        const bool valid = dir ? (sidx >= t) : (sidx <= t);
        const float wgt = valid ? fexp(e0 + uA[sidx]) : 0.f;
        const float v = sv[r] * wgt;
        sv[r] = v; den += v;
      }
#pragma unroll
      for (int s2 = 0; s2 < 2; ++s2)
#pragma unroll
        for (int e = 0; e < 4; ++e) pk[sb][s2][e] = pack2(sv[8 * s2 + 2 * e], sv[8 * s2 + 2 * e + 1]);
    }
    asm volatile("" ::: "memory");
    den += __shfl_xor(den, 32);
    float qn = 0.f;
#pragma unroll
    for (int ks = 0; ks < 8; ++ks) {
      u32x4 qv = *(const u32x4*)(sqt + ks * 16);
#pragma unroll
      for (int e = 0; e < 4; ++e) {
        qn += bflo(qv[e]) * nA[ks * 16 + 8 * h + 2 * e] + bfhi(qv[e]) * nA[ks * 16 + 8 * h + 2 * e + 1];
      }
    }
    qn += __shfl_xor(qn, 32);
    den += w_inter * qn;
    asm volatile("" ::: "memory");
    const float rden = 1.f / fmaxf(fabsf(den), fexp(-mt));
    const bf16* cs = p.Cst() + (size_t)slot * 16384;
    bf16x8 cfa[2][8];
#pragma unroll
    for (int d2 = 0; d2 < 2; ++d2)
#pragma unroll
      for (int ks = 0; ks < 8; ++ks) cfa[d2][ks] = *(const bf16x8*)(cs + ((2 * dvh + d2) * 32 + lq) * 128 + ks * 16 + 8 * h);
    asm volatile("" : "+v"(cfa[0][0]), "+v"(cfa[0][1]), "+v"(cfa[0][2]), "+v"(cfa[0][3]), "+v"(cfa[0][4]), "+v"(cfa[0][5]), "+v"(cfa[0][6]), "+v"(cfa[0][7]),
                      "+v"(cfa[1][0]), "+v"(cfa[1][1]), "+v"(cfa[1][2]), "+v"(cfa[1][3]), "+v"(cfa[1][4]), "+v"(cfa[1][5]), "+v"(cfa[1][6]), "+v"(cfa[1][7]));
#pragma unroll
    for (int d2 = 0; d2 < 2; ++d2) {
      const int dvb = 2 * dvh + d2;
      f32x16 acc;
#pragma unroll
      for (int r = 0; r < 16; ++r) acc[r] = 0.f;
#pragma unroll
      for (int ks = 0; ks < 8; ++ks) acc = MFMA(cfa[d2][ks], *(const bf16x8*)(sqt + ks * 16), acc);
#pragma unroll
      for (int r = 0; r < 16; ++r) acc[r] *= w_inter;
#pragma unroll
      for (int sb = 0; sb < 2; ++sb)
#pragma unroll
        for (int s2 = 0; s2 < 2; ++s2) {
          const bf16* vp = vT + (dvb * 32 + lq) * 72 + sb * 32 + s2 * 16 + 4 * h;
          u32x2 lo = *(const u32x2*)vp, hi = *(const u32x2*)(vp + 8);
          u32x4 av; av[0] = lo[0]; av[1] = lo[1]; av[2] = hi[0]; av[3] = hi[1];
          acc = MFMA(__builtin_bit_cast(bf16x8, av), __builtin_bit_cast(bf16x8, pk[sb][s2]), acc);
        }
#pragma unroll
      for (int r = 0; r < 16; ++r) hacc[d2][r] += acc[r] * rden;
    }
  }
  const int tok = ctok + t;
  float ss = 0.f;
#pragma unroll
  for (int d2 = 0; d2 < 2; ++d2)
#pragma unroll
    for (int g = 0; g < 4; ++g) {
      int dv = (2 * dvh + d2) * 32 + 8 * g + 4 * h;
      u32x2 mo = *(const u32x2*)(p.proj() + (size_t)tok * NPROJ + 4800 + hd * 128 + dv);
      float m0 = bflo(mo[0]), m1 = bfhi(mo[0]), m2 = bflo(mo[1]), m3 = bfhi(mo[1]);
      float v0 = hacc[d2][4 * g] * sigmoid_f(m0), v1 = hacc[d2][4 * g + 1] * sigmoid_f(m1);
      float v2 = hacc[d2][4 * g + 2] * sigmoid_f(m2), v3 = hacc[d2][4 * g + 3] * sigmoid_f(m3);
      hacc[d2][4 * g] = v0; hacc[d2][4 * g + 1] = v1; hacc[d2][4 * g + 2] = v2; hacc[d2][4 * g + 3] = v3;
      ss += v0 * v0 + v1 * v1 + v2 * v2 + v3 * v3;
    }
  ss += __shfl_xor(ss, 32);
  if (h == 0) ssb[dvh * 64 + t] = ss;
  __syncthreads();
  const float rstd = rsqrtf((ssb[t] + ssb[64 + t]) * (1.f / 128.f) + EPS);
  u32x2 zz[2][4]; f32x4 gg[2][4];
#pragma unroll
  for (int d2 = 0; d2 < 2; ++d2)
#pragma unroll
    for (int g = 0; g < 4; ++g) {
      int dv = (2 * dvh + d2) * 32 + 8 * g + 4 * h;
      zz[d2][g] = *(const u32x2*)(p.proj() + (size_t)tok * NPROJ + 5312 + hd * 128 + dv);
      gg[d2][g] = *(const f32x4*)(p.mnorm + l * 512 + hd * 128 + dv);
    }
#pragma unroll
  for (int d2 = 0; d2 < 2; ++d2)
#pragma unroll
    for (int g = 0; g < 4; ++g) {
      int dv = (2 * dvh + d2) * 32 + 8 * g + 4 * h;
      u32x2 z = zz[d2][g];
      f32x4 gn = gg[d2][g];
      float z0 = bflo(z[0]), z1 = bfhi(z[0]), z2 = bflo(z[1]), z3 = bfhi(z[1]);
      u32x2 ov;
      ov[0] = pack2(hacc[d2][4 * g] * rstd * gn[0] * silu_f(z0), hacc[d2][4 * g + 1] * rstd * gn[1] * silu_f(z1));
      ov[1] = pack2(hacc[d2][4 * g + 2] * rstd * gn[2] * silu_f(z2), hacc[d2][4 * g + 3] * rstd * gn[3] * silu_f(z3));
      *(u32x2*)(p.ycat() + (size_t)tok * 1536 + 1024 + hd * 128 + dv) = ov;
    }
}

DI void ckv_fin(const P& p, int l, int tok) {
  const int lane = tidx() & 63;
  const int b = tok >> 8, t = tok & 255;
  float* o = p.out + O_CKV + (size_t)((b * 4 + l) * 256 + t) * 256 + lane * 4;
  u32x2 raw = *(const u32x2*)(p.proj() + (size_t)tok * NPROJ + 384 + lane * 4);
  f32x4 v; v[0] = bflo(raw[0]); v[1] = bfhi(raw[0]); v[2] = bflo(raw[1]); v[3] = bfhi(raw[1]);
  float ss = v[0] * v[0] + v[1] * v[1] + v[2] * v[2] + v[3] * v[3];
#pragma unroll
  for (int of = 32; of >= 1; of >>= 1) ss += __shfl_xor(ss, of);
  const float rstd = rsqrtf(ss * (1.f / 256.f) + EPS);
  f32x4 g = *(const f32x4*)(p.kv_norm + l * 256 + lane * 4);
  v[0] *= rstd * g[0]; v[1] *= rstd * g[1]; v[2] *= rstd * g[2]; v[3] *= rstd * g[3];
  *(f32x4*)o = v;
}

#define XB_TMO      128
#define XB_XCNT(j)  (256  + 64 * (j))
#define XB_XSUB(j)  (1280 + 64 * (j))
#define XB_XGEN(j)  (2304 + 64 * (j))
#define XB_TOP      3328
#define XB_TOPGEN   3392
#define XCD_BAR_WORDS 3456
#define XB_SPIN_CAP (1u << 18)
#define LAS __attribute__((address_space(3)))

__device__ __forceinline__ unsigned xb_ld(unsigned* p)              { return __hip_atomic_load(p, __ATOMIC_RELAXED, __HIP_MEMORY_SCOPE_AGENT); }
__device__ __forceinline__ unsigned xb_add(unsigned* p, unsigned v) { return __hip_atomic_fetch_add(p, v, __ATOMIC_RELAXED, __HIP_MEMORY_SCOPE_AGENT); }
__device__ __forceinline__ unsigned xb_xcc_id() { return (unsigned)__builtin_amdgcn_s_getreg((3 << 11) | 20) & 0xFu; }
#define XB_SPIN(cond, bar) do { unsigned _sp = 0; while (cond) { __builtin_amdgcn_s_sleep(1); \
    if ((++_sp & 255u) == 0u) { if (xb_ld(&(bar)[XB_TMO])) break; if (_sp > XB_SPIN_CAP) { atomicAdd(&(bar)[XB_TMO], 1u); break; } } } } while (0)

struct XcdBarrier {
    unsigned* bar; unsigned x;
    volatile LAS unsigned* st;
};

__device__ __forceinline__ XcdBarrier xcd_barrier_post(unsigned* bar, volatile LAS unsigned* st) {
    XcdBarrier b; b.bar = bar; b.x = xb_xcc_id(); b.st = st;
    if (tidx() == 0) (void)xb_add(&bar[XB_XCNT(b.x)], 1u);
    return b;
}
__device__ __forceinline__ void xcd_barrier_complete(unsigned* bar, unsigned x, unsigned& nloc, unsigned& nx) {
    const unsigned G = gridDim.x * gridDim.y * gridDim.z;
    unsigned sum, cnt, mine, sp = 0u;
    for (;;) {
        sum = 0u; cnt = 0u; mine = 0u;
#pragma unroll
        for (unsigned j = 0; j < 16; ++j) { const unsigned c = xb_ld(&bar[XB_XCNT(j)]); sum += c; cnt += (c > 0u) ? 1u : 0u; mine = (j == x) ? c : mine; }
        if (sum == G) break;
        __builtin_amdgcn_s_sleep(1);
        if ((++sp & 255u) == 0u) { if (xb_ld(&bar[XB_TMO])) break; if (sp > XB_SPIN_CAP) { atomicAdd(&bar[XB_TMO], 1u); break; } }
    }
    nloc = mine > 0u ? mine : 1u; nx = cnt > 0u ? cnt : 1u;
}

__device__ __forceinline__ void xcd_barrier(const XcdBarrier& b) {
    asm volatile("s_waitcnt vmcnt(0)" ::: "memory");
    __syncthreads();
    if (tidx() == 0) {
        unsigned* bar = b.bar;
        __builtin_amdgcn_s_waitcnt(0);
        unsigned nloc = b.st[0], nx = b.st[1];
        if (nloc == 0u) { xcd_barrier_complete(bar, b.x, nloc, nx); b.st[0] = nloc; b.st[1] = nx; }
        const unsigned old = xb_add(&bar[XB_XSUB(b.x)], 1u);
        const unsigned gen = old / nloc;
        if (old + 1u == (gen + 1u) * nloc) {
            __builtin_amdgcn_fence(__ATOMIC_RELEASE, "agent");
            asm volatile("s_waitcnt vmcnt(0)" ::: "memory");
            const unsigned og = xb_add(&bar[XB_TOP], 1u);
            const unsigned tg = og / nx;
            if (og + 1u == (tg + 1u) * nx) xb_add(&bar[XB_TOPGEN], 1u);
            else XB_SPIN(xb_ld(&bar[XB_TOPGEN]) == tg, bar);
            __builtin_amdgcn_fence(__ATOMIC_ACQUIRE, "agent");
            xb_add(&bar[XB_XGEN(b.x)], 1u);
            asm volatile("s_waitcnt vmcnt(0)" ::: "memory");
        } else {
            XB_SPIN(xb_ld(&bar[XB_XGEN(b.x)]) == gen, bar);
            __builtin_amdgcn_fence(__ATOMIC_ACQUIRE, "agent");
            asm volatile("s_waitcnt vmcnt(0)" ::: "memory");
        }
    }
    __syncthreads();
}


DI P launder(const P& p) {
  P q = p;
#define LND(m) { asm volatile("" : "+s"(q.m)); q.m = (decltype(q.m))(__attribute__((address_space(1))) void*)(void*)q.m; }
  LND(x_prompt) LND(x_sample) LND(c_ckv) LND(c_krope) LND(c_dk) LND(c_dv) LND(st_C) LND(st_n) LND(st_m) LND(c) LND(c_ctx)
  LND(g_norm) LND(W_mod) LND(b_mod) LND(W_in) LND(q_norm) LND(W_uq) LND(kv_norm) LND(W_ukv) LND(dlam) LND(dnorm) LND(mconv)
  LND(mgb) LND(mnorm) LND(W_out) LND(g_final) LND(out) LND(ws)
#undef LND
  return q;
}

template <int KIND>
DI void run_phase(const P& p0, int ph, char* smem) {
  const P& p = p0;
  const int G = gridDim.x, B = blockIdx.x, w = wave_of(tidx());
  if ((KIND < 0 || KIND == 0) && ph == 0) { phase_prepass(p, smem); return; }
  if ((KIND < 0 || KIND == 1) && ph == 1) {
    for (int it = B; it < 256 + 2048; it += G) {
      if (it < 256) {
        int mt = it >> 3, nt = it & 7;
        int l = (mt * 128) >> 10;
        f32x16 acc[2][2];
        gemm_core<false>(p.cckv() + (size_t)mt * 128 * 256, 256, p.WukvTp() + (size_t)l * 1024 * 256 + (size_t)nt * 128 * 256, 256, 256, smem, acc);
        epi_kv(p, mt * 128, nt * 128, acc, nullptr, true);
      } else {
        norm_row(p, 0, (it - 256) * 4 + w, 0);
      }
    }
    return;
  }
  const int l = (ph - 2) / 6, sub = (ph - 2) % 6;
  if ((KIND < 0 || KIND == 2) && sub == 0) {
    const int x = B & 7, j = B >> 3, per = G >> 3;
    const bf16* Ab = p.hbuf();
    const bf16* Wb = p.WinT() + (size_t)l * NPROJ * 1024;
    for (int q = j; q < 3 * 64; q += per) {
      const int r = q >> 6, jj = q & 63;
      const int st = r * 8 + x;
      const int mt = (st / 3) * 8 + (jj >> 3), nt = (st % 3) * 8 + (jj & 7);
      if (nt >= 23) continue;
      f32x16 acc[2][4];
      gemm_core_w(Ab + (size_t)mt * 128 * 1024, 1024, Wb + (size_t)nt * 256 * 1024, 1024, 1024, smem, acc);
      epi_inproj_w(p, l, mt * 128, nt * 256, acc, smem);
    }
  } else if ((KIND < 0 || KIND == 3) && sub == 1) {
    const int N_CH = 1024, N_QA = 64 * 3, N_KV = 64 * 4, N_CF = 1024;
    const float* sRowW = (const float*)(smem + (128 + 256) * 72 * 2);
    for (int it = B; it < N_CH + N_QA + N_KV + N_CF; it += G) {
      int u = it;
      __syncthreads();
      if (u < N_CH) { mlstm_local(p, l, u, smem); continue; }
      u -= N_CH;
      if (u < N_QA) {
        int mt = u / 3, nt = u % 3;
        f32x16 acc[2][4];
        gemm_core_w<true>(p.proj() + (size_t)mt * 128 * NPROJ, NPROJ, p.WuqT() + (size_t)l * 768 * 384 + (size_t)nt * 256 * 384, 384, 384, smem, acc);
        epi_qa_w<0>(p, mt * 128, nt * 256, acc, sRowW);
        epi_qa_w<1>(p, mt * 128, nt * 256, acc, sRowW);
        continue;
      }
      u -= N_QA;
      if (u < N_KV) {
        int mt = u >> 2, nt = u & 3;
        f32x16 acc[2][4];
        gemm_core_w<true>(p.proj() + (size_t)mt * 128 * NPROJ + 384, NPROJ, p.WukvT() + (size_t)l * 1024 * 256 + (size_t)nt * 256 * 256, 256, 256, smem, acc);
        epi_kv_w<0>(p, mt * 128, nt * 256, acc, sRowW);
        epi_kv_w<1>(p, mt * 128, nt * 256, acc, sRowW);
        continue;
      }
      u -= N_KV;
      ckv_fin(p, l, u * 4 + w);
    }
  } else if ((KIND < 0 || KIND == 7) && sub == 2) {
    for (int it = B; it < 640; it += G) mlstm_scan(p, l, it);
  } else if ((KIND < 0 || KIND == 4) && sub == 3) {
    const int x = B & 7;
    int* qctr = p.qc() + ph * 8 + x;
    int* sslot = (int*)(smem + SMEM_BYTES - 16);
    for (;;) {
      __syncthreads();
      if (tidx() == 0) *sslot = atomicAdd(qctr, 1);
      __syncthreads();
      const int q = *sslot;
      if (q >= 192) break;
      __syncthreads();
      if (q < 32) { const int pr = 2 * x + (q >> 4); mla_item(p, l, pr * 16 + (q & 15), smem); }
      else if (q < 64) { const int u = q - 32; const int pr = 2 * x + (u >> 4); diff_item(p, l, pr * 16 + (u & 15), smem); }
      else if (q < 128) mlstm_out(p, l, x * 64 + (q - 64), smem);
      else if (q < 160) { const int u = q - 128; const int pr = 8 * x + (u >> 2); mla_item(p, l, 256 + pr * 4 + (u & 3), smem); }
      else { const int u = q - 160; const int pr = 8 * x + (u >> 2); diff_item(p, l, 256 + pr * 4 + (u & 3), smem); }
    }
  } else if ((KIND < 0 || KIND == 5) && sub == 4) {
    const int x = B & 7, j = B >> 3, per = G >> 3;
    for (int q = j; q < 64; q += per) {
      const int mt = x * 8 + (q >> 3), nt = q & 7;
      f32x16 acc[2][2];
      gemm_core<false>(p.ycat() + (size_t)mt * 128 * 1536, 1536, p.WoutT() + (size_t)l * 1024 * 1536 + (size_t)nt * 128 * 1536, 1536, 1536, smem, acc);
      epi_out(p, l, mt * 128, nt * 128, acc);
    }
  } else if ((KIND < 0 || KIND == 6) && sub == 5) {
    for (int it = B; it < 2048; it += G) {
      if (l < 3) norm_row(p, l + 1, it * 4 + w, 0);
      else norm_row(p, 0, it * 4 + w, 1);
    }
  }
}

#if COOP
__global__ void __launch_bounds__(256, 2) mega(P p, int lo, int hi, int coop) {
  __shared__ __attribute__((aligned(16))) char smem[SMEM_BYTES];
  __shared__ uint4 xb_words;
  if (threadIdx.x == 0) xb_words = make_uint4(0u, 0u, 0u, 0u);
  tidx_init();
  XcdBarrier xb = xcd_barrier_post((unsigned*)p.ctr(), (volatile LAS unsigned*)&xb_words);
  for (int ph = lo; ph < hi; ++ph) {
    run_phase<-1>(p, ph, smem);
    if (PROBE_DUP) {
      const int kind = ph < 2 ? ph : 2 + (ph - 2) % 6;
      if ((PROBE_DUP >> kind) & 1) { xcd_barrier(xb); run_phase<-1>(p, ph, smem); }
    }
    if (ph + 1 < hi) xcd_barrier(xb);
  }
  if (coop == 2) cg::this_grid().sync();
}
#endif
template <int KIND>
__global__ void __launch_bounds__(256) phase_k(P p, int ph) {
  __shared__ __attribute__((aligned(16))) char smem[SMEM_BYTES];
  tidx_init();
  run_phase<KIND>(p, ph, smem);
}

extern "C" void kernel_launch(void* const* d_in, const int* in_sizes, int n_in, void* d_out, int out_size, void* d_ws,
                              size_t ws_size, hipStream_t stream) {
  P p{};
  const float** ins = (const float**)&p;
  for (int i = 0; i < 26; ++i) ins[i] = (const float*)d_in[i];
  p.out = (float*)d_out;
  p.ws = (char*)d_ws;
  if (WS_TOTAL > ws_size) { fprintf(stderr, "workspace too small: need %zu have %zu\n", (size_t)WS_TOTAL, ws_size); return; }

#if COOP
  static int grid_blocks = 0;
  if (!grid_blocks) {
    int dev = 0, cus = 0, per_cu = 0;
    (void)hipGetDevice(&dev);
    (void)hipDeviceGetAttribute(&cus, hipDeviceAttributeMultiprocessorCount, dev);
    (void)hipOccupancyMaxActiveBlocksPerMultiprocessor(&per_cu, mega, 256, 0);
    if (per_cu > 2) per_cu = 2;
    grid_blocks = cus * per_cu;
  }
  (void)hipMemsetAsync(p.ws + OFF_ctr, 0, 16384 + 4096, stream);
  int lo = 0, hi = NPHASE, coop = 1;
  void* args[] = {&p, &lo, &hi, &coop};
  hipError_t e = hipLaunchCooperativeKernel((void*)mega, dim3(grid_blocks), dim3(256), args, 0, stream);
  if (e != hipSuccess) fprintf(stderr, "cooperative launch failed: %s (grid %d)\n", hipGetErrorString(e), grid_blocks);
#else
  for (int ph = 0; ph < NPHASE; ++ph) {
    static const int kmap[6] = {2, 3, 7, 4, 5, 6};
    int kind = ph < 2 ? ph : kmap[(ph - 2) % 6];
    switch (kind) {
      case 0: phase_k<0><<<512, 256, 0, stream>>>(p, ph); break;
      case 1: phase_k<1><<<512, 256, 0, stream>>>(p, ph); break;
      case 2: phase_k<2><<<512, 256, 0, stream>>>(p, ph); break;
      case 3: phase_k<3><<<512, 256, 0, stream>>>(p, ph); break;
      case 4: phase_k<4><<<512, 256, 0, stream>>>(p, ph); break;
      case 5: phase_k<5><<<512, 256, 0, stream>>>(p, ph); break;
      case 7: phase_k<7><<<512, 256, 0, stream>>>(p, ph); break;
      default: phase_k<6><<<512, 256, 0, stream>>>(p, ph); break;
    }
  }
#endif
}
```

```cpp
#include <hip/hip_runtime.h>
#include <hip/hip_cooperative_groups.h>
#include <cstdio>
namespace cg = cooperative_groups;

typedef unsigned short bf16;
typedef __attribute__((ext_vector_type(8))) short bf16x8;
typedef __attribute__((ext_vector_type(4))) short s16x4;
typedef __attribute__((ext_vector_type(16))) float f32x16;
typedef __attribute__((ext_vector_type(4))) float f32x4;
typedef __attribute__((ext_vector_type(4))) unsigned u32x4;
typedef __attribute__((ext_vector_type(2))) unsigned u32x2;

#define DI __device__ __forceinline__
#define MFMA(a, b, c) __builtin_amdgcn_mfma_f32_32x32x16_bf16((a), (b), (c), 0, 0, 0)

#ifndef COOP
#define COOP 1
#endif
#define PROBE_DUP 0

constexpr int NTOK = 8192;
constexpr int NPROJ = 5888;
constexpr int NPHASE = 26;
constexpr float EPS = 1e-6f;
constexpr int SMEM_BYTES = 75 * 1024;

constexpr size_t O_YP = 0, O_YS = 4194304, O_CKV = 8388608, O_KROPE = 12582912, O_DK = 13631488,
                 O_DV = 22020096, O_MC = 30408704, O_MN = 38797312, O_MM = 38862848;

constexpr size_t al256(size_t x) { return (x + 255) & ~(size_t)255; }
constexpr size_t OFF_WinT = 0;
constexpr size_t OFF_WuqT = OFF_WinT + al256((size_t)4 * NPROJ * 1024 * 2);
constexpr size_t OFF_WukvT = OFF_WuqT + al256((size_t)4 * 768 * 384 * 2);
constexpr size_t OFF_WukvTp = OFF_WukvT + al256((size_t)4 * 1024 * 256 * 2);
constexpr size_t OFF_WoutT = OFF_WukvTp + al256((size_t)4 * 1024 * 256 * 2);
constexpr size_t OFF_mod = OFF_WoutT + al256((size_t)4 * 1024 * 1536 * 2);
constexpr size_t OFF_ropec = OFF_mod + al256((size_t)4 * 5 * 3072 * 4);
constexpr size_t OFF_ropes = OFF_ropec + al256((size_t)1024 * 32 * 4);
constexpr size_t OFF_lam = OFF_ropes + al256((size_t)1024 * 32 * 4);
constexpr size_t OFF_hbuf = OFF_lam + al256((size_t)256);
constexpr size_t OFF_xbuf = OFF_hbuf + al256((size_t)NTOK * 1024 * 2);
constexpr size_t OFF_proj = OFF_xbuf + al256((size_t)NTOK * 1024 * 4);
constexpr size_t OFF_Qa = OFF_proj + al256((size_t)NTOK * NPROJ * 2);
constexpr size_t OFF_Ka = OFF_Qa + al256((size_t)NTOK * 768 * 2);
constexpr size_t OFF_VaT = OFF_Ka + al256((size_t)NTOK * 768 * 2);
constexpr size_t OFF_Kb = OFF_VaT + al256((size_t)NTOK * 512 * 2);
constexpr size_t OFF_VbT = OFF_Kb + al256((size_t)NTOK * 512 * 2);
constexpr size_t OFF_VmT = OFF_VbT + al256((size_t)NTOK * 512 * 2);
constexpr size_t OFF_ycat = OFF_VmT + al256((size_t)NTOK * 512 * 2);
constexpr size_t OFF_gates = OFF_ycat + al256((size_t)NTOK * 1536 * 2);
constexpr size_t OFF_Cst = OFF_gates + al256((size_t)NTOK * 16 * 4);
constexpr size_t OFF_nst = OFF_Cst + al256((size_t)1024 * 16384 * 2);
constexpr size_t OFF_mst = OFF_nst + al256((size_t)1024 * 128 * 4);
constexpr size_t OFF_cckv = OFF_mst + al256((size_t)1024 * 4);
constexpr size_t OFF_cKa = OFF_cckv + al256((size_t)4096 * 256 * 2);
constexpr size_t OFF_cVaT = OFF_cKa + al256((size_t)64 * 256 * 192 * 2);
constexpr size_t OFF_cKb = OFF_cVaT + al256((size_t)64 * 128 * 256 * 2);
constexpr size_t OFF_cVbT = OFF_cKb + al256((size_t)64 * 256 * 128 * 2);
constexpr size_t OFF_blA = OFF_cVbT + al256((size_t)64 * 128 * 256 * 2);
constexpr size_t OFF_mlA = OFF_blA + 4096;
constexpr size_t OFF_ctr = OFF_mlA + 4096;
constexpr size_t OFF_qc = OFF_ctr + 16384;
constexpr size_t WS_TOTAL = OFF_qc + 4096;
struct P {
  const float *x_prompt, *x_sample, *c_ckv, *c_krope, *c_dk, *c_dv, *st_C, *st_n, *st_m, *c, *c_ctx, *g_norm, *W_mod,
      *b_mod, *W_in, *q_norm, *W_uq, *kv_norm, *W_ukv, *dlam, *dnorm, *mconv, *mgb, *mnorm, *W_out, *g_final;
  float* out;
  char* ws;
  __device__ __forceinline__ bf16* WinT() const { return (bf16*)(ws + OFF_WinT); }
  __device__ __forceinline__ bf16* WuqT() const { return (bf16*)(ws + OFF_WuqT); }
  __device__ __forceinline__ bf16* WukvT() const { return (bf16*)(ws + OFF_WukvT); }
  __device__ __forceinline__ bf16* WukvTp() const { return (bf16*)(ws + OFF_WukvTp); }
  __device__ __forceinline__ bf16* WoutT() const { return (bf16*)(ws + OFF_WoutT); }
  __device__ __forceinline__ float* mod() const { return (float*)(ws + OFF_mod); }
  __device__ __forceinline__ float* ropec() const { return (float*)(ws + OFF_ropec); }
  __device__ __forceinline__ float* ropes() const { return (float*)(ws + OFF_ropes); }
  __device__ __forceinline__ float* lam() const { return (float*)(ws + OFF_lam); }
  __device__ __forceinline__ bf16* hbuf() const { return (bf16*)(ws + OFF_hbuf); }
  __device__ __forceinline__ float* xbuf() const { return (float*)(ws + OFF_xbuf); }
  __device__ __forceinline__ bf16* proj() const { return (bf16*)(ws + OFF_proj); }
  __device__ __forceinline__ bf16* Qa() const { return (bf16*)(ws + OFF_Qa); }
  __device__ __forceinline__ bf16* Ka() const { return (bf16*)(ws + OFF_Ka); }
  __device__ __forceinline__ bf16* VaT() const { return (bf16*)(ws + OFF_VaT); }
  __device__ __forceinline__ bf16* Kb() const { return (bf16*)(ws + OFF_Kb); }
  __device__ __forceinline__ bf16* VbT() const { return (bf16*)(ws + OFF_VbT); }
  __device__ __forceinline__ bf16* VmT() const { return (bf16*)(ws + OFF_VmT); }
  __device__ __forceinline__ bf16* ycat() const { return (bf16*)(ws + OFF_ycat); }
  __device__ __forceinline__ float* gates() const { return (float*)(ws + OFF_gates); }
  __device__ __forceinline__ bf16* Cst() const { return (bf16*)(ws + OFF_Cst); }
  __device__ __forceinline__ float* nst() const { return (float*)(ws + OFF_nst); }
  __device__ __forceinline__ float* mst() const { return (float*)(ws + OFF_mst); }
  __device__ __forceinline__ bf16* cckv() const { return (bf16*)(ws + OFF_cckv); }
  __device__ __forceinline__ bf16* cKa() const { return (bf16*)(ws + OFF_cKa); }
  __device__ __forceinline__ bf16* cVaT() const { return (bf16*)(ws + OFF_cVaT); }
  __device__ __forceinline__ bf16* cKb() const { return (bf16*)(ws + OFF_cKb); }
  __device__ __forceinline__ bf16* cVbT() const { return (bf16*)(ws + OFF_cVbT); }
  __device__ __forceinline__ int* ctr() const { return (int*)(ws + OFF_ctr); }
  __device__ __forceinline__ int* qc() const { return (int*)(ws + OFF_qc); }
  __device__ __forceinline__ float* blA() const { return (float*)(ws + OFF_blA); }
  __device__ __forceinline__ float* mlA() const { return (float*)(ws + OFF_mlA); }
};

DI int tidx() { int t = threadIdx.x; asm volatile("" : "+v"(t)); return t; }
DI void tidx_init() {}
DI int wave_of(int tid) { return __builtin_amdgcn_readfirstlane(tid >> 6); }
typedef __attribute__((ext_vector_type(2))) __bf16 bf16v2;
typedef __attribute__((ext_vector_type(2))) float f32x2;
DI unsigned pack2(float a, float b) {
  f32x2 v; v[0] = a; v[1] = b;
  return __builtin_bit_cast(unsigned, __builtin_convertvector(v, bf16v2));
}
DI bf16 f2bf(float x) { return (bf16)(pack2(x, 0.f) & 0xffffu); }
DI float bf2f(bf16 b) { return __uint_as_float(((unsigned)b) << 16); }
DI float fexp2(float x) { return __builtin_amdgcn_exp2f(x); }
DI float fexp(float x) { return __builtin_amdgcn_exp2f(x * 1.4426950408889634f); }
DI float bflo(unsigned u) { return __uint_as_float(u << 16); }
DI float bfhi(unsigned u) { return __uint_as_float(u & 0xffff0000u); }
DI float silu_f(float x) { return x * __builtin_amdgcn_rcpf(1.f + fexp(-x)); }
DI float sigmoid_f(float x) { return __builtin_amdgcn_rcpf(1.f + fexp(-x)); }
DI float logsig_f(float x) { return fminf(x, 0.f) - log1pf(fexp(-fabsf(x))); }

struct TokInfo { int lat, b, t, T, tok0, modj; };
DI TokInfo tinfo(int tok) {
  TokInfo r;
  if (tok < 4096) { r.lat = 0; r.b = tok >> 8; r.t = tok & 255; r.T = 256; r.tok0 = tok & ~255; r.modj = 0; }
  else { int u = tok - 4096; r.lat = 1; r.b = u >> 10; r.t = u & 1023; r.T = 1024; r.tok0 = 4096 + (u & ~1023); r.modj = 1 + r.b; }
  return r;
}

struct GR { u32x4 ra0[4], rb0[4], ra1[4], rb1[4]; };
DI void gemm_load2(GR& g, const bf16* __restrict__ A, int lda, const bf16* __restrict__ Bt, int ldb) {
  const int tid = tidx();
  const int lr = tid >> 3, lc = tid & 7;
  const bf16* ap = A + (size_t)lr * lda + lc * 8;
  const bf16* bp = Bt + (size_t)lr * ldb + lc * 8;
  const size_t a32 = (size_t)32 * lda, b32 = (size_t)32 * ldb;
#pragma unroll
  for (int i = 0; i < 4; ++i) { g.ra0[i] = *(const u32x4*)(ap + i * a32); g.rb0[i] = *(const u32x4*)(bp + i * b32); }
#pragma unroll
  for (int i = 0; i < 4; ++i) { g.ra1[i] = *(const u32x4*)(ap + 64 + i * a32); g.rb1[i] = *(const u32x4*)(bp + 64 + i * b32); }
}
template <bool ROWSS>
DI void gemm_core_n(GR& g, const bf16* __restrict__ A, int lda, const bf16* __restrict__ Bt, int ldb,
                    const bf16* __restrict__ An, const bf16* __restrict__ Btn, int K, char* smem, f32x16 (&acc)[2][2]) {
  bf16* sA = (bf16*)smem;
  bf16* sB = sA + 128 * 72;
  float* sRow = (float*)(sB + 128 * 72);
  const int tid = tidx(), lane = tid & 63, w = wave_of(tid);
  const int wm = w >> 1, wn = w & 1, lq = lane & 31, h = lane >> 5;
  const int lr = tid >> 3, lc = tid & 7;
  float ss[4] = {0.f, 0.f, 0.f, 0.f};
#pragma unroll
  for (int i = 0; i < 2; ++i)
#pragma unroll
    for (int j = 0; j < 2; ++j)
#pragma unroll
      for (int r = 0; r < 16; ++r) acc[i][j][r] = 0.f;
  const bf16* ap = A + (size_t)lr * lda + lc * 8;
  const bf16* bp = Bt + (size_t)lr * ldb + lc * 8;
  const bf16* apn = An + (size_t)lr * lda + lc * 8;
  const bf16* bpn = Btn + (size_t)lr * ldb + lc * 8;
  const size_t a32 = (size_t)32 * lda, b32 = (size_t)32 * ldb;
  const int nk = K >> 6;
  auto step = [&](u32x4 (&ra)[4], u32x4 (&rb)[4], int kt) {
    if (kt) __syncthreads();
#pragma unroll
    for (int i = 0; i < 4; ++i) {
      *(u32x4*)(sA + (lr + 32 * i) * 72 + lc * 8) = ra[i];
      *(u32x4*)(sB + (lr + 32 * i) * 72 + lc * 8) = rb[i];
    }
    if (ROWSS) {
#pragma unroll
      for (int i = 0; i < 4; ++i)
#pragma unroll
        for (int e = 0; e < 4; ++e) {
          float a0 = bflo(ra[i][e]), a1 = bfhi(ra[i][e]);
          ss[i] += a0 * a0 + a1 * a1;
        }
    }
    __syncthreads();
    {
      const int kn = kt + 2;
      const bf16* ap2 = (kn < nk) ? ap + (size_t)kn * 64 : apn + (size_t)(kn - nk) * 64;
      const bf16* bp2 = (kn < nk) ? bp + (size_t)kn * 64 : bpn + (size_t)(kn - nk) * 64;
#pragma unroll
      for (int i = 0; i < 4; ++i) { ra[i] = *(const u32x4*)(ap2 + i * a32); rb[i] = *(const u32x4*)(bp2 + i * b32); }
    }
#pragma unroll
    for (int ks = 0; ks < 4; ++ks) {
      bf16x8 af[2], bfr[2];
#pragma unroll
      for (int i = 0; i < 2; ++i) af[i] = *(const bf16x8*)(sA + (wm * 64 + i * 32 + lq) * 72 + ks * 16 + h * 8);
#pragma unroll
      for (int j = 0; j < 2; ++j) bfr[j] = *(const bf16x8*)(sB + (wn * 64 + j * 32 + lq) * 72 + ks * 16 + h * 8);
#pragma unroll
      for (int i = 0; i < 2; ++i)
#pragma unroll
        for (int j = 0; j < 2; ++j) acc[i][j] = MFMA(af[i], bfr[j], acc[i][j]);
    }
  };
  for (int kt = 0; kt < nk; kt += 2) {
    step(g.ra0, g.rb0, kt);
    step(g.ra1, g.rb1, kt + 1);
  }
  if (ROWSS) {
#pragma unroll
    for (int i = 0; i < 4; ++i) {
      float v = ss[i];
      v += __shfl_xor(v, 1); v += __shfl_xor(v, 2); v += __shfl_xor(v, 4);
      if (lc == 0) sRow[lr + 32 * i] = v;
    }
  }
  __syncthreads();
}
template <bool ROWSS>
DI void gemm_core(const bf16* __restrict__ A, int lda, const bf16* __restrict__ Bt, int ldb, int K, char* smem,
                  f32x16 (&acc)[2][2]) {
  GR g;
  gemm_load2(g, A, lda, Bt, ldb);
  gemm_core_n<ROWSS>(g, A, lda, Bt, ldb, A, Bt, K, smem, acc);
}

template <bool ROWSS = false>
DI void gemm_core_w(const bf16* __restrict__ A, int lda, const bf16* __restrict__ Bt, int ldb, int K, char* smem,
                    f32x16 (&acc)[2][4]) {
  bf16* sA = (bf16*)smem;
  bf16* sB = sA + 128 * 72;
  const int tid = tidx(), lane = tid & 63, w = wave_of(tid);
  const int wm = w >> 1, wn = w & 1, lq = lane & 31, h = lane >> 5;
  const int lr = tid >> 3, lc = tid & 7;
  u32x4 ra[4], rb[8];
  float ssw[4] = {0.f, 0.f, 0.f, 0.f};
#pragma unroll
  for (int i = 0; i < 2; ++i)
#pragma unroll
    for (int j = 0; j < 4; ++j)
#pragma unroll
      for (int r = 0; r < 16; ++r) acc[i][j][r] = 0.f;
  const bf16* ap = A + (size_t)lr * lda + lc * 8;
  const bf16* bp = Bt + (size_t)lr * ldb + lc * 8;
  const size_t a32 = (size_t)32 * lda, b32 = (size_t)32 * ldb;
#pragma unroll
  for (int i = 0; i < 4; ++i) ra[i] = *(const u32x4*)(ap + i * a32);
#pragma unroll
  for (int i = 0; i < 8; ++i) rb[i] = *(const u32x4*)(bp + i * b32);
  const int nk = K >> 6;
  for (int kt = 0; kt < nk; ++kt) {
    if (kt) __syncthreads();
#pragma unroll
    for (int i = 0; i < 4; ++i) *(u32x4*)(sA + (lr + 32 * i) * 72 + lc * 8) = ra[i];
#pragma unroll
    for (int i = 0; i < 8; ++i) *(u32x4*)(sB + (lr + 32 * i) * 72 + lc * 8) = rb[i];
    if (ROWSS) {
#pragma unroll
      for (int i = 0; i < 4; ++i)
#pragma unroll
        for (int e = 0; e < 4; ++e) {
          float a0 = bflo(ra[i][e]), a1 = bfhi(ra[i][e]);
          ssw[i] += a0 * a0 + a1 * a1;
        }
    }
    __syncthreads();
    {
      const int kn = (kt + 1 < nk) ? kt + 1 : kt;
      const bf16* ap2 = ap + (size_t)kn * 64;
      const bf16* bp2 = bp + (size_t)kn * 64;
#pragma unroll
      for (int i = 0; i < 4; ++i) ra[i] = *(const u32x4*)(ap2 + i * a32);
#pragma unroll
      for (int i = 0; i < 8; ++i) rb[i] = *(const u32x4*)(bp2 + i * b32);
    }
#pragma unroll
    for (int ks = 0; ks < 4; ++ks) {
      bf16x8 af[2], bfr[4];
#pragma unroll
      for (int i = 0; i < 2; ++i) af[i] = *(const bf16x8*)(sA + (wm * 64 + i * 32 + lq) * 72 + ks * 16 + h * 8);
#pragma unroll
      for (int j = 0; j < 4; ++j) bfr[j] = *(const bf16x8*)(sB + (wn * 128 + j * 32 + lq) * 72 + ks * 16 + h * 8);
#pragma unroll
      for (int i = 0; i < 2; ++i)
#pragma unroll
        for (int j = 0; j < 4; ++j) acc[i][j] = MFMA(af[i], bfr[j], acc[i][j]);
    }
  }
  if (ROWSS) {
    float* sRow = (float*)(smem + (128 + 256) * 72 * 2);
#pragma unroll
    for (int i = 0; i < 4; ++i) {
      float v = ssw[i];
      v += __shfl_xor(v, 1); v += __shfl_xor(v, 2); v += __shfl_xor(v, 4);
      if (lc == 0) sRow[lr + 32 * i] = v;
    }
  }
  __syncthreads();
}

DI void store_vt4(bf16* VT, size_t idx, float a, float b, float c, float d) {
  u32x2 v; v[0] = pack2(a, b); v[1] = pack2(c, d);
  *(u32x2*)(VT + idx) = v;
}

DI void transpose_tile(const float* __restrict__ src, int N, int Nvalid, bf16* __restrict__ dst, int K, int k0, int n0,
                       const float* __restrict__ gk, bf16* __restrict__ dst2, char* smem) {
  float* t = (float*)smem;
  const int tid = tidx();
  f32x4 tv[4];
#pragma unroll
  for (int i = 0; i < 4; ++i) {
    int idx = tid + 256 * i; int r = idx >> 4, c = (idx & 15) * 4;
    int n = n0 + c;
    tv[i] = f32x4{0.f, 0.f, 0.f, 0.f};
    if (n < Nvalid) tv[i] = __builtin_nontemporal_load((const f32x4*)(src + (size_t)(k0 + r) * N + n));
  }
#pragma unroll
  for (int i = 0; i < 4; ++i) {
    int idx = tid + 256 * i; int r = idx >> 4, c = (idx & 15) * 4;
    t[r * 65 + c] = tv[i][0]; t[r * 65 + c + 1] = tv[i][1]; t[r * 65 + c + 2] = tv[i][2]; t[r * 65 + c + 3] = tv[i][3];
  }
  __syncthreads();
  const int c2h = (tid & 31) * 2;
  const float gk0 = gk ? gk[k0 + c2h] : 1.f, gk1 = gk ? gk[k0 + c2h + 1] : 1.f;
#pragma unroll
  for (int i = 0; i < 8; ++i) {
    int idx = tid + 256 * i; int r = idx >> 5, c2 = (idx & 31) * 2;
    float v0 = t[c2 * 65 + r], v1 = t[(c2 + 1) * 65 + r];
    if (dst2) *(unsigned*)(dst2 + (size_t)(n0 + r) * K + k0 + c2) = pack2(v0, v1);
    v0 *= gk0; v1 *= gk1;
    *(unsigned*)(dst + (size_t)(n0 + r) * K + k0 + c2) = pack2(v0, v1);
  }
  __syncthreads();
}

DI void mod_item(const P& p, int it, char* smem) {
  float* sl = (float*)smem;
  float* red = sl + 5 * 1024;
  const int tid = tidx(), lane = tid & 63, w = wave_of(tid);
  const int l = it / 48, n0 = (it % 48) * 64;
  {
    float cvv[20];
#pragma unroll
    for (int i = 0; i < 20; ++i) {
      int idx = tid + 256 * i; int j = idx >> 10, k = idx & 1023;
      cvv[i] = (j == 0) ? p.c_ctx[k] : p.c[(j - 1) * 1024 + k];
    }
#pragma unroll
    for (int i = 0; i < 20; ++i) sl[tid + 256 * i] = silu_f(cvv[i]);
  }
  __syncthreads();
  float a[5] = {0.f, 0.f, 0.f, 0.f, 0.f};
  const float* wp = p.W_mod + (size_t)l * 1024 * 3072 + n0 + lane;
  for (int k = w * 256; k < w * 256 + 256; k += 16) {
    float wv[16];
#pragma unroll
    for (int u = 0; u < 16; ++u) wv[u] = __builtin_nontemporal_load(wp + (size_t)(k + u) * 3072);
#pragma unroll
    for (int u = 0; u < 16; ++u)
#pragma unroll
      for (int j = 0; j < 5; ++j) a[j] += sl[j * 1024 + k + u] * wv[u];
  }
#pragma unroll
  for (int j = 0; j < 5; ++j) red[(w * 5 + j) * 64 + lane] = a[j];
  __syncthreads();
  for (int idx = tid; idx < 320; idx += 256) {
    int j = idx >> 6, c = idx & 63;
    float s = red[(0 * 5 + j) * 64 + c] + red[(1 * 5 + j) * 64 + c] + red[(2 * 5 + j) * 64 + c] + red[(3 * 5 + j) * 64 + c];
    p.mod()[(size_t)(l * 5 + j) * 3072 + n0 + c] = s + p.b_mod[l * 3072 + n0 + c];
  }
  __syncthreads();
}

DI void phase_prepass(const P& p, char* smem) {
  const int G = gridDim.x, B = blockIdx.x, tid = tidx();
  const int N_MOD = 192, N_WIN = 4 * 92 * 16, N_WOUT = 4 * 16 * 24, N_WUQ = 4 * 12 * 6, N_WUKV = 4 * 16 * 4;
  const int total = N_MOD + N_WIN + N_WOUT + N_WUQ + N_WUKV;
  for (int it = B; it < total; it += G) {
    int u = it;
    if (u < N_MOD) { mod_item(p, u, smem); continue; }
    u -= N_MOD;
    if (u < N_WIN) {
      int l = u / (92 * 16), r = u % (92 * 16), nt = r / 16, kt = r % 16;
      transpose_tile(p.W_in + (size_t)l * 1024 * 5840, 5840, 5840, p.WinT() + (size_t)l * NPROJ * 1024, 1024, kt * 64, nt * 64, nullptr, nullptr, smem);
      continue;
    }
    u -= N_WIN;
    if (u < N_WOUT) {
      int l = u / (16 * 24), r = u % (16 * 24), nt = r / 24, kt = r % 24;
      transpose_tile(p.W_out + (size_t)l * 1536 * 1024, 1024, 1024, p.WoutT() + (size_t)l * 1024 * 1536, 1536, kt * 64, nt * 64, nullptr, nullptr, smem);
      continue;
    }
    u -= N_WOUT;
    if (u < N_WUQ) {
      int l = u / 72, r = u % 72, nt = r / 6, kt = r % 6;
      transpose_tile(p.W_uq + (size_t)l * 384 * 768, 768, 768, p.WuqT() + (size_t)l * 768 * 384, 384, kt * 64, nt * 64, p.q_norm + l * 384, nullptr, smem);
      continue;
    }
    u -= N_WUQ;
    {
      int l = u / 64, r = u % 64, nt = r / 4, kt = r % 4;
      transpose_tile(p.W_ukv + (size_t)l * 256 * 1024, 1024, 1024, p.WukvT() + (size_t)l * 1024 * 256, 256, kt * 64, nt * 64, p.kv_norm + l * 256, p.WukvTp() + (size_t)l * 1024 * 256, smem);
    }
  }
  const int gtid = B * 256 + tid, gsz = G * 256;
  for (int idx = gtid; idx < 1024 * 32; idx += gsz) {
    int t = idx >> 5, i = idx & 31;
    float pos = (i < 16) ? (float)(t >> 6) : (float)(t & 63);
    float inv = powf(10000.f, -(float)(i & 15) / 16.f);
    float ang = pos * inv;
    p.ropec()[idx] = cosf(ang); p.ropes()[idx] = sinf(ang);
  }
  if (gtid < 4) {
    int l = gtid; const float* lp = p.dlam + l * 256;
    float s1 = 0.f, s2 = 0.f;
    for (int i = 0; i < 64; ++i) { s1 += lp[i] * lp[64 + i]; s2 += lp[128 + i] * lp[192 + i]; }
    float lam_init = 0.8f - 0.6f * expf(-0.3f * (float)l);
    p.lam()[l] = expf(s1) - expf(s2) + lam_init;
  }
  for (int idx = gtid; idx < 4 * 4 * 256 * 256; idx += gsz) {
    int d = idx & 255, t = (idx >> 8) & 255, b = (idx >> 16) & 3, l = idx >> 18;
    p.cckv()[idx] = f2bf(p.c_ckv[(size_t)((b * 4 + l) * 256 + t) * 256 + d]);
  }
  for (int idx = gtid; idx < 4 * 4 * 4 * 256 * 64; idx += gsz) {
    int r = idx & 63, t = (idx >> 6) & 255, hd = (idx >> 14) & 3, b = (idx >> 16) & 3, l = idx >> 18;
    p.cKa()[(size_t)((((l * 4 + b) * 4 + hd) * 256) + t) * 192 + 128 + r] = f2bf(p.c_krope[(size_t)((b * 4 + l) * 256 + t) * 64 + r]);
  }
  for (int idx = gtid; idx < 4 * 4 * 4 * 256 * 128; idx += gsz) {
    int d = idx & 127, t = (idx >> 7) & 255, hd = (idx >> 15) & 3, b = (idx >> 17) & 3, l = idx >> 19;
    p.cKb()[idx] = f2bf(p.c_dk[(size_t)(((b * 4 + l) * 256 + t) * 4 + hd) * 128 + d]);
  }
  for (int idx = gtid; idx < 4 * 4 * 4 * 128 * 256; idx += gsz) {
    int t = idx & 255, d = (idx >> 8) & 127, hd = (idx >> 15) & 3, b = (idx >> 17) & 3, l = idx >> 19;
    p.cVbT()[idx] = f2bf(p.c_dv[(size_t)(((b * 4 + l) * 256 + t) * 4 + hd) * 128 + d]);
  }
}

DI void norm_row(const P& p, int l, int tok, int mode) {
  const int lane = tidx() & 63;
  TokInfo ti = tinfo(tok);
  const float* x;
  if (mode == 0 && l == 0) x = ti.lat ? (p.x_sample + (size_t)(tok - 4096) * 1024) : (p.x_prompt + (size_t)tok * 1024);
  else x = p.xbuf() + (size_t)tok * 1024;
  f32x4 v[4];
  float ss = 0.f;
#pragma unroll
  for (int i = 0; i < 4; ++i) {
    v[i] = *(const f32x4*)(x + i * 256 + lane * 4);
    ss += v[i][0] * v[i][0] + v[i][1] * v[i][1] + v[i][2] * v[i][2] + v[i][3] * v[i][3];
  }
#pragma unroll
  for (int o = 32; o >= 1; o >>= 1) ss += __shfl_xor(ss, o);
  const float rstd = rsqrtf(ss * (1.f / 1024.f) + EPS);
  if (mode == 0) {
    const float* g = p.g_norm + l * 1024;
    const float* md = p.mod() + (size_t)(l * 5 + ti.modj) * 3072;
#pragma unroll
    for (int i = 0; i < 4; ++i) {
      int c = i * 256 + lane * 4;
      f32x4 gv = *(const f32x4*)(g + c), sh = *(const f32x4*)(md + c), sc = *(const f32x4*)(md + 1024 + c);
      float o0 = v[i][0] * rstd * gv[0] * (1.f + sc[0]) + sh[0];
      float o1 = v[i][1] * rstd * gv[1] * (1.f + sc[1]) + sh[1];
      float o2 = v[i][2] * rstd * gv[2] * (1.f + sc[2]) + sh[2];
      float o3 = v[i][3] * rstd * gv[3] * (1.f + sc[3]) + sh[3];
      u32x2 pk; pk[0] = pack2(o0, o1); pk[1] = pack2(o2, o3);
      *(u32x2*)(p.hbuf() + (size_t)tok * 1024 + c) = pk;
    }
  } else {
    float* o = p.out + (ti.lat ? (O_YS + (size_t)(tok - 4096) * 1024) : (O_YP + (size_t)tok * 1024));
#pragma unroll
    for (int i = 0; i < 4; ++i) {
      int c = i * 256 + lane * 4;
      f32x4 gv = *(const f32x4*)(p.g_final + c);
      f32x4 r; r[0] = v[i][0] * rstd * gv[0]; r[1] = v[i][1] * rstd * gv[1]; r[2] = v[i][2] * rstd * gv[2]; r[3] = v[i][3] * rstd * gv[3];
      *(f32x4*)(o + c) = r;
    }
  }
}

DI void img_put(bf16* img, const f32x16 (&acc)[2][2], int wm, int wn, int lq, int h) {
#pragma unroll
  for (int i = 0; i < 2; ++i)
#pragma unroll
    for (int j = 0; j < 2; ++j)
#pragma unroll
      for (int r = 0; r < 16; ++r)
        img[(wm * 64 + i * 32 + 8 * (r >> 2) + 4 * h + (r & 3)) * 136 + wn * 64 + j * 32 + lq] = f2bf(acc[i][j][r]);
}
DI void img_copy(const bf16* img, int half, bf16* dst, size_t stride, int tid) {
  u32x4 v[4];
#pragma unroll
  for (int i = 0; i < 4; ++i) { int idx = tid + 256 * i; int r = idx >> 3, c16 = idx & 7; v[i] = *(const u32x4*)(img + r * 136 + half * 64 + c16 * 8); }
#pragma unroll
  for (int i = 0; i < 4; ++i) { int idx = tid + 256 * i; int r = idx >> 3, c16 = idx & 7; *(u32x4*)(dst + (size_t)r * stride + c16 * 8) = v[i]; }
}
DI bool inproj_rm(int cb) { return !((cb >= 35 && cb <= 42) || (cb >= 67 && cb <= 74) || cb == 91); }

DI void epi_inproj(const P& p, int l, int m0, int n0, f32x16 (&acc)[2][2], char* smem) {
  const int tid_ = tidx(); const int lane = tid_ & 63, w = wave_of(tid_), wm = w >> 1, wn = w & 1, lq = lane & 31, h = lane >> 5;
  const int mb = m0 + wm * 64, nb = n0 + wn * 64;
  const int cb = nb >> 6;
  bf16* img = (bf16*)smem;
  TokInfo tb = tinfo(mb);
  const bool lat = tb.lat;
  if (!lat && (cb == 10 || (cb >= 27 && cb <= 34))) {
    float* ob = (cb == 10) ? p.out + O_KROPE + (size_t)((tb.b * 4 + l) * 256) * 64
                           : p.out + O_DK + (size_t)((tb.b * 4 + l) * 256) * 512 + (cb - 27) * 64;
    const int ostr = (cb == 10) ? 64 : 512;
#pragma unroll
    for (int i = 0; i < 2; ++i)
#pragma unroll
      for (int j = 0; j < 2; ++j)
#pragma unroll
        for (int r = 0; r < 16; ++r) {
          int tl = tb.t + i * 32 + 8 * (r >> 2) + 4 * h + (r & 3);
          ob[(size_t)tl * ostr + j * 32 + lq] = acc[i][j][r];
        }
  }
  const bool ropeT = lat && (cb == 10 || (cb >= 19 && cb <= 34));
  if (ropeT) {
#pragma unroll
    for (int i = 0; i < 2; ++i) {
      float cs[16], sn[16];
#pragma unroll
      for (int r = 0; r < 16; ++r) {
        int t = tb.t + i * 32 + 8 * (r >> 2) + 4 * h + (r & 3);
        cs[r] = p.ropec()[t * 32 + lq]; sn[r] = p.ropes()[t * 32 + lq];
      }
#pragma unroll
      for (int r = 0; r < 16; ++r) {
        float x1 = acc[i][0][r], x2 = acc[i][1][r];
        acc[i][0][r] = x1 * cs[r] - x2 * sn[r];
        acc[i][1][r] = x1 * sn[r] + x2 * cs[r];
      }
    }
  }
  if (inproj_rm(cb)) {
    img_put(img, acc, wm, wn, lq, h);
  } else if (cb == 91) {
    if (lq < 16) {
      float bias = p.mgb[l * 16 + lq];
#pragma unroll
      for (int i = 0; i < 2; ++i)
#pragma unroll
        for (int r = 0; r < 16; ++r) {
          int row = mb + i * 32 + 8 * (r >> 2) + 4 * h + (r & 3);
          p.gates()[row * 16 + lq] = acc[i][0][r] + bias;
        }
    }
  } else {
    const bool isdv = cb <= 42;
    int cc = isdv ? cb - 35 : cb - 67;
    int hd = cc >> 1, sub = cc & 1;
    bf16* VT = isdv ? p.VbT() : p.VmT();
#pragma unroll
    for (int i = 0; i < 2; ++i)
#pragma unroll
      for (int j = 0; j < 2; ++j) {
        int d = sub * 64 + j * 32 + lq;
#pragma unroll
        for (int g = 0; g < 4; ++g) {
          int tl = tb.t + i * 32 + 8 * g + 4 * h;
          store_vt4(VT, (size_t)tb.tok0 * 512 + (size_t)(hd * 128 + d) * tb.T + tl, acc[i][j][4 * g], acc[i][j][4 * g + 1], acc[i][j][4 * g + 2], acc[i][j][4 * g + 3]);
          if (isdv && !lat) {
#pragma unroll
            for (int jj = 0; jj < 4; ++jj)
              p.out[O_DV + (size_t)((tb.b * 4 + l) * 256 + tl + jj) * 512 + cc * 64 + j * 32 + lq] = acc[i][j][4 * g + jj];
          }
        }
      }
  }
  __syncthreads();
#pragma unroll
  for (int half = 0; half < 2; ++half) {
    const int cbh = (n0 >> 6) + half;
    if (!inproj_rm(cbh)) continue;
    if (cbh == 10) {
#pragma unroll
      for (int hd = 0; hd < 4; ++hd) img_copy(img, half, p.Ka() + (size_t)m0 * 768 + hd * 192 + 128, 768, tid_);
    } else if (cbh >= 27 && cbh <= 34) {
      img_copy(img, half, p.Kb() + (size_t)m0 * 512 + (cbh - 27) * 64, 512, tid_);
    } else {
      img_copy(img, half, p.proj() + (size_t)m0 * NPROJ + cbh * 64, NPROJ, tid_);
    }
  }
  __syncthreads();
}

constexpr int IMGW = 264;
DI void img_copy_w(const bf16* img, int half, bf16* dst, size_t stride, int tid) {
  u32x4 v[4];
#pragma unroll
  for (int i = 0; i < 4; ++i) { int idx = tid + 256 * i; int r = idx >> 3, c16 = idx & 7; v[i] = *(const u32x4*)(img + r * IMGW + half * 64 + c16 * 8); }
#pragma unroll
  for (int i = 0; i < 4; ++i) { int idx = tid + 256 * i; int r = idx >> 3, c16 = idx & 7; *(u32x4*)(dst + (size_t)r * stride + c16 * 8) = v[i]; }
}
template <int JP>
DI void epi_inproj_cbw(const P& p, int l, int m0, int cb, int imgcol, f32x16 (&acc)[2][4], bf16* img) {
  const int tid_ = tidx(); const int lane = tid_ & 63, w = wave_of(tid_), wm = w >> 1, lq = lane & 31, h = lane >> 5;
  const int mb = m0 + wm * 64;
  TokInfo tb = tinfo(mb);
  const bool lat = tb.lat;
  if (!lat && (cb == 10 || (cb >= 27 && cb <= 34))) {
    float* ob = (cb == 10) ? p.out + O_KROPE + (size_t)((tb.b * 4 + l) * 256) * 64
                           : p.out + O_DK + (size_t)((tb.b * 4 + l) * 256) * 512 + (cb - 27) * 64;
    const int ostr = (cb == 10) ? 64 : 512;
#pragma unroll
    for (int i = 0; i < 2; ++i)
#pragma unroll
      for (int j = 0; j < 2; ++j)
#pragma unroll
        for (int r = 0; r < 16; ++r) {
          int tl = tb.t + i * 32 + 8 * (r >> 2) + 4 * h + (r & 3);
          ob[(size_t)tl * ostr + j * 32 + lq] = acc[i][2 * JP + j][r];
        }
  }
  if (lat && (cb == 10 || (cb >= 19 && cb <= 34))) {
#pragma unroll
    for (int i = 0; i < 2; ++i) {
      float cs[16], sn[16];
#pragma unroll
      for (int r = 0; r < 16; ++r) {
        int t = tb.t + i * 32 + 8 * (r >> 2) + 4 * h + (r & 3);
        cs[r] = p.ropec()[t * 32 + lq]; sn[r] = p.ropes()[t * 32 + lq];
      }
#pragma unroll
      for (int r = 0; r < 16; ++r) {
        float x1 = acc[i][2 * JP][r], x2 = acc[i][2 * JP + 1][r];
        acc[i][2 * JP][r] = x1 * cs[r] - x2 * sn[r];
        acc[i][2 * JP + 1][r] = x1 * sn[r] + x2 * cs[r];
      }
    }
  }
  if (inproj_rm(cb)) {
#pragma unroll
    for (int i = 0; i < 2; ++i)
#pragma unroll
      for (int j = 0; j < 2; ++j)
#pragma unroll
        for (int r = 0; r < 16; ++r)
          img[(wm * 64 + i * 32 + 8 * (r >> 2) + 4 * h + (r & 3)) * IMGW + imgcol + j * 32 + lq] = f2bf(acc[i][2 * JP + j][r]);
  } else if (cb == 91) {
    if (lq < 16) {
      float bias = p.mgb[l * 16 + lq];
#pragma unroll
      for (int i = 0; i < 2; ++i)
#pragma unroll
        for (int r = 0; r < 16; ++r) {
          int row = mb + i * 32 + 8 * (r >> 2) + 4 * h + (r & 3);
          p.gates()[row * 16 + lq] = acc[i][2 * JP][r] + bias;
        }
    }
  } else {
    const bool isdv = cb <= 42;
    int cc = isdv ? cb - 35 : cb - 67;
    int hd = cc >> 1, sub = cc & 1;
    bf16* VT = isdv ? p.VbT() : p.VmT();
#pragma unroll
    for (int i = 0; i < 2; ++i)
#pragma unroll
      for (int j = 0; j < 2; ++j) {
        int d = sub * 64 + j * 32 + lq;
#pragma unroll
        for (int g = 0; g < 4; ++g) {
          int tl = tb.t + i * 32 + 8 * g + 4 * h;
          store_vt4(VT, (size_t)tb.tok0 * 512 + (size_t)(hd * 128 + d) * tb.T + tl, acc[i][2 * JP + j][4 * g], acc[i][2 * JP + j][4 * g + 1], acc[i][2 * JP + j][4 * g + 2], acc[i][2 * JP + j][4 * g + 3]);
          if (isdv && !lat) {
#pragma unroll
            for (int jj = 0; jj < 4; ++jj)
              p.out[O_DV + (size_t)((tb.b * 4 + l) * 256 + tl + jj) * 512 + cc * 64 + j * 32 + lq] = acc[i][2 * JP + j][4 * g + jj];
          }
        }
      }
  }
}
DI void epi_inproj_w(const P& p, int l, int m0, int n0, f32x16 (&acc)[2][4], char* smem) {
  bf16* img = (bf16*)smem;
  const int tid_ = tidx(); const int wn = wave_of(tid_) & 1;
  const int cb0 = n0 >> 6;
  epi_inproj_cbw<0>(p, l, m0, cb0 + 2 * wn, (2 * wn) * 64, acc, img);
  epi_inproj_cbw<1>(p, l, m0, cb0 + 2 * wn + 1, (2 * wn + 1) * 64, acc, img);
  __syncthreads();
#pragma unroll
  for (int half = 0; half < 4; ++half) {
    const int cbh = cb0 + half;
    if (!inproj_rm(cbh)) continue;
    if (cbh == 10) {
#pragma unroll
      for (int hd = 0; hd < 4; ++hd) img_copy_w(img, half, p.Ka() + (size_t)m0 * 768 + hd * 192 + 128, 768, tid_);
    } else if (cbh >= 27 && cbh <= 34) {
      img_copy_w(img, half, p.Kb() + (size_t)m0 * 512 + (cbh - 27) * 64, 512, tid_);
    } else {
      img_copy_w(img, half, p.proj() + (size_t)m0 * NPROJ + cbh * 64, NPROJ, tid_);
    }
  }
  __syncthreads();
}

DI void epi_qa(const P& p, int m0, int n0, f32x16 (&acc)[2][2], const float* sRow) {
  const int tid_ = tidx(); const int lane = tid_ & 63, w = wave_of(tid_), wm = w >> 1, wn = w & 1, lq = lane & 31, h = lane >> 5;
  const int mb = m0 + wm * 64, nb = n0 + wn * 64;
  const int cb = nb >> 6, hd = cb / 3, part = cb % 3;
  TokInfo tb = tinfo(mb);
  const bool dorope = tb.lat && part == 2;
#pragma unroll
  for (int i = 0; i < 2; ++i) {
    float cs[16], sn[16];
#pragma unroll
    for (int r = 0; r < 16; ++r) { cs[r] = 1.f; sn[r] = 0.f; }
    if (dorope) {
#pragma unroll
      for (int r = 0; r < 16; ++r) {
        int t = tb.t + i * 32 + 8 * (r >> 2) + 4 * h + (r & 3);
        cs[r] = p.ropec()[t * 32 + lq]; sn[r] = p.ropes()[t * 32 + lq];
      }
    }
#pragma unroll
    for (int r = 0; r < 16; ++r) {
      int rl = wm * 64 + i * 32 + 8 * (r >> 2) + 4 * h + (r & 3);
      float rstd = rsqrtf(sRow[rl] * (1.f / 384.f) + EPS);
      float x1 = acc[i][0][r] * rstd, x2 = acc[i][1][r] * rstd;
      {
        float y1 = x1 * cs[r] - x2 * sn[r], y2 = x1 * sn[r] + x2 * cs[r];
        x1 = y1; x2 = y2;
      }
      int row = m0 + rl;
      bf16* q = p.Qa() + (size_t)(row * 4 + hd) * 192 + part * 64;
      q[lq] = f2bf(x1); q[32 + lq] = f2bf(x2);
    }
  }
}

DI void epi_kv(const P& p, int m0, int n0, f32x16 (&acc)[2][2], const float* sRow, bool cache) {
  const int tid_ = tidx(); const int lane = tid_ & 63, w = wave_of(tid_), wm = w >> 1, wn = w & 1, lq = lane & 31, h = lane >> 5;
  const int mb = m0 + wm * 64, nb = n0 + wn * 64;
  const int cb = nb >> 6, hd = cb >> 2, part = cb & 3;
  TokInfo tb = tinfo(mb);
#pragma unroll
  for (int i = 0; i < 2; ++i)
#pragma unroll
    for (int j = 0; j < 2; ++j)
#pragma unroll
      for (int g = 0; g < 4; ++g) {
        float v[4];
#pragma unroll
        for (int jj = 0; jj < 4; ++jj) {
          int rl = wm * 64 + i * 32 + 8 * g + 4 * h + jj;
          float rstd = cache ? 1.f : rsqrtf(sRow[rl] * (1.f / 256.f) + EPS);
          v[jj] = acc[i][j][4 * g + jj] * rstd;
        }
        int c = j * 32 + lq;
        int row0 = mb + i * 32 + 8 * g + 4 * h;
        if (part < 2) {
#pragma unroll
          for (int jj = 0; jj < 4; ++jj) {
            int row = row0 + jj;
            if (cache) {
              int lb = row >> 8, t = row & 255;
              p.cKa()[(size_t)((lb * 4 + hd) * 256 + t) * 192 + part * 64 + c] = f2bf(v[jj]);
            } else {
              p.Ka()[(size_t)(row * 4 + hd) * 192 + part * 64 + c] = f2bf(v[jj]);
            }
          }
        } else {
          int d = (part - 2) * 64 + c;
          if (cache) {
            int lb = row0 >> 8, t = row0 & 255;
            store_vt4(p.cVaT(), (size_t)((lb * 4 + hd) * 128 + d) * 256 + t, v[0], v[1], v[2], v[3]);
          } else {
            int tl = tb.t + i * 32 + 8 * g + 4 * h;
            store_vt4(p.VaT(), (size_t)tb.tok0 * 512 + (size_t)(hd * 128 + d) * tb.T + tl, v[0], v[1], v[2], v[3]);
          }
        }
      }
}

template <int JP>
DI void epi_qa_w(const P& p, int m0, int n0, f32x16 (&acc)[2][4], const float* sRow) {
  const int tid_ = tidx(); const int lane = tid_ & 63, w = wave_of(tid_), wm = w >> 1, wn = w & 1, lq = lane & 31, h = lane >> 5;
  const int mb = m0 + wm * 64;
  const int cb = (n0 >> 6) + 2 * wn + JP, hd = cb / 3, part = cb % 3;
  TokInfo tb = tinfo(mb);
  const bool dorope = tb.lat && part == 2;
#pragma unroll
  for (int i = 0; i < 2; ++i) {
    float cs[16], sn[16];
#pragma unroll
    for (int r = 0; r < 16; ++r) { cs[r] = 1.f; sn[r] = 0.f; }
    if (dorope) {
#pragma unroll
      for (int r = 0; r < 16; ++r) {
        int t = tb.t + i * 32 + 8 * (r >> 2) + 4 * h + (r & 3);
        cs[r] = p.ropec()[t * 32 + lq]; sn[r] = p.ropes()[t * 32 + lq];
      }
    }
#pragma unroll
    for (int r = 0; r < 16; ++r) {
      int rl = wm * 64 + i * 32 + 8 * (r >> 2) + 4 * h + (r & 3);
      float rstd = rsqrtf(sRow[rl] * (1.f / 384.f) + EPS);
      float x1 = acc[i][2 * JP][r] * rstd, x2 = acc[i][2 * JP + 1][r] * rstd;
      float y1 = x1 * cs[r] - x2 * sn[r], y2 = x1 * sn[r] + x2 * cs[r];
      int row = m0 + rl;
      bf16* q = p.Qa() + (size_t)(row * 4 + hd) * 192 + part * 64;
      q[lq] = f2bf(y1); q[32 + lq] = f2bf(y2);
    }
  }
}
template <int JP>
DI void epi_kv_w(const P& p, int m0, int n0, f32x16 (&acc)[2][4], const float* sRow) {
  const int tid_ = tidx(); const int lane = tid_ & 63, w = wave_of(tid_), wm = w >> 1, wn = w & 1, lq = lane & 31, h = lane >> 5;
  const int mb = m0 + wm * 64;
  const int cb = (n0 >> 6) + 2 * wn + JP, hd = cb >> 2, part = cb & 3;
  TokInfo tb = tinfo(mb);
#pragma unroll
  for (int i = 0; i < 2; ++i)
#pragma unroll
    for (int j = 0; j < 2; ++j)
#pragma unroll
      for (int g = 0; g < 4; ++g) {
        float v[4];
#pragma unroll
        for (int jj = 0; jj < 4; ++jj) {
          int rl = wm * 64 + i * 32 + 8 * g + 4 * h + jj;
          float rstd = rsqrtf(sRow[rl] * (1.f / 256.f) + EPS);
          v[jj] = acc[i][2 * JP + j][4 * g + jj] * rstd;
        }
        int c = j * 32 + lq;
        int row0 = mb + i * 32 + 8 * g + 4 * h;
        if (part < 2) {
#pragma unroll
          for (int jj = 0; jj < 4; ++jj) p.Ka()[(size_t)((row0 + jj) * 4 + hd) * 192 + part * 64 + c] = f2bf(v[jj]);
        } else {
          int d = (part - 2) * 64 + c;
          int tl = tb.t + i * 32 + 8 * g + 4 * h;
          store_vt4(p.VaT(), (size_t)tb.tok0 * 512 + (size_t)(hd * 128 + d) * tb.T + tl, v[0], v[1], v[2], v[3]);
        }
      }
}

DI void epi_out(const P& p, int l, int m0, int n0, f32x16 (&acc)[2][2]) {
  const int tid_ = tidx(); const int lane = tid_ & 63, w = wave_of(tid_), wm = w >> 1, wn = w & 1, lq = lane & 31, h = lane >> 5;
  const int mb = m0 + wm * 64, nb = n0 + wn * 64;
  TokInfo tb = tinfo(mb);
  const float* gate = p.mod() + (size_t)(l * 5 + tb.modj) * 3072 + 2048;
  const float* xsrc = (l == 0) ? (tb.lat ? p.x_sample - (size_t)4096 * 1024 : p.x_prompt) : (const float*)p.xbuf();
#pragma unroll
  for (int i = 0; i < 2; ++i)
#pragma unroll
    for (int j = 0; j < 2; ++j) {
      int col = nb + j * 32 + lq;
      float gv = gate[col];
      float xo[16];
#pragma unroll
      for (int r = 0; r < 16; ++r) {
        int row = mb + i * 32 + 8 * (r >> 2) + 4 * h + (r & 3);
        xo[r] = xsrc[(size_t)row * 1024 + col];
      }
#pragma unroll
      for (int r = 0; r < 16; ++r) {
        int row = mb + i * 32 + 8 * (r >> 2) + 4 * h + (r & 3);
        p.xbuf()[(size_t)row * 1024 + col] = xo[r] + gv * acc[i][j][r];
      }
    }
}

template <int KW, int DQ, int KSPLIT>
DI void attn_pass(const bf16* __restrict__ qptr, int koff, int kh, const bf16* __restrict__ Kmain, int ldk, int Tmain,
                  const bf16* __restrict__ Kc, int ldkc, int Tc, const bf16* __restrict__ VTmain,
                  const bf16* __restrict__ VTc, float c, char* smem, f32x16 (&o)[4], float& lsum, float& m_out) {
  constexpr int KS = KW + 8;
  constexpr int NKB = 2 / KSPLIT;
  bf16* sK = (bf16*)smem;
  bf16* sV = sK + 64 * KS;
  const int tid = tidx(), lane = tid & 63, lq = lane & 31, h = lane >> 5;
  constexpr bool QLDS = (KSPLIT == 2);
  constexpr int QS = DQ + 8;
  bf16* sQ = sV + 128 * 72;
  bf16x8 qf[QLDS ? 1 : DQ / 16];
  if (QLDS) {
    constexpr int QCH = DQ / 8, NQL = 64 * QCH / 256;
    u32x4 tq[NQL];
#pragma unroll
    for (int i = 0; i < NQL; ++i) { int idx = tid + 256 * i; int r = idx / QCH, cc = idx % QCH; tq[i] = *(const u32x4*)(qptr + (size_t)r * 768 + cc * 8); }
#pragma unroll
    for (int i = 0; i < NQL; ++i) { int idx = tid + 256 * i; int r = idx / QCH, cc = idx % QCH; *(u32x4*)(sQ + r * QS + cc * 8) = tq[i]; }
  } else {
#pragma unroll
    for (int ks = 0; ks < DQ / 16; ++ks) qf[ks] = *(const bf16x8*)(qptr + ks * 16 + h * 8);
  }
  const bf16* sQl = sQ + (((wave_of(tid) & 1) * 32) + lq) * QS + h * 8;
#pragma unroll
  for (int db = 0; db < 4; ++db)
#pragma unroll
    for (int r = 0; r < 16; ++r) o[db][r] = 0.f;
  lsum = 0.f;
  float m_run = -INFINITY;
  const int nt = (Tmain + Tc) >> 6;
  constexpr int CH = KW / 8, NKL = 64 * CH / 256;
  u32x4 kr[NKL], vr[4];
  auto issue = [&](int kt) {
    const bf16* ksrc; int ld; const bf16* vsrc; int ldv;
    if (kt * 64 < Tmain) { ksrc = Kmain + (size_t)(kt * 64) * ldk; ld = ldk; vsrc = VTmain + kt * 64; ldv = Tmain; }
    else { ksrc = Kc + (size_t)(kt * 64 - Tmain) * ldkc; ld = ldkc; vsrc = VTc + (kt * 64 - Tmain); ldv = Tc; }
#pragma unroll
    for (int i = 0; i < NKL; ++i) {
      int idx = tid + 256 * i; int r = idx / CH, cc = idx % CH;
      kr[i] = *(const u32x4*)(ksrc + (size_t)r * ld + cc * 8);
    }
#pragma unroll
    for (int i = 0; i < 4; ++i) {
      int idx = tid + 256 * i; int r = idx >> 3, cc = idx & 7;
      vr[i] = *(const u32x4*)(vsrc + (size_t)r * ldv + cc * 8);
    }
  };
  issue(0);
  for (int kt = 0; kt < nt; ++kt) {
    __syncthreads();
#pragma unroll
    for (int i = 0; i < NKL; ++i) {
      int idx = tid + 256 * i; int r = idx / CH, cc = idx % CH;
      *(u32x4*)(sK + r * KS + cc * 8) = kr[i];
    }
#pragma unroll
    for (int i = 0; i < 4; ++i) {
      int idx = tid + 256 * i; int r = idx >> 3, cc = idx & 7;
      *(u32x4*)(sV + r * 72 + cc * 8) = vr[i];
    }
    __syncthreads();
    issue((kt + 1 < nt) ? kt + 1 : kt);
    f32x16 s[NKB];
#pragma unroll
    for (int kbi = 0; kbi < NKB; ++kbi)
#pragma unroll
      for (int r = 0; r < 16; ++r) s[kbi][r] = 0.f;
#pragma unroll
    for (int ks = 0; ks < DQ / 16; ++ks)
#pragma unroll
      for (int kbi = 0; kbi < NKB; ++kbi) {
        const int kb = (KSPLIT == 2) ? kh : kbi;
        bf16x8 a = *(const bf16x8*)(sK + (kb * 32 + lq) * KS + koff + ks * 16 + h * 8);
        s[kbi] = MFMA(a, QLDS ? *(const bf16x8*)(sQl + ks * 16) : qf[QLDS ? 0 : ks], s[kbi]);
      }
    float mx = -INFINITY;
#pragma unroll
    for (int kbi = 0; kbi < NKB; ++kbi)
#pragma unroll
      for (int r = 0; r < 16; ++r) mx = fmaxf(mx, s[kbi][r]);
    mx = fmaxf(mx, __shfl_xor(mx, 32));
    const float m_new = fmaxf(m_run, mx);
    const float alpha = fexp2((m_run - m_new) * c);
    m_run = m_new;
    lsum *= alpha;
#pragma unroll
    for (int db = 0; db < 4; ++db)
#pragma unroll
      for (int r = 0; r < 16; ++r) o[db][r] *= alpha;
    const float mc = m_new * c;
#pragma unroll
    for (int kbi = 0; kbi < NKB; ++kbi)
#pragma unroll
      for (int r = 0; r < 16; ++r) { float pv = fexp2(s[kbi][r] * c - mc); s[kbi][r] = pv; lsum += pv; }
#pragma unroll
    for (int kbi = 0; kbi < NKB; ++kbi) {
      const int kb = (KSPLIT == 2) ? kh : kbi;
#pragma unroll
      for (int s2 = 0; s2 < 2; ++s2) {
        u32x4 pk;
#pragma unroll
        for (int e = 0; e < 4; ++e) pk[e] = pack2(s[kbi][8 * s2 + 2 * e], s[kbi][8 * s2 + 2 * e + 1]);
        bf16x8 pb = __builtin_bit_cast(bf16x8, pk);
#pragma unroll
        for (int db = 0; db < 4; ++db) {
          const bf16* vp = sV + (db * 32 + lq) * 72 + kb * 32 + s2 * 16 + 4 * h;
          u32x2 lo = *(const u32x2*)vp, hi = *(const u32x2*)(vp + 8);
          u32x4 av; av[0] = lo[0]; av[1] = lo[1]; av[2] = hi[0]; av[3] = hi[1];
          o[db] = MFMA(__builtin_bit_cast(bf16x8, av), pb, o[db]);
        }
      }
    }
  }
  lsum += __shfl_xor(lsum, 32);
  m_out = m_run;
}

DI void mla_item(const P& p, int l, int it, char* smem) {
  const int tid = tidx(), lane = tid & 63, w = wave_of(tid), lq = lane & 31, h = lane >> 5;
  int lat, b, hd, qb;
  if (it < 256) { lat = 1; b = it >> 6; hd = (it >> 4) & 3; qb = it & 15; }
  else { int u = it - 256; lat = 0; b = u >> 4; hd = (u >> 2) & 3; qb = u & 3; }
  const int T = lat ? 1024 : 256, tok0 = lat ? 4096 + b * 1024 : b * 256;
  const int qsub = w & 1, kh = w >> 1;
  const int tok = tok0 + qb * 64 + qsub * 32 + lq;
  f32x16 o[4]; float lsum, mrun;
  const float c = 0.07216878364870322f * 1.4426950408889634f;
  attn_pass<192, 192, 2>(p.Qa() + (size_t)((tok0 + qb * 64) * 4 + hd) * 192, 0, kh, p.Ka() + (size_t)(tok0 * 4 + hd) * 192, 768, T,
                 p.cKa() + (size_t)((l * 4 + b) * 4 + hd) * 256 * 192, 192, lat ? 256 : 0,
                 p.VaT() + (size_t)tok0 * 512 + (size_t)hd * 128 * T, p.cVaT() + (size_t)((l * 4 + b) * 4 + hd) * 128 * 256, c, smem, o, lsum, mrun);
  float* ex = (float*)smem;
  float* exm = ex + 2 * 128 * 32;
  float* exl = exm + 64;
  __syncthreads();
  if (kh == 1) {
#pragma unroll
    for (int db = 0; db < 4; ++db)
#pragma unroll
      for (int r = 0; r < 16; ++r) {
        int dv = db * 32 + 8 * (r >> 2) + 4 * h + (r & 3);
        ex[(qsub * 128 + dv) * 32 + lq] = o[db][r];
      }
    if (h == 0) { exm[qsub * 32 + lq] = mrun; exl[qsub * 32 + lq] = lsum; }
  }
  __syncthreads();
  if (kh == 0) {
    const float m1 = exm[qsub * 32 + lq], l1 = exl[qsub * 32 + lq];
    const float mm = fmaxf(mrun, m1);
    const float f0 = fexp2((mrun - mm) * c), f1 = fexp2((m1 - mm) * c);
    const float inv = 1.f / (lsum * f0 + l1 * f1);
    const float g0 = f0 * inv, g1 = f1 * inv;
    u32x2 zz[4][4];
#pragma unroll
    for (int db = 0; db < 4; ++db)
#pragma unroll
      for (int g = 0; g < 4; ++g) zz[db][g] = *(const u32x2*)(p.proj() + (size_t)tok * NPROJ + 704 + hd * 128 + db * 32 + 8 * g + 4 * h);
#pragma unroll
    for (int db = 0; db < 4; ++db)
#pragma unroll
      for (int g = 0; g < 4; ++g) {
        int dv = db * 32 + 8 * g + 4 * h;
        float ov4[4];
#pragma unroll
        for (int jj = 0; jj < 4; ++jj) ov4[jj] = o[db][4 * g + jj] * g0 + ex[(qsub * 128 + dv + jj) * 32 + lq] * g1;
        u32x2 z = zz[db][g];
        float z0 = bflo(z[0]), z1 = bfhi(z[0]), z2 = bflo(z[1]), z3 = bfhi(z[1]);
        u32x2 ov;
        ov[0] = pack2(ov4[0] * silu_f(z0), ov4[1] * silu_f(z1));
        ov[1] = pack2(ov4[2] * silu_f(z2), ov4[3] * silu_f(z3));
        *(u32x2*)(p.ycat() + (size_t)tok * 1536 + hd * 128 + dv) = ov;
      }
  }
}

DI void diff_item(const P& p, int l, int it, char* smem) {
  const int tid = tidx(), lane = tid & 63, w = wave_of(tid), lq = lane & 31, h = lane >> 5;
  int lat, b, hd, qb;
  if (it < 256) { lat = 1; b = it >> 6; hd = (it >> 4) & 3; qb = it & 15; }
  else { int u = it - 256; lat = 0; b = u >> 4; hd = (u >> 2) & 3; qb = u & 3; }
  const int T = lat ? 1024 : 256, tok0 = lat ? 4096 + b * 1024 : b * 256;
  const int map = w >> 1, qsub = w & 1;
  const int tok = tok0 + qb * 64 + qsub * 32 + lq;
  const float c = 0.125f * 1.4426950408889634f;
  const bf16* vt = p.VbT() + (size_t)tok0 * 512 + (size_t)hd * 128 * T;
  const bf16* vtc = p.cVbT() + (size_t)((l * 4 + b) * 4 + hd) * 128 * 256;
  const bf16* kc = p.cKb() + (size_t)((l * 4 + b) * 4 + hd) * 256 * 128;
  f32x16 o[4]; float ls, mdummy;
  attn_pass<128, 64, 1>(p.proj() + (size_t)tok * NPROJ + 1216 + hd * 128 + map * 64, map * 64, 0, p.Kb() + (size_t)(tok0 * 4 + hd) * 128, 512, T, kc, 128,
                     lat ? 256 : 0, vt, vtc, c, smem, o, ls, mdummy);
  float* ex = (float*)smem;
  __syncthreads();
  if (map == 1) {
    const float sc2 = p.lam()[l] / ls;
#pragma unroll
    for (int db = 0; db < 4; ++db)
#pragma unroll
      for (int r = 0; r < 16; ++r) {
        int dv = db * 32 + 8 * (r >> 2) + 4 * h + (r & 3);
        ex[(qsub * 128 + dv) * 32 + lq] = o[db][r] * sc2;
      }
  }
  __syncthreads();
  if (map == 0) {
    const float i1 = 1.f / ls;
    float ss = 0.f;
#pragma unroll
    for (int db = 0; db < 4; ++db)
#pragma unroll
      for (int r = 0; r < 16; ++r) {
        int dv = db * 32 + 8 * (r >> 2) + 4 * h + (r & 3);
        float v = o[db][r] * i1 - ex[(qsub * 128 + dv) * 32 + lq];
        o[db][r] = v; ss += v * v;
      }
    ss += __shfl_xor(ss, 32);
    const float lam_init = 0.8f - 0.6f * fexp(-0.3f * (float)l);
    const float sc = rsqrtf(ss * (1.f / 128.f) + EPS) * (1.f - lam_init);
#pragma unroll
    for (int db = 0; db < 4; ++db) {
      u32x2 zz[4]; f32x4 gg[4];
#pragma unroll
      for (int g = 0; g < 4; ++g) {
        int dv = db * 32 + 8 * g + 4 * h;
        zz[g] = *(const u32x2*)(p.proj() + (size_t)tok * NPROJ + 2752 + hd * 128 + dv);
        gg[g] = *(const f32x4*)(p.dnorm + l * 128 + dv);
      }
#pragma unroll
      for (int g = 0; g < 4; ++g) {
        int dv = db * 32 + 8 * g + 4 * h;
        u32x2 z = zz[g];
        f32x4 gn = gg[g];
        float z0 = bflo(z[0]), z1 = bfhi(z[0]), z2 = bflo(z[1]), z3 = bfhi(z[1]);
        u32x2 ov;
        ov[0] = pack2(o[db][4 * g] * sc * gn[0] * silu_f(z0), o[db][4 * g + 1] * sc * gn[1] * silu_f(z1));
        ov[1] = pack2(o[db][4 * g + 2] * sc * gn[2] * silu_f(z2), o[db][4 * g + 3] * sc * gn[3] * silu_f(z3));
        *(u32x2*)(p.ycat() + (size_t)tok * 1536 + 512 + hd * 128 + dv) = ov;
      }
    }
  }
}

DI void conv8(const P& p, int l, int tok, int t, int T, int col, int wcol, float (&o)[8]) {
  const bf16* base = p.proj() + (size_t)tok * NPROJ + col;
  u32x4 cur = *(const u32x4*)base;
  u32x4 prv = {0u, 0u, 0u, 0u}, nxt = {0u, 0u, 0u, 0u};
  if (t > 0) prv = *(const u32x4*)(base - NPROJ);
  if (t < T - 1) nxt = *(const u32x4*)(base + NPROJ);
  const float* w0 = p.mconv + (size_t)l * 3 * 1024 + wcol;
  f32x4 wa0 = *(const f32x4*)w0, wa1 = *(const f32x4*)(w0 + 4);
  f32x4 wb0 = *(const f32x4*)(w0 + 1024), wb1 = *(const f32x4*)(w0 + 1028);
  f32x4 wc0 = *(const f32x4*)(w0 + 2048), wc1 = *(const f32x4*)(w0 + 2052);
#pragma unroll
  for (int e = 0; e < 4; ++e) {
    float wA0 = e < 2 ? wa0[2 * e] : wa1[2 * e - 4], wA1 = e < 2 ? wa0[2 * e + 1] : wa1[2 * e - 3];
    float wB0 = e < 2 ? wb0[2 * e] : wb1[2 * e - 4], wB1 = e < 2 ? wb0[2 * e + 1] : wb1[2 * e - 3];
    float wC0 = e < 2 ? wc0[2 * e] : wc1[2 * e - 4], wC1 = e < 2 ? wc0[2 * e + 1] : wc1[2 * e - 3];
    float v0 = wA0 * bflo(prv[e]) + wB0 * bflo(cur[e]) + wC0 * bflo(nxt[e]);
    float v1 = wA1 * bfhi(prv[e]) + wB1 * bfhi(cur[e]) + wC1 * bfhi(nxt[e]);
    o[2 * e] = silu_f(v0); o[2 * e + 1] = silu_f(v1);
  }
}

DI float wave_incl_scan_add(float v, int lane) {
#pragma unroll
  for (int o = 1; o < 64; o <<= 1) { float t = __shfl_up(v, o); if (lane >= o) v += t; }
  return v;
}
DI float wave_incl_scan_max(float v, int lane) {
#pragma unroll
  for (int o = 1; o < 64; o <<= 1) { float t = __shfl_up(v, o); if (lane >= o) v = fmaxf(v, t); }
  return v;
}

DI void mlstm_local(const P& p, int l, int slot, char* smem) {
  bf16* vT = (bf16*)smem;
  bf16* kT = vT + 128 * 72;
  float* wbuf = (float*)(kT + 128 * 72);
  const int tid = tidx(), lane = tid & 63, w = wave_of(tid), lq = lane & 31, h = lane >> 5;
  const int cp = slot >> 3, hd = (slot >> 1) & 3, dir = slot & 1;
  const int ctok = cp * 64;
  TokInfo ti = tinfo(ctok);
  const int T = ti.T;
  if (w == 0) {
    const int s = dir ? 63 - lane : lane;
    const int tk = ctok + s;
    const float ig = p.gates()[tk * 16 + dir * 8 + hd];
    const float lf = logsig_f(p.gates()[tk * 16 + dir * 8 + 4 + hd]);
    const float bc = wave_incl_scan_add(lf, lane);
    const float b_last = __shfl(bc, 63);
    const float val = b_last - bc + ig;
    float mx = val;
#pragma unroll
    for (int o = 32; o >= 1; o >>= 1) mx = fmaxf(mx, __shfl_xor(mx, o));
    wbuf[s] = fexp(val - mx);
    if (lane == 0) { p.blA()[slot] = b_last; p.mlA()[slot] = mx; }
  }
  __syncthreads();
  {
    const int s = tid >> 2, chb = (tid & 3) * 32;
    const float ws = wbuf[s];
    float kvv[4][8];
#pragma unroll
    for (int q = 0; q < 4; ++q) {
      const int ch = chb + q * 8;
      conv8(p, l, ctok + s, ti.t + s, T, 3776 + hd * 128 + ch, 512 + hd * 128 + ch, kvv[q]);
    }
#pragma unroll
    for (int q = 0; q < 4; ++q) {
      const int ch = chb + q * 8;
#pragma unroll
      for (int e = 0; e < 8; ++e) kT[(ch + e) * 72 + s] = f2bf(kvv[q][e] * ws);
    }
    const bf16* vsrc = p.VmT() + (size_t)ti.tok0 * 512 + (size_t)hd * 128 * T + ti.t;
    u32x4 tvv[4];
#pragma unroll
    for (int i = 0; i < 4; ++i) { int idx = tid + 256 * i; int r = idx >> 3, cc = idx & 7; tvv[i] = *(const u32x4*)(vsrc + (size_t)r * T + cc * 8); }
#pragma unroll
    for (int i = 0; i < 4; ++i) { int idx = tid + 256 * i; int r = idx >> 3, cc = idx & 7; *(u32x4*)(vT + r * 72 + cc * 8) = tvv[i]; }
  }
  __syncthreads();
  f32x16 acc[4];
#pragma unroll
  for (int cb = 0; cb < 4; ++cb)
#pragma unroll
    for (int r = 0; r < 16; ++r) acc[cb][r] = 0.f;
#pragma unroll
  for (int ks = 0; ks < 4; ++ks) {
    bf16x8 a = *(const bf16x8*)(vT + (32 * w + lq) * 72 + ks * 16 + 8 * h);
#pragma unroll
    for (int cb = 0; cb < 4; ++cb) {
      bf16x8 bb = *(const bf16x8*)(kT + (32 * cb + lq) * 72 + ks * 16 + 8 * h);
      acc[cb] = MFMA(a, bb, acc[cb]);
    }
  }
  bf16* cs = p.Cst() + (size_t)slot * 16384;
#pragma unroll
  for (int cb = 0; cb < 4; ++cb)
#pragma unroll
    for (int r = 0; r < 16; ++r) {
      int dvv = 32 * w + 8 * (r >> 2) + 4 * h + (r & 3);
      cs[dvv * 128 + 32 * cb + lq] = f2bf(acc[cb][r]);
    }
  if (tid < 128) {
    float sum = 0.f;
#pragma unroll
    for (int q = 0; q < 8; ++q) {
      u32x4 v = *(const u32x4*)(kT + tid * 72 + q * 8);
#pragma unroll
      for (int e = 0; e < 4; ++e) sum += bflo(v[e]) + bfhi(v[e]);
    }
    p.nst()[slot * 128 + tid] = sum;
  }
}

DI void mlstm_scan(const P& p, int l, int it) {
  const int tid = tidx();
  const int ch = it >> 2, qt = it & 3;
  int lat, b, hd, dir;
  if (ch < 32) { lat = 1; b = ch >> 3; hd = (ch >> 1) & 3; dir = ch & 1; }
  else { int u = ch - 32; lat = 0; b = u >> 3; hd = (u >> 1) & 3; dir = u & 1; }
  const int T = lat ? 1024 : 256, tok0 = lat ? 4096 + b * 1024 : b * 256, nc = T >> 6;
  const int dv0 = 32 * qt + 4 * (tid >> 5), dk0 = 4 * (tid & 31);
  float C[4][4];
  float n_val = 0.f, m_prev = 0.f;
  const bool do_n = (qt == 0) && (tid < 128);
  const size_t sidx = (size_t)((b * 4 + l) * 2 + dir) * 4 + hd;
  if (lat) {
    const float* C0 = p.st_C + sidx * 16384;
#pragma unroll
    for (int j = 0; j < 4; ++j) {
      f32x4 v = *(const f32x4*)(C0 + (size_t)(dk0 + j) * 128 + dv0);
      C[0][j] = v[0]; C[1][j] = v[1]; C[2][j] = v[2]; C[3][j] = v[3];
    }
    if (do_n) n_val = p.st_n[sidx * 128 + tid];
    m_prev = p.st_m[sidx];
  } else {
#pragma unroll
    for (int i = 0; i < 4; ++i)
#pragma unroll
      for (int j = 0; j < 4; ++j) C[i][j] = 0.f;
  }
  u32x2 dnx[4]; float blx, mlx, dnnx = 0.f;
  {
    const int c = dir ? nc - 1 : 0;
    const int slot = ((((tok0 >> 6) + c) * 4 + hd) * 2) + dir;
    const bf16* cs = p.Cst() + (size_t)slot * 16384 + dv0 * 128 + dk0;
#pragma unroll
    for (int i = 0; i < 4; ++i) dnx[i] = *(const u32x2*)(cs + i * 128);
    blx = p.blA()[slot]; mlx = p.mlA()[slot];
    if (do_n) dnnx = p.nst()[slot * 128 + tid];
  }
  for (int ci = 0; ci < nc; ++ci) {
    const int c = dir ? nc - 1 - ci : ci;
    const int slot = ((((tok0 >> 6) + c) * 4 + hd) * 2) + dir;
    bf16* cs = p.Cst() + (size_t)slot * 16384 + dv0 * 128 + dk0;
    u32x2 d[4];
#pragma unroll
    for (int i = 0; i < 4; ++i) d[i] = dnx[i];
    const float bl = blx, ml = mlx;
    const float dn = dnnx;
    {
      const int cn = (ci + 1 < nc) ? (dir ? nc - 2 - ci : ci + 1) : c;
      const int sn = ((((tok0 >> 6) + cn) * 4 + hd) * 2) + dir;
      const bf16* csn = p.Cst() + (size_t)sn * 16384 + dv0 * 128 + dk0;
#pragma unroll
      for (int i = 0; i < 4; ++i) dnx[i] = *(const u32x2*)(csn + i * 128);
      blx = p.blA()[sn]; mlx = p.mlA()[sn];
      if (do_n) dnnx = p.nst()[sn * 128 + tid];
    }
#pragma unroll
    for (int i = 0; i < 4; ++i) {
      u32x2 o; o[0] = pack2(C[i][0], C[i][1]); o[1] = pack2(C[i][2], C[i][3]);
      *(u32x2*)(cs + i * 128) = o;
    }
    if (do_n) p.nst()[slot * 128 + tid] = n_val;
    if (qt == 0 && tid == 0) p.mst()[slot] = m_prev;
    const float m_new = fmaxf(bl + m_prev, ml);
    const float a = fexp(bl + m_prev - m_new), bs = fexp(ml - m_new);
#pragma unroll
    for (int i = 0; i < 4; ++i) {
      C[i][0] = a * C[i][0] + bs * bflo(d[i][0]); C[i][1] = a * C[i][1] + bs * bfhi(d[i][0]);
      C[i][2] = a * C[i][2] + bs * bflo(d[i][1]); C[i][3] = a * C[i][3] + bs * bfhi(d[i][1]);
    }
    n_val = a * n_val + bs * dn;
    m_prev = m_new;
  }
  if (!lat) {
    float* Co = p.out + O_MC + sidx * 16384;
#pragma unroll
    for (int j = 0; j < 4; ++j) {
      f32x4 v; v[0] = C[0][j]; v[1] = C[1][j]; v[2] = C[2][j]; v[3] = C[3][j];
      *(f32x4*)(Co + (size_t)(dk0 + j) * 128 + dv0) = v;
    }
    if (do_n) p.out[O_MN + sidx * 128 + tid] = n_val;
    if (qt == 0 && tid == 0) p.out[O_MM + sidx] = m_prev;
  }
}

DI void mlstm_out(const P& p, int l, int it, char* smem) {
  bf16* sq = (bf16*)smem;
  bf16* sk = sq + 64 * 136;
  bf16* vT = sk + 64 * 136;
  float* bcA2 = (float*)(vT + 128 * 72);
  float* uA2 = bcA2 + 128, *mtA2 = uA2 + 128, *nA2 = mtA2 + 128  , *ssb = nA2 + 256  ;
  const int tid = tidx(), lane = tid & 63, w = wave_of(tid), lq = lane & 31, h = lane >> 5;
  const int cp = it >> 2, hd = it & 3;
  const int ctok = cp * 64;
  TokInfo ti = tinfo(ctok);
  const int T = ti.T;
  const float m_prev0 = p.mst()[(cp * 4 + hd) * 2], m_prev1 = p.mst()[(cp * 4 + hd) * 2 + 1];
  if (w < 2) {
    const int dir = w;
    const float m_prev = dir ? m_prev1 : m_prev0;
    const int s = dir ? 63 - lane : lane;
    const int tk = ctok + s;
    const float ig = p.gates()[tk * 16 + dir * 8 + hd];
    const float lf = logsig_f(p.gates()[tk * 16 + dir * 8 + 4 + hd]);
    const float bc = wave_incl_scan_add(lf, lane);
    const float u = ig - bc;
    const float pm = wave_incl_scan_max(u, lane);
    bcA2[dir * 64 + s] = bc; uA2[dir * 64 + s] = u; mtA2[dir * 64 + s] = bc + fmaxf(m_prev, pm);
  } else {
    const int dir = w - 2;
    const int slot = (cp * 4 + hd) * 2 + dir;
    nA2[dir * 128 + lane] = p.nst()[slot * 128 + lane];
    nA2[dir * 128 + 64 + lane] = p.nst()[slot * 128 + 64 + lane];
  }
  {
    const int s = tid >> 2, chb = (tid & 3) * 32;
#pragma unroll 2
    for (int q = 0; q < 4; ++q) {
      const int ch = chb + q * 8;
      float v[8];
      conv8(p, l, ctok + s, ti.t + s, T, 3264 + hd * 128 + ch, hd * 128 + ch, v);
      u32x4 pk;
#pragma unroll
      for (int e = 0; e < 4; ++e) pk[e] = pack2(v[2 * e] * 0.08838834764831845f, v[2 * e + 1] * 0.08838834764831845f);
      *(u32x4*)(sq + s * 136 + ch) = pk;
      conv8(p, l, ctok + s, ti.t + s, T, 3776 + hd * 128 + ch, 512 + hd * 128 + ch, v);
#pragma unroll
      for (int e = 0; e < 4; ++e) pk[e] = pack2(v[2 * e], v[2 * e + 1]);
      *(u32x4*)(sk + s * 136 + ch) = pk;
    }
    const bf16* vsrc = p.VmT() + (size_t)ti.tok0 * 512 + (size_t)hd * 128 * T + ti.t;
    u32x4 tvv[4];
#pragma unroll
    for (int i = 0; i < 4; ++i) { int idx = tid + 256 * i; int r = idx >> 3, cc = idx & 7; tvv[i] = *(const u32x4*)(vsrc + (size_t)r * T + cc * 8); }
#pragma unroll
    for (int i = 0; i < 4; ++i) { int idx = tid + 256 * i; int r = idx >> 3, cc = idx & 7; *(u32x4*)(vT + r * 72 + cc * 8) = tvv[i]; }
  }
  __syncthreads();
  const int tb = w & 1, dvh = w >> 1;
  const int t = 32 * tb + lq;
  f32x16 hacc[2];
#pragma unroll
  for (int d2 = 0; d2 < 2; ++d2)
#pragma unroll
    for (int r = 0; r < 16; ++r) hacc[d2][r] = 0.f;
  const bf16* sqt = sq + t * 136 + 8 * h;
  for (int dir = 0; dir < 2; ++dir) {
    const int slot = (cp * 4 + hd) * 2 + dir;
    const float m_prev = dir ? m_prev1 : m_prev0;
    const float* bcA = bcA2 + dir * 64;
    const float* uA = uA2 + dir * 64;
    const float* mtA = mtA2 + dir * 64;
    const float* nA = nA2 + dir * 128;
    const float bc_t = bcA[t], mt = mtA[t];
    const float w_inter = fexp(bc_t + m_prev - mt);
    float den = 0.f;
    const float e0 = bc_t - mt;
    u32x4 pk[2][2];
#pragma unroll
    for (int sb = 0; sb < 2; ++sb) {
      asm volatile("" ::: "memory");
      f32x16 sv;
#pragma unroll
      for (int r = 0; r < 16; ++r) sv[r] = 0.f;
#pragma unroll
      for (int ks = 0; ks < 8; ++ks) {
        bf16x8 a = *(const bf16x8*)(sk + (32 * sb + lq) * 136 + ks * 16 + 8 * h);
        sv = MFMA(a, *(const bf16x8*)(sqt + ks * 16), sv);
      }
#pragma unroll
      for (int r = 0; r < 16; ++r) {
        const int sidx = 32 * sb + 8 * (r >> 2) + 4 * h + (r & 3);
        const bool valid = dir ? (sidx >= t) : (sidx <= t);
        const float wgt = valid ? fexp(e0 + uA[sidx]) : 0.f;
        const float v = sv[r] * wgt;
        sv[r] = v; den += v;
      }
#pragma unroll
      for (int s2 = 0; s2 < 2; ++s2)
#pragma unroll
        for (int e = 0; e < 4; ++e) pk[sb][s2][e] = pack2(sv[8 * s2 + 2 * e], sv[8 * s2 + 2 * e + 1]);
    }
    asm volatile("" ::: "memory");
    den += __shfl_xor(den, 32);
    float qn = 0.f;
#pragma unroll
    for (int ks = 0; ks < 8; ++ks) {
      u32x4 qv = *(const u32x4*)(sqt + ks * 16);
#pragma unroll
      for (int e = 0; e < 4; ++e) {
        qn += bflo(qv[e]) * nA[ks * 16 + 8 * h + 2 * e] + bfhi(qv[e]) * nA[ks * 16 + 8 * h + 2 * e + 1];
      }
    }
    qn += __shfl_xor(qn, 32);
    den += w_inter * qn;
    asm volatile("" ::: "memory");
    const float rden = 1.f / fmaxf(fabsf(den), fexp(-mt));
    const bf16* cs = p.Cst() + (size_t)slot * 16384;
    bf16x8 cfa[2][8];
#pragma unroll
    for (int d2 = 0; d2 < 2; ++d2)
#pragma unroll
      for (int ks = 0; ks < 8; ++ks) cfa[d2][ks] = *(const bf16x8*)(cs + ((2 * dvh + d2) * 32 + lq) * 128 + ks * 16 + 8 * h);
    asm volatile("" : "+v"(cfa[0][0]), "+v"(cfa[0][1]), "+v"(cfa[0][2]), "+v"(cfa[0][3]), "+v"(cfa[0][4]), "+v"(cfa[0][5]), "+v"(cfa[0][6]), "+v"(cfa[0][7]),
                      "+v"(cfa[1][0]), "+v"(cfa[1][1]), "+v"(cfa[1][2]), "+v"(cfa[1][3]), "+v"(cfa[1][4]), "+v"(cfa[1][5]), "+v"(cfa[1][6]), "+v"(cfa[1][7]));
#pragma unroll
    for (int d2 = 0; d2 < 2; ++d2) {
      const int dvb = 2 * dvh + d2;
      f32x16 acc;
#pragma unroll
      for (int r = 0; r < 16; ++r) acc[r] = 0.f;
#pragma unroll
      for (int ks = 0; ks < 8; ++ks) acc = MFMA(cfa[d2][ks], *(const bf16x8*)(sqt + ks * 16), acc);
#pragma unroll
      for (int r = 0; r < 16; ++r) acc[r] *= w_inter;
#pragma unroll
      for (int sb = 0; sb < 2; ++sb)
#pragma unroll
        for (int s2 = 0; s2 < 2; ++s2) {
          const bf16* vp = vT + (dvb * 32 + lq) * 72 + sb * 32 + s2 * 16 + 4 * h;
          u32x2 lo = *(const u32x2*)vp, hi = *(const u32x2*)(vp + 8);
          u32x4 av; av[0] = lo[0]; av[1] = lo[1]; av[2] = hi[0]; av[3] = hi[1];
          acc = MFMA(__builtin_bit_cast(bf16x8, av), __builtin_bit_cast(bf16x8, pk[sb][s2]), acc);
        }
#pragma unroll
      for (int r = 0; r < 16; ++r) hacc[d2][r] += acc[r] * rden;
    }
  }
  const int tok = ctok + t;
  float ss = 0.f;
#pragma unroll
  for (int d2 = 0; d2 < 2; ++d2)
#pragma unroll
    for (int g = 0; g < 4; ++g) {
      int dv = (2 * dvh + d2) * 32 + 8 * g + 4 * h;
      u32x2 mo = *(const u32x2*)(p.proj() + (size_t)tok * NPROJ + 4800 + hd * 128 + dv);
      float m0 = bflo(mo[0]), m1 = bfhi(mo[0]), m2 = bflo(mo[1]), m3 = bfhi(mo[1]);
      float v0 = hacc[d2][4 * g] * sigmoid_f(m0), v1 = hacc[d2][4 * g + 1] * sigmoid_f(m1);
      float v2 = hacc[d2][4 * g + 2] * sigmoid_f(m2), v3 = hacc[d2][4 * g + 3] * sigmoid_f(m3);
      hacc[d2][4 * g] = v0; hacc[d2][4 * g + 1] = v1; hacc[d2][4 * g + 2] = v2; hacc[d2][4 * g + 3] = v3;
      ss += v0 * v0 + v1 * v1 + v2 * v2 + v3 * v3;
    }
  ss += __shfl_xor(ss, 32);
  if (h == 0) ssb[dvh * 64 + t] = ss;
  __syncthreads();
  const float rstd = rsqrtf((ssb[t] + ssb[64 + t]) * (1.f / 128.f) + EPS);
  u32x2 zz[2][4]; f32x4 gg[2][4];
#pragma unroll
  for (int d2 = 0; d2 < 2; ++d2)
#pragma unroll
    for (int g = 0; g < 4; ++g) {
      int dv = (2 * dvh + d2) * 32 + 8 * g + 4 * h;
      zz[d2][g] = *(const u32x2*)(p.proj() + (size_t)tok * NPROJ + 5312 + hd * 128 + dv);
      gg[d2][g] = *(const f32x4*)(p.mnorm + l * 512 + hd * 128 + dv);
    }
#pragma unroll
  for (int d2 = 0; d2 < 2; ++d2)
#pragma unroll
    for (int g = 0; g < 4; ++g) {
      int dv = (2 * dvh + d2) * 32 + 8 * g + 4 * h;
      u32x2 z = zz[d2][g];
      f32x4 gn = gg[d2][g];
      float z0 = bflo(z[0]), z1 = bfhi(z[0]), z2 = bflo(z[1]), z3 = bfhi(z[1]);
      u32x2 ov;
      ov[0] = pack2(hacc[d2][4 * g] * rstd * gn[0] * silu_f(z0), hacc[d2][4 * g + 1] * rstd * gn[1] * silu_f(z1));
      ov[1] = pack2(hacc[d2][4 * g + 2] * rstd * gn[2] * silu_f(z2), hacc[d2][4 * g + 3] * rstd * gn[3] * silu_f(z3));
      *(u32x2*)(p.ycat() + (size_t)tok * 1536 + 1024 + hd * 128 + dv) = ov;
    }
}

DI void ckv_fin(const P& p, int l, int tok) {
  const int lane = tidx() & 63;
  const int b = tok >> 8, t = tok & 255;
  float* o = p.out + O_CKV + (size_t)((b * 4 + l) * 256 + t) * 256 + lane * 4;
  u32x2 raw = *(const u32x2*)(p.proj() + (size_t)tok * NPROJ + 384 + lane * 4);
  f32x4 v; v[0] = bflo(raw[0]); v[1] = bfhi(raw[0]); v[2] = bflo(raw[1]); v[3] = bfhi(raw[1]);
  float ss = v[0] * v[0] + v[1] * v[1] + v[2] * v[2] + v[3] * v[3];
#pragma unroll
  for (int of = 32; of >= 1; of >>= 1) ss += __shfl_xor(ss, of);
  const float rstd = rsqrtf(ss * (1.f / 256.f) + EPS);
  f32x4 g = *(const f32x4*)(p.kv_norm + l * 256 + lane * 4);
  v[0] *= rstd * g[0]; v[1] *= rstd * g[1]; v[2] *= rstd * g[2]; v[3] *= rstd * g[3];
  *(f32x4*)o = v;
}

#define XB_TMO      128
#define XB_XCNT(j)  (256  + 64 * (j))
#define XB_XSUB(j)  (1280 + 64 * (j))
#define XB_XGEN(j)  (2304 + 64 * (j))
#define XB_TOP      3328
#define XB_TOPGEN   3392
#define XCD_BAR_WORDS 3456
#define XB_SPIN_CAP (1u << 18)
#define LAS __attribute__((address_space(3)))

__device__ __forceinline__ unsigned xb_ld(unsigned* p)              { return __hip_atomic_load(p, __ATOMIC_RELAXED, __HIP_MEMORY_SCOPE_AGENT); }
__device__ __forceinline__ unsigned xb_add(unsigned* p, unsigned v) { return __hip_atomic_fetch_add(p, v, __ATOMIC_RELAXED, __HIP_MEMORY_SCOPE_AGENT); }
__device__ __forceinline__ unsigned xb_xcc_id() { return (unsigned)__builtin_amdgcn_s_getreg((3 << 11) | 20) & 0xFu; }
#define XB_SPIN(cond, bar) do { unsigned _sp = 0; while (cond) { __builtin_amdgcn_s_sleep(1); \
    if ((++_sp & 255u) == 0u) { if (xb_ld(&(bar)[XB_TMO])) break; if (_sp > XB_SPIN_CAP) { atomicAdd(&(bar)[XB_TMO], 1u); break; } } } } while (0)

struct XcdBarrier {
    unsigned* bar; unsigned x;
    volatile LAS unsigned* st;
};

__device__ __forceinline__ XcdBarrier xcd_barrier_post(unsigned* bar, volatile LAS unsigned* st) {
    XcdBarrier b; b.bar = bar; b.x = xb_xcc_id(); b.st = st;
    if (tidx() == 0) (void)xb_add(&bar[XB_XCNT(b.x)], 1u);
    return b;
}
__device__ __forceinline__ void xcd_barrier_complete(unsigned* bar, unsigned x, unsigned& nloc, unsigned& nx) {
    const unsigned G = gridDim.x * gridDim.y * gridDim.z;
    unsigned sum, cnt, mine, sp = 0u;
    for (;;) {
        sum = 0u; cnt = 0u; mine = 0u;
#pragma unroll
        for (unsigned j = 0; j < 16; ++j) { const unsigned c = xb_ld(&bar[XB_XCNT(j)]); sum += c; cnt += (c > 0u) ? 1u : 0u; mine = (j == x) ? c : mine; }
        if (sum == G) break;
        __builtin_amdgcn_s_sleep(1);
        if ((++sp & 255u) == 0u) { if (xb_ld(&bar[XB_TMO])) break; if (sp > XB_SPIN_CAP) { atomicAdd(&bar[XB_TMO], 1u); break; } }
    }
    nloc = mine > 0u ? mine : 1u; nx = cnt > 0u ? cnt : 1u;
}

__device__ __forceinline__ void xcd_barrier(const XcdBarrier& b) {
    asm volatile("s_waitcnt vmcnt(0)" ::: "memory");
    __syncthreads();
    if (tidx() == 0) {
        unsigned* bar = b.bar;
        __builtin_amdgcn_s_waitcnt(0);
        unsigned nloc = b.st[0], nx = b.st[1];
        if (nloc == 0u) { xcd_barrier_complete(bar, b.x, nloc, nx); b.st[0] = nloc; b.st[1] = nx; }
        const unsigned old = xb_add(&bar[XB_XSUB(b.x)], 1u);
        const unsigned gen = old / nloc;
        if (old + 1u == (gen + 1u) * nloc) {
            __builtin_amdgcn_fence(__ATOMIC_RELEASE, "agent");
            asm volatile("s_waitcnt vmcnt(0)" ::: "memory");
            const unsigned og = xb_add(&bar[XB_TOP], 1u);
            const unsigned tg = og / nx;
            if (og + 1u == (tg + 1u) * nx) xb_add(&bar[XB_TOPGEN], 1u);
            else XB_SPIN(xb_ld(&bar[XB_TOPGEN]) == tg, bar);
            __builtin_amdgcn_fence(__ATOMIC_ACQUIRE, "agent");
            xb_add(&bar[XB_XGEN(b.x)], 1u);
            asm volatile("s_waitcnt vmcnt(0)" ::: "memory");
        } else {
            XB_SPIN(xb_ld(&bar[XB_XGEN(b.x)]) == gen, bar);
            __builtin_amdgcn_fence(__ATOMIC_ACQUIRE, "agent");
            asm volatile("s_waitcnt vmcnt(0)" ::: "memory");
        }
    }
    __syncthreads();
}


DI P launder(const P& p) {
  P q = p;
#define LND(m) { asm volatile("" : "+s"(q.m)); q.m = (decltype(q.m))(__attribute__((address_space(1))) void*)(void*)q.m; }
  LND(x_prompt) LND(x_sample) LND(c_ckv) LND(c_krope) LND(c_dk) LND(c_dv) LND(st_C) LND(st_n) LND(st_m) LND(c) LND(c_ctx)
  LND(g_norm) LND(W_mod) LND(b_mod) LND(W_in) LND(q_norm) LND(W_uq) LND(kv_norm) LND(W_ukv) LND(dlam) LND(dnorm) LND(mconv)
  LND(mgb) LND(mnorm) LND(W_out) LND(g_final) LND(out) LND(ws)
#undef LND
  return q;
}

template <int KIND>
DI void run_phase(const P& p0, int ph, char* smem) {
  const P& p = p0;
  const int G = gridDim.x, B = blockIdx.x, w = wave_of(tidx());
  if ((KIND < 0 || KIND == 0) && ph == 0) { phase_prepass(p, smem); return; }
  if ((KIND < 0 || KIND == 1) && ph == 1) {
    for (int it = B; it < 256 + 2048; it += G) {
      if (it < 256) {
        int mt = it >> 3, nt = it & 7;
        int l = (mt * 128) >> 10;
        f32x16 acc[2][2];
        gemm_core<false>(p.cckv() + (size_t)mt * 128 * 256, 256, p.WukvTp() + (size_t)l * 1024 * 256 + (size_t)nt * 128 * 256, 256, 256, smem, acc);
        epi_kv(p, mt * 128, nt * 128, acc, nullptr, true);
      } else {
        norm_row(p, 0, (it - 256) * 4 + w, 0);
      }
    }
    return;
  }
  const int l = (ph - 2) / 6, sub = (ph - 2) % 6;
  if ((KIND < 0 || KIND == 2) && sub == 0) {
    const int x = B & 7, j = B >> 3, per = G >> 3;
    const bf16* Ab = p.hbuf();
    const bf16* Wb = p.WinT() + (size_t)l * NPROJ * 1024;
    for (int q = j; q < 3 * 64; q += per) {
      const int r = q >> 6, jj = q & 63;
      const int st = r * 8 + x;
      const int mt = (st / 3) * 8 + (jj >> 3), nt = (st % 3) * 8 + (jj & 7);
      if (nt >= 23) continue;
      f32x16 acc[2][4];
      gemm_core_w(Ab + (size_t)mt * 128 * 1024, 1024, Wb + (size_t)nt * 256 * 1024, 1024, 1024, smem, acc);
      epi_inproj_w(p, l, mt * 128, nt * 256, acc, smem);
    }
  } else if ((KIND < 0 || KIND == 3) && sub == 1) {
    const int N_CH = 1024, N_QA = 64 * 3, N_KV = 64 * 4, N_CF = 1024;
    const float* sRowW = (const float*)(smem + (128 + 256) * 72 * 2);
    for (int it = B; it < N_CH + N_QA + N_KV + N_CF; it += G) {
      int u = it;
      __syncthreads();
      if (u < N_CH) { mlstm_local(p, l, u, smem); continue; }
      u -= N_CH;
      if (u < N_QA) {
        int mt = u / 3, nt = u % 3;
        f32x16 acc[2][4];
        gemm_core_w<true>(p.proj() + (size_t)mt * 128 * NPROJ, NPROJ, p.WuqT() + (size_t)l * 768 * 384 + (size_t)nt * 256 * 384, 384, 384, smem, acc);
        epi_qa_w<0>(p, mt * 128, nt * 256, acc, sRowW);
        epi_qa_w<1>(p, mt * 128, nt * 256, acc, sRowW);
        continue;
      }
      u -= N_QA;
      if (u < N_KV) {
        int mt = u >> 2, nt = u & 3;
        f32x16 acc[2][4];
        gemm_core_w<true>(p.proj() + (size_t)mt * 128 * NPROJ + 384, NPROJ, p.WukvT() + (size_t)l * 1024 * 256 + (size_t)nt * 256 * 256, 256, 256, smem, acc);
        epi_kv_w<0>(p, mt * 128, nt * 256, acc, sRowW);
        epi_kv_w<1>(p, mt * 128, nt * 256, acc, sRowW);
        continue;
      }
      u -= N_KV;
      ckv_fin(p, l, u * 4 + w);
    }
  } else if ((KIND < 0 || KIND == 7) && sub == 2) {
    for (int it = B; it < 640; it += G) mlstm_scan(p, l, it);
  } else if ((KIND < 0 || KIND == 4) && sub == 3) {
    const int x = B & 7;
    int* qctr = p.qc() + ph * 8 + x;
    int* sslot = (int*)(smem + SMEM_BYTES - 16);
    const int nfirst = G >> 3;
    int q = B >> 3;
    for (;;) {
      if (q >= 192) break;
      __syncthreads();
      if (q < 32) { const int pr = 2 * x + (q >> 4); mla_item(p, l, pr * 16 + (q & 15), smem); }
      else if (q < 64) { const int u = q - 32; const int pr = 2 * x + (u >> 4); diff_item(p, l, pr * 16 + (u & 15), smem); }
      else if (q < 128) mlstm_out(p, l, x * 64 + (q - 64), smem);
      else if (q < 160) { const int u = q - 128; const int pr = 8 * x + (u >> 2); mla_item(p, l, 256 + pr * 4 + (u & 3), smem); }
      else { const int u = q - 160; const int pr = 8 * x + (u >> 2); diff_item(p, l, 256 + pr * 4 + (u & 3), smem); }
      __syncthreads();
      if (tidx() == 0) *sslot = nfirst + atomicAdd(qctr, 1);
      __syncthreads();
      q = *sslot;
    }
  } else if ((KIND < 0 || KIND == 5) && sub == 4) {
    const int x = B & 7, j = B >> 3, per = G >> 3;
    for (int q = j; q < 64; q += per) {
      const int mt = x * 8 + (q >> 3), nt = q & 7;
      f32x16 acc[2][2];
      gemm_core<false>(p.ycat() + (size_t)mt * 128 * 1536, 1536, p.WoutT() + (size_t)l * 1024 * 1536 + (size_t)nt * 128 * 1536, 1536, 1536, smem, acc);
      epi_out(p, l, mt * 128, nt * 128, acc);
    }
  } else if ((KIND < 0 || KIND == 6) && sub == 5) {
    for (int it = B; it < 2048; it += G) {
      if (l < 3) norm_row(p, l + 1, it * 4 + w, 0);
      else norm_row(p, 0, it * 4 + w, 1);
    }
  }
}

#if COOP
__global__ void __launch_bounds__(256, 2) mega(P p, int lo, int hi, int coop) {
  __shared__ __attribute__((aligned(16))) char smem[SMEM_BYTES];
  __shared__ uint4 xb_words;
  if (threadIdx.x == 0) xb_words = make_uint4(0u, 0u, 0u, 0u);
  tidx_init();
  XcdBarrier xb = xcd_barrier_post((unsigned*)p.ctr(), (volatile LAS unsigned*)&xb_words);
  for (int ph = lo; ph < hi; ++ph) {
    run_phase<-1>(p, ph, smem);
    if (PROBE_DUP) {
      const int kind = ph < 2 ? ph : 2 + (ph - 2) % 6;
      if ((PROBE_DUP >> kind) & 1) { xcd_barrier(xb); run_phase<-1>(p, ph, smem); }
    }
    if (ph + 1 < hi) xcd_barrier(xb);
  }
  if (coop == 2) cg::this_grid().sync();
}
#endif
template <int KIND>
__global__ void __launch_bounds__(256) phase_k(P p, int ph) {
  __shared__ __attribute__((aligned(16))) char smem[SMEM_BYTES];
  tidx_init();
  run_phase<KIND>(p, ph, smem);
}

extern "C" void kernel_launch(void* const* d_in, const int* in_sizes, int n_in, void* d_out, int out_size, void* d_ws,
                              size_t ws_size, hipStream_t stream) {
  P p{};
  const float** ins = (const float**)&p;
  for (int i = 0; i < 26; ++i) ins[i] = (const float*)d_in[i];
  p.out = (float*)d_out;
  p.ws = (char*)d_ws;
  if (WS_TOTAL > ws_size) { fprintf(stderr, "workspace too small: need %zu have %zu\n", (size_t)WS_TOTAL, ws_size); return; }

#if COOP
  static int grid_blocks = 0;
  if (!grid_blocks) {
    int dev = 0, cus = 0, per_cu = 0;
    (void)hipGetDevice(&dev);
    (void)hipDeviceGetAttribute(&cus, hipDeviceAttributeMultiprocessorCount, dev);
    (void)hipOccupancyMaxActiveBlocksPerMultiprocessor(&per_cu, mega, 256, 0);
    if (per_cu > 2) per_cu = 2;
    grid_blocks = cus * per_cu;
  }
  (void)hipMemsetAsync(p.ws + OFF_ctr, 0, 16384 + 4096, stream);
  int lo = 0, hi = NPHASE, coop = 1;
  void* args[] = {&p, &lo, &hi, &coop};
  hipError_t e = hipLaunchCooperativeKernel((void*)mega, dim3(grid_blocks), dim3(256), args, 0, stream);
  if (e != hipSuccess) fprintf(stderr, "cooperative launch failed: %s (grid %d)\n", hipGetErrorString(e), grid_blocks);
#else
  for (int ph = 0; ph < NPHASE; ++ph) {
    static const int kmap[6] = {2, 3, 7, 4, 5, 6};
    int kind = ph < 2 ? ph : kmap[(ph - 2) % 6];
    switch (kind) {
      case 0: phase_k<0><<<512, 256, 0, stream>>>(p, ph); break;
      case 1: phase_k<1><<<512, 256, 0, stream>>>(p, ph); break;
      case 2: phase_k<2><<<512, 256, 0, stream>>>(p, ph); break;
      case 3: phase_k<3><<<512, 256, 0, stream>>>(p, ph); break;
      case 4: phase_k<4><<<512, 256, 0, stream>>>(p, ph); break;
      case 5: phase_k<5><<<512, 256, 0, stream>>>(p, ph); break;
      case 7: phase_k<7><<<512, 256, 0, stream>>>(p, ph); break;
      default: phase_k<6><<<512, 256, 0, stream>>>(p, ph); break;
    }
  }
#endif
}
```

```cpp
#include <hip/hip_runtime.h>
#include <hip/hip_cooperative_groups.h>
#include <cstdio>
namespace cg = cooperative_groups;

typedef unsigned short bf16;
typedef __attribute__((ext_vector_type(8))) short bf16x8;
typedef __attribute__((ext_vector_type(4))) short s16x4;
typedef __attribute__((ext_vector_type(16))) float f32x16;
typedef __attribute__((ext_vector_type(4))) float f32x4;
typedef __attribute__((ext_vector_type(4))) unsigned u32x4;
typedef __attribute__((ext_vector_type(2))) unsigned u32x2;

#define DI __device__ __forceinline__
#define MFMA(a, b, c) __builtin_amdgcn_mfma_f32_32x32x16_bf16((a), (b), (c), 0, 0, 0)

#ifndef COOP
#define COOP 1
#endif
#define PROBE_DUP 0

constexpr int NTOK = 8192;
constexpr int NPROJ = 5888;
constexpr int NPHASE = 26;
constexpr float EPS = 1e-6f;
constexpr int SMEM_BYTES = 75 * 1024;

constexpr size_t O_YP = 0, O_YS = 4194304, O_CKV = 8388608, O_KROPE = 12582912, O_DK = 13631488,
                 O_DV = 22020096, O_MC = 30408704, O_MN = 38797312, O_MM = 38862848;

constexpr size_t al256(size_t x) { return (x + 255) & ~(size_t)255; }
constexpr size_t OFF_WinT = 0;
constexpr size_t OFF_WuqT = OFF_WinT + al256((size_t)4 * NPROJ * 1024 * 2);
constexpr size_t OFF_WukvT = OFF_WuqT + al256((size_t)4 * 768 * 384 * 2);
constexpr size_t OFF_WukvTp = OFF_WukvT + al256((size_t)4 * 1024 * 256 * 2);
constexpr size_t OFF_WoutT = OFF_WukvTp + al256((size_t)4 * 1024 * 256 * 2);
constexpr size_t OFF_mod = OFF_WoutT + al256((size_t)4 * 1024 * 1536 * 2);
constexpr size_t OFF_ropec = OFF_mod + al256((size_t)4 * 5 * 3072 * 4);
constexpr size_t OFF_ropes = OFF_ropec + al256((size_t)1024 * 32 * 4);
constexpr size_t OFF_lam = OFF_ropes + al256((size_t)1024 * 32 * 4);
constexpr size_t OFF_hbuf = OFF_lam + al256((size_t)256);
constexpr size_t OFF_xbuf = OFF_hbuf + al256((size_t)NTOK * 1024 * 2);
constexpr size_t OFF_proj = OFF_xbuf + al256((size_t)NTOK * 1024 * 4);
constexpr size_t OFF_Qa = OFF_proj + al256((size_t)NTOK * NPROJ * 2);
constexpr size_t OFF_Ka = OFF_Qa + al256((size_t)NTOK * 768 * 2);
constexpr size_t OFF_VaT = OFF_Ka + al256((size_t)NTOK * 768 * 2);
constexpr size_t OFF_Kb = OFF_VaT + al256((size_t)NTOK * 512 * 2);
constexpr size_t OFF_VbT = OFF_Kb + al256((size_t)NTOK * 512 * 2);
constexpr size_t OFF_VmT = OFF_VbT + al256((size_t)NTOK * 512 * 2);
constexpr size_t OFF_ycat = OFF_VmT + al256((size_t)NTOK * 512 * 2);
constexpr size_t OFF_gates = OFF_ycat + al256((size_t)NTOK * 1536 * 2);
constexpr size_t OFF_Cst = OFF_gates + al256((size_t)NTOK * 16 * 4);
constexpr size_t OFF_nst = OFF_Cst + al256((size_t)1024 * 16384 * 2);
constexpr size_t OFF_mst = OFF_nst + al256((size_t)1024 * 128 * 4);
constexpr size_t OFF_cckv = OFF_mst + al256((size_t)1024 * 4);
constexpr size_t OFF_cKa = OFF_cckv + al256((size_t)4096 * 256 * 2);
constexpr size_t OFF_cVaT = OFF_cKa + al256((size_t)64 * 256 * 192 * 2);
constexpr size_t OFF_cKb = OFF_cVaT + al256((size_t)64 * 128 * 256 * 2);
constexpr size_t OFF_cVbT = OFF_cKb + al256((size_t)64 * 256 * 128 * 2);
constexpr size_t OFF_blA = OFF_cVbT + al256((size_t)64 * 128 * 256 * 2);
constexpr size_t OFF_mlA = OFF_blA + 4096;
constexpr size_t OFF_ctr = OFF_mlA + 4096;
constexpr size_t OFF_qc = OFF_ctr + 16384;
constexpr size_t WS_TOTAL = OFF_qc + 4096;
struct P {
  const float *x_prompt, *x_sample, *c_ckv, *c_krope, *c_dk, *c_dv, *st_C, *st_n, *st_m, *c, *c_ctx, *g_norm, *W_mod,
      *b_mod, *W_in, *q_norm, *W_uq, *kv_norm, *W_ukv, *dlam, *dnorm, *mconv, *mgb, *mnorm, *W_out, *g_final;
  float* out;
  char* ws;
  __device__ __forceinline__ bf16* WinT() const { return (bf16*)(ws + OFF_WinT); }
  __device__ __forceinline__ bf16* WuqT() const { return (bf16*)(ws + OFF_WuqT); }
  __device__ __forceinline__ bf16* WukvT() const { return (bf16*)(ws + OFF_WukvT); }
  __device__ __forceinline__ bf16* WukvTp() const { return (bf16*)(ws + OFF_WukvTp); }
  __device__ __forceinline__ bf16* WoutT() const { return (bf16*)(ws + OFF_WoutT); }
  __device__ __forceinline__ float* mod() const { return (float*)(ws + OFF_mod); }
  __device__ __forceinline__ float* ropec() const { return (float*)(ws + OFF_ropec); }
  __device__ __forceinline__ float* ropes() const { return (float*)(ws + OFF_ropes); }
  __device__ __forceinline__ float* lam() const { return (float*)(ws + OFF_lam); }
  __device__ __forceinline__ bf16* hbuf() const { return (bf16*)(ws + OFF_hbuf); }
  __device__ __forceinline__ float* xbuf() const { return (float*)(ws + OFF_xbuf); }
  __device__ __forceinline__ bf16* proj() const { return (bf16*)(ws + OFF_proj); }
  __device__ __forceinline__ bf16* Qa() const { return (bf16*)(ws + OFF_Qa); }
  __device__ __forceinline__ bf16* Ka() const { return (bf16*)(ws + OFF_Ka); }
  __device__ __forceinline__ bf16* VaT() const { return (bf16*)(ws + OFF_VaT); }
  __device__ __forceinline__ bf16* Kb() const { return (bf16*)(ws + OFF_Kb); }
  __device__ __forceinline__ bf16* VbT() const { return (bf16*)(ws + OFF_VbT); }
  __device__ __forceinline__ bf16* VmT() const { return (bf16*)(ws + OFF_VmT); }
  __device__ __forceinline__ bf16* ycat() const { return (bf16*)(ws + OFF_ycat); }
  __device__ __forceinline__ float* gates() const { return (float*)(ws + OFF_gates); }
  __device__ __forceinline__ bf16* Cst() const { return (bf16*)(ws + OFF_Cst); }
  __device__ __forceinline__ float* nst() const { return (float*)(ws + OFF_nst); }
  __device__ __forceinline__ float* mst() const { return (float*)(ws + OFF_mst); }
  __device__ __forceinline__ bf16* cckv() const { return (bf16*)(ws + OFF_cckv); }
  __device__ __forceinline__ bf16* cKa() const { return (bf16*)(ws + OFF_cKa); }
  __device__ __forceinline__ bf16* cVaT() const { return (bf16*)(ws + OFF_cVaT); }
  __device__ __forceinline__ bf16* cKb() const { return (bf16*)(ws + OFF_cKb); }
  __device__ __forceinline__ bf16* cVbT() const { return (bf16*)(ws + OFF_cVbT); }
  __device__ __forceinline__ int* ctr() const { return (int*)(ws + OFF_ctr); }
  __device__ __forceinline__ int* qc() const { return (int*)(ws + OFF_qc); }
  __device__ __forceinline__ float* blA() const { return (float*)(ws + OFF_blA); }
  __device__ __forceinline__ float* mlA() const { return (float*)(ws + OFF_mlA); }
};

DI int tidx() { int t = threadIdx.x; asm volatile("" : "+v"(t)); return t; }
DI void tidx_init() {}
DI int wave_of(int tid) { return __builtin_amdgcn_readfirstlane(tid >> 6); }
typedef __attribute__((ext_vector_type(2))) __bf16 bf16v2;
typedef __attribute__((ext_vector_type(2))) float f32x2;
DI unsigned pack2(float a, float b) {
  f32x2 v; v[0] = a; v[1] = b;
  return __builtin_bit_cast(unsigned, __builtin_convertvector(v, bf16v2));
}
DI bf16 f2bf(float x) { return (bf16)(pack2(x, 0.f) & 0xffffu); }
DI float bf2f(bf16 b) { return __uint_as_float(((unsigned)b) << 16); }
DI float fexp2(float x) { return __builtin_amdgcn_exp2f(x); }
DI float fexp(float x) { return __builtin_amdgcn_exp2f(x * 1.4426950408889634f); }
DI float bflo(unsigned u) { return __uint_as_float(u << 16); }
DI float bfhi(unsigned u) { return __uint_as_float(u & 0xffff0000u); }
DI float silu_f(float x) { return x * __builtin_amdgcn_rcpf(1.f + fexp(-x)); }
DI float sigmoid_f(float x) { return __builtin_amdgcn_rcpf(1.f + fexp(-x)); }
DI float logsig_f(float x) { return fminf(x, 0.f) - log1pf(fexp(-fabsf(x))); }

struct TokInfo { int lat, b, t, T, tok0, modj; };
DI TokInfo tinfo(int tok) {
  TokInfo r;
  if (tok < 4096) { r.lat = 0; r.b = tok >> 8; r.t = tok & 255; r.T = 256; r.tok0 = tok & ~255; r.modj = 0; }
  else { int u = tok - 4096; r.lat = 1; r.b = u >> 10; r.t = u & 1023; r.T = 1024; r.tok0 = 4096 + (u & ~1023); r.modj = 1 + r.b; }
  return r;
}

struct GR { u32x4 ra0[4], rb0[4], ra1[4], rb1[4]; };
DI void gemm_load2(GR& g, const bf16* __restrict__ A, int lda, const bf16* __restrict__ Bt, int ldb) {
  const int tid = tidx();
  const int lr = tid >> 3, lc = tid & 7;
  const bf16* ap = A + (size_t)lr * lda + lc * 8;
  const bf16* bp = Bt + (size_t)lr * ldb + lc * 8;
  const size_t a32 = (size_t)32 * lda, b32 = (size_t)32 * ldb;
#pragma unroll
  for (int i = 0; i < 4; ++i) { g.ra0[i] = *(const u32x4*)(ap + i * a32); g.rb0[i] = *(const u32x4*)(bp + i * b32); }
#pragma unroll
  for (int i = 0; i < 4; ++i) { g.ra1[i] = *(const u32x4*)(ap + 64 + i * a32); g.rb1[i] = *(const u32x4*)(bp + 64 + i * b32); }
}
template <bool ROWSS>
DI void gemm_core_n(GR& g, const bf16* __restrict__ A, int lda, const bf16* __restrict__ Bt, int ldb,
                    const bf16* __restrict__ An, const bf16* __restrict__ Btn, int K, char* smem, f32x16 (&acc)[2][2]) {
  bf16* sA = (bf16*)smem;
  bf16* sB = sA + 128 * 72;
  float* sRow = (float*)(sB + 128 * 72);
  const int tid = tidx(), lane = tid & 63, w = wave_of(tid);
  const int wm = w >> 1, wn = w & 1, lq = lane & 31, h = lane >> 5;
  const int lr = tid >> 3, lc = tid & 7;
  float ss[4] = {0.f, 0.f, 0.f, 0.f};
#pragma unroll
  for (int i = 0; i < 2; ++i)
#pragma unroll
    for (int j = 0; j < 2; ++j)
#pragma unroll
      for (int r = 0; r < 16; ++r) acc[i][j][r] = 0.f;
  const bf16* ap = A + (size_t)lr * lda + lc * 8;
  const bf16* bp = Bt + (size_t)lr * ldb + lc * 8;
  const bf16* apn = An + (size_t)lr * lda + lc * 8;
  const bf16* bpn = Btn + (size_t)lr * ldb + lc * 8;
  const size_t a32 = (size_t)32 * lda, b32 = (size_t)32 * ldb;
  const int nk = K >> 6;
  auto step = [&](u32x4 (&ra)[4], u32x4 (&rb)[4], int kt) {
    if (kt) __syncthreads();
#pragma unroll
    for (int i = 0; i < 4; ++i) {
      *(u32x4*)(sA + (lr + 32 * i) * 72 + lc * 8) = ra[i];
      *(u32x4*)(sB + (lr + 32 * i) * 72 + lc * 8) = rb[i];
    }
    if (ROWSS) {
#pragma unroll
      for (int i = 0; i < 4; ++i)
#pragma unroll
        for (int e = 0; e < 4; ++e) {
          float a0 = bflo(ra[i][e]), a1 = bfhi(ra[i][e]);
          ss[i] += a0 * a0 + a1 * a1;
        }
    }
    __syncthreads();
    {
      const int kn = kt + 2;
      const bf16* ap2 = (kn < nk) ? ap + (size_t)kn * 64 : apn + (size_t)(kn - nk) * 64;
      const bf16* bp2 = (kn < nk) ? bp + (size_t)kn * 64 : bpn + (size_t)(kn - nk) * 64;
#pragma unroll
      for (int i = 0; i < 4; ++i) { ra[i] = *(const u32x4*)(ap2 + i * a32); rb[i] = *(const u32x4*)(bp2 + i * b32); }
    }
#pragma unroll
    for (int ks = 0; ks < 4; ++ks) {
      bf16x8 af[2], bfr[2];
#pragma unroll
      for (int i = 0; i < 2; ++i) af[i] = *(const bf16x8*)(sA + (wm * 64 + i * 32 + lq) * 72 + ks * 16 + h * 8);
#pragma unroll
      for (int j = 0; j < 2; ++j) bfr[j] = *(const bf16x8*)(sB + (wn * 64 + j * 32 + lq) * 72 + ks * 16 + h * 8);
#pragma unroll
      for (int i = 0; i < 2; ++i)
#pragma unroll
        for (int j = 0; j < 2; ++j) acc[i][j] = MFMA(af[i], bfr[j], acc[i][j]);
    }
  };
  for (int kt = 0; kt < nk; kt += 2) {
    step(g.ra0, g.rb0, kt);
    step(g.ra1, g.rb1, kt + 1);
  }
  if (ROWSS) {
#pragma unroll
    for (int i = 0; i < 4; ++i) {
      float v = ss[i];
      v += __shfl_xor(v, 1); v += __shfl_xor(v, 2); v += __shfl_xor(v, 4);
      if (lc == 0) sRow[lr + 32 * i] = v;
    }
  }
  __syncthreads();
}
template <bool ROWSS>
DI void gemm_core(const bf16* __restrict__ A, int lda, const bf16* __restrict__ Bt, int ldb, int K, char* smem,
                  f32x16 (&acc)[2][2]) {
  GR g;
  gemm_load2(g, A, lda, Bt, ldb);
  gemm_core_n<ROWSS>(g, A, lda, Bt, ldb, A, Bt, K, smem, acc);
}

template <bool ROWSS = false>
DI void gemm_core_w(const bf16* __restrict__ A, int lda, const bf16* __restrict__ Bt, int ldb, int K, char* smem,
                    f32x16 (&acc)[2][4]) {
  bf16* sA = (bf16*)smem;
  bf16* sB = sA + 128 * 72;
  const int tid = tidx(), lane = tid & 63, w = wave_of(tid);
  const int wm = w >> 1, wn = w & 1, lq = lane & 31, h = lane >> 5;
  const int lr = tid >> 3, lc = tid & 7;
  u32x4 ra[4], rb[8];
  float ssw[4] = {0.f, 0.f, 0.f, 0.f};
#pragma unroll
  for (int i = 0; i < 2; ++i)
#pragma unroll
    for (int j = 0; j < 4; ++j)
#pragma unroll
      for (int r = 0; r < 16; ++r) acc[i][j][r] = 0.f;
  const bf16* ap = A + (size_t)lr * lda + lc * 8;
  const bf16* bp = Bt + (size_t)lr * ldb + lc * 8;
  const size_t a32 = (size_t)32 * lda, b32 = (size_t)32 * ldb;
#pragma unroll
  for (int i = 0; i < 4; ++i) ra[i] = *(const u32x4*)(ap + i * a32);
#pragma unroll
  for (int i = 0; i < 8; ++i) rb[i] = *(const u32x4*)(bp + i * b32);
  const int nk = K >> 6;
  for (int kt = 0; kt < nk; ++kt) {
    if (kt) __syncthreads();
#pragma unroll
    for (int i = 0; i < 4; ++i) *(u32x4*)(sA + (lr + 32 * i) * 72 + lc * 8) = ra[i];
#pragma unroll
    for (int i = 0; i < 8; ++i) *(u32x4*)(sB + (lr + 32 * i) * 72 + lc * 8) = rb[i];
    if (ROWSS) {
#pragma unroll
      for (int i = 0; i < 4; ++i)
#pragma unroll
        for (int e = 0; e < 4; ++e) {
          float a0 = bflo(ra[i][e]), a1 = bfhi(ra[i][e]);
          ssw[i] += a0 * a0 + a1 * a1;
        }
    }
    __syncthreads();
    {
      const int kn = (kt + 1 < nk) ? kt + 1 : kt;
      const bf16* ap2 = ap + (size_t)kn * 64;
      const bf16* bp2 = bp + (size_t)kn * 64;
#pragma unroll
      for (int i = 0; i < 4; ++i) ra[i] = *(const u32x4*)(ap2 + i * a32);
#pragma unroll
      for (int i = 0; i < 8; ++i) rb[i] = *(const u32x4*)(bp2 + i * b32);
    }
#pragma unroll
    for (int ks = 0; ks < 4; ++ks) {
      bf16x8 af[2], bfr[4];
#pragma unroll
      for (int i = 0; i < 2; ++i) af[i] = *(const bf16x8*)(sA + (wm * 64 + i * 32 + lq) * 72 + ks * 16 + h * 8);
#pragma unroll
      for (int j = 0; j < 4; ++j) bfr[j] = *(const bf16x8*)(sB + (wn * 128 + j * 32 + lq) * 72 + ks * 16 + h * 8);
#pragma unroll
      for (int i = 0; i < 2; ++i)
#pragma unroll
        for (int j = 0; j < 4; ++j) acc[i][j] = MFMA(af[i], bfr[j], acc[i][j]);
    }
  }
  if (ROWSS) {
    float* sRow = (float*)(smem + (128 + 256) * 72 * 2);
#pragma unroll
    for (int i = 0; i < 4; ++i) {
      float v = ssw[i];
      v += __shfl_xor(v, 1); v += __shfl_xor(v, 2); v += __shfl_xor(v, 4);
      if (lc == 0) sRow[lr + 32 * i] = v;
    }
  }
  __syncthreads();
}

DI void store_vt4(bf16* VT, size_t idx, float a, float b, float c, float d) {
  u32x2 v; v[0] = pack2(a, b); v[1] = pack2(c, d);
  *(u32x2*)(VT + idx) = v;
}

DI void transpose_tile(const float* __restrict__ src, int N, int Nvalid, bf16* __restrict__ dst, int K, int k0, int n0,
                       const float* __restrict__ gk, bf16* __restrict__ dst2, char* smem) {
  float* t = (float*)smem;
  const int tid = tidx();
  f32x4 tv[4];
#pragma unroll
  for (int i = 0; i < 4; ++i) {
    int idx = tid + 256 * i; int r = idx >> 4, c = (idx & 15) * 4;
    int n = n0 + c;
    tv[i] = f32x4{0.f, 0.f, 0.f, 0.f};
    if (n < Nvalid) tv[i] = __builtin_nontemporal_load((const f32x4*)(src + (size_t)(k0 + r) * N + n));
  }
#pragma unroll
  for (int i = 0; i < 4; ++i) {
    int idx = tid + 256 * i; int r = idx >> 4, c = (idx & 15) * 4;
    t[r * 65 + c] = tv[i][0]; t[r * 65 + c + 1] = tv[i][1]; t[r * 65 + c + 2] = tv[i][2]; t[r * 65 + c + 3] = tv[i][3];
  }
  __syncthreads();
  const int c2h = (tid & 31) * 2;
  const float gk0 = gk ? gk[k0 + c2h] : 1.f, gk1 = gk ? gk[k0 + c2h + 1] : 1.f;
#pragma unroll
  for (int i = 0; i < 8; ++i) {
    int idx = tid + 256 * i; int r = idx >> 5, c2 = (idx & 31) * 2;
    float v0 = t[c2 * 65 + r], v1 = t[(c2 + 1) * 65 + r];
    if (dst2) *(unsigned*)(dst2 + (size_t)(n0 + r) * K + k0 + c2) = pack2(v0, v1);
    v0 *= gk0; v1 *= gk1;
    *(unsigned*)(dst + (size_t)(n0 + r) * K + k0 + c2) = pack2(v0, v1);
  }
  __syncthreads();
}

DI void mod_item(const P& p, int it, char* smem) {
  float* sl = (float*)smem;
  float* red = sl + 5 * 1024;
  const int tid = tidx(), lane = tid & 63, w = wave_of(tid);
  const int l = it / 48, n0 = (it % 48) * 64;
  {
    float cvv[20];
#pragma unroll
    for (int i = 0; i < 20; ++i) {
      int idx = tid + 256 * i; int j = idx >> 10, k = idx & 1023;
      cvv[i] = (j == 0) ? p.c_ctx[k] : p.c[(j - 1) * 1024 + k];
    }
#pragma unroll
    for (int i = 0; i < 20; ++i) sl[tid + 256 * i] = silu_f(cvv[i]);
  }
  __syncthreads();
  float a[5] = {0.f, 0.f, 0.f, 0.f, 0.f};
  const float* wp = p.W_mod + (size_t)l * 1024 * 3072 + n0 + lane;
  for (int k = w * 256; k < w * 256 + 256; k += 16) {
    float wv[16];
#pragma unroll
    for (int u = 0; u < 16; ++u) wv[u] = __builtin_nontemporal_load(wp + (size_t)(k + u) * 3072);
#pragma unroll
    for (int u = 0; u < 16; ++u)
#pragma unroll
      for (int j = 0; j < 5; ++j) a[j] += sl[j * 1024 + k + u] * wv[u];
  }
#pragma unroll
  for (int j = 0; j < 5; ++j) red[(w * 5 + j) * 64 + lane] = a[j];
  __syncthreads();
  for (int idx = tid; idx < 320; idx += 256) {
    int j = idx >> 6, c = idx & 63;
    float s = red[(0 * 5 + j) * 64 + c] + red[(1 * 5 + j) * 64 + c] + red[(2 * 5 + j) * 64 + c] + red[(3 * 5 + j) * 64 + c];
    p.mod()[(size_t)(l * 5 + j) * 3072 + n0 + c] = s + p.b_mod[l * 3072 + n0 + c];
  }
  __syncthreads();
}

DI void phase_prepass(const P& p, char* smem) {
  const int G = gridDim.x, B = blockIdx.x, tid = tidx();
  const int N_MOD = 192, N_WIN = 4 * 92 * 16, N_WOUT = 4 * 16 * 24, N_WUQ = 4 * 12 * 6, N_WUKV = 4 * 16 * 4;
  const int total = N_MOD + N_WIN + N_WOUT + N_WUQ + N_WUKV;
  for (int it = B; it < total; it += G) {
    int u = it;
    if (u < N_MOD) { mod_item(p, u, smem); continue; }
    u -= N_MOD;
    if (u < N_WIN) {
      int l = u / (92 * 16), r = u % (92 * 16), nt = r / 16, kt = r % 16;
      transpose_tile(p.W_in + (size_t)l * 1024 * 5840, 5840, 5840, p.WinT() + (size_t)l * NPROJ * 1024, 1024, kt * 64, nt * 64, nullptr, nullptr, smem);
      continue;
    }
    u -= N_WIN;
    if (u < N_WOUT) {
      int l = u / (16 * 24), r = u % (16 * 24), nt = r / 24, kt = r % 24;
      transpose_tile(p.W_out + (size_t)l * 1536 * 1024, 1024, 1024, p.WoutT() + (size_t)l * 1024 * 1536, 1536, kt * 64, nt * 64, nullptr, nullptr, smem);
      continue;
    }
    u -= N_WOUT;
    if (u < N_WUQ) {
      int l = u / 72, r = u % 72, nt = r / 6, kt = r % 6;
      transpose_tile(p.W_uq + (size_t)l * 384 * 768, 768, 768, p.WuqT() + (size_t)l * 768 * 384, 384, kt * 64, nt * 64, p.q_norm + l * 384, nullptr, smem);
      continue;
    }
    u -= N_WUQ;
    {
      int l = u / 64, r = u % 64, nt = r / 4, kt = r % 4;
      transpose_tile(p.W_ukv + (size_t)l * 256 * 1024, 1024, 1024, p.WukvT() + (size_t)l * 1024 * 256, 256, kt * 64, nt * 64, p.kv_norm + l * 256, p.WukvTp() + (size_t)l * 1024 * 256, smem);
    }
  }
  const int gtid = B * 256 + tid, gsz = G * 256;
  for (int idx = gtid; idx < 1024 * 32; idx += gsz) {
    int t = idx >> 5, i = idx & 31;
    float pos = (i < 16) ? (float)(t >> 6) : (float)(t & 63);
    float inv = powf(10000.f, -(float)(i & 15) / 16.f);
    float ang = pos * inv;
    p.ropec()[idx] = cosf(ang); p.ropes()[idx] = sinf(ang);
  }
  if (gtid < 4) {
    int l = gtid; const float* lp = p.dlam + l * 256;
    float s1 = 0.f, s2 = 0.f;
    for (int i = 0; i < 64; ++i) { s1 += lp[i] * lp[64 + i]; s2 += lp[128 + i] * lp[192 + i]; }
    float lam_init = 0.8f - 0.6f * expf(-0.3f * (float)l);
    p.lam()[l] = expf(s1) - expf(s2) + lam_init;
  }
  for (int idx = gtid; idx < 4 * 4 * 256 * 256; idx += gsz) {
    int d = idx & 255, t = (idx >> 8) & 255, b = (idx >> 16) & 3, l = idx >> 18;
    p.cckv()[idx] = f2bf(p.c_ckv[(size_t)((b * 4 + l) * 256 + t) * 256 + d]);
  }
  for (int idx = gtid; idx < 4 * 4 * 4 * 256 * 64; idx += gsz) {
    int r = idx & 63, t = (idx >> 6) & 255, hd = (idx >> 14) & 3, b = (idx >> 16) & 3, l = idx >> 18;
    p.cKa()[(size_t)((((l * 4 + b) * 4 + hd) * 256) + t) * 192 + 128 + r] = f2bf(p.c_krope[(size_t)((b * 4 + l) * 256 + t) * 64 + r]);
  }
  for (int idx = gtid; idx < 4 * 4 * 4 * 256 * 128; idx += gsz) {
    int d = idx & 127, t = (idx >> 7) & 255, hd = (idx >> 15) & 3, b = (idx >> 17) & 3, l = idx >> 19;
    p.cKb()[idx] = f2bf(p.c_dk[(size_t)(((b * 4 + l) * 256 + t) * 4 + hd) * 128 + d]);
  }
  for (int idx = gtid; idx < 4 * 4 * 4 * 128 * 256; idx += gsz) {
    int t = idx & 255, d = (idx >> 8) & 127, hd = (idx >> 15) & 3, b = (idx >> 17) & 3, l = idx >> 19;
    p.cVbT()[idx] = f2bf(p.c_dv[(size_t)(((b * 4 + l) * 256 + t) * 4 + hd) * 128 + d]);
  }
}

DI void norm_rows4(const P& p, int l, int tok0, int mode) {
  const int lane = tidx() & 63;
  TokInfo ti = tinfo(tok0);
  const float* x;
  if (mode == 0 && l == 0) x = ti.lat ? (p.x_sample + (size_t)(tok0 - 4096) * 1024) : (p.x_prompt + (size_t)tok0 * 1024);
  else x = p.xbuf() + (size_t)tok0 * 1024;
  f32x4 v[4][4];
#pragma unroll
  for (int k = 0; k < 4; ++k)
#pragma unroll
    for (int i = 0; i < 4; ++i) v[k][i] = *(const f32x4*)(x + (size_t)k * 1024 + i * 256 + lane * 4);
  float rstd[4];
#pragma unroll
  for (int k = 0; k < 4; ++k) {
    float ss = 0.f;
#pragma unroll
    for (int i = 0; i < 4; ++i) ss += v[k][i][0] * v[k][i][0] + v[k][i][1] * v[k][i][1] + v[k][i][2] * v[k][i][2] + v[k][i][3] * v[k][i][3];
#pragma unroll
    for (int o = 32; o >= 1; o >>= 1) ss += __shfl_xor(ss, o);
    rstd[k] = rsqrtf(ss * (1.f / 1024.f) + EPS);
  }
  if (mode == 0) {
    const float* g = p.g_norm + l * 1024;
    const float* md = p.mod() + (size_t)(l * 5 + ti.modj) * 3072;
#pragma unroll
    for (int i = 0; i < 4; ++i) {
      int c = i * 256 + lane * 4;
      f32x4 gv = *(const f32x4*)(g + c), sh = *(const f32x4*)(md + c), sc = *(const f32x4*)(md + 1024 + c);
#pragma unroll
      for (int k = 0; k < 4; ++k) {
        float o0 = v[k][i][0] * rstd[k] * gv[0] * (1.f + sc[0]) + sh[0];
        float o1 = v[k][i][1] * rstd[k] * gv[1] * (1.f + sc[1]) + sh[1];
        float o2 = v[k][i][2] * rstd[k] * gv[2] * (1.f + sc[2]) + sh[2];
        float o3 = v[k][i][3] * rstd[k] * gv[3] * (1.f + sc[3]) + sh[3];
        u32x2 pk; pk[0] = pack2(o0, o1); pk[1] = pack2(o2, o3);
        *(u32x2*)(p.hbuf() + (size_t)(tok0 + k) * 1024 + c) = pk;
      }
    }
  } else {
    float* o = p.out + (ti.lat ? (O_YS + (size_t)(tok0 - 4096) * 1024) : (O_YP + (size_t)tok0 * 1024));
#pragma unroll
    for (int i = 0; i < 4; ++i) {
      int c = i * 256 + lane * 4;
      f32x4 gv = *(const f32x4*)(p.g_final + c);
#pragma unroll
      for (int k = 0; k < 4; ++k) {
        f32x4 r; r[0] = v[k][i][0] * rstd[k] * gv[0]; r[1] = v[k][i][1] * rstd[k] * gv[1]; r[2] = v[k][i][2] * rstd[k] * gv[2]; r[3] = v[k][i][3] * rstd[k] * gv[3];
        *(f32x4*)(o + (size_t)k * 1024 + c) = r;
      }
    }
  }
}

DI void norm_row(const P& p, int l, int tok, int mode) {
  const int lane = tidx() & 63;
  TokInfo ti = tinfo(tok);
  const float* x;
  if (mode == 0 && l == 0) x = ti.lat ? (p.x_sample + (size_t)(tok - 4096) * 1024) : (p.x_prompt + (size_t)tok * 1024);
  else x = p.xbuf() + (size_t)tok * 1024;
  f32x4 v[4];
  float ss = 0.f;
#pragma unroll
  for (int i = 0; i < 4; ++i) {
    v[i] = *(const f32x4*)(x + i * 256 + lane * 4);
    ss += v[i][0] * v[i][0] + v[i][1] * v[i][1] + v[i][2] * v[i][2] + v[i][3] * v[i][3];
  }
#pragma unroll
  for (int o = 32; o >= 1; o >>= 1) ss += __shfl_xor(ss, o);
  const float rstd = rsqrtf(ss * (1.f / 1024.f) + EPS);
  if (mode == 0) {
    const float* g = p.g_norm + l * 1024;
    const float* md = p.mod() + (size_t)(l * 5 + ti.modj) * 3072;
#pragma unroll
    for (int i = 0; i < 4; ++i) {
      int c = i * 256 + lane * 4;
      f32x4 gv = *(const f32x4*)(g + c), sh = *(const f32x4*)(md + c), sc = *(const f32x4*)(md + 1024 + c);
      float o0 = v[i][0] * rstd * gv[0] * (1.f + sc[0]) + sh[0];
      float o1 = v[i][1] * rstd * gv[1] * (1.f + sc[1]) + sh[1];
      float o2 = v[i][2] * rstd * gv[2] * (1.f + sc[2]) + sh[2];
      float o3 = v[i][3] * rstd * gv[3] * (1.f + sc[3]) + sh[3];
      u32x2 pk; pk[0] = pack2(o0, o1); pk[1] = pack2(o2, o3);
      *(u32x2*)(p.hbuf() + (size_t)tok * 1024 + c) = pk;
    }
  } else {
    float* o = p.out + (ti.lat ? (O_YS + (size_t)(tok - 4096) * 1024) : (O_YP + (size_t)tok * 1024));
#pragma unroll
    for (int i = 0; i < 4; ++i) {
      int c = i * 256 + lane * 4;
      f32x4 gv = *(const f32x4*)(p.g_final + c);
      f32x4 r; r[0] = v[i][0] * rstd * gv[0]; r[1] = v[i][1] * rstd * gv[1]; r[2] = v[i][2] * rstd * gv[2]; r[3] = v[i][3] * rstd * gv[3];
      *(f32x4*)(o + c) = r;
    }
  }
}

DI void img_put(bf16* img, const f32x16 (&acc)[2][2], int wm, int wn, int lq, int h) {
#pragma unroll
  for (int i = 0; i < 2; ++i)
#pragma unroll
    for (int j = 0; j < 2; ++j)
#pragma unroll
      for (int r = 0; r < 16; ++r)
        img[(wm * 64 + i * 32 + 8 * (r >> 2) + 4 * h + (r & 3)) * 136 + wn * 64 + j * 32 + lq] = f2bf(acc[i][j][r]);
}
DI void img_copy(const bf16* img, int half, bf16* dst, size_t stride, int tid) {
  u32x4 v[4];
#pragma unroll
  for (int i = 0; i < 4; ++i) { int idx = tid + 256 * i; int r = idx >> 3, c16 = idx & 7; v[i] = *(const u32x4*)(img + r * 136 + half * 64 + c16 * 8); }
#pragma unroll
  for (int i = 0; i < 4; ++i) { int idx = tid + 256 * i; int r = idx >> 3, c16 = idx & 7; *(u32x4*)(dst + (size_t)r * stride + c16 * 8) = v[i]; }
}
DI bool inproj_rm(int cb) { return !((cb >= 35 && cb <= 42) || (cb >= 67 && cb <= 74) || cb == 91); }

DI void epi_inproj(const P& p, int l, int m0, int n0, f32x16 (&acc)[2][2], char* smem) {
  const int tid_ = tidx(); const int lane = tid_ & 63, w = wave_of(tid_), wm = w >> 1, wn = w & 1, lq = lane & 31, h = lane >> 5;
  const int mb = m0 + wm * 64, nb = n0 + wn * 64;
  const int cb = nb >> 6;
  bf16* img = (bf16*)smem;
  TokInfo tb = tinfo(mb);
  const bool lat = tb.lat;
  if (!lat && (cb == 10 || (cb >= 27 && cb <= 34))) {
    float* ob = (cb == 10) ? p.out + O_KROPE + (size_t)((tb.b * 4 + l) * 256) * 64
                           : p.out + O_DK + (size_t)((tb.b * 4 + l) * 256) * 512 + (cb - 27) * 64;
    const int ostr = (cb == 10) ? 64 : 512;
#pragma unroll
    for (int i = 0; i < 2; ++i)
#pragma unroll
      for (int j = 0; j < 2; ++j)
#pragma unroll
        for (int r = 0; r < 16; ++r) {
          int tl = tb.t + i * 32 + 8 * (r >> 2) + 4 * h + (r & 3);
          ob[(size_t)tl * ostr + j * 32 + lq] = acc[i][j][r];
        }
  }
  const bool ropeT = lat && (cb == 10 || (cb >= 19 && cb <= 34));
  if (ropeT) {
#pragma unroll
    for (int i = 0; i < 2; ++i) {
      float cs[16], sn[16];
#pragma unroll
      for (int r = 0; r < 16; ++r) {
        int t = tb.t + i * 32 + 8 * (r >> 2) + 4 * h + (r & 3);
        cs[r] = p.ropec()[t * 32 + lq]; sn[r] = p.ropes()[t * 32 + lq];
      }
#pragma unroll
      for (int r = 0; r < 16; ++r) {
        float x1 = acc[i][0][r], x2 = acc[i][1][r];
        acc[i][0][r] = x1 * cs[r] - x2 * sn[r];
        acc[i][1][r] = x1 * sn[r] + x2 * cs[r];
      }
    }
  }
  if (inproj_rm(cb)) {
    img_put(img, acc, wm, wn, lq, h);
  } else if (cb == 91) {
    if (lq < 16) {
      float bias = p.mgb[l * 16 + lq];
#pragma unroll
      for (int i = 0; i < 2; ++i)
#pragma unroll
        for (int r = 0; r < 16; ++r) {
          int row = mb + i * 32 + 8 * (r >> 2) + 4 * h + (r & 3);
          p.gates()[row * 16 + lq] = acc[i][0][r] + bias;
        }
    }
  } else {
    const bool isdv = cb <= 42;
    int cc = isdv ? cb - 35 : cb - 67;
    int hd = cc >> 1, sub = cc & 1;
    bf16* VT = isdv ? p.VbT() : p.VmT();
#pragma unroll
    for (int i = 0; i < 2; ++i)
#pragma unroll
      for (int j = 0; j < 2; ++j) {
        int d = sub * 64 + j * 32 + lq;
#pragma unroll
        for (int g = 0; g < 4; ++g) {
          int tl = tb.t + i * 32 + 8 * g + 4 * h;
          store_vt4(VT, (size_t)tb.tok0 * 512 + (size_t)(hd * 128 + d) * tb.T + tl, acc[i][j][4 * g], acc[i][j][4 * g + 1], acc[i][j][4 * g + 2], acc[i][j][4 * g + 3]);
          if (isdv && !lat) {
#pragma unroll
            for (int jj = 0; jj < 4; ++jj)
              p.out[O_DV + (size_t)((tb.b * 4 + l) * 256 + tl + jj) * 512 + cc * 64 + j * 32 + lq] = acc[i][j][4 * g + jj];
          }
        }
      }
  }
  __syncthreads();
#pragma unroll
  for (int half = 0; half < 2; ++half) {
    const int cbh = (n0 >> 6) + half;
    if (!inproj_rm(cbh)) continue;
    if (cbh == 10) {
#pragma unroll
      for (int hd = 0; hd < 4; ++hd) img_copy(img, half, p.Ka() + (size_t)m0 * 768 + hd * 192 + 128, 768, tid_);
    } else if (cbh >= 27 && cbh <= 34) {
      img_copy(img, half, p.Kb() + (size_t)m0 * 512 + (cbh - 27) * 64, 512, tid_);
    } else {
      img_copy(img, half, p.proj() + (size_t)m0 * NPROJ + cbh * 64, NPROJ, tid_);
    }
  }
  __syncthreads();
}

constexpr int IMGW = 264;
DI void img_copy_w(const bf16* img, int half, bf16* dst, size_t stride, int tid) {
  u32x4 v[4];
#pragma unroll
  for (int i = 0; i < 4; ++i) { int idx = tid + 256 * i; int r = idx >> 3, c16 = idx & 7; v[i] = *(const u32x4*)(img + r * IMGW + half * 64 + c16 * 8); }
#pragma unroll
  for (int i = 0; i < 4; ++i) { int idx = tid + 256 * i; int r = idx >> 3, c16 = idx & 7; *(u32x4*)(dst + (size_t)r * stride + c16 * 8) = v[i]; }
}
template <int JP>
DI void epi_inproj_cbw(const P& p, int l, int m0, int cb, int imgcol, f32x16 (&acc)[2][4], bf16* img) {
  const int tid_ = tidx(); const int lane = tid_ & 63, w = wave_of(tid_), wm = w >> 1, lq = lane & 31, h = lane >> 5;
  const int mb = m0 + wm * 64;
  TokInfo tb = tinfo(mb);
  const bool lat = tb.lat;
  if (!lat && (cb == 10 || (cb >= 27 && cb <= 34))) {
    float* ob = (cb == 10) ? p.out + O_KROPE + (size_t)((tb.b * 4 + l) * 256) * 64
                           : p.out + O_DK + (size_t)((tb.b * 4 + l) * 256) * 512 + (cb - 27) * 64;
    const int ostr = (cb == 10) ? 64 : 512;
#pragma unroll
    for (int i = 0; i < 2; ++i)
#pragma unroll
      for (int j = 0; j < 2; ++j)
#pragma unroll
        for (int r = 0; r < 16; ++r) {
          int tl = tb.t + i * 32 + 8 * (r >> 2) + 4 * h + (r & 3);
          ob[(size_t)tl * ostr + j * 32 + lq] = acc[i][2 * JP + j][r];
        }
  }
  if (lat && (cb == 10 || (cb >= 19 && cb <= 34))) {
#pragma unroll
    for (int i = 0; i < 2; ++i) {
      float cs[16], sn[16];
#pragma unroll
      for (int r = 0; r < 16; ++r) {
        int t = tb.t + i * 32 + 8 * (r >> 2) + 4 * h + (r & 3);
        cs[r] = p.ropec()[t * 32 + lq]; sn[r] = p.ropes()[t * 32 + lq];
      }
#pragma unroll
      for (int r = 0; r < 16; ++r) {
        float x1 = acc[i][2 * JP][r], x2 = acc[i][2 * JP + 1][r];
        acc[i][2 * JP][r] = x1 * cs[r] - x2 * sn[r];
        acc[i][2 * JP + 1][r] = x1 * sn[r] + x2 * cs[r];
      }
    }
  }
  if (inproj_rm(cb)) {
#pragma unroll
    for (int i = 0; i < 2; ++i)
#pragma unroll
      for (int j = 0; j < 2; ++j)
#pragma unroll
        for (int r = 0; r < 16; ++r)
          img[(wm * 64 + i * 32 + 8 * (r >> 2) + 4 * h + (r & 3)) * IMGW + imgcol + j * 32 + lq] = f2bf(acc[i][2 * JP + j][r]);
  } else if (cb == 91) {
    if (lq < 16) {
      float bias = p.mgb[l * 16 + lq];
#pragma unroll
      for (int i = 0; i < 2; ++i)
#pragma unroll
        for (int r = 0; r < 16; ++r) {
          int row = mb + i * 32 + 8 * (r >> 2) + 4 * h + (r & 3);
          p.gates()[row * 16 + lq] = acc[i][2 * JP][r] + bias;
        }
    }
  } else {
    const bool isdv = cb <= 42;
    int cc = isdv ? cb - 35 : cb - 67;
    int hd = cc >> 1, sub = cc & 1;
    bf16* VT = isdv ? p.VbT() : p.VmT();
#pragma unroll
    for (int i = 0; i < 2; ++i)
#pragma unroll
      for (int j = 0; j < 2; ++j) {
        int d = sub * 64 + j * 32 + lq;
#pragma unroll
        for (int g = 0; g < 4; ++g) {
          int tl = tb.t + i * 32 + 8 * g + 4 * h;
          store_vt4(VT, (size_t)tb.tok0 * 512 + (size_t)(hd * 128 + d) * tb.T + tl, acc[i][2 * JP + j][4 * g], acc[i][2 * JP + j][4 * g + 1], acc[i][2 * JP + j][4 * g + 2], acc[i][2 * JP + j][4 * g + 3]);
          if (isdv && !lat) {
#pragma unroll
            for (int jj = 0; jj < 4; ++jj)
              p.out[O_DV + (size_t)((tb.b * 4 + l) * 256 + tl + jj) * 512 + cc * 64 + j * 32 + lq] = acc[i][2 * JP + j][4 * g + jj];
          }
        }
      }
  }
}
DI void epi_inproj_w(const P& p, int l, int m0, int n0, f32x16 (&acc)[2][4], char* smem) {
  bf16* img = (bf16*)smem;
  const int tid_ = tidx(); const int wn = wave_of(tid_) & 1;
  const int cb0 = n0 >> 6;
  epi_inproj_cbw<0>(p, l, m0, cb0 + 2 * wn, (2 * wn) * 64, acc, img);
  epi_inproj_cbw<1>(p, l, m0, cb0 + 2 * wn + 1, (2 * wn + 1) * 64, acc, img);
  __syncthreads();
#pragma unroll
  for (int half = 0; half < 4; ++half) {
    const int cbh = cb0 + half;
    if (!inproj_rm(cbh)) continue;
    if (cbh == 10) {
#pragma unroll
      for (int hd = 0; hd < 4; ++hd) img_copy_w(img, half, p.Ka() + (size_t)m0 * 768 + hd * 192 + 128, 768, tid_);
    } else if (cbh >= 27 && cbh <= 34) {
      img_copy_w(img, half, p.Kb() + (size_t)m0 * 512 + (cbh - 27) * 64, 512, tid_);
    } else {
      img_copy_w(img, half, p.proj() + (size_t)m0 * NPROJ + cbh * 64, NPROJ, tid_);
    }
  }
  __syncthreads();
}

DI void epi_qa(const P& p, int m0, int n0, f32x16 (&acc)[2][2], const float* sRow) {
  const int tid_ = tidx(); const int lane = tid_ & 63, w = wave_of(tid_), wm = w >> 1, wn = w & 1, lq = lane & 31, h = lane >> 5;
  const int mb = m0 + wm * 64, nb = n0 + wn * 64;
  const int cb = nb >> 6, hd = cb / 3, part = cb % 3;
  TokInfo tb = tinfo(mb);
  const bool dorope = tb.lat && part == 2;
#pragma unroll
  for (int i = 0; i < 2; ++i) {
    float cs[16], sn[16];
#pragma unroll
    for (int r = 0; r < 16; ++r) { cs[r] = 1.f; sn[r] = 0.f; }
    if (dorope) {
#pragma unroll
      for (int r = 0; r < 16; ++r) {
        int t = tb.t + i * 32 + 8 * (r >> 2) + 4 * h + (r & 3);
        cs[r] = p.ropec()[t * 32 + lq]; sn[r] = p.ropes()[t * 32 + lq];
      }
    }
#pragma unroll
    for (int r = 0; r < 16; ++r) {
      int rl = wm * 64 + i * 32 + 8 * (r >> 2) + 4 * h + (r & 3);
      float rstd = rsqrtf(sRow[rl] * (1.f / 384.f) + EPS);
      float x1 = acc[i][0][r] * rstd, x2 = acc[i][1][r] * rstd;
      {
        float y1 = x1 * cs[r] - x2 * sn[r], y2 = x1 * sn[r] + x2 * cs[r];
        x1 = y1; x2 = y2;
      }
      int row = m0 + rl;
      bf16* q = p.Qa() + (size_t)(row * 4 + hd) * 192 + part * 64;
      q[lq] = f2bf(x1); q[32 + lq] = f2bf(x2);
    }
  }
}

DI void epi_kv(const P& p, int m0, int n0, f32x16 (&acc)[2][2], const float* sRow, bool cache) {
  const int tid_ = tidx(); const int lane = tid_ & 63, w = wave_of(tid_), wm = w >> 1, wn = w & 1, lq = lane & 31, h = lane >> 5;
  const int mb = m0 + wm * 64, nb = n0 + wn * 64;
  const int cb = nb >> 6, hd = cb >> 2, part = cb & 3;
  TokInfo tb = tinfo(mb);
#pragma unroll
  for (int i = 0; i < 2; ++i)
#pragma unroll
    for (int j = 0; j < 2; ++j)
#pragma unroll
      for (int g = 0; g < 4; ++g) {
        float v[4];
#pragma unroll
        for (int jj = 0; jj < 4; ++jj) {
          int rl = wm * 64 + i * 32 + 8 * g + 4 * h + jj;
          float rstd = cache ? 1.f : rsqrtf(sRow[rl] * (1.f / 256.f) + EPS);
          v[jj] = acc[i][j][4 * g + jj] * rstd;
        }
        int c = j * 32 + lq;
        int row0 = mb + i * 32 + 8 * g + 4 * h;
        if (part < 2) {
#pragma unroll
          for (int jj = 0; jj < 4; ++jj) {
            int row = row0 + jj;
            if (cache) {
              int lb = row >> 8, t = row & 255;
              p.cKa()[(size_t)((lb * 4 + hd) * 256 + t) * 192 + part * 64 + c] = f2bf(v[jj]);
            } else {
              p.Ka()[(size_t)(row * 4 + hd) * 192 + part * 64 + c] = f2bf(v[jj]);
            }
          }
        } else {
          int d = (part - 2) * 64 + c;
          if (cache) {
            int lb = row0 >> 8, t = row0 & 255;
            store_vt4(p.cVaT(), (size_t)((lb * 4 + hd) * 128 + d) * 256 + t, v[0], v[1], v[2], v[3]);
          } else {
            int tl = tb.t + i * 32 + 8 * g + 4 * h;
            store_vt4(p.VaT(), (size_t)tb.tok0 * 512 + (size_t)(hd * 128 + d) * tb.T + tl, v[0], v[1], v[2], v[3]);
          }
        }
      }
}

template <int JP>
DI void epi_qa_w(const P& p, int m0, int n0, f32x16 (&acc)[2][4], const float* sRow) {
  const int tid_ = tidx(); const int lane = tid_ & 63, w = wave_of(tid_), wm = w >> 1, wn = w & 1, lq = lane & 31, h = lane >> 5;
  const int mb = m0 + wm * 64;
  const int cb = (n0 >> 6) + 2 * wn + JP, hd = cb / 3, part = cb % 3;
  TokInfo tb = tinfo(mb);
  const bool dorope = tb.lat && part == 2;
#pragma unroll
  for (int i = 0; i < 2; ++i) {
    float cs[16], sn[16];
#pragma unroll
    for (int r = 0; r < 16; ++r) { cs[r] = 1.f; sn[r] = 0.f; }
    if (dorope) {
#pragma unroll
      for (int r = 0; r < 16; ++r) {
        int t = tb.t + i * 32 + 8 * (r >> 2) + 4 * h + (r & 3);
        cs[r] = p.ropec()[t * 32 + lq]; sn[r] = p.ropes()[t * 32 + lq];
      }
    }
#pragma unroll
    for (int r = 0; r < 16; ++r) {
      int rl = wm * 64 + i * 32 + 8 * (r >> 2) + 4 * h + (r & 3);
      float rstd = rsqrtf(sRow[rl] * (1.f / 384.f) + EPS);
      float x1 = acc[i][2 * JP][r] * rstd, x2 = acc[i][2 * JP + 1][r] * rstd;
      float y1 = x1 * cs[r] - x2 * sn[r], y2 = x1 * sn[r] + x2 * cs[r];
      int row = m0 + rl;
      bf16* q = p.Qa() + (size_t)(row * 4 + hd) * 192 + part * 64;
      q[lq] = f2bf(y1); q[32 + lq] = f2bf(y2);
    }
  }
}
template <int JP>
DI void epi_kv_w(const P& p, int m0, int n0, f32x16 (&acc)[2][4], const float* sRow) {
  const int tid_ = tidx(); const int lane = tid_ & 63, w = wave_of(tid_), wm = w >> 1, wn = w & 1, lq = lane & 31, h = lane >> 5;
  const int mb = m0 + wm * 64;
  const int cb = (n0 >> 6) + 2 * wn + JP, hd = cb >> 2, part = cb & 3;
  TokInfo tb = tinfo(mb);
#pragma unroll
  for (int i = 0; i < 2; ++i)
#pragma unroll
    for (int j = 0; j < 2; ++j)
#pragma unroll
      for (int g = 0; g < 4; ++g) {
        float v[4];
#pragma unroll
        for (int jj = 0; jj < 4; ++jj) {
          int rl = wm * 64 + i * 32 + 8 * g + 4 * h + jj;
          float rstd = rsqrtf(sRow[rl] * (1.f / 256.f) + EPS);
          v[jj] = acc[i][2 * JP + j][4 * g + jj] * rstd;
        }
        int c = j * 32 + lq;
        int row0 = mb + i * 32 + 8 * g + 4 * h;
        if (part < 2) {
#pragma unroll
          for (int jj = 0; jj < 4; ++jj) p.Ka()[(size_t)((row0 + jj) * 4 + hd) * 192 + part * 64 + c] = f2bf(v[jj]);
        } else {
          int d = (part - 2) * 64 + c;
          int tl = tb.t + i * 32 + 8 * g + 4 * h;
          store_vt4(p.VaT(), (size_t)tb.tok0 * 512 + (size_t)(hd * 128 + d) * tb.T + tl, v[0], v[1], v[2], v[3]);
        }
      }
}

DI void epi_out(const P& p, int l, int m0, int n0, f32x16 (&acc)[2][2]) {
  const int tid_ = tidx(); const int lane = tid_ & 63, w = wave_of(tid_), wm = w >> 1, wn = w & 1, lq = lane & 31, h = lane >> 5;
  const int mb = m0 + wm * 64, nb = n0 + wn * 64;
  TokInfo tb = tinfo(mb);
  const float* gate = p.mod() + (size_t)(l * 5 + tb.modj) * 3072 + 2048;
  const float* xsrc = (l == 0) ? (tb.lat ? p.x_sample - (size_t)4096 * 1024 : p.x_prompt) : (const float*)p.xbuf();
#pragma unroll
  for (int i = 0; i < 2; ++i)
#pragma unroll
    for (int j = 0; j < 2; ++j) {
      int col = nb + j * 32 + lq;
      float gv = gate[col];
      float xo[16];
#pragma unroll
      for (int r = 0; r < 16; ++r) {
        int row = mb + i * 32 + 8 * (r >> 2) + 4 * h + (r & 3);
        xo[r] = xsrc[(size_t)row * 1024 + col];
      }
#pragma unroll
      for (int r = 0; r < 16; ++r) {
        int row = mb + i * 32 + 8 * (r >> 2) + 4 * h + (r & 3);
        p.xbuf()[(size_t)row * 1024 + col] = xo[r] + gv * acc[i][j][r];
      }
    }
}

template <int KW, int DQ, int KSPLIT>
DI void attn_pass(const bf16* __restrict__ qptr, int koff, int kh, const bf16* __restrict__ Kmain, int ldk, int Tmain,
                  const bf16* __restrict__ Kc, int ldkc, int Tc, const bf16* __restrict__ VTmain,
                  const bf16* __restrict__ VTc, float c, char* smem, f32x16 (&o)[4], float& lsum, float& m_out) {
  constexpr int KS = KW + 8;
  constexpr int NKB = 2 / KSPLIT;
  bf16* sK = (bf16*)smem;
  bf16* sV = sK + 64 * KS;
  const int tid = tidx(), lane = tid & 63, lq = lane & 31, h = lane >> 5;
  constexpr bool QLDS = (KSPLIT == 2);
  constexpr int QS = DQ + 8;
  bf16* sQ = sV + 128 * 72;
  bf16x8 qf[QLDS ? 1 : DQ / 16];
  if (QLDS) {
    constexpr int QCH = DQ / 8, NQL = 64 * QCH / 256;
    u32x4 tq[NQL];
#pragma unroll
    for (int i = 0; i < NQL; ++i) { int idx = tid + 256 * i; int r = idx / QCH, cc = idx % QCH; tq[i] = *(const u32x4*)(qptr + (size_t)r * 768 + cc * 8); }
#pragma unroll
    for (int i = 0; i < NQL; ++i) { int idx = tid + 256 * i; int r = idx / QCH, cc = idx % QCH; *(u32x4*)(sQ + r * QS + cc * 8) = tq[i]; }
  } else {
#pragma unroll
    for (int ks = 0; ks < DQ / 16; ++ks) qf[ks] = *(const bf16x8*)(qptr + ks * 16 + h * 8);
  }
  const bf16* sQl = sQ + (((wave_of(tid) & 1) * 32) + lq) * QS + h * 8;
#pragma unroll
  for (int db = 0; db < 4; ++db)
#pragma unroll
    for (int r = 0; r < 16; ++r) o[db][r] = 0.f;
  lsum = 0.f;
  float m_run = -INFINITY;
  const int nt = (Tmain + Tc) >> 6;
  constexpr int CH = KW / 8, NKL = 64 * CH / 256;
  u32x4 kr[NKL], vr[4];
  auto issue = [&](int kt) {
    const bf16* ksrc; int ld; const bf16* vsrc; int ldv;
    if (kt * 64 < Tmain) { ksrc = Kmain + (size_t)(kt * 64) * ldk; ld = ldk; vsrc = VTmain + kt * 64; ldv = Tmain; }
    else { ksrc = Kc + (size_t)(kt * 64 - Tmain) * ldkc; ld = ldkc; vsrc = VTc + (kt * 64 - Tmain); ldv = Tc; }
#pragma unroll
    for (int i = 0; i < NKL; ++i) {
      int idx = tid + 256 * i; int r = idx / CH, cc = idx % CH;
      kr[i] = *(const u32x4*)(ksrc + (size_t)r * ld + cc * 8);
    }
#pragma unroll
    for (int i = 0; i < 4; ++i) {
      int idx = tid + 256 * i; int r = idx >> 3, cc = idx & 7;
      vr[i] = *(const u32x4*)(vsrc + (size_t)r * ldv + cc * 8);
    }
  };
  issue(0);
  for (int kt = 0; kt < nt; ++kt) {
    __syncthreads();
#pragma unroll
    for (int i = 0; i < NKL; ++i) {
      int idx = tid + 256 * i; int r = idx / CH, cc = idx % CH;
      *(u32x4*)(sK + r * KS + cc * 8) = kr[i];
    }
#pragma unroll
    for (int i = 0; i < 4; ++i) {
      int idx = tid + 256 * i; int r = idx >> 3, cc = idx & 7;
      *(u32x4*)(sV + r * 72 + cc * 8) = vr[i];
    }
    __syncthreads();
    issue((kt + 1 < nt) ? kt + 1 : kt);
    f32x16 s[NKB];
#pragma unroll
    for (int kbi = 0; kbi < NKB; ++kbi)
#pragma unroll
      for (int r = 0; r < 16; ++r) s[kbi][r] = 0.f;
#pragma unroll
    for (int ks = 0; ks < DQ / 16; ++ks)
#pragma unroll
      for (int kbi = 0; kbi < NKB; ++kbi) {
        const int kb = (KSPLIT == 2) ? kh : kbi;
        bf16x8 a = *(const bf16x8*)(sK + (kb * 32 + lq) * KS + koff + ks * 16 + h * 8);
        s[kbi] = MFMA(a, QLDS ? *(const bf16x8*)(sQl + ks * 16) : qf[QLDS ? 0 : ks], s[kbi]);
      }
    float mx = -INFINITY;
#pragma unroll
    for (int kbi = 0; kbi < NKB; ++kbi)
#pragma unroll
      for (int r = 0; r < 16; ++r) mx = fmaxf(mx, s[kbi][r]);
    mx = fmaxf(mx, __shfl_xor(mx, 32));
    const float m_new = fmaxf(m_run, mx);
    const float alpha = fexp2((m_run - m_new) * c);
    m_run = m_new;
    lsum *= alpha;
#pragma unroll
    for (int db = 0; db < 4; ++db)
#pragma unroll
      for (int r = 0; r < 16; ++r) o[db][r] *= alpha;
    const float mc = m_new * c;
#pragma unroll
    for (int kbi = 0; kbi < NKB; ++kbi)
#pragma unroll
      for (int r = 0; r < 16; ++r) { float pv = fexp2(s[kbi][r] * c - mc); s[kbi][r] = pv; lsum += pv; }
#pragma unroll
    for (int kbi = 0; kbi < NKB; ++kbi) {
      const int kb = (KSPLIT == 2) ? kh : kbi;
#pragma unroll
      for (int s2 = 0; s2 < 2; ++s2) {
        u32x4 pk;
#pragma unroll
        for (int e = 0; e < 4; ++e) pk[e] = pack2(s[kbi][8 * s2 + 2 * e], s[kbi][8 * s2 + 2 * e + 1]);
        bf16x8 pb = __builtin_bit_cast(bf16x8, pk);
#pragma unroll
        for (int db = 0; db < 4; ++db) {
          const bf16* vp = sV + (db * 32 + lq) * 72 + kb * 32 + s2 * 16 + 4 * h;
          u32x2 lo = *(const u32x2*)vp, hi = *(const u32x2*)(vp + 8);
          u32x4 av; av[0] = lo[0]; av[1] = lo[1]; av[2] = hi[0]; av[3] = hi[1];
          o[db] = MFMA(__builtin_bit_cast(bf16x8, av), pb, o[db]);
        }
      }
    }
  }
  lsum += __shfl_xor(lsum, 32);
  m_out = m_run;
}

DI void mla_item(const P& p, int l, int it, char* smem) {
  const int tid = tidx(), lane = tid & 63, w = wave_of(tid), lq = lane & 31, h = lane >> 5;
  int lat, b, hd, qb;
  if (it < 256) { lat = 1; b = it >> 6; hd = (it >> 4) & 3; qb = it & 15; }
  else { int u = it - 256; lat = 0; b = u >> 4; hd = (u >> 2) & 3; qb = u & 3; }
  const int T = lat ? 1024 : 256, tok0 = lat ? 4096 + b * 1024 : b * 256;
  const int qsub = w & 1, kh = w >> 1;
  const int tok = tok0 + qb * 64 + qsub * 32 + lq;
  f32x16 o[4]; float lsum, mrun;
  const float c = 0.07216878364870322f * 1.4426950408889634f;
  attn_pass<192, 192, 2>(p.Qa() + (size_t)((tok0 + qb * 64) * 4 + hd) * 192, 0, kh, p.Ka() + (size_t)(tok0 * 4 + hd) * 192, 768, T,
                 p.cKa() + (size_t)((l * 4 + b) * 4 + hd) * 256 * 192, 192, lat ? 256 : 0,
                 p.VaT() + (size_t)tok0 * 512 + (size_t)hd * 128 * T, p.cVaT() + (size_t)((l * 4 + b) * 4 + hd) * 128 * 256, c, smem, o, lsum, mrun);
  float* ex = (float*)smem;
  float* exm = ex + 2 * 128 * 32;
  float* exl = exm + 64;
  __syncthreads();
  if (kh == 1) {
#pragma unroll
    for (int db = 0; db < 4; ++db)
#pragma unroll
      for (int r = 0; r < 16; ++r) {
        int dv = db * 32 + 8 * (r >> 2) + 4 * h + (r & 3);
        ex[(qsub * 128 + dv) * 32 + lq] = o[db][r];
      }
    if (h == 0) { exm[qsub * 32 + lq] = mrun; exl[qsub * 32 + lq] = lsum; }
  }
  __syncthreads();
  if (kh == 0) {
    const float m1 = exm[qsub * 32 + lq], l1 = exl[qsub * 32 + lq];
    const float mm = fmaxf(mrun, m1);
    const float f0 = fexp2((mrun - mm) * c), f1 = fexp2((m1 - mm) * c);
    const float inv = 1.f / (lsum * f0 + l1 * f1);
    const float g0 = f0 * inv, g1 = f1 * inv;
    u32x2 zz[4][4];
#pragma unroll
    for (int db = 0; db < 4; ++db)
#pragma unroll
      for (int g = 0; g < 4; ++g) zz[db][g] = *(const u32x2*)(p.proj() + (size_t)tok * NPROJ + 704 + hd * 128 + db * 32 + 8 * g + 4 * h);
#pragma unroll
    for (int db = 0; db < 4; ++db)
#pragma unroll
      for (int g = 0; g < 4; ++g) {
        int dv = db * 32 + 8 * g + 4 * h;
        float ov4[4];
#pragma unroll
        for (int jj = 0; jj < 4; ++jj) ov4[jj] = o[db][4 * g + jj] * g0 + ex[(qsub * 128 + dv + jj) * 32 + lq] * g1;
        u32x2 z = zz[db][g];
        float z0 = bflo(z[0]), z1 = bfhi(z[0]), z2 = bflo(z[1]), z3 = bfhi(z[1]);
        u32x2 ov;
        ov[0] = pack2(ov4[0] * silu_f(z0), ov4[1] * silu_f(z1));
        ov[1] = pack2(ov4[2] * silu_f(z2), ov4[3] * silu_f(z3));
        *(u32x2*)(p.ycat() + (size_t)tok * 1536 + hd * 128 + dv) = ov;
      }
  }
}

DI void diff_item(const P& p, int l, int it, char* smem) {
  const int tid = tidx(), lane = tid & 63, w = wave_of(tid), lq = lane & 31, h = lane >> 5;
  int lat, b, hd, qb;
  if (it < 256) { lat = 1; b = it >> 6; hd = (it >> 4) & 3; qb = it & 15; }
  else { int u = it - 256; lat = 0; b = u >> 4; hd = (u >> 2) & 3; qb = u & 3; }
  const int T = lat ? 1024 : 256, tok0 = lat ? 4096 + b * 1024 : b * 256;
  const int map = w >> 1, qsub = w & 1;
  const int tok = tok0 + qb * 64 + qsub * 32 + lq;
  const float c = 0.125f * 1.4426950408889634f;
  const bf16* vt = p.VbT() + (size_t)tok0 * 512 + (size_t)hd * 128 * T;
  const bf16* vtc = p.cVbT() + (size_t)((l * 4 + b) * 4 + hd) * 128 * 256;
  const bf16* kc = p.cKb() + (size_t)((l * 4 + b) * 4 + hd) * 256 * 128;
  f32x16 o[4]; float ls, mdummy;
  attn_pass<128, 64, 1>(p.proj() + (size_t)tok * NPROJ + 1216 + hd * 128 + map * 64, map * 64, 0, p.Kb() + (size_t)(tok0 * 4 + hd) * 128, 512, T, kc, 128,
                     lat ? 256 : 0, vt, vtc, c, smem, o, ls, mdummy);
  float* ex = (float*)smem;
  __syncthreads();
  if (map == 1) {
    const float sc2 = p.lam()[l] / ls;
#pragma unroll
    for (int db = 0; db < 4; ++db)
#pragma unroll
      for (int r = 0; r < 16; ++r) {
        int dv = db * 32 + 8 * (r >> 2) + 4 * h + (r & 3);
        ex[(qsub * 128 + dv) * 32 + lq] = o[db][r] * sc2;
      }
  }
  __syncthreads();
  if (map == 0) {
    const float i1 = 1.f / ls;
    float ss = 0.f;
#pragma unroll
    for (int db = 0; db < 4; ++db)
#pragma unroll
      for (int r = 0; r < 16; ++r) {
        int dv = db * 32 + 8 * (r >> 2) + 4 * h + (r & 3);
        float v = o[db][r] * i1 - ex[(qsub * 128 + dv) * 32 + lq];
        o[db][r] = v; ss += v * v;
      }
    ss += __shfl_xor(ss, 32);
    const float lam_init = 0.8f - 0.6f * fexp(-0.3f * (float)l);
    const float sc = rsqrtf(ss * (1.f / 128.f) + EPS) * (1.f - lam_init);
#pragma unroll
    for (int db = 0; db < 4; ++db) {
      u32x2 zz[4]; f32x4 gg[4];
#pragma unroll
      for (int g = 0; g < 4; ++g) {
        int dv = db * 32 + 8 * g + 4 * h;
        zz[g] = *(const u32x2*)(p.proj() + (size_t)tok * NPROJ + 2752 + hd * 128 + dv);
        gg[g] = *(const f32x4*)(p.dnorm + l * 128 + dv);
      }
#pragma unroll
      for (int g = 0; g < 4; ++g) {
        int dv = db * 32 + 8 * g + 4 * h;
        u32x2 z = zz[g];
        f32x4 gn = gg[g];
        float z0 = bflo(z[0]), z1 = bfhi(z[0]), z2 = bflo(z[1]), z3 = bfhi(z[1]);
        u32x2 ov;
        ov[0] = pack2(o[db][4 * g] * sc * gn[0] * silu_f(z0), o[db][4 * g + 1] * sc * gn[1] * silu_f(z1));
        ov[1] = pack2(o[db][4 * g + 2] * sc * gn[2] * silu_f(z2), o[db][4 * g + 3] * sc * gn[3] * silu_f(z3));
        *(u32x2*)(p.ycat() + (size_t)tok * 1536 + 512 + hd * 128 + dv) = ov;
      }
    }
  }
}

DI void conv8(const P& p, int l, int tok, int t, int T, int col, int wcol, float (&o)[8]) {
  const bf16* base = p.proj() + (size_t)tok * NPROJ + col;
  u32x4 cur = *(const u32x4*)base;
  u32x4 prv = {0u, 0u, 0u, 0u}, nxt = {0u, 0u, 0u, 0u};
  if (t > 0) prv = *(const u32x4*)(base - NPROJ);
  if (t < T - 1) nxt = *(const u32x4*)(base + NPROJ);
  const float* w0 = p.mconv + (size_t)l * 3 * 1024 + wcol;
  f32x4 wa0 = *(const f32x4*)w0, wa1 = *(const f32x4*)(w0 + 4);
  f32x4 wb0 = *(const f32x4*)(w0 + 1024), wb1 = *(const f32x4*)(w0 + 1028);
  f32x4 wc0 = *(const f32x4*)(w0 + 2048), wc1 = *(const f32x4*)(w0 + 2052);
#pragma unroll
  for (int e = 0; e < 4; ++e) {
    float wA0 = e < 2 ? wa0[2 * e] : wa1[2 * e - 4], wA1 = e < 2 ? wa0[2 * e + 1] : wa1[2 * e - 3];
    float wB0 = e < 2 ? wb0[2 * e] : wb1[2 * e - 4], wB1 = e < 2 ? wb0[2 * e + 1] : wb1[2 * e - 3];
    float wC0 = e < 2 ? wc0[2 * e] : wc1[2 * e - 4], wC1 = e < 2 ? wc0[2 * e + 1] : wc1[2 * e - 3];
    float v0 = wA0 * bflo(prv[e]) + wB0 * bflo(cur[e]) + wC0 * bflo(nxt[e]);
    float v1 = wA1 * bfhi(prv[e]) + wB1 * bfhi(cur[e]) + wC1 * bfhi(nxt[e]);
    o[2 * e] = silu_f(v0); o[2 * e + 1] = silu_f(v1);
  }
}

DI float wave_incl_scan_add(float v, int lane) {
#pragma unroll
  for (int o = 1; o < 64; o <<= 1) { float t = __shfl_up(v, o); if (lane >= o) v += t; }
  return v;
}
DI float wave_incl_scan_max(float v, int lane) {
#pragma unroll
  for (int o = 1; o < 64; o <<= 1) { float t = __shfl_up(v, o); if (lane >= o) v = fmaxf(v, t); }
  return v;
}

DI void mlstm_local(const P& p, int l, int slot, char* smem) {
  bf16* vT = (bf16*)smem;
  bf16* kT = vT + 128 * 72;
  float* wbuf = (float*)(kT + 128 * 72);
  const int tid = tidx(), lane = tid & 63, w = wave_of(tid), lq = lane & 31, h = lane >> 5;
  const int cp = slot >> 3, hd = (slot >> 1) & 3, dir = slot & 1;
  const int ctok = cp * 64;
  TokInfo ti = tinfo(ctok);
  const int T = ti.T;
  if (w == 0) {
    const int s = dir ? 63 - lane : lane;
    const int tk = ctok + s;
    const float ig = p.gates()[tk * 16 + dir * 8 + hd];
    const float lf = logsig_f(p.gates()[tk * 16 + dir * 8 + 4 + hd]);
    const float bc = wave_incl_scan_add(lf, lane);
    const float b_last = __shfl(bc, 63);
    const float val = b_last - bc + ig;
    float mx = val;
#pragma unroll
    for (int o = 32; o >= 1; o >>= 1) mx = fmaxf(mx, __shfl_xor(mx, o));
    wbuf[s] = fexp(val - mx);
    if (lane == 0) { p.blA()[slot] = b_last; p.mlA()[slot] = mx; }
  }
  __syncthreads();
  {
    const int s = tid >> 2, chb = (tid & 3) * 32;
    const float ws = wbuf[s];
    float kvv[4][8];
#pragma unroll
    for (int q = 0; q < 4; ++q) {
      const int ch = chb + q * 8;
      conv8(p, l, ctok + s, ti.t + s, T, 3776 + hd * 128 + ch, 512 + hd * 128 + ch, kvv[q]);
    }
#pragma unroll
    for (int q = 0; q < 4; ++q) {
      const int ch = chb + q * 8;
#pragma unroll
      for (int e = 0; e < 8; ++e) kT[(ch + e) * 72 + s] = f2bf(kvv[q][e] * ws);
    }
    const bf16* vsrc = p.VmT() + (size_t)ti.tok0 * 512 + (size_t)hd * 128 * T + ti.t;
    u32x4 tvv[4];
#pragma unroll
    for (int i = 0; i < 4; ++i) { int idx = tid + 256 * i; int r = idx >> 3, cc = idx & 7; tvv[i] = *(const u32x4*)(vsrc + (size_t)r * T + cc * 8); }
#pragma unroll
    for (int i = 0; i < 4; ++i) { int idx = tid + 256 * i; int r = idx >> 3, cc = idx & 7; *(u32x4*)(vT + r * 72 + cc * 8) = tvv[i]; }
  }
  __syncthreads();
  f32x16 acc[4];
#pragma unroll
  for (int cb = 0; cb < 4; ++cb)
#pragma unroll
    for (int r = 0; r < 16; ++r) acc[cb][r] = 0.f;
#pragma unroll
  for (int ks = 0; ks < 4; ++ks) {
    bf16x8 a = *(const bf16x8*)(vT + (32 * w + lq) * 72 + ks * 16 + 8 * h);
#pragma unroll
    for (int cb = 0; cb < 4; ++cb) {
      bf16x8 bb = *(const bf16x8*)(kT + (32 * cb + lq) * 72 + ks * 16 + 8 * h);
      acc[cb] = MFMA(a, bb, acc[cb]);
    }
  }
  bf16* cs = p.Cst() + (size_t)slot * 16384;
#pragma unroll
  for (int cb = 0; cb < 4; ++cb)
#pragma unroll
    for (int r = 0; r < 16; ++r) {
      int dvv = 32 * w + 8 * (r >> 2) + 4 * h + (r & 3);
      cs[dvv * 128 + 32 * cb + lq] = f2bf(acc[cb][r]);
    }
  if (tid < 128) {
    float sum = 0.f;
#pragma unroll
    for (int q = 0; q < 8; ++q) {
      u32x4 v = *(const u32x4*)(kT + tid * 72 + q * 8);
#pragma unroll
      for (int e = 0; e < 4; ++e) sum += bflo(v[e]) + bfhi(v[e]);
    }
    p.nst()[slot * 128 + tid] = sum;
  }
}

DI void mlstm_scan(const P& p, int l, int it) {
  const int tid = tidx();
  const int ch = it >> 2, qt = it & 3;
  int lat, b, hd, dir;
  if (ch < 32) { lat = 1; b = ch >> 3; hd = (ch >> 1) & 3; dir = ch & 1; }
  else { int u = ch - 32; lat = 0; b = u >> 3; hd = (u >> 1) & 3; dir = u & 1; }
  const int T = lat ? 1024 : 256, tok0 = lat ? 4096 + b * 1024 : b * 256, nc = T >> 6;
  const int dv0 = 32 * qt + 4 * (tid >> 5), dk0 = 4 * (tid & 31);
  float C[4][4];
  float n_val = 0.f, m_prev = 0.f;
  const bool do_n = (qt == 0) && (tid < 128);
  const size_t sidx = (size_t)((b * 4 + l) * 2 + dir) * 4 + hd;
  if (lat) {
    const float* C0 = p.st_C + sidx * 16384;
#pragma unroll
    for (int j = 0; j < 4; ++j) {
      f32x4 v = *(const f32x4*)(C0 + (size_t)(dk0 + j) * 128 + dv0);
      C[0][j] = v[0]; C[1][j] = v[1]; C[2][j] = v[2]; C[3][j] = v[3];
    }
    if (do_n) n_val = p.st_n[sidx * 128 + tid];
    m_prev = p.st_m[sidx];
  } else {
#pragma unroll
    for (int i = 0; i < 4; ++i)
#pragma unroll
      for (int j = 0; j < 4; ++j) C[i][j] = 0.f;
  }
  u32x2 dnx[4]; float blx, mlx, dnnx = 0.f;
  {
    const int c = dir ? nc - 1 : 0;
    const int slot = ((((tok0 >> 6) + c) * 4 + hd) * 2) + dir;
    const bf16* cs = p.Cst() + (size_t)slot * 16384 + dv0 * 128 + dk0;
#pragma unroll
    for (int i = 0; i < 4; ++i) dnx[i] = *(const u32x2*)(cs + i * 128);
    blx = p.blA()[slot]; mlx = p.mlA()[slot];
    if (do_n) dnnx = p.nst()[slot * 128 + tid];
  }
  for (int ci = 0; ci < nc; ++ci) {
    const int c = dir ? nc - 1 - ci : ci;
    const int slot = ((((tok0 >> 6) + c) * 4 + hd) * 2) + dir;
    bf16* cs = p.Cst() + (size_t)slot * 16384 + dv0 * 128 + dk0;
    u32x2 d[4];
#pragma unroll
    for (int i = 0; i < 4; ++i) d[i] = dnx[i];
    const float bl = blx, ml = mlx;
    const float dn = dnnx;
    {
      const int cn = (ci + 1 < nc) ? (dir ? nc - 2 - ci : ci + 1) : c;
      const int sn = ((((tok0 >> 6) + cn) * 4 + hd) * 2) + dir;
      const bf16* csn = p.Cst() + (size_t)sn * 16384 + dv0 * 128 + dk0;
#pragma unroll
      for (int i = 0; i < 4; ++i) dnx[i] = *(const u32x2*)(csn + i * 128);
      blx = p.blA()[sn]; mlx = p.mlA()[sn];
      if (do_n) dnnx = p.nst()[sn * 128 + tid];
    }
#pragma unroll
    for (int i = 0; i < 4; ++i) {
      u32x2 o; o[0] = pack2(C[i][0], C[i][1]); o[1] = pack2(C[i][2], C[i][3]);
      *(u32x2*)(cs + i * 128) = o;
    }
    if (do_n) p.nst()[slot * 128 + tid] = n_val;
    if (qt == 0 && tid == 0) p.mst()[slot] = m_prev;
    const float m_new = fmaxf(bl + m_prev, ml);
    const float a = fexp(bl + m_prev - m_new), bs = fexp(ml - m_new);
#pragma unroll
    for (int i = 0; i < 4; ++i) {
      C[i][0] = a * C[i][0] + bs * bflo(d[i][0]); C[i][1] = a * C[i][1] + bs * bfhi(d[i][0]);
      C[i][2] = a * C[i][2] + bs * bflo(d[i][1]); C[i][3] = a * C[i][3] + bs * bfhi(d[i][1]);
    }
    n_val = a * n_val + bs * dn;
    m_prev = m_new;
  }
  if (!lat) {
    float* Co = p.out + O_MC + sidx * 16384;
#pragma unroll
    for (int j = 0; j < 4; ++j) {
      f32x4 v; v[0] = C[0][j]; v[1] = C[1][j]; v[2] = C[2][j]; v[3] = C[3][j];
      *(f32x4*)(Co + (size_t)(dk0 + j) * 128 + dv0) = v;
    }
    if (do_n) p.out[O_MN + sidx * 128 + tid] = n_val;
    if (qt == 0 && tid == 0) p.out[O_MM + sidx] = m_prev;
  }
}

DI void mlstm_out(const P& p, int l, int it, char* smem) {
  bf16* sq = (bf16*)smem;
  bf16* sk = sq + 64 * 136;
  bf16* vT = sk + 64 * 136;
  float* bcA2 = (float*)(vT + 128 * 72);
  float* uA2 = bcA2 + 128, *mtA2 = uA2 + 128, *nA2 = mtA2 + 128  , *ssb = nA2 + 256  ;
  const int tid = tidx(), lane = tid & 63, w = wave_of(tid), lq = lane & 31, h = lane >> 5;
  const int cp = it >> 2, hd = it & 3;
  const int ctok = cp * 64;
  TokInfo ti = tinfo(ctok);
  const int T = ti.T;
  const float m_prev0 = p.mst()[(cp * 4 + hd) * 2], m_prev1 = p.mst()[(cp * 4 + hd) * 2 + 1];
  if (w < 2) {
    const int dir = w;
    const float m_prev = dir ? m_prev1 : m_prev0;
    const int s = dir ? 63 - lane : lane;
    const int tk = ctok + s;
    const float ig = p.gates()[tk * 16 + dir * 8 + hd];
    const float lf = logsig_f(p.gates()[tk * 16 + dir * 8 + 4 + hd]);
    const float bc = wave_incl_scan_add(lf, lane);
    const float u = ig - bc;
    const float pm = wave_incl_scan_max(u, lane);
    bcA2[dir * 64 + s] = bc; uA2[dir * 64 + s] = u; mtA2[dir * 64 + s] = bc + fmaxf(m_prev, pm);
  } else {
    const int dir = w - 2;
    const int slot = (cp * 4 + hd) * 2 + dir;
    nA2[dir * 128 + lane] = p.nst()[slot * 128 + lane];
    nA2[dir * 128 + 64 + lane] = p.nst()[slot * 128 + 64 + lane];
  }
  {
    const int s = tid >> 2, chb = (tid & 3) * 32;
#pragma unroll 2
    for (int q = 0; q < 4; ++q) {
      const int ch = chb + q * 8;
      float v[8];
      conv8(p, l, ctok + s, ti.t + s, T, 3264 + hd * 128 + ch, hd * 128 + ch, v);
      u32x4 pk;
#pragma unroll
      for (int e = 0; e < 4; ++e) pk[e] = pack2(v[2 * e] * 0.08838834764831845f, v[2 * e + 1] * 0.08838834764831845f);
      *(u32x4*)(sq + s * 136 + ch) = pk;
      conv8(p, l, ctok + s, ti.t + s, T, 3776 + hd * 128 + ch, 512 + hd * 128 + ch, v);
#pragma unroll
      for (int e = 0; e < 4; ++e) pk[e] = pack2(v[2 * e], v[2 * e + 1]);
      *(u32x4*)(sk + s * 136 + ch) = pk;
    }
    const bf16* vsrc = p.VmT() + (size_t)ti.tok0 * 512 + (size_t)hd * 128 * T + ti.t;
    u32x4 tvv[4];
#pragma unroll
    for (int i = 0; i < 4; ++i) { int idx = tid + 256 * i; int r = idx >> 3, cc = idx & 7; tvv[i] = *(const u32x4*)(vsrc + (size_t)r * T + cc * 8); }
#pragma unroll
    for (int i = 0; i < 4; ++i) { int idx = tid + 256 * i; int r = idx >> 3, cc = idx & 7; *(u32x4*)(vT + r * 72 + cc * 8) = tvv[i]; }
  }
  __syncthreads();
  const int tb = w & 1, dvh = w >> 1;
  const int t = 32 * tb + lq;
  f32x16 hacc[2];
#pragma unroll
  for (int d2 = 0; d2 < 2; ++d2)
#pragma unroll
    for (int r = 0; r < 16; ++r) hacc[d2][r] = 0.f;
  const bf16* sqt = sq + t * 136 + 8 * h;
  for (int dir = 0; dir < 2; ++dir) {
    const int slot = (cp * 4 + hd) * 2 + dir;
    const float m_prev = dir ? m_prev1 : m_prev0;
    const float* bcA = bcA2 + dir * 64;
    const float* uA = uA2 + dir * 64;
    const float* mtA = mtA2 + dir * 64;
    const float* nA = nA2 + dir * 128;
    const float bc_t = bcA[t], mt = mtA[t];
    const float w_inter = fexp(bc_t + m_prev - mt);
    float den = 0.f;
    const float e0 = bc_t - mt;
    u32x4 pk[2][2];
#pragma unroll
    for (int sb = 0; sb < 2; ++sb) {
      asm volatile("" ::: "memory");
      f32x16 sv;
#pragma unroll
      for (int r = 0; r < 16; ++r) sv[r] = 0.f;
#pragma unroll
      for (int ks = 0; ks < 8; ++ks) {
        bf16x8 a = *(const bf16x8*)(sk + (32 * sb + lq) * 136 + ks * 16 + 8 * h);
        sv = MFMA(a, *(const bf16x8*)(sqt + ks * 16), sv);
      }
#pragma unroll
      for (int r = 0; r < 16; ++r) {
        const int sidx = 32 * sb + 8 * (r >> 2) + 4 * h + (r & 3);
        const bool valid = dir ? (sidx >= t) : (sidx <= t);
        const float wgt = valid ? fexp(e0 + uA[sidx]) : 0.f;
        const float v = sv[r] * wgt;
        sv[r] = v; den += v;
      }
#pragma unroll
      for (int s2 = 0; s2 < 2; ++s2)
#pragma unroll
        for (int e = 0; e < 4; ++e) pk[sb][s2][e] = pack2(sv[8 * s2 + 2 * e], sv[8 * s2 + 2 * e + 1]);
    }
    asm volatile("" ::: "memory");
    den += __shfl_xor(den, 32);
    float qn = 0.f;
#pragma unroll
    for (int ks = 0; ks < 8; ++ks) {
      u32x4 qv = *(const u32x4*)(sqt + ks * 16);
#pragma unroll
      for (int e = 0; e < 4; ++e) {
        qn += bflo(qv[e]) * nA[ks * 16 + 8 * h + 2 * e] + bfhi(qv[e]) * nA[ks * 16 + 8 * h + 2 * e + 1];
      }
    }
    qn += __shfl_xor(qn, 32);
    den += w_inter * qn;
    asm volatile("" ::: "memory");
    const float rden = 1.f / fmaxf(fabsf(den), fexp(-mt));
    const bf16* cs = p.Cst() + (size_t)slot * 16384;
    bf16x8 cfa[2][8];
#pragma unroll
    for (int d2 = 0; d2 < 2; ++d2)
#pragma unroll
      for (int ks = 0; ks < 8; ++ks) cfa[d2][ks] = *(const bf16x8*)(cs + ((2 * dvh + d2) * 32 + lq) * 128 + ks * 16 + 8 * h);
    asm volatile("" : "+v"(cfa[0][0]), "+v"(cfa[0][1]), "+v"(cfa[0][2]), "+v"(cfa[0][3]), "+v"(cfa[0][4]), "+v"(cfa[0][5]), "+v"(cfa[0][6]), "+v"(cfa[0][7]),
                      "+v"(cfa[1][0]), "+v"(cfa[1][1]), "+v"(cfa[1][2]), "+v"(cfa[1][3]), "+v"(cfa[1][4]), "+v"(cfa[1][5]), "+v"(cfa[1][6]), "+v"(cfa[1][7]));
#pragma unroll
    for (int d2 = 0; d2 < 2; ++d2) {
      const int dvb = 2 * dvh + d2;
      f32x16 acc;
#pragma unroll
      for (int r = 0; r < 16; ++r) acc[r] = 0.f;
#pragma unroll
      for (int ks = 0; ks < 8; ++ks) acc = MFMA(cfa[d2][ks], *(const bf16x8*)(sqt + ks * 16), acc);
#pragma unroll
      for (int r = 0; r < 16; ++r) acc[r] *= w_inter;
#pragma unroll
      for (int sb = 0; sb < 2; ++sb)
#pragma unroll
        for (int s2 = 0; s2 < 2; ++s2) {
          const bf16* vp = vT + (dvb * 32 + lq) * 72 + sb * 32 + s2 * 16 + 4 * h;
          u32x2 lo = *(const u32x2*)vp, hi = *(const u32x2*)(vp + 8);
          u32x4 av; av[0] = lo[0]; av[1] = lo[1]; av[2] = hi[0]; av[3] = hi[1];
          acc = MFMA(__builtin_bit_cast(bf16x8, av), __builtin_bit_cast(bf16x8, pk[sb][s2]), acc);
        }
#pragma unroll
      for (int r = 0; r < 16; ++r) hacc[d2][r] += acc[r] * rden;
    }
  }
  const int tok = ctok + t;
  float ss = 0.f;
#pragma unroll
  for (int d2 = 0; d2 < 2; ++d2)
#pragma unroll
    for (int g = 0; g < 4; ++g) {
      int dv = (2 * dvh + d2) * 32 + 8 * g + 4 * h;
      u32x2 mo = *(const u32x2*)(p.proj() + (size_t)tok * NPROJ + 4800 + hd * 128 + dv);
      float m0 = bflo(mo[0]), m1 = bfhi(mo[0]), m2 = bflo(mo[1]), m3 = bfhi(mo[1]);
      float v0 = hacc[d2][4 * g] * sigmoid_f(m0), v1 = hacc[d2][4 * g + 1] * sigmoid_f(m1);
      float v2 = hacc[d2][4 * g + 2] * sigmoid_f(m2), v3 = hacc[d2][4 * g + 3] * sigmoid_f(m3);
      hacc[d2][4 * g] = v0; hacc[d2][4 * g + 1] = v1; hacc[d2][4 * g + 2] = v2; hacc[d2][4 * g + 3] = v3;
      ss += v0 * v0 + v1 * v1 + v2 * v2 + v3 * v3;
    }
  ss += __shfl_xor(ss, 32);
  if (h == 0) ssb[dvh * 64 + t] = ss;
  __syncthreads();
  const float rstd = rsqrtf((ssb[t] + ssb[64 + t]) * (1.f / 128.f) + EPS);
  u32x2 zz[2][4]; f32x4 gg[2][4];
#pragma unroll
  for (int d2 = 0; d2 < 2; ++d2)
#pragma unroll
    for (int g = 0; g < 4; ++g) {
      int dv = (2 * dvh + d2) * 32 + 8 * g + 4 * h;
      zz[d2][g] = *(const u32x2*)(p.proj() + (size_t)tok * NPROJ + 5312 + hd * 128 + dv);
      gg[d2][g] = *(const f32x4*)(p.mnorm + l * 512 + hd * 128 + dv);
    }
#pragma unroll
  for (int d2 = 0; d2 < 2; ++d2)
#pragma unroll
    for (int g = 0; g < 4; ++g) {
      int dv = (2 * dvh + d2) * 32 + 8 * g + 4 * h;
      u32x2 z = zz[d2][g];
      f32x4 gn = gg[d2][g];
      float z0 = bflo(z[0]), z1 = bfhi(z[0]), z2 = bflo(z[1]), z3 = bfhi(z[1]);
      u32x2 ov;
      ov[0] = pack2(hacc[d2][4 * g] * rstd * gn[0] * silu_f(z0), hacc[d2][4 * g + 1] * rstd * gn[1] * silu_f(z1));
      ov[1] = pack2(hacc[d2][4 * g + 2] * rstd * gn[2] * silu_f(z2), hacc[d2][4 * g + 3] * rstd * gn[3] * silu_f(z3));
      *(u32x2*)(p.ycat() + (size_t)tok * 1536 + 1024 + hd * 128 + dv) = ov;
    }
}

DI void ckv_fin(const P& p, int l, int tok) {
  const int lane = tidx() & 63;
  const int b = tok >> 8, t = tok & 255;
  float* o = p.out + O_CKV + (size_t)((b * 4 + l) * 256 + t) * 256 + lane * 4;
  u32x2 raw = *(const u32x2*)(p.proj() + (size_t)tok * NPROJ + 384 + lane * 4);
  f32x4 v; v[0] = bflo(raw[0]); v[1] = bfhi(raw[0]); v[2] = bflo(raw[1]); v[3] = bfhi(raw[1]);
  float ss = v[0] * v[0] + v[1] * v[1] + v[2] * v[2] + v[3] * v[3];
#pragma unroll
  for (int of = 32; of >= 1; of >>= 1) ss += __shfl_xor(ss, of);
  const float rstd = rsqrtf(ss * (1.f / 256.f) + EPS);
  f32x4 g = *(const f32x4*)(p.kv_norm + l * 256 + lane * 4);
  v[0] *= rstd * g[0]; v[1] *= rstd * g[1]; v[2] *= rstd * g[2]; v[3] *= rstd * g[3];
  *(f32x4*)o = v;
}

#define XB_TMO      128
#define XB_XCNT(j)  (256  + 64 * (j))
#define XB_XSUB(j)  (1280 + 64 * (j))
#define XB_XGEN(j)  (2304 + 64 * (j))
#define XB_TOP      3328
#define XB_TOPGEN   3392
#define XCD_BAR_WORDS 3456
#define XB_SPIN_CAP (1u << 18)
#define LAS __attribute__((address_space(3)))

__device__ __forceinline__ unsigned xb_ld(unsigned* p)              { return __hip_atomic_load(p, __ATOMIC_RELAXED, __HIP_MEMORY_SCOPE_AGENT); }
__device__ __forceinline__ unsigned xb_add(unsigned* p, unsigned v) { return __hip_atomic_fetch_add(p, v, __ATOMIC_RELAXED, __HIP_MEMORY_SCOPE_AGENT); }
__device__ __forceinline__ unsigned xb_xcc_id() { return (unsigned)__builtin_amdgcn_s_getreg((3 << 11) | 20) & 0xFu; }
#define XB_SPIN(cond, bar) do { unsigned _sp = 0; while (cond) { __builtin_amdgcn_s_sleep(1); \
    if ((++_sp & 255u) == 0u) { if (xb_ld(&(bar)[XB_TMO])) break; if (_sp > XB_SPIN_CAP) { atomicAdd(&(bar)[XB_TMO], 1u); break; } } } } while (0)

struct XcdBarrier {
    unsigned* bar; unsigned x;
    volatile LAS unsigned* st;
};

__device__ __forceinline__ XcdBarrier xcd_barrier_post(unsigned* bar, volatile LAS unsigned* st) {
    XcdBarrier b; b.bar = bar; b.x = xb_xcc_id(); b.st = st;
    if (tidx() == 0) (void)xb_add(&bar[XB_XCNT(b.x)], 1u);
    return b;
}
__device__ __forceinline__ void xcd_barrier_complete(unsigned* bar, unsigned x, unsigned& nloc, unsigned& nx) {
    const unsigned G = gridDim.x * gridDim.y * gridDim.z;
    unsigned sum, cnt, mine, sp = 0u;
    for (;;) {
        sum = 0u; cnt = 0u; mine = 0u;
#pragma unroll
        for (unsigned j = 0; j < 16; ++j) { const unsigned c = xb_ld(&bar[XB_XCNT(j)]); sum += c; cnt += (c > 0u) ? 1u : 0u; mine = (j == x) ? c : mine; }
        if (sum == G) break;
        __builtin_amdgcn_s_sleep(1);
        if ((++sp & 255u) == 0u) { if (xb_ld(&bar[XB_TMO])) break; if (sp > XB_SPIN_CAP) { atomicAdd(&bar[XB_TMO], 1u); break; } }
    }
    nloc = mine > 0u ? mine : 1u; nx = cnt > 0u ? cnt : 1u;
}

__device__ __forceinline__ void xcd_barrier(const XcdBarrier& b) {
    asm volatile("s_waitcnt vmcnt(0)" ::: "memory");
    __syncthreads();
    if (tidx() == 0) {
        unsigned* bar = b.bar;
        __builtin_amdgcn_s_waitcnt(0);
        unsigned nloc = b.st[0], nx = b.st[1];
        if (nloc == 0u) { xcd_barrier_complete(bar, b.x, nloc, nx); b.st[0] = nloc; b.st[1] = nx; }
        const unsigned old = xb_add(&bar[XB_XSUB(b.x)], 1u);
        const unsigned gen = old / nloc;
        if (old + 1u == (gen + 1u) * nloc) {
            __builtin_amdgcn_fence(__ATOMIC_RELEASE, "agent");
            asm volatile("s_waitcnt vmcnt(0)" ::: "memory");
            const unsigned og = xb_add(&bar[XB_TOP], 1u);
            const unsigned tg = og / nx;
            if (og + 1u == (tg + 1u) * nx) xb_add(&bar[XB_TOPGEN], 1u);
            else XB_SPIN(xb_ld(&bar[XB_TOPGEN]) == tg, bar);
            __builtin_amdgcn_fence(__ATOMIC_ACQUIRE, "agent");
            xb_add(&bar[XB_XGEN(b.x)], 1u);
            asm volatile("s_waitcnt vmcnt(0)" ::: "memory");
        } else {
            XB_SPIN(xb_ld(&bar[XB_XGEN(b.x)]) == gen, bar);
            __builtin_amdgcn_fence(__ATOMIC_ACQUIRE, "agent");
            asm volatile("s_waitcnt vmcnt(0)" ::: "memory");
        }
    }
    __syncthreads();
}


DI P launder(const P& p) {
  P q = p;
#define LND(m) { asm volatile("" : "+s"(q.m)); q.m = (decltype(q.m))(__attribute__((address_space(1))) void*)(void*)q.m; }
  LND(x_prompt) LND(x_sample) LND(c_ckv) LND(c_krope) LND(c_dk) LND(c_dv) LND(st_C) LND(st_n) LND(st_m) LND(c) LND(c_ctx)
  LND(g_norm) LND(W_mod) LND(b_mod) LND(W_in) LND(q_norm) LND(W_uq) LND(kv_norm) LND(W_ukv) LND(dlam) LND(dnorm) LND(mconv)
  LND(mgb) LND(mnorm) LND(W_out) LND(g_final) LND(out) LND(ws)
#undef LND
  return q;
}

template <int KIND>
DI void run_phase(const P& p0, int ph, char* smem) {
  const P& p = p0;
  const int G = gridDim.x, B = blockIdx.x, w = wave_of(tidx());
  if ((KIND < 0 || KIND == 0) && ph == 0) { phase_prepass(p, smem); return; }
  if ((KIND < 0 || KIND == 1) && ph == 1) {
    for (int it = B; it < 256 + 2048; it += G) {
      if (it < 256) {
        int mt = it >> 3, nt = it & 7;
        int l = (mt * 128) >> 10;
        f32x16 acc[2][2];
        gemm_core<false>(p.cckv() + (size_t)mt * 128 * 256, 256, p.WukvTp() + (size_t)l * 1024 * 256 + (size_t)nt * 128 * 256, 256, 256, smem, acc);
        epi_kv(p, mt * 128, nt * 128, acc, nullptr, true);
      } else {
        if (it - 256 < 512) norm_rows4(p, 0, (it - 256) * 16 + w * 4, 0);
      }
    }
    return;
  }
  const int l = (ph - 2) / 6, sub = (ph - 2) % 6;
  if ((KIND < 0 || KIND == 2) && sub == 0) {
    const int x = B & 7, j = B >> 3, per = G >> 3;
    const bf16* Ab = p.hbuf();
    const bf16* Wb = p.WinT() + (size_t)l * NPROJ * 1024;
    for (int q = j; q < 3 * 64; q += per) {
      const int r = q >> 6, jj = q & 63;
      const int st = r * 8 + x;
      const int mt = (st / 3) * 8 + (jj >> 3), nt = (st % 3) * 8 + (jj & 7);
      if (nt >= 23) continue;
      f32x16 acc[2][4];
      gemm_core_w(Ab + (size_t)mt * 128 * 1024, 1024, Wb + (size_t)nt * 256 * 1024, 1024, 1024, smem, acc);
      epi_inproj_w(p, l, mt * 128, nt * 256, acc, smem);
    }
  } else if ((KIND < 0 || KIND == 3) && sub == 1) {
    const int N_CH = 1024, N_QA = 64 * 3, N_KV = 64 * 4, N_CF = 1024;
    const float* sRowW = (const float*)(smem + (128 + 256) * 72 * 2);
    for (int it = B; it < N_CH + N_QA + N_KV + N_CF; it += G) {
      int u = it;
      __syncthreads();
      if (u < N_CH) { mlstm_local(p, l, u, smem); continue; }
      u -= N_CH;
      if (u < N_QA) {
        int mt = u / 3, nt = u % 3;
        f32x16 acc[2][4];
        gemm_core_w<true>(p.proj() + (size_t)mt * 128 * NPROJ, NPROJ, p.WuqT() + (size_t)l * 768 * 384 + (size_t)nt * 256 * 384, 384, 384, smem, acc);
        epi_qa_w<0>(p, mt * 128, nt * 256, acc, sRowW);
        epi_qa_w<1>(p, mt * 128, nt * 256, acc, sRowW);
        continue;
      }
      u -= N_QA;
      if (u < N_KV) {
        int mt = u >> 2, nt = u & 3;
        f32x16 acc[2][4];
        gemm_core_w<true>(p.proj() + (size_t)mt * 128 * NPROJ + 384, NPROJ, p.WukvT() + (size_t)l * 1024 * 256 + (size_t)nt * 256 * 256, 256, 256, smem, acc);
        epi_kv_w<0>(p, mt * 128, nt * 256, acc, sRowW);
        epi_kv_w<1>(p, mt * 128, nt * 256, acc, sRowW);
        continue;
      }
      u -= N_KV;
      ckv_fin(p, l, u * 4 + w);
    }
  } else if ((KIND < 0 || KIND == 7) && sub == 2) {
    for (int it = B; it < 640; it += G) mlstm_scan(p, l, it);
  } else if ((KIND < 0 || KIND == 4) && sub == 3) {
    const int x = B & 7;
    int* qctr = p.qc() + ph * 8 + x;
    int* sslot = (int*)(smem + SMEM_BYTES - 16);
    const int nfirst = G >> 3;
    int q = B >> 3;
    for (;;) {
      if (q >= 192) break;
      __syncthreads();
      if (q < 32) { const int pr = 2 * x + (q >> 4); mla_item(p, l, pr * 16 + (q & 15), smem); }
      else if (q < 64) { const int u = q - 32; const int pr = 2 * x + (u >> 4); diff_item(p, l, pr * 16 + (u & 15), smem); }
      else if (q < 128) mlstm_out(p, l, x * 64 + (q - 64), smem);
      else if (q < 160) { const int u = q - 128; const int pr = 8 * x + (u >> 2); mla_item(p, l, 256 + pr * 4 + (u & 3), smem); }
      else { const int u = q - 160; const int pr = 8 * x + (u >> 2); diff_item(p, l, 256 + pr * 4 + (u & 3), smem); }
      __syncthreads();
      if (tidx() == 0) *sslot = nfirst + atomicAdd(qctr, 1);
      __syncthreads();
      q = *sslot;
    }
  } else if ((KIND < 0 || KIND == 5) && sub == 4) {
    const int x = B & 7, j = B >> 3, per = G >> 3;
    for (int q = j; q < 64; q += per) {
      const int mt = x * 8 + (q >> 3), nt = q & 7;
      f32x16 acc[2][2];
      gemm_core<false>(p.ycat() + (size_t)mt * 128 * 1536, 1536, p.WoutT() + (size_t)l * 1024 * 1536 + (size_t)nt * 128 * 1536, 1536, 1536, smem, acc);
      epi_out(p, l, mt * 128, nt * 128, acc);
    }
  } else if ((KIND < 0 || KIND == 6) && sub == 5) {
    for (int it = B; it < 2048; it += G) {
      if (it < 512) {
        if (l < 3) norm_rows4(p, l + 1, it * 16 + w * 4, 0);
        else norm_rows4(p, 0, it * 16 + w * 4, 1);
      }
    }
  }
}

#if COOP
__global__ void __launch_bounds__(256, 2) mega(P p, int lo, int hi, int coop) {
  __shared__ __attribute__((aligned(16))) char smem[SMEM_BYTES];
  __shared__ uint4 xb_words;
  if (threadIdx.x == 0) xb_words = make_uint4(0u, 0u, 0u, 0u);
  tidx_init();
  XcdBarrier xb = xcd_barrier_post((unsigned*)p.ctr(), (volatile LAS unsigned*)&xb_words);
  for (int ph = lo; ph < hi; ++ph) {
    run_phase<-1>(p, ph, smem);
    if (PROBE_DUP) {
      const int kind = ph < 2 ? ph : 2 + (ph - 2) % 6;
      if ((PROBE_DUP >> kind) & 1) { xcd_barrier(xb); run_phase<-1>(p, ph, smem); }
    }
    if (ph + 1 < hi) xcd_barrier(xb);
  }
  if (coop == 2) cg::this_grid().sync();
}
#endif
template <int KIND>
__global__ void __launch_bounds__(256) phase_k(P p, int ph) {
  __shared__ __attribute__((aligned(16))) char smem[SMEM_BYTES];
  tidx_init();
  run_phase<KIND>(p, ph, smem);
}

extern "C" void kernel_launch(void* const* d_in, const int* in_sizes, int n_in, void* d_out, int out_size, void* d_ws,
                              size_t ws_size, hipStream_t stream) {
  P p{};
  const float** ins = (const float**)&p;
  for (int i = 0; i < 26; ++i) ins[i] = (const float*)d_in[i];
  p.out = (float*)d_out;
  p.ws = (char*)d_ws;
  if (WS_TOTAL > ws_size) { fprintf(stderr, "workspace too small: need %zu have %zu\n", (size_t)WS_TOTAL, ws_size); return; }

#if COOP
  static int grid_blocks = 0;
  if (!grid_blocks) {
    int dev = 0, cus = 0, per_cu = 0;
    (void)hipGetDevice(&dev);
    (void)hipDeviceGetAttribute(&cus, hipDeviceAttributeMultiprocessorCount, dev);
    (void)hipOccupancyMaxActiveBlocksPerMultiprocessor(&per_cu, mega, 256, 0);
    if (per_cu > 2) per_cu = 2;
    grid_blocks = cus * per_cu;
  }
  (void)hipMemsetAsync(p.ws + OFF_ctr, 0, 16384 + 4096, stream);
  int lo = 0, hi = NPHASE, coop = 1;
  void* args[] = {&p, &lo, &hi, &coop};
  hipError_t e = hipLaunchCooperativeKernel((void*)mega, dim3(grid_blocks), dim3(256), args, 0, stream);
  if (e != hipSuccess) fprintf(stderr, "cooperative launch failed: %s (grid %d)\n", hipGetErrorString(e), grid_blocks);
#else
  for (int ph = 0; ph < NPHASE; ++ph) {
    static const int kmap[6] = {2, 3, 7, 4, 5, 6};
    int kind = ph < 2 ? ph : kmap[(ph - 2) % 6];
    switch (kind) {
      case 0: phase_k<0><<<512, 256, 0, stream>>>(p, ph); break;
      case 1: phase_k<1><<<512, 256, 0, stream>>>(p, ph); break;
      case 2: phase_k<2><<<512, 256, 0, stream>>>(p, ph); break;
      case 3: phase_k<3><<<512, 256, 0, stream>>>(p, ph); break;
      case 4: phase_k<4><<<512, 256, 0, stream>>>(p, ph); break;
      case 5: phase_k<5><<<512, 256, 0, stream>>>(p, ph); break;
      case 7: phase_k<7><<<512, 256, 0, stream>>>(p, ph); break;
      default: phase_k<6><<<512, 256, 0, stream>>>(p, ph); break;
    }
  }
#endif
}
```

```cpp
#include <hip/hip_runtime.h>
#include <hip/hip_cooperative_groups.h>
#include <cstdio>
namespace cg = cooperative_groups;

typedef unsigned short bf16;
typedef __attribute__((ext_vector_type(8))) short bf16x8;
typedef __attribute__((ext_vector_type(4))) short s16x4;
typedef __attribute__((ext_vector_type(16))) float f32x16;
typedef __attribute__((ext_vector_type(4))) float f32x4;
typedef __attribute__((ext_vector_type(4))) unsigned u32x4;
typedef __attribute__((ext_vector_type(2))) unsigned u32x2;

#define DI __device__ __forceinline__
#define MFMA(a, b, c) __builtin_amdgcn_mfma_f32_32x32x16_bf16((a), (b), (c), 0, 0, 0)

#ifndef COOP
#define COOP 1
#endif
#define PROBE_DUP 0

constexpr int NTOK = 8192;
constexpr int NPROJ = 5888;
constexpr int NPHASE = 26;
constexpr float EPS = 1e-6f;
constexpr int SMEM_BYTES = 75 * 1024;

constexpr size_t O_YP = 0, O_YS = 4194304, O_CKV = 8388608, O_KROPE = 12582912, O_DK = 13631488,
                 O_DV = 22020096, O_MC = 30408704, O_MN = 38797312, O_MM = 38862848;

constexpr size_t al256(size_t x) { return (x + 255) & ~(size_t)255; }
constexpr size_t OFF_WinT = 0;
constexpr size_t OFF_WuqT = OFF_WinT + al256((size_t)4 * NPROJ * 1024 * 2);
constexpr size_t OFF_WukvT = OFF_WuqT + al256((size_t)4 * 768 * 384 * 2);
constexpr size_t OFF_WukvTp = OFF_WukvT + al256((size_t)4 * 1024 * 256 * 2);
constexpr size_t OFF_WoutT = OFF_WukvTp + al256((size_t)4 * 1024 * 256 * 2);
constexpr size_t OFF_mod = OFF_WoutT + al256((size_t)4 * 1024 * 1536 * 2);
constexpr size_t OFF_ropec = OFF_mod + al256((size_t)4 * 5 * 3072 * 4);
constexpr size_t OFF_ropes = OFF_ropec + al256((size_t)1024 * 32 * 4);
constexpr size_t OFF_lam = OFF_ropes + al256((size_t)1024 * 32 * 4);
constexpr size_t OFF_hbuf = OFF_lam + al256((size_t)256);
constexpr size_t OFF_xbuf = OFF_hbuf + al256((size_t)NTOK * 1024 * 2);
constexpr size_t OFF_proj = OFF_xbuf + al256((size_t)NTOK * 1024 * 4);
constexpr size_t OFF_Qa = OFF_proj + al256((size_t)NTOK * NPROJ * 2);
constexpr size_t OFF_Ka = OFF_Qa + al256((size_t)NTOK * 768 * 2);
constexpr size_t OFF_VaT = OFF_Ka + al256((size_t)NTOK * 768 * 2);
constexpr size_t OFF_Kb = OFF_VaT + al256((size_t)NTOK * 512 * 2);
constexpr size_t OFF_VbT = OFF_Kb + al256((size_t)NTOK * 512 * 2);
constexpr size_t OFF_VmT = OFF_VbT + al256((size_t)NTOK * 512 * 2);
constexpr size_t OFF_ycat = OFF_VmT + al256((size_t)NTOK * 512 * 2);
constexpr size_t OFF_gates = OFF_ycat + al256((size_t)NTOK * 1536 * 2);
constexpr size_t OFF_Cst = OFF_gates + al256((size_t)NTOK * 16 * 4);
constexpr size_t OFF_nst = OFF_Cst + al256((size_t)1024 * 16384 * 2);
constexpr size_t OFF_mst = OFF_nst + al256((size_t)1024 * 128 * 4);
constexpr size_t OFF_cckv = OFF_mst + al256((size_t)1024 * 4);
constexpr size_t OFF_cKa = OFF_cckv + al256((size_t)4096 * 256 * 2);
constexpr size_t OFF_cVaT = OFF_cKa + al256((size_t)64 * 256 * 192 * 2);
constexpr size_t OFF_cKb = OFF_cVaT + al256((size_t)64 * 128 * 256 * 2);
constexpr size_t OFF_cVbT = OFF_cKb + al256((size_t)64 * 256 * 128 * 2);
constexpr size_t OFF_blA = OFF_cVbT + al256((size_t)64 * 128 * 256 * 2);
constexpr size_t OFF_mlA = OFF_blA + 4096;
constexpr size_t OFF_ctr = OFF_mlA + 4096;
constexpr size_t OFF_qc = OFF_ctr + 16384;
constexpr size_t WS_TOTAL = OFF_qc + 4096;
struct P {
  const float *x_prompt, *x_sample, *c_ckv, *c_krope, *c_dk, *c_dv, *st_C, *st_n, *st_m, *c, *c_ctx, *g_norm, *W_mod,
      *b_mod, *W_in, *q_norm, *W_uq, *kv_norm, *W_ukv, *dlam, *dnorm, *mconv, *mgb, *mnorm, *W_out, *g_final;
  float* out;
  char* ws;
  __device__ __forceinline__ bf16* WinT() const { return (bf16*)(ws + OFF_WinT); }
  __device__ __forceinline__ bf16* WuqT() const { return (bf16*)(ws + OFF_WuqT); }
  __device__ __forceinline__ bf16* WukvT() const { return (bf16*)(ws + OFF_WukvT); }
  __device__ __forceinline__ bf16* WukvTp() const { return (bf16*)(ws + OFF_WukvTp); }
  __device__ __forceinline__ bf16* WoutT() const { return (bf16*)(ws + OFF_WoutT); }
  __device__ __forceinline__ float* mod() const { return (float*)(ws + OFF_mod); }
  __device__ __forceinline__ float* ropec() const { return (float*)(ws + OFF_ropec); }
  __device__ __forceinline__ float* ropes() const { return (float*)(ws + OFF_ropes); }
  __device__ __forceinline__ float* lam() const { return (float*)(ws + OFF_lam); }
  __device__ __forceinline__ bf16* hbuf() const { return (bf16*)(ws + OFF_hbuf); }
  __device__ __forceinline__ float* xbuf() const { return (float*)(ws + OFF_xbuf); }
  __device__ __forceinline__ bf16* proj() const { return (bf16*)(ws + OFF_proj); }
  __device__ __forceinline__ bf16* Qa() const { return (bf16*)(ws + OFF_Qa); }
  __device__ __forceinline__ bf16* Ka() const { return (bf16*)(ws + OFF_Ka); }
  __device__ __forceinline__ bf16* VaT() const { return (bf16*)(ws + OFF_VaT); }
  __device__ __forceinline__ bf16* Kb() const { return (bf16*)(ws + OFF_Kb); }
  __device__ __forceinline__ bf16* VbT() const { return (bf16*)(ws + OFF_VbT); }
  __device__ __forceinline__ bf16* VmT() const { return (bf16*)(ws + OFF_VmT); }
  __device__ __forceinline__ bf16* ycat() const { return (bf16*)(ws + OFF_ycat); }
  __device__ __forceinline__ float* gates() const { return (float*)(ws + OFF_gates); }
  __device__ __forceinline__ bf16* Cst() const { return (bf16*)(ws + OFF_Cst); }
  __device__ __forceinline__ float* nst() const { return (float*)(ws + OFF_nst); }
  __device__ __forceinline__ float* mst() const { return (float*)(ws + OFF_mst); }
  __device__ __forceinline__ bf16* cckv() const { return (bf16*)(ws + OFF_cckv); }
  __device__ __forceinline__ bf16* cKa() const { return (bf16*)(ws + OFF_cKa); }
  __device__ __forceinline__ bf16* cVaT() const { return (bf16*)(ws + OFF_cVaT); }
  __device__ __forceinline__ bf16* cKb() const { return (bf16*)(ws + OFF_cKb); }
  __device__ __forceinline__ bf16* cVbT() const { return (bf16*)(ws + OFF_cVbT); }
  __device__ __forceinline__ int* ctr() const { return (int*)(ws + OFF_ctr); }
  __device__ __forceinline__ int* qc() const { return (int*)(ws + OFF_qc); }
  __device__ __forceinline__ float* blA() const { return (float*)(ws + OFF_blA); }
  __device__ __forceinline__ float* mlA() const { return (float*)(ws + OFF_mlA); }
};

DI int tidx() { int t = threadIdx.x; asm volatile("" : "+v"(t)); return t; }
DI void tidx_init() {}
DI int wave_of(int tid) { return __builtin_amdgcn_readfirstlane(tid >> 6); }
typedef __attribute__((ext_vector_type(2))) __bf16 bf16v2;
typedef __attribute__((ext_vector_type(2))) float f32x2;
DI unsigned pack2(float a, float b) {
  f32x2 v; v[0] = a; v[1] = b;
  return __builtin_bit_cast(unsigned, __builtin_convertvector(v, bf16v2));
}
DI bf16 f2bf(float x) { return (bf16)(pack2(x, 0.f) & 0xffffu); }
DI float bf2f(bf16 b) { return __uint_as_float(((unsigned)b) << 16); }
DI float fexp2(float x) { return __builtin_amdgcn_exp2f(x); }
DI float fexp(float x) { return __builtin_amdgcn_exp2f(x * 1.4426950408889634f); }
DI float bflo(unsigned u) { return __uint_as_float(u << 16); }
DI float bfhi(unsigned u) { return __uint_as_float(u & 0xffff0000u); }
DI float silu_f(float x) { return x * __builtin_amdgcn_rcpf(1.f + fexp(-x)); }
DI float sigmoid_f(float x) { return __builtin_amdgcn_rcpf(1.f + fexp(-x)); }
DI float logsig_f(float x) { return fminf(x, 0.f) - log1pf(fexp(-fabsf(x))); }

struct TokInfo { int lat, b, t, T, tok0, modj; };
DI TokInfo tinfo(int tok) {
  TokInfo r;
  if (tok < 4096) { r.lat = 0; r.b = tok >> 8; r.t = tok & 255; r.T = 256; r.tok0 = tok & ~255; r.modj = 0; }
  else { int u = tok - 4096; r.lat = 1; r.b = u >> 10; r.t = u & 1023; r.T = 1024; r.tok0 = 4096 + (u & ~1023); r.modj = 1 + r.b; }
  return r;
}

struct GR { u32x4 ra0[4], rb0[4], ra1[4], rb1[4]; };
DI void gemm_load2(GR& g, const bf16* __restrict__ A, int lda, const bf16* __restrict__ Bt, int ldb) {
  const int tid = tidx();
  const int lr = tid >> 3, lc = tid & 7;
  const bf16* ap = A + (size_t)lr * lda + lc * 8;
  const bf16* bp = Bt + (size_t)lr * ldb + lc * 8;
  const size_t a32 = (size_t)32 * lda, b32 = (size_t)32 * ldb;
#pragma unroll
  for (int i = 0; i < 4; ++i) { g.ra0[i] = *(const u32x4*)(ap + i * a32); g.rb0[i] = *(const u32x4*)(bp + i * b32); }
#pragma unroll
  for (int i = 0; i < 4; ++i) { g.ra1[i] = *(const u32x4*)(ap + 64 + i * a32); g.rb1[i] = *(const u32x4*)(bp + 64 + i * b32); }
}
template <bool ROWSS>
DI void gemm_core_n(GR& g, const bf16* __restrict__ A, int lda, const bf16* __restrict__ Bt, int ldb,
                    const bf16* __restrict__ An, const bf16* __restrict__ Btn, int K, char* smem, f32x16 (&acc)[2][2]) {
  bf16* sA = (bf16*)smem;
  bf16* sB = sA + 128 * 72;
  float* sRow = (float*)(sB + 128 * 72);
  const int tid = tidx(), lane = tid & 63, w = wave_of(tid);
  const int wm = w >> 1, wn = w & 1, lq = lane & 31, h = lane >> 5;
  const int lr = tid >> 3, lc = tid & 7;
  float ss[4] = {0.f, 0.f, 0.f, 0.f};
#pragma unroll
  for (int i = 0; i < 2; ++i)
#pragma unroll
    for (int j = 0; j < 2; ++j)
#pragma unroll
      for (int r = 0; r < 16; ++r) acc[i][j][r] = 0.f;
  const bf16* ap = A + (size_t)lr * lda + lc * 8;
  const bf16* bp = Bt + (size_t)lr * ldb + lc * 8;
  const bf16* apn = An + (size_t)lr * lda + lc * 8;
  const bf16* bpn = Btn + (size_t)lr * ldb + lc * 8;
  const size_t a32 = (size_t)32 * lda, b32 = (size_t)32 * ldb;
  const int nk = K >> 6;
  auto step = [&](u32x4 (&ra)[4], u32x4 (&rb)[4], int kt) {
    if (kt) __syncthreads();
#pragma unroll
    for (int i = 0; i < 4; ++i) {
      *(u32x4*)(sA + (lr + 32 * i) * 72 + lc * 8) = ra[i];
      *(u32x4*)(sB + (lr + 32 * i) * 72 + lc * 8) = rb[i];
    }
    if (ROWSS) {
#pragma unroll
      for (int i = 0; i < 4; ++i)
#pragma unroll
        for (int e = 0; e < 4; ++e) {
          float a0 = bflo(ra[i][e]), a1 = bfhi(ra[i][e]);
          ss[i] += a0 * a0 + a1 * a1;
        }
    }
    __syncthreads();
    {
      const int kn = kt + 2;
      const bf16* ap2 = (kn < nk) ? ap + (size_t)kn * 64 : apn + (size_t)(kn - nk) * 64;
      const bf16* bp2 = (kn < nk) ? bp + (size_t)kn * 64 : bpn + (size_t)(kn - nk) * 64;
#pragma unroll
      for (int i = 0; i < 4; ++i) { ra[i] = *(const u32x4*)(ap2 + i * a32); rb[i] = *(const u32x4*)(bp2 + i * b32); }
    }
#pragma unroll
    for (int ks = 0; ks < 4; ++ks) {
      bf16x8 af[2], bfr[2];
#pragma unroll
      for (int i = 0; i < 2; ++i) af[i] = *(const bf16x8*)(sA + (wm * 64 + i * 32 + lq) * 72 + ks * 16 + h * 8);
#pragma unroll
      for (int j = 0; j < 2; ++j) bfr[j] = *(const bf16x8*)(sB + (wn * 64 + j * 32 + lq) * 72 + ks * 16 + h * 8);
#pragma unroll
      for (int i = 0; i < 2; ++i)
#pragma unroll
        for (int j = 0; j < 2; ++j) acc[i][j] = MFMA(af[i], bfr[j], acc[i][j]);
    }
  };
  for (int kt = 0; kt < nk; kt += 2) {
    step(g.ra0, g.rb0, kt);
    step(g.ra1, g.rb1, kt + 1);
  }
  if (ROWSS) {
#pragma unroll
    for (int i = 0; i < 4; ++i) {
      float v = ss[i];
      v += __shfl_xor(v, 1); v += __shfl_xor(v, 2); v += __shfl_xor(v, 4);
      if (lc == 0) sRow[lr + 32 * i] = v;
    }
  }
  __syncthreads();
}
template <bool ROWSS>
DI void gemm_core(const bf16* __restrict__ A, int lda, const bf16* __restrict__ Bt, int ldb, int K, char* smem,
                  f32x16 (&acc)[2][2]) {
  GR g;
  gemm_load2(g, A, lda, Bt, ldb);
  gemm_core_n<ROWSS>(g, A, lda, Bt, ldb, A, Bt, K, smem, acc);
}

template <bool ROWSS = false>
DI void gemm_core_w(const bf16* __restrict__ A, int lda, const bf16* __restrict__ Bt, int ldb, int K, char* smem,
                    f32x16 (&acc)[2][4]) {
  bf16* sA = (bf16*)smem;
  bf16* sB = sA + 128 * 72;
  const int tid = tidx(), lane = tid & 63, w = wave_of(tid);
  const int wm = w >> 1, wn = w & 1, lq = lane & 31, h = lane >> 5;
  const int lr = tid >> 3, lc = tid & 7;
  u32x4 ra[4], rb[8];
  float ssw[4] = {0.f, 0.f, 0.f, 0.f};
#pragma unroll
  for (int i = 0; i < 2; ++i)
#pragma unroll
    for (int j = 0; j < 4; ++j)
#pragma unroll
      for (int r = 0; r < 16; ++r) acc[i][j][r] = 0.f;
  const bf16* ap = A + (size_t)lr * lda + lc * 8;
  const bf16* bp = Bt + (size_t)lr * ldb + lc * 8;
  const size_t a32 = (size_t)32 * lda, b32 = (size_t)32 * ldb;
#pragma unroll
  for (int i = 0; i < 4; ++i) ra[i] = *(const u32x4*)(ap + i * a32);
#pragma unroll
  for (int i = 0; i < 8; ++i) rb[i] = *(const u32x4*)(bp + i * b32);
  const int nk = K >> 6;
  for (int kt = 0; kt < nk; ++kt) {
    if (kt) __syncthreads();
#pragma unroll
    for (int i = 0; i < 4; ++i) *(u32x4*)(sA + (lr + 32 * i) * 72 + lc * 8) = ra[i];
#pragma unroll
    for (int i = 0; i < 8; ++i) *(u32x4*)(sB + (lr + 32 * i) * 72 + lc * 8) = rb[i];
    if (ROWSS) {
#pragma unroll
      for (int i = 0; i < 4; ++i)
#pragma unroll
        for (int e = 0; e < 4; ++e) {
          float a0 = bflo(ra[i][e]), a1 = bfhi(ra[i][e]);
          ssw[i] += a0 * a0 + a1 * a1;
        }
    }
    __syncthreads();
    {
      const int kn = (kt + 1 < nk) ? kt + 1 : kt;
      const bf16* ap2 = ap + (size_t)kn * 64;
      const bf16* bp2 = bp + (size_t)kn * 64;
#pragma unroll
      for (int i = 0; i < 4; ++i) ra[i] = *(const u32x4*)(ap2 + i * a32);
#pragma unroll
      for (int i = 0; i < 8; ++i) rb[i] = *(const u32x4*)(bp2 + i * b32);
    }
#pragma unroll
    for (int ks = 0; ks < 4; ++ks) {
      bf16x8 af[2], bfr[4];
#pragma unroll
      for (int i = 0; i < 2; ++i) af[i] = *(const bf16x8*)(sA + (wm * 64 + i * 32 + lq) * 72 + ks * 16 + h * 8);
#pragma unroll
      for (int j = 0; j < 4; ++j) bfr[j] = *(const bf16x8*)(sB + (wn * 128 + j * 32 + lq) * 72 + ks * 16 + h * 8);
#pragma unroll
      for (int i = 0; i < 2; ++i)
#pragma unroll
        for (int j = 0; j < 4; ++j) acc[i][j] = MFMA(af[i], bfr[j], acc[i][j]);
    }
  }
  if (ROWSS) {
    float* sRow = (float*)(smem + (128 + 256) * 72 * 2);
#pragma unroll
    for (int i = 0; i < 4; ++i) {
      float v = ssw[i];
      v += __shfl_xor(v, 1); v += __shfl_xor(v, 2); v += __shfl_xor(v, 4);
      if (lc == 0) sRow[lr + 32 * i] = v;
    }
  }
  __syncthreads();
}

DI void store_vt4(bf16* VT, size_t idx, float a, float b, float c, float d) {
  u32x2 v; v[0] = pack2(a, b); v[1] = pack2(c, d);
  *(u32x2*)(VT + idx) = v;
}

DI void transpose_tile(const float* __restrict__ src, int N, int Nvalid, bf16* __restrict__ dst, int K, int k0, int n0,
                       const float* __restrict__ gk, bf16* __restrict__ dst2, char* smem) {
  float* t = (float*)smem;
  const int tid = tidx();
  f32x4 tv[4];
#pragma unroll
  for (int i = 0; i < 4; ++i) {
    int idx = tid + 256 * i; int r = idx >> 4, c = (idx & 15) * 4;
    int n = n0 + c;
    tv[i] = f32x4{0.f, 0.f, 0.f, 0.f};
    if (n < Nvalid) tv[i] = __builtin_nontemporal_load((const f32x4*)(src + (size_t)(k0 + r) * N + n));
  }
#pragma unroll
  for (int i = 0; i < 4; ++i) {
    int idx = tid + 256 * i; int r = idx >> 4, c = (idx & 15) * 4;
    t[r * 65 + c] = tv[i][0]; t[r * 65 + c + 1] = tv[i][1]; t[r * 65 + c + 2] = tv[i][2]; t[r * 65 + c + 3] = tv[i][3];
  }
  __syncthreads();
  const int c2h = (tid & 31) * 2;
  const float gk0 = gk ? gk[k0 + c2h] : 1.f, gk1 = gk ? gk[k0 + c2h + 1] : 1.f;
#pragma unroll
  for (int i = 0; i < 8; ++i) {
    int idx = tid + 256 * i; int r = idx >> 5, c2 = (idx & 31) * 2;
    float v0 = t[c2 * 65 + r], v1 = t[(c2 + 1) * 65 + r];
    if (dst2) *(unsigned*)(dst2 + (size_t)(n0 + r) * K + k0 + c2) = pack2(v0, v1);
    v0 *= gk0; v1 *= gk1;
    *(unsigned*)(dst + (size_t)(n0 + r) * K + k0 + c2) = pack2(v0, v1);
  }
  __syncthreads();
}

DI void mod_item(const P& p, int it, char* smem) {
  float* sl = (float*)smem;
  float* red = sl + 5 * 1024;
  const int tid = tidx(), lane = tid & 63, w = wave_of(tid);
  const int l = it / 48, n0 = (it % 48) * 64;
  {
    float cvv[20];
#pragma unroll
    for (int i = 0; i < 20; ++i) {
      int idx = tid + 256 * i; int j = idx >> 10, k = idx & 1023;
      cvv[i] = (j == 0) ? p.c_ctx[k] : p.c[(j - 1) * 1024 + k];
    }
#pragma unroll
    for (int i = 0; i < 20; ++i) sl[tid + 256 * i] = silu_f(cvv[i]);
  }
  __syncthreads();
  float a[5] = {0.f, 0.f, 0.f, 0.f, 0.f};
  const float* wp = p.W_mod + (size_t)l * 1024 * 3072 + n0 + lane;
  for (int k = w * 256; k < w * 256 + 256; k += 16) {
    float wv[16];
#pragma unroll
    for (int u = 0; u < 16; ++u) wv[u] = __builtin_nontemporal_load(wp + (size_t)(k + u) * 3072);
#pragma unroll
    for (int u = 0; u < 16; ++u)
#pragma unroll
      for (int j = 0; j < 5; ++j) a[j] += sl[j * 1024 + k + u] * wv[u];
  }
#pragma unroll
  for (int j = 0; j < 5; ++j) red[(w * 5 + j) * 64 + lane] = a[j];
  __syncthreads();
  for (int idx = tid; idx < 320; idx += 256) {
    int j = idx >> 6, c = idx & 63;
    float s = red[(0 * 5 + j) * 64 + c] + red[(1 * 5 + j) * 64 + c] + red[(2 * 5 + j) * 64 + c] + red[(3 * 5 + j) * 64 + c];
    p.mod()[(size_t)(l * 5 + j) * 3072 + n0 + c] = s + p.b_mod[l * 3072 + n0 + c];
  }
  __syncthreads();
}

DI void phase_prepass(const P& p, char* smem) {
  const int G = gridDim.x, B = blockIdx.x, tid = tidx();
  const int N_MOD = 192, N_WIN = 4 * 92 * 16, N_WOUT = 4 * 16 * 24, N_WUQ = 4 * 12 * 6, N_WUKV = 4 * 16 * 4;
  const int total = N_MOD + N_WIN + N_WOUT + N_WUQ + N_WUKV;
  for (int it = B; it < total; it += G) {
    int u = it;
    if (u < N_MOD) { mod_item(p, u, smem); continue; }
    u -= N_MOD;
    if (u < N_WIN) {
      int l = u / (92 * 16), r = u % (92 * 16), nt = r / 16, kt = r % 16;
      transpose_tile(p.W_in + (size_t)l * 1024 * 5840, 5840, 5840, p.WinT() + (size_t)l * NPROJ * 1024, 1024, kt * 64, nt * 64, nullptr, nullptr, smem);
      continue;
    }
    u -= N_WIN;
    if (u < N_WOUT) {
      int l = u / (16 * 24), r = u % (16 * 24), nt = r / 24, kt = r % 24;
      transpose_tile(p.W_out + (size_t)l * 1536 * 1024, 1024, 1024, p.WoutT() + (size_t)l * 1024 * 1536, 1536, kt * 64, nt * 64, nullptr, nullptr, smem);
      continue;
    }
    u -= N_WOUT;
    if (u < N_WUQ) {
      int l = u / 72, r = u % 72, nt = r / 6, kt = r % 6;
      transpose_tile(p.W_uq + (size_t)l * 384 * 768, 768, 768, p.WuqT() + (size_t)l * 768 * 384, 384, kt * 64, nt * 64, p.q_norm + l * 384, nullptr, smem);
      continue;
    }
    u -= N_WUQ;
    {
      int l = u / 64, r = u % 64, nt = r / 4, kt = r % 4;
      transpose_tile(p.W_ukv + (size_t)l * 256 * 1024, 1024, 1024, p.WukvT() + (size_t)l * 1024 * 256, 256, kt * 64, nt * 64, p.kv_norm + l * 256, p.WukvTp() + (size_t)l * 1024 * 256, smem);
    }
  }
  const int gtid = B * 256 + tid, gsz = G * 256;
  for (int idx = gtid; idx < 1024 * 32; idx += gsz) {
    int t = idx >> 5, i = idx & 31;
    float pos = (i < 16) ? (float)(t >> 6) : (float)(t & 63);
    float inv = powf(10000.f, -(float)(i & 15) / 16.f);
    float ang = pos * inv;
    p.ropec()[idx] = cosf(ang); p.ropes()[idx] = sinf(ang);
  }
  if (gtid < 4) {
    int l = gtid; const float* lp = p.dlam + l * 256;
    float s1 = 0.f, s2 = 0.f;
    for (int i = 0; i < 64; ++i) { s1 += lp[i] * lp[64 + i]; s2 += lp[128 + i] * lp[192 + i]; }
    float lam_init = 0.8f - 0.6f * expf(-0.3f * (float)l);
    p.lam()[l] = expf(s1) - expf(s2) + lam_init;
  }
  for (int idx = gtid; idx < 4 * 4 * 256 * 256; idx += gsz) {
    int d = idx & 255, t = (idx >> 8) & 255, b = (idx >> 16) & 3, l = idx >> 18;
    p.cckv()[idx] = f2bf(p.c_ckv[(size_t)((b * 4 + l) * 256 + t) * 256 + d]);
  }
  for (int idx = gtid; idx < 4 * 4 * 4 * 256 * 64; idx += gsz) {
    int r = idx & 63, t = (idx >> 6) & 255, hd = (idx >> 14) & 3, b = (idx >> 16) & 3, l = idx >> 18;
    p.cKa()[(size_t)((((l * 4 + b) * 4 + hd) * 256) + t) * 192 + 128 + r] = f2bf(p.c_krope[(size_t)((b * 4 + l) * 256 + t) * 64 + r]);
  }
  for (int idx = gtid; idx < 4 * 4 * 4 * 256 * 128; idx += gsz) {
    int d = idx & 127, t = (idx >> 7) & 255, hd = (idx >> 15) & 3, b = (idx >> 17) & 3, l = idx >> 19;
    p.cKb()[idx] = f2bf(p.c_dk[(size_t)(((b * 4 + l) * 256 + t) * 4 + hd) * 128 + d]);
  }
  for (int idx = gtid; idx < 4 * 4 * 4 * 128 * 256; idx += gsz) {
    int t = idx & 255, d = (idx >> 8) & 127, hd = (idx >> 15) & 3, b = (idx >> 17) & 3, l = idx >> 19;
    p.cVbT()[idx] = f2bf(p.c_dv[(size_t)(((b * 4 + l) * 256 + t) * 4 + hd) * 128 + d]);
  }
}

DI void norm_rows4(const P& p, int l, int tok0, int mode) {
  const int lane = tidx() & 63;
  TokInfo ti = tinfo(tok0);
  const float* x;
  if (mode == 0 && l == 0) x = ti.lat ? (p.x_sample + (size_t)(tok0 - 4096) * 1024) : (p.x_prompt + (size_t)tok0 * 1024);
  else x = p.xbuf() + (size_t)tok0 * 1024;
  f32x4 v[4][4];
#pragma unroll
  for (int k = 0; k < 4; ++k)
#pragma unroll
    for (int i = 0; i < 4; ++i) v[k][i] = *(const f32x4*)(x + (size_t)k * 1024 + i * 256 + lane * 4);
  float rstd[4];
#pragma unroll
  for (int k = 0; k < 4; ++k) {
    float ss = 0.f;
#pragma unroll
    for (int i = 0; i < 4; ++i) ss += v[k][i][0] * v[k][i][0] + v[k][i][1] * v[k][i][1] + v[k][i][2] * v[k][i][2] + v[k][i][3] * v[k][i][3];
#pragma unroll
    for (int o = 32; o >= 1; o >>= 1) ss += __shfl_xor(ss, o);
    rstd[k] = rsqrtf(ss * (1.f / 1024.f) + EPS);
  }
  if (mode == 0) {
    const float* g = p.g_norm + l * 1024;
    const float* md = p.mod() + (size_t)(l * 5 + ti.modj) * 3072;
#pragma unroll
    for (int i = 0; i < 4; ++i) {
      int c = i * 256 + lane * 4;
      f32x4 gv = *(const f32x4*)(g + c), sh = *(const f32x4*)(md + c), sc = *(const f32x4*)(md + 1024 + c);
#pragma unroll
      for (int k = 0; k < 4; ++k) {
        float o0 = v[k][i][0] * rstd[k] * gv[0] * (1.f + sc[0]) + sh[0];
        float o1 = v[k][i][1] * rstd[k] * gv[1] * (1.f + sc[1]) + sh[1];
        float o2 = v[k][i][2] * rstd[k] * gv[2] * (1.f + sc[2]) + sh[2];
        float o3 = v[k][i][3] * rstd[k] * gv[3] * (1.f + sc[3]) + sh[3];
        u32x2 pk; pk[0] = pack2(o0, o1); pk[1] = pack2(o2, o3);
        *(u32x2*)(p.hbuf() + (size_t)(tok0 + k) * 1024 + c) = pk;
      }
    }
  } else {
    float* o = p.out + (ti.lat ? (O_YS + (size_t)(tok0 - 4096) * 1024) : (O_YP + (size_t)tok0 * 1024));
#pragma unroll
    for (int i = 0; i < 4; ++i) {
      int c = i * 256 + lane * 4;
      f32x4 gv = *(const f32x4*)(p.g_final + c);
#pragma unroll
      for (int k = 0; k < 4; ++k) {
        f32x4 r; r[0] = v[k][i][0] * rstd[k] * gv[0]; r[1] = v[k][i][1] * rstd[k] * gv[1]; r[2] = v[k][i][2] * rstd[k] * gv[2]; r[3] = v[k][i][3] * rstd[k] * gv[3];
        *(f32x4*)(o + (size_t)k * 1024 + c) = r;
      }
    }
  }
}

DI void norm_row(const P& p, int l, int tok, int mode) {
  const int lane = tidx() & 63;
  TokInfo ti = tinfo(tok);
  const float* x;
  if (mode == 0 && l == 0) x = ti.lat ? (p.x_sample + (size_t)(tok - 4096) * 1024) : (p.x_prompt + (size_t)tok * 1024);
  else x = p.xbuf() + (size_t)tok * 1024;
  f32x4 v[4];
  float ss = 0.f;
#pragma unroll
  for (int i = 0; i < 4; ++i) {
    v[i] = *(const f32x4*)(x + i * 256 + lane * 4);
    ss += v[i][0] * v[i][0] + v[i][1] * v[i][1] + v[i][2] * v[i][2] + v[i][3] * v[i][3];
  }
#pragma unroll
  for (int o = 32; o >= 1; o >>= 1) ss += __shfl_xor(ss, o);
  const float rstd = rsqrtf(ss * (1.f / 1024.f) + EPS);
  if (mode == 0) {
    const float* g = p.g_norm + l * 1024;
    const float* md = p.mod() + (size_t)(l * 5 + ti.modj) * 3072;
#pragma unroll
    for (int i = 0; i < 4; ++i) {
      int c = i * 256 + lane * 4;
      f32x4 gv = *(const f32x4*)(g + c), sh = *(const f32x4*)(md + c), sc = *(const f32x4*)(md + 1024 + c);
      float o0 = v[i][0] * rstd * gv[0] * (1.f + sc[0]) + sh[0];
      float o1 = v[i][1] * rstd * gv[1] * (1.f + sc[1]) + sh[1];
      float o2 = v[i][2] * rstd * gv[2] * (1.f + sc[2]) + sh[2];
      float o3 = v[i][3] * rstd * gv[3] * (1.f + sc[3]) + sh[3];
      u32x2 pk; pk[0] = pack2(o0, o1); pk[1] = pack2(o2, o3);
      *(u32x2*)(p.hbuf() + (size_t)tok * 1024 + c) = pk;
    }
  } else {
    float* o = p.out + (ti.lat ? (O_YS + (size_t)(tok - 4096) * 1024) : (O_YP + (size_t)tok * 1024));
#pragma unroll
    for (int i = 0; i < 4; ++i) {
      int c = i * 256 + lane * 4;
      f32x4 gv = *(const f32x4*)(p.g_final + c);
      f32x4 r; r[0] = v[i][0] * rstd * gv[0]; r[1] = v[i][1] * rstd * gv[1]; r[2] = v[i][2] * rstd * gv[2]; r[3] = v[i][3] * rstd * gv[3];
      *(f32x4*)(o + c) = r;
    }
  }
}

DI void img_put(bf16* img, const f32x16 (&acc)[2][2], int wm, int wn, int lq, int h) {
#pragma unroll
  for (int i = 0; i < 2; ++i)
#pragma unroll
    for (int j = 0; j < 2; ++j)
#pragma unroll
      for (int r = 0; r < 16; ++r)
        img[(wm * 64 + i * 32 + 8 * (r >> 2) + 4 * h + (r & 3)) * 136 + wn * 64 + j * 32 + lq] = f2bf(acc[i][j][r]);
}
DI void img_copy(const bf16* img, int half, bf16* dst, size_t stride, int tid) {
  u32x4 v[4];
#pragma unroll
  for (int i = 0; i < 4; ++i) { int idx = tid + 256 * i; int r = idx >> 3, c16 = idx & 7; v[i] = *(const u32x4*)(img + r * 136 + half * 64 + c16 * 8); }
#pragma unroll
  for (int i = 0; i < 4; ++i) { int idx = tid + 256 * i; int r = idx >> 3, c16 = idx & 7; *(u32x4*)(dst + (size_t)r * stride + c16 * 8) = v[i]; }
}
DI bool inproj_rm(int cb) { return !((cb >= 35 && cb <= 42) || (cb >= 67 && cb <= 74) || cb == 91); }

DI void epi_inproj(const P& p, int l, int m0, int n0, f32x16 (&acc)[2][2], char* smem) {
  const int tid_ = tidx(); const int lane = tid_ & 63, w = wave_of(tid_), wm = w >> 1, wn = w & 1, lq = lane & 31, h = lane >> 5;
  const int mb = m0 + wm * 64, nb = n0 + wn * 64;
  const int cb = nb >> 6;
  bf16* img = (bf16*)smem;
  TokInfo tb = tinfo(mb);
  const bool lat = tb.lat;
  if (!lat && (cb == 10 || (cb >= 27 && cb <= 34))) {
    float* ob = (cb == 10) ? p.out + O_KROPE + (size_t)((tb.b * 4 + l) * 256) * 64
                           : p.out + O_DK + (size_t)((tb.b * 4 + l) * 256) * 512 + (cb - 27) * 64;
    const int ostr = (cb == 10) ? 64 : 512;
#pragma unroll
    for (int i = 0; i < 2; ++i)
#pragma unroll
      for (int j = 0; j < 2; ++j)
#pragma unroll
        for (int r = 0; r < 16; ++r) {
          int tl = tb.t + i * 32 + 8 * (r >> 2) + 4 * h + (r & 3);
          ob[(size_t)tl * ostr + j * 32 + lq] = acc[i][j][r];
        }
  }
  const bool ropeT = lat && (cb == 10 || (cb >= 19 && cb <= 34));
  if (ropeT) {
#pragma unroll
    for (int i = 0; i < 2; ++i) {
      float cs[16], sn[16];
#pragma unroll
      for (int r = 0; r < 16; ++r) {
        int t = tb.t + i * 32 + 8 * (r >> 2) + 4 * h + (r & 3);
        cs[r] = p.ropec()[t * 32 + lq]; sn[r] = p.ropes()[t * 32 + lq];
      }
#pragma unroll
      for (int r = 0; r < 16; ++r) {
        float x1 = acc[i][0][r], x2 = acc[i][1][r];
        acc[i][0][r] = x1 * cs[r] - x2 * sn[r];
        acc[i][1][r] = x1 * sn[r] + x2 * cs[r];
      }
    }
  }
  if (inproj_rm(cb)) {
    img_put(img, acc, wm, wn, lq, h);
  } else if (cb == 91) {
    if (lq < 16) {
      float bias = p.mgb[l * 16 + lq];
#pragma unroll
      for (int i = 0; i < 2; ++i)
#pragma unroll
        for (int r = 0; r < 16; ++r) {
          int row = mb + i * 32 + 8 * (r >> 2) + 4 * h + (r & 3);
          p.gates()[row * 16 + lq] = acc[i][0][r] + bias;
        }
    }
  } else {
    const bool isdv = cb <= 42;
    int cc = isdv ? cb - 35 : cb - 67;
    int hd = cc >> 1, sub = cc & 1;
    bf16* VT = isdv ? p.VbT() : p.VmT();
#pragma unroll
    for (int i = 0; i < 2; ++i)
#pragma unroll
      for (int j = 0; j < 2; ++j) {
        int d = sub * 64 + j * 32 + lq;
#pragma unroll
        for (int g = 0; g < 4; ++g) {
          int tl = tb.t + i * 32 + 8 * g + 4 * h;
          store_vt4(VT, (size_t)tb.tok0 * 512 + (size_t)(hd * 128 + d) * tb.T + tl, acc[i][j][4 * g], acc[i][j][4 * g + 1], acc[i][j][4 * g + 2], acc[i][j][4 * g + 3]);
          if (isdv && !lat) {
#pragma unroll
            for (int jj = 0; jj < 4; ++jj)
              p.out[O_DV + (size_t)((tb.b * 4 + l) * 256 + tl + jj) * 512 + cc * 64 + j * 32 + lq] = acc[i][j][4 * g + jj];
          }
        }
      }
  }
  __syncthreads();
#pragma unroll
  for (int half = 0; half < 2; ++half) {
    const int cbh = (n0 >> 6) + half;
    if (!inproj_rm(cbh)) continue;
    if (cbh == 10) {
#pragma unroll
      for (int hd = 0; hd < 4; ++hd) img_copy(img, half, p.Ka() + (size_t)m0 * 768 + hd * 192 + 128, 768, tid_);
    } else if (cbh >= 27 && cbh <= 34) {
      img_copy(img, half, p.Kb() + (size_t)m0 * 512 + (cbh - 27) * 64, 512, tid_);
    } else {
      img_copy(img, half, p.proj() + (size_t)m0 * NPROJ + cbh * 64, NPROJ, tid_);
    }
  }
  __syncthreads();
}

constexpr int IMGW = 264;
DI void img_copy_w(const bf16* img, int half, bf16* dst, size_t stride, int tid) {
  u32x4 v[4];
#pragma unroll
  for (int i = 0; i < 4; ++i) { int idx = tid + 256 * i; int r = idx >> 3, c16 = idx & 7; v[i] = *(const u32x4*)(img + r * IMGW + half * 64 + c16 * 8); }
#pragma unroll
  for (int i = 0; i < 4; ++i) { int idx = tid + 256 * i; int r = idx >> 3, c16 = idx & 7; *(u32x4*)(dst + (size_t)r * stride + c16 * 8) = v[i]; }
}
template <int JP>
DI void epi_inproj_cbw(const P& p, int l, int m0, int cb, int imgcol, f32x16 (&acc)[2][4], bf16* img) {
  const int tid_ = tidx(); const int lane = tid_ & 63, w = wave_of(tid_), wm = w >> 1, lq = lane & 31, h = lane >> 5;
  const int mb = m0 + wm * 64;
  TokInfo tb = tinfo(mb);
  const bool lat = tb.lat;
  if (!lat && (cb == 10 || (cb >= 27 && cb <= 34))) {
    float* ob = (cb == 10) ? p.out + O_KROPE + (size_t)((tb.b * 4 + l) * 256) * 64
                           : p.out + O_DK + (size_t)((tb.b * 4 + l) * 256) * 512 + (cb - 27) * 64;
    const int ostr = (cb == 10) ? 64 : 512;
#pragma unroll
    for (int i = 0; i < 2; ++i)
#pragma unroll
      for (int j = 0; j < 2; ++j)
#pragma unroll
        for (int r = 0; r < 16; ++r) {
          int tl = tb.t + i * 32 + 8 * (r >> 2) + 4 * h + (r & 3);
          ob[(size_t)tl * ostr + j * 32 + lq] = acc[i][2 * JP + j][r];
        }
  }
  if (lat && (cb == 10 || (cb >= 19 && cb <= 34))) {
#pragma unroll
    for (int i = 0; i < 2; ++i) {
      float cs[16], sn[16];
#pragma unroll
      for (int r = 0; r < 16; ++r) {
        int t = tb.t + i * 32 + 8 * (r >> 2) + 4 * h + (r & 3);
        cs[r] = p.ropec()[t * 32 + lq]; sn[r] = p.ropes()[t * 32 + lq];
      }
#pragma unroll
      for (int r = 0; r < 16; ++r) {
        float x1 = acc[i][2 * JP][r], x2 = acc[i][2 * JP + 1][r];
        acc[i][2 * JP][r] = x1 * cs[r] - x2 * sn[r];
        acc[i][2 * JP + 1][r] = x1 * sn[r] + x2 * cs[r];
      }
    }
  }
  if (inproj_rm(cb)) {
#pragma unroll
    for (int i = 0; i < 2; ++i)
#pragma unroll
      for (int j = 0; j < 2; ++j)
#pragma unroll
        for (int r = 0; r < 16; ++r)
          img[(wm * 64 + i * 32 + 8 * (r >> 2) + 4 * h + (r & 3)) * IMGW + imgcol + j * 32 + lq] = f2bf(acc[i][2 * JP + j][r]);
  } else if (cb == 91) {
    if (lq < 16) {
      float bias = p.mgb[l * 16 + lq];
#pragma unroll
      for (int i = 0; i < 2; ++i)
#pragma unroll
        for (int r = 0; r < 16; ++r) {
          int row = mb + i * 32 + 8 * (r >> 2) + 4 * h + (r & 3);
          p.gates()[row * 16 + lq] = acc[i][2 * JP][r] + bias;
        }
    }
  } else {
    const bool isdv = cb <= 42;
    int cc = isdv ? cb - 35 : cb - 67;
    int hd = cc >> 1, sub = cc & 1;
    bf16* VT = isdv ? p.VbT() : p.VmT();
#pragma unroll
    for (int i = 0; i < 2; ++i)
#pragma unroll
      for (int j = 0; j < 2; ++j) {
        int d = sub * 64 + j * 32 + lq;
#pragma unroll
        for (int g = 0; g < 4; ++g) {
          int tl = tb.t + i * 32 + 8 * g + 4 * h;
          store_vt4(VT, (size_t)tb.tok0 * 512 + (size_t)(hd * 128 + d) * tb.T + tl, acc[i][2 * JP + j][4 * g], acc[i][2 * JP + j][4 * g + 1], acc[i][2 * JP + j][4 * g + 2], acc[i][2 * JP + j][4 * g + 3]);
          if (isdv && !lat) {
#pragma unroll
            for (int jj = 0; jj < 4; ++jj)
              p.out[O_DV + (size_t)((tb.b * 4 + l) * 256 + tl + jj) * 512 + cc * 64 + j * 32 + lq] = acc[i][2 * JP + j][4 * g + jj];
          }
        }
      }
  }
}
DI void epi_inproj_w(const P& p, int l, int m0, int n0, f32x16 (&acc)[2][4], char* smem) {
  bf16* img = (bf16*)smem;
  const int tid_ = tidx(); const int wn = wave_of(tid_) & 1;
  const int cb0 = n0 >> 6;
  epi_inproj_cbw<0>(p, l, m0, cb0 + 2 * wn, (2 * wn) * 64, acc, img);
  epi_inproj_cbw<1>(p, l, m0, cb0 + 2 * wn + 1, (2 * wn + 1) * 64, acc, img);
  __syncthreads();
#pragma unroll
  for (int half = 0; half < 4; ++half) {
    const int cbh = cb0 + half;
    if (!inproj_rm(cbh)) continue;
    if (cbh == 10) {
#pragma unroll
      for (int hd = 0; hd < 4; ++hd) img_copy_w(img, half, p.Ka() + (size_t)m0 * 768 + hd * 192 + 128, 768, tid_);
    } else if (cbh >= 27 && cbh <= 34) {
      img_copy_w(img, half, p.Kb() + (size_t)m0 * 512 + (cbh - 27) * 64, 512, tid_);
    } else {
      img_copy_w(img, half, p.proj() + (size_t)m0 * NPROJ + cbh * 64, NPROJ, tid_);
    }
  }
  __syncthreads();
}

DI void epi_qa(const P& p, int m0, int n0, f32x16 (&acc)[2][2], const float* sRow) {
  const int tid_ = tidx(); const int lane = tid_ & 63, w = wave_of(tid_), wm = w >> 1, wn = w & 1, lq = lane & 31, h = lane >> 5;
  const int mb = m0 + wm * 64, nb = n0 + wn * 64;
  const int cb = nb >> 6, hd = cb / 3, part = cb % 3;
  TokInfo tb = tinfo(mb);
  const bool dorope = tb.lat && part == 2;
#pragma unroll
  for (int i = 0; i < 2; ++i) {
    float cs[16], sn[16];
#pragma unroll
    for (int r = 0; r < 16; ++r) { cs[r] = 1.f; sn[r] = 0.f; }
    if (dorope) {
#pragma unroll
      for (int r = 0; r < 16; ++r) {
        int t = tb.t + i * 32 + 8 * (r >> 2) + 4 * h + (r & 3);
        cs[r] = p.ropec()[t * 32 + lq]; sn[r] = p.ropes()[t * 32 + lq];
      }
    }
#pragma unroll
    for (int r = 0; r < 16; ++r) {
      int rl = wm * 64 + i * 32 + 8 * (r >> 2) + 4 * h + (r & 3);
      float rstd = rsqrtf(sRow[rl] * (1.f / 384.f) + EPS);
      float x1 = acc[i][0][r] * rstd, x2 = acc[i][1][r] * rstd;
      {
        float y1 = x1 * cs[r] - x2 * sn[r], y2 = x1 * sn[r] + x2 * cs[r];
        x1 = y1; x2 = y2;
      }
      int row = m0 + rl;
      bf16* q = p.Qa() + (size_t)(row * 4 + hd) * 192 + part * 64;
      q[lq] = f2bf(x1); q[32 + lq] = f2bf(x2);
    }
  }
}

DI void epi_kv(const P& p, int m0, int n0, f32x16 (&acc)[2][2], const float* sRow, bool cache) {
  const int tid_ = tidx(); const int lane = tid_ & 63, w = wave_of(tid_), wm = w >> 1, wn = w & 1, lq = lane & 31, h = lane >> 5;
  const int mb = m0 + wm * 64, nb = n0 + wn * 64;
  const int cb = nb >> 6, hd = cb >> 2, part = cb & 3;
  TokInfo tb = tinfo(mb);
#pragma unroll
  for (int i = 0; i < 2; ++i)
#pragma unroll
    for (int j = 0; j < 2; ++j)
#pragma unroll
      for (int g = 0; g < 4; ++g) {
        float v[4];
#pragma unroll
        for (int jj = 0; jj < 4; ++jj) {
          int rl = wm * 64 + i * 32 + 8 * g + 4 * h + jj;
          float rstd = cache ? 1.f : rsqrtf(sRow[rl] * (1.f / 256.f) + EPS);
          v[jj] = acc[i][j][4 * g + jj] * rstd;
        }
        int c = j * 32 + lq;
        int row0 = mb + i * 32 + 8 * g + 4 * h;
        if (part < 2) {
#pragma unroll
          for (int jj = 0; jj < 4; ++jj) {
            int row = row0 + jj;
            if (cache) {
              int lb = row >> 8, t = row & 255;
              p.cKa()[(size_t)((lb * 4 + hd) * 256 + t) * 192 + part * 64 + c] = f2bf(v[jj]);
            } else {
              p.Ka()[(size_t)(row * 4 + hd) * 192 + part * 64 + c] = f2bf(v[jj]);
            }
          }
        } else {
          int d = (part - 2) * 64 + c;
          if (cache) {
            int lb = row0 >> 8, t = row0 & 255;
            store_vt4(p.cVaT(), (size_t)((lb * 4 + hd) * 128 + d) * 256 + t, v[0], v[1], v[2], v[3]);
          } else {
            int tl = tb.t + i * 32 + 8 * g + 4 * h;
            store_vt4(p.VaT(), (size_t)tb.tok0 * 512 + (size_t)(hd * 128 + d) * tb.T + tl, v[0], v[1], v[2], v[3]);
          }
        }
      }
}

template <int JP>
DI void epi_qa_w(const P& p, int m0, int n0, f32x16 (&acc)[2][4], const float* sRow) {
  const int tid_ = tidx(); const int lane = tid_ & 63, w = wave_of(tid_), wm = w >> 1, wn = w & 1, lq = lane & 31, h = lane >> 5;
  const int mb = m0 + wm * 64;
  const int cb = (n0 >> 6) + 2 * wn + JP, hd = cb / 3, part = cb % 3;
  TokInfo tb = tinfo(mb);
  const bool dorope = tb.lat && part == 2;
#pragma unroll
  for (int i = 0; i < 2; ++i) {
    float cs[16], sn[16];
#pragma unroll
    for (int r = 0; r < 16; ++r) { cs[r] = 1.f; sn[r] = 0.f; }
    if (dorope) {
#pragma unroll
      for (int r = 0; r < 16; ++r) {
        int t = tb.t + i * 32 + 8 * (r >> 2) + 4 * h + (r & 3);
        cs[r] = p.ropec()[t * 32 + lq]; sn[r] = p.ropes()[t * 32 + lq];
      }
    }
#pragma unroll
    for (int r = 0; r < 16; ++r) {
      int rl = wm * 64 + i * 32 + 8 * (r >> 2) + 4 * h + (r & 3);
      float rstd = rsqrtf(sRow[rl] * (1.f / 384.f) + EPS);
      float x1 = acc[i][2 * JP][r] * rstd, x2 = acc[i][2 * JP + 1][r] * rstd;
      float y1 = x1 * cs[r] - x2 * sn[r], y2 = x1 * sn[r] + x2 * cs[r];
      int row = m0 + rl;
      bf16* q = p.Qa() + (size_t)(row * 4 + hd) * 192 + part * 64;
      q[lq] = f2bf(y1); q[32 + lq] = f2bf(y2);
    }
  }
}
template <int JP>
DI void epi_kv_w(const P& p, int m0, int n0, f32x16 (&acc)[2][4], const float* sRow) {
  const int tid_ = tidx(); const int lane = tid_ & 63, w = wave_of(tid_), wm = w >> 1, wn = w & 1, lq = lane & 31, h = lane >> 5;
  const int mb = m0 + wm * 64;
  const int cb = (n0 >> 6) + 2 * wn + JP, hd = cb >> 2, part = cb & 3;
  TokInfo tb = tinfo(mb);
#pragma unroll
  for (int i = 0; i < 2; ++i)
#pragma unroll
    for (int j = 0; j < 2; ++j)
#pragma unroll
      for (int g = 0; g < 4; ++g) {
        float v[4];
#pragma unroll
        for (int jj = 0; jj < 4; ++jj) {
          int rl = wm * 64 + i * 32 + 8 * g + 4 * h + jj;
          float rstd = rsqrtf(sRow[rl] * (1.f / 256.f) + EPS);
          v[jj] = acc[i][2 * JP + j][4 * g + jj] * rstd;
        }
        int c = j * 32 + lq;
        int row0 = mb + i * 32 + 8 * g + 4 * h;
        if (part < 2) {
#pragma unroll
          for (int jj = 0; jj < 4; ++jj) p.Ka()[(size_t)((row0 + jj) * 4 + hd) * 192 + part * 64 + c] = f2bf(v[jj]);
        } else {
          int d = (part - 2) * 64 + c;
          int tl = tb.t + i * 32 + 8 * g + 4 * h;
          store_vt4(p.VaT(), (size_t)tb.tok0 * 512 + (size_t)(hd * 128 + d) * tb.T + tl, v[0], v[1], v[2], v[3]);
        }
      }
}

DI void epi_out(const P& p, int l, int m0, int n0, f32x16 (&acc)[2][2]) {
  const int tid_ = tidx(); const int lane = tid_ & 63, w = wave_of(tid_), wm = w >> 1, wn = w & 1, lq = lane & 31, h = lane >> 5;
  const int mb = m0 + wm * 64, nb = n0 + wn * 64;
  TokInfo tb = tinfo(mb);
  const float* gate = p.mod() + (size_t)(l * 5 + tb.modj) * 3072 + 2048;
  const float* xsrc = (l == 0) ? (tb.lat ? p.x_sample - (size_t)4096 * 1024 : p.x_prompt) : (const float*)p.xbuf();
#pragma unroll
  for (int i = 0; i < 2; ++i)
#pragma unroll
    for (int j = 0; j < 2; ++j) {
      int col = nb + j * 32 + lq;
      float gv = gate[col];
      float xo[16];
#pragma unroll
      for (int r = 0; r < 16; ++r) {
        int row = mb + i * 32 + 8 * (r >> 2) + 4 * h + (r & 3);
        xo[r] = xsrc[(size_t)row * 1024 + col];
      }
#pragma unroll
      for (int r = 0; r < 16; ++r) {
        int row = mb + i * 32 + 8 * (r >> 2) + 4 * h + (r & 3);
        p.xbuf()[(size_t)row * 1024 + col] = xo[r] + gv * acc[i][j][r];
      }
    }
}

template <int KW, int DQ, int KSPLIT>
DI void attn_pass(const bf16* __restrict__ qptr, int koff, int kh, const bf16* __restrict__ Kmain, int ldk, int Tmain,
                  const bf16* __restrict__ Kc, int ldkc, int Tc, const bf16* __restrict__ VTmain,
                  const bf16* __restrict__ VTc, float c, char* smem, f32x16 (&o)[4], float& lsum, float& m_out) {
  constexpr int KS = KW + 8;
  constexpr int NKB = 2 / KSPLIT;
  bf16* sK = (bf16*)smem;
  bf16* sV = sK + 64 * KS;
  const int tid = tidx(), lane = tid & 63, lq = lane & 31, h = lane >> 5;
  constexpr bool QLDS = (KSPLIT == 2);
  constexpr int QS = DQ + 8;
  bf16* sQ = sV + 128 * 72;
  bf16x8 qf[QLDS ? 1 : DQ / 16];
  if (QLDS) {
    constexpr int QCH = DQ / 8, NQL = 64 * QCH / 256;
    u32x4 tq[NQL];
#pragma unroll
    for (int i = 0; i < NQL; ++i) { int idx = tid + 256 * i; int r = idx / QCH, cc = idx % QCH; tq[i] = *(const u32x4*)(qptr + (size_t)r * 768 + cc * 8); }
#pragma unroll
    for (int i = 0; i < NQL; ++i) { int idx = tid + 256 * i; int r = idx / QCH, cc = idx % QCH; *(u32x4*)(sQ + r * QS + cc * 8) = tq[i]; }
  } else {
#pragma unroll
    for (int ks = 0; ks < DQ / 16; ++ks) qf[ks] = *(const bf16x8*)(qptr + ks * 16 + h * 8);
  }
  const bf16* sQl = sQ + (((wave_of(tid) & 1) * 32) + lq) * QS + h * 8;
#pragma unroll
  for (int db = 0; db < 4; ++db)
#pragma unroll
    for (int r = 0; r < 16; ++r) o[db][r] = 0.f;
  lsum = 0.f;
  float m_run = -INFINITY;
  const int nt = (Tmain + Tc) >> 6;
  constexpr int CH = KW / 8, NKL = 64 * CH / 256;
  u32x4 kr[NKL], vr[4];
  auto issue = [&](int kt) {
    const bf16* ksrc; int ld; const bf16* vsrc; int ldv;
    if (kt * 64 < Tmain) { ksrc = Kmain + (size_t)(kt * 64) * ldk; ld = ldk; vsrc = VTmain + kt * 64; ldv = Tmain; }
    else { ksrc = Kc + (size_t)(kt * 64 - Tmain) * ldkc; ld = ldkc; vsrc = VTc + (kt * 64 - Tmain); ldv = Tc; }
#pragma unroll
    for (int i = 0; i < NKL; ++i) {
      int idx = tid + 256 * i; int r = idx / CH, cc = idx % CH;
      kr[i] = *(const u32x4*)(ksrc + (size_t)r * ld + cc * 8);
    }
#pragma unroll
    for (int i = 0; i < 4; ++i) {
      int idx = tid + 256 * i; int r = idx >> 3, cc = idx & 7;
      vr[i] = *(const u32x4*)(vsrc + (size_t)r * ldv + cc * 8);
    }
  };
  issue(0);
  for (int kt = 0; kt < nt; ++kt) {
    __syncthreads();
#pragma unroll
    for (int i = 0; i < NKL; ++i) {
      int idx = tid + 256 * i; int r = idx / CH, cc = idx % CH;
      *(u32x4*)(sK + r * KS + cc * 8) = kr[i];
    }
#pragma unroll
    for (int i = 0; i < 4; ++i) {
      int idx = tid + 256 * i; int r = idx >> 3, cc = idx & 7;
      *(u32x4*)(sV + r * 72 + cc * 8) = vr[i];
    }
    __syncthreads();
    issue((kt + 1 < nt) ? kt + 1 : kt);
    f32x16 s[NKB];
#pragma unroll
    for (int kbi = 0; kbi < NKB; ++kbi)
#pragma unroll
      for (int r = 0; r < 16; ++r) s[kbi][r] = 0.f;
#pragma unroll
    for (int ks = 0; ks < DQ / 16; ++ks)
#pragma unroll
      for (int kbi = 0; kbi < NKB; ++kbi) {
        const int kb = (KSPLIT == 2) ? kh : kbi;
        bf16x8 a = *(const bf16x8*)(sK + (kb * 32 + lq) * KS + koff + ks * 16 + h * 8);
        s[kbi] = MFMA(a, QLDS ? *(const bf16x8*)(sQl + ks * 16) : qf[QLDS ? 0 : ks], s[kbi]);
      }
    float mx = -INFINITY;
#pragma unroll
    for (int kbi = 0; kbi < NKB; ++kbi)
#pragma unroll
      for (int r = 0; r < 16; ++r) mx = fmaxf(mx, s[kbi][r]);
    mx = fmaxf(mx, __shfl_xor(mx, 32));
    const float m_new = fmaxf(m_run, mx);
    const float alpha = fexp2((m_run - m_new) * c);
    m_run = m_new;
    lsum *= alpha;
#pragma unroll
    for (int db = 0; db < 4; ++db)
#pragma unroll
      for (int r = 0; r < 16; ++r) o[db][r] *= alpha;
    const float mc = m_new * c;
#pragma unroll
    for (int kbi = 0; kbi < NKB; ++kbi)
#pragma unroll
      for (int r = 0; r < 16; ++r) { float pv = fexp2(s[kbi][r] * c - mc); s[kbi][r] = pv; lsum += pv; }
#pragma unroll
    for (int kbi = 0; kbi < NKB; ++kbi) {
      const int kb = (KSPLIT == 2) ? kh : kbi;
#pragma unroll
      for (int s2 = 0; s2 < 2; ++s2) {
        u32x4 pk;
#pragma unroll
        for (int e = 0; e < 4; ++e) pk[e] = pack2(s[kbi][8 * s2 + 2 * e], s[kbi][8 * s2 + 2 * e + 1]);
        bf16x8 pb = __builtin_bit_cast(bf16x8, pk);
#pragma unroll
        for (int db = 0; db < 4; ++db) {
          const bf16* vp = sV + (db * 32 + lq) * 72 + kb * 32 + s2 * 16 + 4 * h;
          u32x2 lo = *(const u32x2*)vp, hi = *(const u32x2*)(vp + 8);
          u32x4 av; av[0] = lo[0]; av[1] = lo[1]; av[2] = hi[0]; av[3] = hi[1];
          o[db] = MFMA(__builtin_bit_cast(bf16x8, av), pb, o[db]);
        }
      }
    }
  }
  lsum += __shfl_xor(lsum, 32);
  m_out = m_run;
}

DI void mla_item(const P& p, int l, int it, char* smem) {
  const int tid = tidx(), lane = tid & 63, w = wave_of(tid), lq = lane & 31, h = lane >> 5;
  int lat, b, hd, qb;
  if (it < 256) { lat = 1; b = it >> 6; hd = (it >> 4) & 3; qb = it & 15; }
  else { int u = it - 256; lat = 0; b = u >> 4; hd = (u >> 2) & 3; qb = u & 3; }
  const int T = lat ? 1024 : 256, tok0 = lat ? 4096 + b * 1024 : b * 256;
  const int qsub = w & 1, kh = w >> 1;
  const int tok = tok0 + qb * 64 + qsub * 32 + lq;
  f32x16 o[4]; float lsum, mrun;
  const float c = 0.07216878364870322f * 1.4426950408889634f;
  attn_pass<192, 192, 2>(p.Qa() + (size_t)((tok0 + qb * 64) * 4 + hd) * 192, 0, kh, p.Ka() + (size_t)(tok0 * 4 + hd) * 192, 768, T,
                 p.cKa() + (size_t)((l * 4 + b) * 4 + hd) * 256 * 192, 192, lat ? 256 : 0,
                 p.VaT() + (size_t)tok0 * 512 + (size_t)hd * 128 * T, p.cVaT() + (size_t)((l * 4 + b) * 4 + hd) * 128 * 256, c, smem, o, lsum, mrun);
  float* ex = (float*)smem;
  float* exm = ex + 2 * 128 * 32;
  float* exl = exm + 64;
  __syncthreads();
  if (kh == 1) {
#pragma unroll
    for (int db = 0; db < 4; ++db)
#pragma unroll
      for (int r = 0; r < 16; ++r) {
        int dv = db * 32 + 8 * (r >> 2) + 4 * h + (r & 3);
        ex[(qsub * 128 + dv) * 32 + lq] = o[db][r];
      }
    if (h == 0) { exm[qsub * 32 + lq] = mrun; exl[qsub * 32 + lq] = lsum; }
  }
  __syncthreads();
  if (kh == 0) {
    const float m1 = exm[qsub * 32 + lq], l1 = exl[qsub * 32 + lq];
    const float mm = fmaxf(mrun, m1);
    const float f0 = fexp2((mrun - mm) * c), f1 = fexp2((m1 - mm) * c);
    const float inv = 1.f / (lsum * f0 + l1 * f1);
    const float g0 = f0 * inv, g1 = f1 * inv;
    u32x2 zz[4][4];
#pragma unroll
    for (int db = 0; db < 4; ++db)
#pragma unroll
      for (int g = 0; g < 4; ++g) zz[db][g] = *(const u32x2*)(p.proj() + (size_t)tok * NPROJ + 704 + hd * 128 + db * 32 + 8 * g + 4 * h);
#pragma unroll
    for (int db = 0; db < 4; ++db)
#pragma unroll
      for (int g = 0; g < 4; ++g) {
        int dv = db * 32 + 8 * g + 4 * h;
        float ov4[4];
#pragma unroll
        for (int jj = 0; jj < 4; ++jj) ov4[jj] = o[db][4 * g + jj] * g0 + ex[(qsub * 128 + dv + jj) * 32 + lq] * g1;
        u32x2 z = zz[db][g];
        float z0 = bflo(z[0]), z1 = bfhi(z[0]), z2 = bflo(z[1]), z3 = bfhi(z[1]);
        u32x2 ov;
        ov[0] = pack2(ov4[0] * silu_f(z0), ov4[1] * silu_f(z1));
        ov[1] = pack2(ov4[2] * silu_f(z2), ov4[3] * silu_f(z3));
        *(u32x2*)(p.ycat() + (size_t)tok * 1536 + hd * 128 + dv) = ov;
      }
  }
}

DI void diff_item(const P& p, int l, int it, char* smem) {
  const int tid = tidx(), lane = tid & 63, w = wave_of(tid), lq = lane & 31, h = lane >> 5;
  int lat, b, hd, qb;
  if (it < 256) { lat = 1; b = it >> 6; hd = (it >> 4) & 3; qb = it & 15; }
  else { int u = it - 256; lat = 0; b = u >> 4; hd = (u >> 2) & 3; qb = u & 3; }
  const int T = lat ? 1024 : 256, tok0 = lat ? 4096 + b * 1024 : b * 256;
  const int map = w >> 1, qsub = w & 1;
  const int tok = tok0 + qb * 64 + qsub * 32 + lq;
  const float c = 0.125f * 1.4426950408889634f;
  const bf16* vt = p.VbT() + (size_t)tok0 * 512 + (size_t)hd * 128 * T;
  const bf16* vtc = p.cVbT() + (size_t)((l * 4 + b) * 4 + hd) * 128 * 256;
  const bf16* kc = p.cKb() + (size_t)((l * 4 + b) * 4 + hd) * 256 * 128;
  f32x16 o[4]; float ls, mdummy;
  attn_pass<128, 64, 1>(p.proj() + (size_t)tok * NPROJ + 1216 + hd * 128 + map * 64, map * 64, 0, p.Kb() + (size_t)(tok0 * 4 + hd) * 128, 512, T, kc, 128,
                     lat ? 256 : 0, vt, vtc, c, smem, o, ls, mdummy);
  float* ex = (float*)smem;
  __syncthreads();
  if (map == 1) {
    const float sc2 = p.lam()[l] / ls;
#pragma unroll
    for (int db = 0; db < 4; ++db)
#pragma unroll
      for (int r = 0; r < 16; ++r) {
        int dv = db * 32 + 8 * (r >> 2) + 4 * h + (r & 3);
        ex[(qsub * 128 + dv) * 32 + lq] = o[db][r] * sc2;
      }
  }
  __syncthreads();
  if (map == 0) {
    const float i1 = 1.f / ls;
    float ss = 0.f;
#pragma unroll
    for (int db = 0; db < 4; ++db)
#pragma unroll
      for (int r = 0; r < 16; ++r) {
        int dv = db * 32 + 8 * (r >> 2) + 4 * h + (r & 3);
        float v = o[db][r] * i1 - ex[(qsub * 128 + dv) * 32 + lq];
        o[db][r] = v; ss += v * v;
      }
    ss += __shfl_xor(ss, 32);
    const float lam_init = 0.8f - 0.6f * fexp(-0.3f * (float)l);
    const float sc = rsqrtf(ss * (1.f / 128.f) + EPS) * (1.f - lam_init);
#pragma unroll
    for (int db = 0; db < 4; ++db) {
      u32x2 zz[4]; f32x4 gg[4];
#pragma unroll
      for (int g = 0; g < 4; ++g) {
        int dv = db * 32 + 8 * g + 4 * h;
        zz[g] = *(const u32x2*)(p.proj() + (size_t)tok * NPROJ + 2752 + hd * 128 + dv);
        gg[g] = *(const f32x4*)(p.dnorm + l * 128 + dv);
      }
#pragma unroll
      for (int g = 0; g < 4; ++g) {
        int dv = db * 32 + 8 * g + 4 * h;
        u32x2 z = zz[g];
        f32x4 gn = gg[g];
        float z0 = bflo(z[0]), z1 = bfhi(z[0]), z2 = bflo(z[1]), z3 = bfhi(z[1]);
        u32x2 ov;
        ov[0] = pack2(o[db][4 * g] * sc * gn[0] * silu_f(z0), o[db][4 * g + 1] * sc * gn[1] * silu_f(z1));
        ov[1] = pack2(o[db][4 * g + 2] * sc * gn[2] * silu_f(z2), o[db][4 * g + 3] * sc * gn[3] * silu_f(z3));
        *(u32x2*)(p.ycat() + (size_t)tok * 1536 + 512 + hd * 128 + dv) = ov;
      }
    }
  }
}

DI void conv8(const P& p, int l, int tok, int t, int T, int col, int wcol, float (&o)[8]) {
  const bf16* base = p.proj() + (size_t)tok * NPROJ + col;
  u32x4 cur = *(const u32x4*)base;
  u32x4 prv = {0u, 0u, 0u, 0u}, nxt = {0u, 0u, 0u, 0u};
  if (t > 0) prv = *(const u32x4*)(base - NPROJ);
  if (t < T - 1) nxt = *(const u32x4*)(base + NPROJ);
  const float* w0 = p.mconv + (size_t)l * 3 * 1024 + wcol;
  f32x4 wa0 = *(const f32x4*)w0, wa1 = *(const f32x4*)(w0 + 4);
  f32x4 wb0 = *(const f32x4*)(w0 + 1024), wb1 = *(const f32x4*)(w0 + 1028);
  f32x4 wc0 = *(const f32x4*)(w0 + 2048), wc1 = *(const f32x4*)(w0 + 2052);
#pragma unroll
  for (int e = 0; e < 4; ++e) {
    float wA0 = e < 2 ? wa0[2 * e] : wa1[2 * e - 4], wA1 = e < 2 ? wa0[2 * e + 1] : wa1[2 * e - 3];
    float wB0 = e < 2 ? wb0[2 * e] : wb1[2 * e - 4], wB1 = e < 2 ? wb0[2 * e + 1] : wb1[2 * e - 3];
    float wC0 = e < 2 ? wc0[2 * e] : wc1[2 * e - 4], wC1 = e < 2 ? wc0[2 * e + 1] : wc1[2 * e - 3];
    float v0 = wA0 * bflo(prv[e]) + wB0 * bflo(cur[e]) + wC0 * bflo(nxt[e]);
    float v1 = wA1 * bfhi(prv[e]) + wB1 * bfhi(cur[e]) + wC1 * bfhi(nxt[e]);
    o[2 * e] = silu_f(v0); o[2 * e + 1] = silu_f(v1);
  }
}

DI float wave_incl_scan_add(float v, int lane) {
#pragma unroll
  for (int o = 1; o < 64; o <<= 1) { float t = __shfl_up(v, o); if (lane >= o) v += t; }
  return v;
}
DI float wave_incl_scan_max(float v, int lane) {
#pragma unroll
  for (int o = 1; o < 64; o <<= 1) { float t = __shfl_up(v, o); if (lane >= o) v = fmaxf(v, t); }
  return v;
}

DI void mlstm_local(const P& p, int l, int slot, char* smem) {
  bf16* vT = (bf16*)smem;
  bf16* kT = vT + 128 * 72;
  float* wbuf = (float*)(kT + 128 * 72);
  const int tid = tidx(), lane = tid & 63, w = wave_of(tid), lq = lane & 31, h = lane >> 5;
  const int cp = slot >> 3, hd = (slot >> 1) & 3, dir = slot & 1;
  const int ctok = cp * 64;
  TokInfo ti = tinfo(ctok);
  const int T = ti.T;
  if (w == 0) {
    const int s = dir ? 63 - lane : lane;
    const int tk = ctok + s;
    const float ig = p.gates()[tk * 16 + dir * 8 + hd];
    const float lf = logsig_f(p.gates()[tk * 16 + dir * 8 + 4 + hd]);
    const float bc = wave_incl_scan_add(lf, lane);
    const float b_last = __shfl(bc, 63);
    const float val = b_last - bc + ig;
    float mx = val;
#pragma unroll
    for (int o = 32; o >= 1; o >>= 1) mx = fmaxf(mx, __shfl_xor(mx, o));
    wbuf[s] = fexp(val - mx);
    if (lane == 0) { p.blA()[slot] = b_last; p.mlA()[slot] = mx; }
  }
  __syncthreads();
  {
    const int s = tid >> 2, chb = (tid & 3) * 32;
    const float ws = wbuf[s];
    float kvv[4][8];
#pragma unroll
    for (int q = 0; q < 4; ++q) {
      const int ch = chb + q * 8;
      conv8(p, l, ctok + s, ti.t + s, T, 3776 + hd * 128 + ch, 512 + hd * 128 + ch, kvv[q]);
    }
#pragma unroll
    for (int q = 0; q < 4; ++q) {
      const int ch = chb + q * 8;
#pragma unroll
      for (int e = 0; e < 8; ++e) kT[(ch + e) * 72 + s] = f2bf(kvv[q][e] * ws);
    }
    const bf16* vsrc = p.VmT() + (size_t)ti.tok0 * 512 + (size_t)hd * 128 * T + ti.t;
    u32x4 tvv[4];
#pragma unroll
    for (int i = 0; i < 4; ++i) { int idx = tid + 256 * i; int r = idx >> 3, cc = idx & 7; tvv[i] = *(const u32x4*)(vsrc + (size_t)r * T + cc * 8); }
#pragma unroll
    for (int i = 0; i < 4; ++i) { int idx = tid + 256 * i; int r = idx >> 3, cc = idx & 7; *(u32x4*)(vT + r * 72 + cc * 8) = tvv[i]; }
  }
  __syncthreads();
  f32x16 acc[4];
#pragma unroll
  for (int cb = 0; cb < 4; ++cb)
#pragma unroll
    for (int r = 0; r < 16; ++r) acc[cb][r] = 0.f;
#pragma unroll
  for (int ks = 0; ks < 4; ++ks) {
    bf16x8 a = *(const bf16x8*)(vT + (32 * w + lq) * 72 + ks * 16 + 8 * h);
#pragma unroll
    for (int cb = 0; cb < 4; ++cb) {
      bf16x8 bb = *(const bf16x8*)(kT + (32 * cb + lq) * 72 + ks * 16 + 8 * h);
      acc[cb] = MFMA(a, bb, acc[cb]);
    }
  }
  bf16* cs = p.Cst() + (size_t)slot * 16384;
#pragma unroll
  for (int cb = 0; cb < 4; ++cb)
#pragma unroll
    for (int r = 0; r < 16; ++r) {
      int dvv = 32 * w + 8 * (r >> 2) + 4 * h + (r & 3);
      cs[dvv * 128 + 32 * cb + lq] = f2bf(acc[cb][r]);
    }
  if (tid < 128) {
    float sum = 0.f;
#pragma unroll
    for (int q = 0; q < 8; ++q) {
      u32x4 v = *(const u32x4*)(kT + tid * 72 + q * 8);
#pragma unroll
      for (int e = 0; e < 4; ++e) sum += bflo(v[e]) + bfhi(v[e]);
    }
    p.nst()[slot * 128 + tid] = sum;
  }
}

DI void mlstm_scan(const P& p, int l, int it) {
  const int tid = tidx();
  const int ch = it >> 2, qt = it & 3;
  int lat, b, hd, dir;
  if (ch < 32) { lat = 1; b = ch >> 3; hd = (ch >> 1) & 3; dir = ch & 1; }
  else { int u = ch - 32; lat = 0; b = u >> 3; hd = (u >> 1) & 3; dir = u & 1; }
  const int T = lat ? 1024 : 256, tok0 = lat ? 4096 + b * 1024 : b * 256, nc = T >> 6;
  const int dv0 = 32 * qt + 4 * (tid >> 5), dk0 = 4 * (tid & 31);
  float C[4][4];
  float n_val = 0.f, m_prev = 0.f;
  const bool do_n = (qt == 0) && (tid < 128);
  const size_t sidx = (size_t)((b * 4 + l) * 2 + dir) * 4 + hd;
  if (lat) {
    const float* C0 = p.st_C + sidx * 16384;
#pragma unroll
    for (int j = 0; j < 4; ++j) {
      f32x4 v = *(const f32x4*)(C0 + (size_t)(dk0 + j) * 128 + dv0);
      C[0][j] = v[0]; C[1][j] = v[1]; C[2][j] = v[2]; C[3][j] = v[3];
    }
    if (do_n) n_val = p.st_n[sidx * 128 + tid];
    m_prev = p.st_m[sidx];
  } else {
#pragma unroll
    for (int i = 0; i < 4; ++i)
#pragma unroll
      for (int j = 0; j < 4; ++j) C[i][j] = 0.f;
  }
  u32x2 dnx[4]; float blx, mlx, dnnx = 0.f;
  {
    const int c = dir ? nc - 1 : 0;
    const int slot = ((((tok0 >> 6) + c) * 4 + hd) * 2) + dir;
    const bf16* cs = p.Cst() + (size_t)slot * 16384 + dv0 * 128 + dk0;
#pragma unroll
    for (int i = 0; i < 4; ++i) dnx[i] = *(const u32x2*)(cs + i * 128);
    blx = p.blA()[slot]; mlx = p.mlA()[slot];
    if (do_n) dnnx = p.nst()[slot * 128 + tid];
  }
  for (int ci = 0; ci < nc; ++ci) {
    const int c = dir ? nc - 1 - ci : ci;
    const int slot = ((((tok0 >> 6) + c) * 4 + hd) * 2) + dir;
    bf16* cs = p.Cst() + (size_t)slot * 16384 + dv0 * 128 + dk0;
    u32x2 d[4];
#pragma unroll
    for (int i = 0; i < 4; ++i) d[i] = dnx[i];
    const float bl = blx, ml = mlx;
    const float dn = dnnx;
    {
      const int cn = (ci + 1 < nc) ? (dir ? nc - 2 - ci : ci + 1) : c;
      const int sn = ((((tok0 >> 6) + cn) * 4 + hd) * 2) + dir;
      const bf16* csn = p.Cst() + (size_t)sn * 16384 + dv0 * 128 + dk0;
#pragma unroll
      for (int i = 0; i < 4; ++i) dnx[i] = *(const u32x2*)(csn + i * 128);
      blx = p.blA()[sn]; mlx = p.mlA()[sn];
      if (do_n) dnnx = p.nst()[sn * 128 + tid];
    }
#pragma unroll
    for (int i = 0; i < 4; ++i) {
      u32x2 o; o[0] = pack2(C[i][0], C[i][1]); o[1] = pack2(C[i][2], C[i][3]);
      *(u32x2*)(cs + i * 128) = o;
    }
    if (do_n) p.nst()[slot * 128 + tid] = n_val;
    if (qt == 0 && tid == 0) p.mst()[slot] = m_prev;
    const float m_new = fmaxf(bl + m_prev, ml);
    const float a = fexp(bl + m_prev - m_new), bs = fexp(ml - m_new);
#pragma unroll
    for (int i = 0; i < 4; ++i) {
      C[i][0] = a * C[i][0] + bs * bflo(d[i][0]); C[i][1] = a * C[i][1] + bs * bfhi(d[i][0]);
      C[i][2] = a * C[i][2] + bs * bflo(d[i][1]); C[i][3] = a * C[i][3] + bs * bfhi(d[i][1]);
    }
    n_val = a * n_val + bs * dn;
    m_prev = m_new;
  }
  if (!lat) {
    float* Co = p.out + O_MC + sidx * 16384;
#pragma unroll
    for (int j = 0; j < 4; ++j) {
      f32x4 v; v[0] = C[0][j]; v[1] = C[1][j]; v[2] = C[2][j]; v[3] = C[3][j];
      *(f32x4*)(Co + (size_t)(dk0 + j) * 128 + dv0) = v;
    }
    if (do_n) p.out[O_MN + sidx * 128 + tid] = n_val;
    if (qt == 0 && tid == 0) p.out[O_MM + sidx] = m_prev;
  }
}

DI void mlstm_out(const P& p, int l, int it, char* smem) {
  bf16* sq = (bf16*)smem;
  bf16* sk = sq + 64 * 136;
  bf16* vT = sk + 64 * 136;
  float* bcA2 = (float*)(vT + 128 * 72);
  float* uA2 = bcA2 + 128, *mtA2 = uA2 + 128, *nA2 = mtA2 + 128  , *ssb = nA2 + 256  ;
  const int tid = tidx(), lane = tid & 63, w = wave_of(tid), lq = lane & 31, h = lane >> 5;
  const int cp = it >> 2, hd = it & 3;
  const int ctok = cp * 64;
  TokInfo ti = tinfo(ctok);
  const int T = ti.T;
  const float m_prev0 = p.mst()[(cp * 4 + hd) * 2], m_prev1 = p.mst()[(cp * 4 + hd) * 2 + 1];
  if (w < 2) {
    const int dir = w;
    const float m_prev = dir ? m_prev1 : m_prev0;
    const int s = dir ? 63 - lane : lane;
    const int tk = ctok + s;
    const float ig = p.gates()[tk * 16 + dir * 8 + hd];
    const float lf = logsig_f(p.gates()[tk * 16 + dir * 8 + 4 + hd]);
    const float bc = wave_incl_scan_add(lf, lane);
    const float u = ig - bc;
    const float pm = wave_incl_scan_max(u, lane);
    bcA2[dir * 64 + s] = bc; uA2[dir * 64 + s] = u; mtA2[dir * 64 + s] = bc + fmaxf(m_prev, pm);
  } else {
    const int dir = w - 2;
    const int slot = (cp * 4 + hd) * 2 + dir;
    nA2[dir * 128 + lane] = p.nst()[slot * 128 + lane];
    nA2[dir * 128 + 64 + lane] = p.nst()[slot * 128 + 64 + lane];
  }
  {
    const int s = tid >> 2, chb = (tid & 3) * 32;
#pragma unroll 2
    for (int q = 0; q < 4; ++q) {
      const int ch = chb + q * 8;
      float v[8];
      conv8(p, l, ctok + s, ti.t + s, T, 3264 + hd * 128 + ch, hd * 128 + ch, v);
      u32x4 pk;
#pragma unroll
      for (int e = 0; e < 4; ++e) pk[e] = pack2(v[2 * e] * 0.08838834764831845f, v[2 * e + 1] * 0.08838834764831845f);
      *(u32x4*)(sq + s * 136 + ch) = pk;
      conv8(p, l, ctok + s, ti.t + s, T, 3776 + hd * 128 + ch, 512 + hd * 128 + ch, v);
#pragma unroll
      for (int e = 0; e < 4; ++e) pk[e] = pack2(v[2 * e], v[2 * e + 1]);
      *(u32x4*)(sk + s * 136 + ch) = pk;
    }
    const bf16* vsrc = p.VmT() + (size_t)ti.tok0 * 512 + (size_t)hd * 128 * T + ti.t;
    u32x4 tvv[4];
#pragma unroll
    for (int i = 0; i < 4; ++i) { int idx = tid + 256 * i; int r = idx >> 3, cc = idx & 7; tvv[i] = *(const u32x4*)(vsrc + (size_t)r * T + cc * 8); }
#pragma unroll
    for (int i = 0; i < 4; ++i) { int idx = tid + 256 * i; int r = idx >> 3, cc = idx & 7; *(u32x4*)(vT + r * 72 + cc * 8) = tvv[i]; }
  }
  __syncthreads();
  const int tb = w & 1, dvh = w >> 1;
  const int t = 32 * tb + lq;
  f32x16 hacc[2];
#pragma unroll
  for (int d2 = 0; d2 < 2; ++d2)
#pragma unroll
    for (int r = 0; r < 16; ++r) hacc[d2][r] = 0.f;
  const bf16* sqt = sq + t * 136 + 8 * h;
  for (int dir = 0; dir < 2; ++dir) {
    const int slot = (cp * 4 + hd) * 2 + dir;
    const float m_prev = dir ? m_prev1 : m_prev0;
    const float* bcA = bcA2 + dir * 64;
    const float* uA = uA2 + dir * 64;
    const float* mtA = mtA2 + dir * 64;
    const float* nA = nA2 + dir * 128;
    const float bc_t = bcA[t], mt = mtA[t];
    const float w_inter = fexp(bc_t + m_prev - mt);
    float den = 0.f;
    const float e0 = bc_t - mt;
    u32x4 pk[2][2];
#pragma unroll
    for (int sb = 0; sb < 2; ++sb) {
      asm volatile("" ::: "memory");
      f32x16 sv;
#pragma unroll
      for (int r = 0; r < 16; ++r) sv[r] = 0.f;
#pragma unroll
      for (int ks = 0; ks < 8; ++ks) {
        bf16x8 a = *(const bf16x8*)(sk + (32 * sb + lq) * 136 + ks * 16 + 8 * h);
        sv = MFMA(a, *(const bf16x8*)(sqt + ks * 16), sv);
      }
#pragma unroll
      for (int r = 0; r < 16; ++r) {
        const int sidx = 32 * sb + 8 * (r >> 2) + 4 * h + (r & 3);
        const bool valid = dir ? (sidx >= t) : (sidx <= t);
        const float wgt = valid ? fexp(e0 + uA[sidx]) : 0.f;
        const float v = sv[r] * wgt;
        sv[r] = v; den += v;
      }
#pragma unroll
      for (int s2 = 0; s2 < 2; ++s2)
#pragma unroll
        for (int e = 0; e < 4; ++e) pk[sb][s2][e] = pack2(sv[8 * s2 + 2 * e], sv[8 * s2 + 2 * e + 1]);
    }
    asm volatile("" ::: "memory");
    den += __shfl_xor(den, 32);
    float qn = 0.f;
#pragma unroll
    for (int ks = 0; ks < 8; ++ks) {
      u32x4 qv = *(const u32x4*)(sqt + ks * 16);
#pragma unroll
      for (int e = 0; e < 4; ++e) {
        qn += bflo(qv[e]) * nA[ks * 16 + 8 * h + 2 * e] + bfhi(qv[e]) * nA[ks * 16 + 8 * h + 2 * e + 1];
      }
    }
    qn += __shfl_xor(qn, 32);
    den += w_inter * qn;
    asm volatile("" ::: "memory");
    const float rden = 1.f / fmaxf(fabsf(den), fexp(-mt));
    const bf16* cs = p.Cst() + (size_t)slot * 16384;
    bf16x8 cfa[2][8];
#pragma unroll
    for (int d2 = 0; d2 < 2; ++d2)
#pragma unroll
      for (int ks = 0; ks < 8; ++ks) cfa[d2][ks] = *(const bf16x8*)(cs + ((2 * dvh + d2) * 32 + lq) * 128 + ks * 16 + 8 * h);
    asm volatile("" : "+v"(cfa[0][0]), "+v"(cfa[0][1]), "+v"(cfa[0][2]), "+v"(cfa[0][3]), "+v"(cfa[0][4]), "+v"(cfa[0][5]), "+v"(cfa[0][6]), "+v"(cfa[0][7]),
                      "+v"(cfa[1][0]), "+v"(cfa[1][1]), "+v"(cfa[1][2]), "+v"(cfa[1][3]), "+v"(cfa[1][4]), "+v"(cfa[1][5]), "+v"(cfa[1][6]), "+v"(cfa[1][7]));
#pragma unroll
    for (int d2 = 0; d2 < 2; ++d2) {
      const int dvb = 2 * dvh + d2;
      f32x16 acc;
#pragma unroll
      for (int r = 0; r < 16; ++r) acc[r] = 0.f;
#pragma unroll
      for (int ks = 0; ks < 8; ++ks) acc = MFMA(cfa[d2][ks], *(const bf16x8*)(sqt + ks * 16), acc);
#pragma unroll
      for (int r = 0; r < 16; ++r) acc[r] *= w_inter;
#pragma unroll
      for (int sb = 0; sb < 2; ++sb)
#pragma unroll
        for (int s2 = 0; s2 < 2; ++s2) {
          const bf16* vp = vT + (dvb * 32 + lq) * 72 + sb * 32 + s2 * 16 + 4 * h;
          u32x2 lo = *(const u32x2*)vp, hi = *(const u32x2*)(vp + 8);
          u32x4 av; av[0] = lo[0]; av[1] = lo[1]; av[2] = hi[0]; av[3] = hi[1];
          acc = MFMA(__builtin_bit_cast(bf16x8, av), __builtin_bit_cast(bf16x8, pk[sb][s2]), acc);
        }
#pragma unroll
      for (int r = 0; r < 16; ++r) hacc[d2][r] += acc[r] * rden;
    }
  }
  const int tok = ctok + t;
  float ss = 0.f;
#pragma unroll
  for (int d2 = 0; d2 < 2; ++d2)
#pragma unroll
    for (int g = 0; g < 4; ++g) {
      int dv = (2 * dvh + d2) * 32 + 8 * g + 4 * h;
      u32x2 mo = *(const u32x2*)(p.proj() + (size_t)tok * NPROJ + 4800 + hd * 128 + dv);
      float m0 = bflo(mo[0]), m1 = bfhi(mo[0]), m2 = bflo(mo[1]), m3 = bfhi(mo[1]);
      float v0 = hacc[d2][4 * g] * sigmoid_f(m0), v1 = hacc[d2][4 * g + 1] * sigmoid_f(m1);
      float v2 = hacc[d2][4 * g + 2] * sigmoid_f(m2), v3 = hacc[d2][4 * g + 3] * sigmoid_f(m3);
      hacc[d2][4 * g] = v0; hacc[d2][4 * g + 1] = v1; hacc[d2][4 * g + 2] = v2; hacc[d2][4 * g + 3] = v3;
      ss += v0 * v0 + v1 * v1 + v2 * v2 + v3 * v3;
    }
  ss += __shfl_xor(ss, 32);
  if (h == 0) ssb[dvh * 64 + t] = ss;
  __syncthreads();
  const float rstd = rsqrtf((ssb[t] + ssb[64 + t]) * (1.f / 128.f) + EPS);
  u32x2 zz[2][4]; f32x4 gg[2][4];
#pragma unroll
  for (int d2 = 0; d2 < 2; ++d2)
#pragma unroll
    for (int g = 0; g < 4; ++g) {
      int dv = (2 * dvh + d2) * 32 + 8 * g + 4 * h;
      zz[d2][g] = *(const u32x2*)(p.proj() + (size_t)tok * NPROJ + 5312 + hd * 128 + dv);
      gg[d2][g] = *(const f32x4*)(p.mnorm + l * 512 + hd * 128 + dv);
    }
#pragma unroll
  for (int d2 = 0; d2 < 2; ++d2)
#pragma unroll
    for (int g = 0; g < 4; ++g) {
      int dv = (2 * dvh + d2) * 32 + 8 * g + 4 * h;
      u32x2 z = zz[d2][g];
      f32x4 gn = gg[d2][g];
      float z0 = bflo(z[0]), z1 = bfhi(z[0]), z2 = bflo(z[1]), z3 = bfhi(z[1]);
      u32x2 ov;
      ov[0] = pack2(hacc[d2][4 * g] * rstd * gn[0] * silu_f(z0), hacc[d2][4 * g + 1] * rstd * gn[1] * silu_f(z1));
      ov[1] = pack2(hacc[d2][4 * g + 2] * rstd * gn[2] * silu_f(z2), hacc[d2][4 * g + 3] * rstd * gn[3] * silu_f(z3));
      *(u32x2*)(p.ycat() + (size_t)tok * 1536 + 1024 + hd * 128 + dv) = ov;
    }
}

DI void ckv_fin2(const P& p, int l, int tok0) {
  const int lane = tidx() & 63;
  u32x2 raw[2]; f32x4 g = *(const f32x4*)(p.kv_norm + l * 256 + lane * 4);
#pragma unroll
  for (int k = 0; k < 2; ++k) raw[k] = *(const u32x2*)(p.proj() + (size_t)(tok0 + k) * NPROJ + 384 + lane * 4);
#pragma unroll
  for (int k = 0; k < 2; ++k) {
    const int tok = tok0 + k;
    const int b = tok >> 8, t = tok & 255;
    float* o = p.out + O_CKV + (size_t)((b * 4 + l) * 256 + t) * 256 + lane * 4;
    f32x4 v; v[0] = bflo(raw[k][0]); v[1] = bfhi(raw[k][0]); v[2] = bflo(raw[k][1]); v[3] = bfhi(raw[k][1]);
    float ss = v[0] * v[0] + v[1] * v[1] + v[2] * v[2] + v[3] * v[3];
#pragma unroll
    for (int of = 32; of >= 1; of >>= 1) ss += __shfl_xor(ss, of);
    const float rstd = rsqrtf(ss * (1.f / 256.f) + EPS);
    v[0] *= rstd * g[0]; v[1] *= rstd * g[1]; v[2] *= rstd * g[2]; v[3] *= rstd * g[3];
    *(f32x4*)o = v;
  }
}

DI void ckv_fin(const P& p, int l, int tok) {
  const int lane = tidx() & 63;
  const int b = tok >> 8, t = tok & 255;
  float* o = p.out + O_CKV + (size_t)((b * 4 + l) * 256 + t) * 256 + lane * 4;
  u32x2 raw = *(const u32x2*)(p.proj() + (size_t)tok * NPROJ + 384 + lane * 4);
  f32x4 v; v[0] = bflo(raw[0]); v[1] = bfhi(raw[0]); v[2] = bflo(raw[1]); v[3] = bfhi(raw[1]);
  float ss = v[0] * v[0] + v[1] * v[1] + v[2] * v[2] + v[3] * v[3];
#pragma unroll
  for (int of = 32; of >= 1; of >>= 1) ss += __shfl_xor(ss, of);
  const float rstd = rsqrtf(ss * (1.f / 256.f) + EPS);
  f32x4 g = *(const f32x4*)(p.kv_norm + l * 256 + lane * 4);
  v[0] *= rstd * g[0]; v[1] *= rstd * g[1]; v[2] *= rstd * g[2]; v[3] *= rstd * g[3];
  *(f32x4*)o = v;
}

#define XB_TMO      128
#define XB_XCNT(j)  (256  + 64 * (j))
#define XB_XSUB(j)  (1280 + 64 * (j))
#define XB_XGEN(j)  (2304 + 64 * (j))
#define XB_TOP      3328
#define XB_TOPGEN   3392
#define XCD_BAR_WORDS 3456
#define XB_SPIN_CAP (1u << 18)
#define LAS __attribute__((address_space(3)))

__device__ __forceinline__ unsigned xb_ld(unsigned* p)              { return __hip_atomic_load(p, __ATOMIC_RELAXED, __HIP_MEMORY_SCOPE_AGENT); }
__device__ __forceinline__ unsigned xb_add(unsigned* p, unsigned v) { return __hip_atomic_fetch_add(p, v, __ATOMIC_RELAXED, __HIP_MEMORY_SCOPE_AGENT); }
__device__ __forceinline__ unsigned xb_xcc_id() { return (unsigned)__builtin_amdgcn_s_getreg((3 << 11) | 20) & 0xFu; }
#define XB_SPIN(cond, bar) do { unsigned _sp = 0; while (cond) { __builtin_amdgcn_s_sleep(1); \
    if ((++_sp & 255u) == 0u) { if (xb_ld(&(bar)[XB_TMO])) break; if (_sp > XB_SPIN_CAP) { atomicAdd(&(bar)[XB_TMO], 1u); break; } } } } while (0)

struct XcdBarrier {
    unsigned* bar; unsigned x;
    volatile LAS unsigned* st;
};

__device__ __forceinline__ XcdBarrier xcd_barrier_post(unsigned* bar, volatile LAS unsigned* st) {
    XcdBarrier b; b.bar = bar; b.x = xb_xcc_id(); b.st = st;
    if (tidx() == 0) (void)xb_add(&bar[XB_XCNT(b.x)], 1u);
    return b;
}
__device__ __forceinline__ void xcd_barrier_complete(unsigned* bar, unsigned x, unsigned& nloc, unsigned& nx) {
    const unsigned G = gridDim.x * gridDim.y * gridDim.z;
    unsigned sum, cnt, mine, sp = 0u;
    for (;;) {
        sum = 0u; cnt = 0u; mine = 0u;
#pragma unroll
        for (unsigned j = 0; j < 16; ++j) { const unsigned c = xb_ld(&bar[XB_XCNT(j)]); sum += c; cnt += (c > 0u) ? 1u : 0u; mine = (j == x) ? c : mine; }
        if (sum == G) break;
        __builtin_amdgcn_s_sleep(1);
        if ((++sp & 255u) == 0u) { if (xb_ld(&bar[XB_TMO])) break; if (sp > XB_SPIN_CAP) { atomicAdd(&bar[XB_TMO], 1u); break; } }
    }
    nloc = mine > 0u ? mine : 1u; nx = cnt > 0u ? cnt : 1u;
}

__device__ __forceinline__ void xcd_barrier(const XcdBarrier& b) {
    asm volatile("s_waitcnt vmcnt(0)" ::: "memory");
    __syncthreads();
    if (tidx() == 0) {
        unsigned* bar = b.bar;
        __builtin_amdgcn_s_waitcnt(0);
        unsigned nloc = b.st[0], nx = b.st[1];
        if (nloc == 0u) { xcd_barrier_complete(bar, b.x, nloc, nx); b.st[0] = nloc; b.st[1] = nx; }
        const unsigned old = xb_add(&bar[XB_XSUB(b.x)], 1u);
        const unsigned gen = old / nloc;
        if (old + 1u == (gen + 1u) * nloc) {
            __builtin_amdgcn_fence(__ATOMIC_RELEASE, "agent");
            asm volatile("s_waitcnt vmcnt(0)" ::: "memory");
            const unsigned og = xb_add(&bar[XB_TOP], 1u);
            const unsigned tg = og / nx;
            if (og + 1u == (tg + 1u) * nx) xb_add(&bar[XB_TOPGEN], 1u);
            else XB_SPIN(xb_ld(&bar[XB_TOPGEN]) == tg, bar);
            __builtin_amdgcn_fence(__ATOMIC_ACQUIRE, "agent");
            xb_add(&bar[XB_XGEN(b.x)], 1u);
            asm volatile("s_waitcnt vmcnt(0)" ::: "memory");
        } else {
            XB_SPIN(xb_ld(&bar[XB_XGEN(b.x)]) == gen, bar);
            __builtin_amdgcn_fence(__ATOMIC_ACQUIRE, "agent");
            asm volatile("s_waitcnt vmcnt(0)" ::: "memory");
        }
    }
    __syncthreads();
}


DI P launder(const P& p) {
  P q = p;
#define LND(m) { asm volatile("" : "+s"(q.m)); q.m = (decltype(q.m))(__attribute__((address_space(1))) void*)(void*)q.m; }
  LND(x_prompt) LND(x_sample) LND(c_ckv) LND(c_krope) LND(c_dk) LND(c_dv) LND(st_C) LND(st_n) LND(st_m) LND(c) LND(c_ctx)
  LND(g_norm) LND(W_mod) LND(b_mod) LND(W_in) LND(q_norm) LND(W_uq) LND(kv_norm) LND(W_ukv) LND(dlam) LND(dnorm) LND(mconv)
  LND(mgb) LND(mnorm) LND(W_out) LND(g_final) LND(out) LND(ws)
#undef LND
  return q;
}

template <int KIND>
DI void run_phase(const P& p0, int ph, char* smem) {
  const P& p = p0;
  const int G = gridDim.x, B = blockIdx.x, w = wave_of(tidx());
  if ((KIND < 0 || KIND == 0) && ph == 0) { phase_prepass(p, smem); return; }
  if ((KIND < 0 || KIND == 1) && ph == 1) {
    for (int it = B; it < 256 + 2048; it += G) {
      if (it < 256) {
        int mt = it >> 3, nt = it & 7;
        int l = (mt * 128) >> 10;
        f32x16 acc[2][2];
        gemm_core<false>(p.cckv() + (size_t)mt * 128 * 256, 256, p.WukvTp() + (size_t)l * 1024 * 256 + (size_t)nt * 128 * 256, 256, 256, smem, acc);
        epi_kv(p, mt * 128, nt * 128, acc, nullptr, true);
      } else {
        if (it - 256 < 512) norm_rows4(p, 0, (it - 256) * 16 + w * 4, 0);
      }
    }
    return;
  }
  const int l = (ph - 2) / 6, sub = (ph - 2) % 6;
  if ((KIND < 0 || KIND == 2) && sub == 0) {
    const int x = B & 7, j = B >> 3, per = G >> 3;
    const bf16* Ab = p.hbuf();
    const bf16* Wb = p.WinT() + (size_t)l * NPROJ * 1024;
    for (int q = j; q < 3 * 64; q += per) {
      const int r = q >> 6, jj = q & 63;
      const int st = r * 8 + x;
      const int mt = (st / 3) * 8 + (jj >> 3), nt = (st % 3) * 8 + (jj & 7);
      if (nt >= 23) continue;
      f32x16 acc[2][4];
      gemm_core_w(Ab + (size_t)mt * 128 * 1024, 1024, Wb + (size_t)nt * 256 * 1024, 1024, 1024, smem, acc);
      epi_inproj_w(p, l, mt * 128, nt * 256, acc, smem);
    }
  } else if ((KIND < 0 || KIND == 3) && sub == 1) {
    const int N_CH = 1024, N_QA = 64 * 3, N_KV = 64 * 4, N_CF = 512;
    const float* sRowW = (const float*)(smem + (128 + 256) * 72 * 2);
    for (int it = B; it < N_CH + N_QA + N_KV + N_CF; it += G) {
      int u = it;
      __syncthreads();
      if (u < N_CH) { mlstm_local(p, l, u, smem); continue; }
      u -= N_CH;
      if (u < N_QA) {
        int mt = u / 3, nt = u % 3;
        f32x16 acc[2][4];
        gemm_core_w<true>(p.proj() + (size_t)mt * 128 * NPROJ, NPROJ, p.WuqT() + (size_t)l * 768 * 384 + (size_t)nt * 256 * 384, 384, 384, smem, acc);
        epi_qa_w<0>(p, mt * 128, nt * 256, acc, sRowW);
        epi_qa_w<1>(p, mt * 128, nt * 256, acc, sRowW);
        continue;
      }
      u -= N_QA;
      if (u < N_KV) {
        int mt = u >> 2, nt = u & 3;
        f32x16 acc[2][4];
        gemm_core_w<true>(p.proj() + (size_t)mt * 128 * NPROJ + 384, NPROJ, p.WukvT() + (size_t)l * 1024 * 256 + (size_t)nt * 256 * 256, 256, 256, smem, acc);
        epi_kv_w<0>(p, mt * 128, nt * 256, acc, sRowW);
        epi_kv_w<1>(p, mt * 128, nt * 256, acc, sRowW);
        continue;
      }
      u -= N_KV;
      ckv_fin2(p, l, u * 8 + w * 2);
    }
  } else if ((KIND < 0 || KIND == 7) && sub == 2) {
    for (int it = B; it < 640; it += G) mlstm_scan(p, l, it);
  } else if ((KIND < 0 || KIND == 4) && sub == 3) {
    const int x = B & 7;
    int* qctr = p.qc() + ph * 8 + x;
    int* sslot = (int*)(smem + SMEM_BYTES - 16);
    const int nfirst = G >> 3;
    int q = B >> 3;
    for (;;) {
      if (q >= 192) break;
      __syncthreads();
      if (q < 32) { const int pr = 2 * x + (q >> 4); mla_item(p, l, pr * 16 + (q & 15), smem); }
      else if (q < 64) { const int u = q - 32; const int pr = 2 * x + (u >> 4); diff_item(p, l, pr * 16 + (u & 15), smem); }
      else if (q < 128) mlstm_out(p, l, x * 64 + (q - 64), smem);
      else if (q < 160) { const int u = q - 128; const int pr = 8 * x + (u >> 2); mla_item(p, l, 256 + pr * 4 + (u & 3), smem); }
      else { const int u = q - 160; const int pr = 8 * x + (u >> 2); diff_item(p, l, 256 + pr * 4 + (u & 3), smem); }
      __syncthreads();
      if (tidx() == 0) *sslot = nfirst + atomicAdd(qctr, 1);
      __syncthreads();
      q = *sslot;
    }
  } else if ((KIND < 0 || KIND == 5) && sub == 4) {
    const int x = B & 7, j = B >> 3, per = G >> 3;
    for (int q = j; q < 64; q += per) {
      const int mt = x * 8 + (q >> 3), nt = q & 7;
      f32x16 acc[2][2];
      gemm_core<false>(p.ycat() + (size_t)mt * 128 * 1536, 1536, p.WoutT() + (size_t)l * 1024 * 1536 + (size_t)nt * 128 * 1536, 1536, 1536, smem, acc);
      epi_out(p, l, mt * 128, nt * 128, acc);
    }
  } else if ((KIND < 0 || KIND == 6) && sub == 5) {
    for (int it = B; it < 2048; it += G) {
      if (it < 512) {
        if (l < 3) norm_rows4(p, l + 1, it * 16 + w * 4, 0);
        else norm_rows4(p, 0, it * 16 + w * 4, 1);
      }
    }
  }
}

#if COOP
__global__ void __launch_bounds__(256, 2) mega(P p, int lo, int hi, int coop) {
  __shared__ __attribute__((aligned(16))) char smem[SMEM_BYTES];
  __shared__ uint4 xb_words;
  if (threadIdx.x == 0) xb_words = make_uint4(0u, 0u, 0u, 0u);
  tidx_init();
  XcdBarrier xb = xcd_barrier_post((unsigned*)p.ctr(), (volatile LAS unsigned*)&xb_words);
  for (int ph = lo; ph < hi; ++ph) {
    run_phase<-1>(p, ph, smem);
    if (PROBE_DUP) {
      const int kind = ph < 2 ? ph : 2 + (ph - 2) % 6;
      if ((PROBE_DUP >> kind) & 1) { xcd_barrier(xb); run_phase<-1>(p, ph, smem); }
    }
    if (ph + 1 < hi) xcd_barrier(xb);
  }
  if (coop == 2) cg::this_grid().sync();
}
#endif
template <int KIND>
__global__ void __launch_bounds__(256) phase_k(P p, int ph) {
  __shared__ __attribute__((aligned(16))) char smem[SMEM_BYTES];
  tidx_init();
  run_phase<KIND>(p, ph, smem);
}

extern "C" void kernel_launch(void* const* d_in, const int* in_sizes, int n_in, void* d_out, int out_size, void* d_ws,
                              size_t ws_size, hipStream_t stream) {
  P p{};
  const float** ins = (const float**)&p;
  for (int i = 0; i < 26; ++i) ins[i] = (const float*)d_in[i];
  p.out = (float*)d_out;
  p.ws = (char*)d_ws;
  if (WS_TOTAL > ws_size) { fprintf(stderr, "workspace too small: need %zu have %zu\n", (size_t)WS_TOTAL, ws_size); return; }

#if COOP
  static int grid_blocks = 0;
  if (!grid_blocks) {
    int dev = 0, cus = 0, per_cu = 0;
    (void)hipGetDevice(&dev);
    (void)hipDeviceGetAttribute(&cus, hipDeviceAttributeMultiprocessorCount, dev);
    (void)hipOccupancyMaxActiveBlocksPerMultiprocessor(&per_cu, mega, 256, 0);
    if (per_cu > 2) per_cu = 2;
    grid_blocks = cus * per_cu;
  }
  (void)hipMemsetAsync(p.ws + OFF_ctr, 0, 16384 + 4096, stream);
  int lo = 0, hi = NPHASE, coop = 1;
  void* args[] = {&p, &lo, &hi, &coop};
  hipError_t e = hipLaunchCooperativeKernel((void*)mega, dim3(grid_blocks), dim3(256), args, 0, stream);
  if (e != hipSuccess) fprintf(stderr, "cooperative launch failed: %s (grid %d)\n", hipGetErrorString(e), grid_blocks);
#else
  for (int ph = 0; ph < NPHASE; ++ph) {
    static const int kmap[6] = {2, 3, 7, 4, 5, 6};
    int kind = ph < 2 ? ph : kmap[(ph - 2) % 6];
    switch (kind) {
      case 0: phase_k<0><<<512, 256, 0, stream>>>(p, ph); break;
      case 1: phase_k<1><<<512, 256, 0, stream>>>(p, ph); break;
      case 2: phase_k<2><<<512, 256, 0, stream>>>(p, ph); break;
      case 3: phase_k<3><<<512, 256, 0, stream>>>(p, ph); break;
      case 4: phase_k<4><<<512, 256, 0, stream>>>(p, ph); break;
      case 5: phase_k<5><<<512, 256, 0, stream>>>(p, ph); break;
      case 7: phase_k<7><<<512, 256, 0, stream>>>(p, ph); break;
      default: phase_k<6><<<512, 256, 0, stream>>>(p, ph); break;
    }
  }
#endif
}
```
